# Optimizing an MI355X kernel written in HIP

```python
import jax, jax.numpy as jnp
from jax import lax
import numpy as np

D_MODEL = 4096
BATCH = 1
SEQ = 8192
DEPTH = 2

MIX_WIDTH = D_MODEL
RET_WIDTH = MIX_WIDTH // 2
GLA_WIDTH = MIX_WIDTH - RET_WIDTH
RET_HEADS = 8
RET_DK = RET_WIDTH // RET_HEADS
RET_DV = RET_WIDTH // RET_HEADS
GLA_HEADS = 4
GLA_DV = GLA_WIDTH // GLA_HEADS
GLA_DK = GLA_DV // 2
GLA_KEY_WIDTH = GLA_HEADS * GLA_DK
GLA_GATE_RANK = 16
GLA_GATE_TAU = 16.0
_FFN_RAW = -(-8 * D_MODEL // 3)
FFN_HIDDEN = -(-_FFN_RAW // 256) * 256
RET_CHUNK = 128
GLA_CHUNK = 64
ROPE_BASE = 10000.0
EPS = 1e-6

IN_SPLITS = (RET_WIDTH, RET_WIDTH, RET_WIDTH, RET_WIDTH,
             GLA_KEY_WIDTH, GLA_KEY_WIDTH, GLA_WIDTH, GLA_WIDTH,
             GLA_GATE_RANK)
IN_WIDTH = sum(IN_SPLITS)

kernel_name = "hybrid_retention_gla_parallel_heads"


def rms_norm(x, gain):
    xf = x.astype(jnp.float32)
    y = xf * lax.rsqrt(jnp.mean(xf * xf, axis=-1, keepdims=True) + EPS)
    return (y * gain.astype(jnp.float32)).astype(x.dtype)


def apply_rotary(t, positions):
    half = t.shape[-1] // 2
    inv_freq = ROPE_BASE ** (-jnp.arange(half, dtype=jnp.float32) / half)
    ang = positions.astype(jnp.float32)[..., None] * inv_freq
    cos = jnp.cos(ang)[:, :, None, :]
    sin = jnp.sin(ang)[:, :, None, :]
    t1, t2 = t[..., :half], t[..., half:]
    return jnp.concatenate([t1 * cos - t2 * sin, t1 * sin + t2 * cos], axis=-1)


def to_chunks(t, c):
    b, s, h, d = t.shape
    return t.reshape(b, s // c, c, h, d).transpose(1, 0, 3, 2, 4)


def from_chunks(t):
    n, b, h, c, d = t.shape
    return t.transpose(1, 0, 3, 2, 4).reshape(b, n * c, h, d)


def retention_chunkwise(q, k, v):
    b, s, h, dk = q.shape
    dv = v.shape[-1]
    c = RET_CHUNK
    log_gamma = jnp.log1p(-jnp.exp2(-5.0 - jnp.arange(h, dtype=jnp.float32)))
    k = k * (dk ** -0.5)
    idx = jnp.arange(c, dtype=jnp.float32)
    diff = idx[:, None] - idx[None, :]
    decay = jnp.where(diff >= 0,
                      jnp.exp(log_gamma[:, None, None] * jnp.maximum(diff, 0.0)),
                      0.0)
    q_decay = jnp.exp(log_gamma[:, None] * (idx + 1.0))[None, :, :, None]
    k_decay = jnp.exp(log_gamma[:, None] * (c - 1.0 - idx))[None, :, :, None]
    chunk_decay = jnp.exp(log_gamma * c)[None, :, None, None]

    def step(state, inp):
        qb, kb, vb = inp
        scores = jnp.einsum('bhid,bhjd->bhij', qb, kb) * decay
        out = (jnp.einsum('bhij,bhjv->bhiv', scores, vb)
               + jnp.einsum('bhid,bhdv->bhiv', qb, state) * q_decay)
        state = state * chunk_decay + jnp.einsum('bhjd,bhjv->bhdv', kb * k_decay, vb)
        return state, out

    s0 = jnp.zeros((b, h, dk, dv), jnp.float32)
    _, o = lax.scan(step, s0, (to_chunks(q, c), to_chunks(k, c), to_chunks(v, c)))
    return from_chunks(o)


def gla_chunked(q, k, v, log_a):
    b, s, h, dk = q.shape
    dv = v.shape[-1]
    c = GLA_CHUNK
    q = q * (dk ** -0.5)
    causal = jnp.tril(jnp.ones((c, c), dtype=bool))[:, :, None]

    def step(state, inp):
        qb, kb, vb, ab = inp
        cum = jnp.cumsum(ab, axis=2)
        rel = cum[:, :, :, None, :] - cum[:, :, None, :, :]
        w = jnp.exp(jnp.where(causal, rel, -jnp.inf))
        attn = jnp.einsum('bhid,bhmd,bhimd->bhim', qb, kb, w)
        out = (jnp.einsum('bhim,bhmv->bhiv', attn, vb)
               + jnp.einsum('bhid,bhdv->bhiv', qb * jnp.exp(cum), state))
        last = cum[:, :, -1:, :]
        state = (state * jnp.exp(last)[:, :, 0, :, None]
                 + jnp.einsum('bhmd,bhmv->bhdv', kb * jnp.exp(last - cum), vb))
        return state, out

    s0 = jnp.zeros((b, h, dk, dv), jnp.float32)
    _, o = lax.scan(step, s0, (to_chunks(q, c), to_chunks(k, c),
                               to_chunks(v, c), to_chunks(log_a, c)))
    return from_chunks(o)


def head_group_norm(o, gain):
    mu = jnp.mean(o, axis=-1, keepdims=True)
    var = jnp.mean(jnp.square(o - mu), axis=-1, keepdims=True)
    y = (o - mu) * lax.rsqrt(var + EPS)
    return y.reshape(o.shape[0], o.shape[1], -1) * gain


def head_rms_norm(o, gain):
    y = o * lax.rsqrt(jnp.mean(o * o, axis=-1, keepdims=True) + EPS)
    return y.reshape(o.shape[0], o.shape[1], -1) * gain


def hybrid_mixer(h, positions, w_in, gla_w_up, gla_b, ret_gain, gla_gain, w_out):
    b, s, _ = h.shape
    proj = (h @ w_in).astype(jnp.float32)
    cuts = list(np.cumsum(IN_SPLITS)[:-1])
    rq, rk, rv, rg, gq, gk, gv, gg, ga = jnp.split(proj, cuts, axis=-1)

    rq = apply_rotary(rq.reshape(b, s, RET_HEADS, RET_DK), positions)
    rk = apply_rotary(rk.reshape(b, s, RET_HEADS, RET_DK), positions)
    rv = rv.reshape(b, s, RET_HEADS, RET_DV)
    r_out = retention_chunkwise(rq, rk, rv)
    r_out = jax.nn.silu(rg) * head_group_norm(r_out, ret_gain.astype(jnp.float32))

    gate_logits = ga @ gla_w_up.astype(jnp.float32) + gla_b.astype(jnp.float32)
    log_a = (jax.nn.log_sigmoid(gate_logits) / GLA_GATE_TAU).reshape(b, s, GLA_HEADS, GLA_DK)
    g_out = gla_chunked(gq.reshape(b, s, GLA_HEADS, GLA_DK),
                        gk.reshape(b, s, GLA_HEADS, GLA_DK),
                        gv.reshape(b, s, GLA_HEADS, GLA_DV), log_a)
    g_out = jax.nn.silu(gg) * head_rms_norm(g_out, gla_gain.astype(jnp.float32))

    mixed = jnp.concatenate([r_out, g_out], axis=-1).astype(h.dtype)
    return mixed @ w_out


def swiglu(h, w_gate, w_up, w_down):
    return (jax.nn.silu(h @ w_gate) * (h @ w_up)) @ w_down


def setup_inputs(seed: int = 0) -> dict:
    key = jax.random.key(seed)
    ks = jax.random.split(key, 14)
    f32 = jnp.float32
    x = jax.random.normal(ks[0], (BATCH, SEQ, D_MODEL), f32)
    positions = jnp.broadcast_to(jnp.arange(SEQ, dtype=jnp.int32), (BATCH, SEQ))
    mix_norm = 1.0 + 0.02 * jax.random.normal(ks[1], (DEPTH, D_MODEL), f32)
    w_in = jax.random.normal(ks[2], (DEPTH, D_MODEL, IN_WIDTH), f32) * D_MODEL ** -0.5
    gla_w_up = jax.random.normal(ks[3], (DEPTH, GLA_GATE_RANK, GLA_KEY_WIDTH), f32) * GLA_GATE_RANK ** -0.5
    gla_b = 0.1 * jax.random.normal(ks[4], (DEPTH, GLA_KEY_WIDTH), f32)
    ret_gain = 1.0 + 0.02 * jax.random.normal(ks[5], (DEPTH, RET_WIDTH), f32)
    gla_gain = 1.0 + 0.02 * jax.random.normal(ks[6], (DEPTH, GLA_WIDTH), f32)
    w_out = jax.random.normal(ks[7], (DEPTH, MIX_WIDTH, D_MODEL), f32) * MIX_WIDTH ** -0.5
    ffn_norm = 1.0 + 0.02 * jax.random.normal(ks[8], (DEPTH, D_MODEL), f32)
    w_gate = jax.random.normal(ks[9], (DEPTH, D_MODEL, FFN_HIDDEN), f32) * D_MODEL ** -0.5
    w_up = jax.random.normal(ks[10], (DEPTH, D_MODEL, FFN_HIDDEN), f32) * D_MODEL ** -0.5
    w_down = jax.random.normal(ks[11], (DEPTH, FFN_HIDDEN, D_MODEL), f32) * FFN_HIDDEN ** -0.5
    final_norm = 1.0 + 0.02 * jax.random.normal(ks[12], (D_MODEL,), f32)
    return {"x": x, "positions": positions, "mix_norm": mix_norm, "w_in": w_in,
            "gla_w_up": gla_w_up, "gla_b": gla_b, "ret_gain": ret_gain,
            "gla_gain": gla_gain, "w_out": w_out, "ffn_norm": ffn_norm,
            "w_gate": w_gate, "w_up": w_up, "w_down": w_down,
            "final_norm": final_norm}


def reference(x, positions, mix_norm, w_in, gla_w_up, gla_b, ret_gain, gla_gain,
              w_out, ffn_norm, w_gate, w_up, w_down, final_norm):
    for l in range(DEPTH):
        h = rms_norm(x, mix_norm[l])
        x = x + hybrid_mixer(h, positions, w_in[l], gla_w_up[l], gla_b[l],
                             ret_gain[l], gla_gain[l], w_out[l])
        h = rms_norm(x, ffn_norm[l])
        x = x + swiglu(h, w_gate[l], w_up[l], w_down[l])
    return rms_norm(x, final_norm)
```

```cpp
#include <hip/hip_runtime.h>
#include <cstdio>
#include <cstdint>

namespace nv {
constexpr int T_ = 8192, D_ = 4096, INW = 14352, FF_ = 11008;
constexpr int O_RQ = 0, O_RK = 2048, O_RV = 4096, O_RG = 6144, O_GQ = 8192, O_GK = 9216, O_GV = 10240, O_GG = 12288, O_GA = 14336;

__global__ __launch_bounds__(256) void k_rmsnorm(const float* __restrict__ x, const float* __restrict__ g, float* __restrict__ out) {
    const int row = blockIdx.x; const float* xr = x + (size_t)row * D_;
    float s = 0.f;
    for (int i = threadIdx.x; i < D_; i += 256) { const float v = xr[i]; s += v * v; }
    __shared__ float red[4];
    for (int o = 32; o > 0; o >>= 1) s += __shfl_xor(s, o);
    if ((threadIdx.x & 63) == 0) red[threadIdx.x >> 6] = s;
    __syncthreads();
    s = red[0] + red[1] + red[2] + red[3];
    const float r = 1.0f / sqrtf(s / (float)D_ + 1e-6f);
    for (int i = threadIdx.x; i < D_; i += 256) out[(size_t)row * D_ + i] = xr[i] * r * g[i];
}

template <int EPI>
__global__ __launch_bounds__(256) void k_sgemm(const float* __restrict__ A, const float* __restrict__ B, float* __restrict__ C, const float* __restrict__ R, int M, int N, int K) {
    __shared__ float As[16][132];
    __shared__ float Bs[16][132];
    const int bm = blockIdx.y * 128, bn = blockIdx.x * 128;
    const int tid = threadIdx.x, tx = tid & 15, ty = tid >> 4;
    float acc[8][8];
#pragma unroll
    for (int i = 0; i < 8; ++i)
#pragma unroll
        for (int j = 0; j < 8; ++j) acc[i][j] = 0.f;
    for (int k0 = 0; k0 < K; k0 += 16) {
#pragma unroll
        for (int i = 0; i < 2; ++i) {
            const int idx = tid + i * 256, r = idx >> 2, c4 = (idx & 3) * 4;
            const float4 v = *(const float4*)&A[(size_t)(bm + r) * K + k0 + c4];
            As[c4 + 0][r] = v.x; As[c4 + 1][r] = v.y; As[c4 + 2][r] = v.z; As[c4 + 3][r] = v.w;
        }
#pragma unroll
        for (int i = 0; i < 2; ++i) {
            const int idx = tid + i * 256, kr = idx >> 5, c4 = (idx & 31) * 4;
            float4 v = make_float4(0.f, 0.f, 0.f, 0.f);
            if (bn + c4 < N) v = *(const float4*)&B[(size_t)(k0 + kr) * N + bn + c4];
            *(float4*)&Bs[kr][c4] = v;
        }
        __syncthreads();
#pragma unroll
        for (int kk = 0; kk < 16; ++kk) {
            float a[8], b[8];
            const float4 a0 = *(const float4*)&As[kk][ty * 8], a1 = *(const float4*)&As[kk][ty * 8 + 4];
            const float4 b0 = *(const float4*)&Bs[kk][tx * 8], b1 = *(const float4*)&Bs[kk][tx * 8 + 4];
            a[0] = a0.x; a[1] = a0.y; a[2] = a0.z; a[3] = a0.w; a[4] = a1.x; a[5] = a1.y; a[6] = a1.z; a[7] = a1.w;
            b[0] = b0.x; b[1] = b0.y; b[2] = b0.z; b[3] = b0.w; b[4] = b1.x; b[5] = b1.y; b[6] = b1.z; b[7] = b1.w;
#pragma unroll
            for (int i = 0; i < 8; ++i)
#pragma unroll
                for (int j = 0; j < 8; ++j) acc[i][j] = fmaf(a[i], b[j], acc[i][j]);
        }
        __syncthreads();
    }
#pragma unroll
    for (int i = 0; i < 8; ++i) {
        const int r = bm + ty * 8 + i;
#pragma unroll
        for (int j4 = 0; j4 < 2; ++j4) {
            const int c = bn + tx * 8 + j4 * 4;
            if (c < N) {
                float4 v = make_float4(acc[i][j4 * 4 + 0], acc[i][j4 * 4 + 1], acc[i][j4 * 4 + 2], acc[i][j4 * 4 + 3]);
                if (EPI == 1) { const float4 rr = *(const float4*)&R[(size_t)r * N + c]; v.x += rr.x; v.y += rr.y; v.z += rr.z; v.w += rr.w; }
                if (EPI == 2) { const float4 gg = *(const float4*)&C[(size_t)r * N + c]; v.x *= gg.x / (1.0f + __expf(-gg.x)); v.y *= gg.y / (1.0f + __expf(-gg.y)); v.z *= gg.z / (1.0f + __expf(-gg.z)); v.w *= gg.w / (1.0f + __expf(-gg.w)); }
                *(float4*)&C[(size_t)r * N + c] = v;
            }
        }
    }
}

__device__ __forceinline__ float siluf(float x) { return x / (1.0f + __expf(-x)); }

__global__ __launch_bounds__(256) void k_rotary(float* __restrict__ proj, const int* __restrict__ pos) {
    const size_t gid = (size_t)blockIdx.x * 256 + threadIdx.x;
    const int i = (int)(gid & 127), h = (int)((gid >> 7) & 7), w = (int)((gid >> 10) & 1); const int t = (int)(gid >> 11);
    if (t >= T_) return;
    const float inv_freq = powf(10000.0f, -(float)i / 128.0f);
    const float ang = (float)pos[t] * inv_freq;
    const double rev = (double)ang * 0.15915494309189533577;
    const float fr = (float)(rev - floor(rev));
    const float c = __builtin_amdgcn_cosf(fr), s = __builtin_amdgcn_sinf(fr);
    float* p = proj + (size_t)t * INW + (w ? O_RK : O_RQ) + h * 256 + i;
    const float t1 = p[0], t2 = p[128];
    p[0] = t1 * c - t2 * s; p[128] = t1 * s + t2 * c;
}

__global__ __launch_bounds__(256) void k_gate(const float* __restrict__ proj, const float* __restrict__ wup, const float* __restrict__ b, float* __restrict__ loga) {
    const int t = blockIdx.x;
    const float* ga = proj + (size_t)t * INW + O_GA;
    for (int c = threadIdx.x; c < 1024; c += 256) {
        float z = b[c];
#pragma unroll
        for (int r = 0; r < 16; ++r) z = fmaf(ga[r], wup[r * 1024 + c], z);
        const float ls = fminf(z, 0.f) - log1pf(expf(-fabsf(z)));
        loga[(size_t)t * 1024 + c] = ls * (1.0f / 16.0f);
    }
}

template <int GLA>
__global__ __launch_bounds__(256) void k_recur(const float* __restrict__ proj, int qoff, int koff, int voff, int dv, const float* __restrict__ loga, float qs, float ks, float* __restrict__ out, int ostride) {
    const int vt = blockIdx.x, h = blockIdx.y, d = threadIdx.x, lane = d & 63, wave = d >> 6;
    float S[16];
#pragma unroll
    for (int j = 0; j < 16; ++j) S[j] = 0.f;
    const float gamma = 1.0f - exp2f(-5.0f - (float)h);
    __shared__ float part[2][4][16];
    for (int t = 0; t < T_; ++t) {
        const float* row = proj + (size_t)t * INW;
        const float q = row[qoff + h * 256 + d] * qs, k = row[koff + h * 256 + d] * ks;
        const float a = GLA ? expf(loga[(size_t)t * 1024 + h * 256 + d]) : gamma;
        float p[16];
#pragma unroll
        for (int j4 = 0; j4 < 4; ++j4) {
            const float4 v = *(const float4*)&row[voff + h * dv + vt * 16 + j4 * 4];
            S[j4 * 4 + 0] = a * S[j4 * 4 + 0] + k * v.x; S[j4 * 4 + 1] = a * S[j4 * 4 + 1] + k * v.y;
            S[j4 * 4 + 2] = a * S[j4 * 4 + 2] + k * v.z; S[j4 * 4 + 3] = a * S[j4 * 4 + 3] + k * v.w;
        }
#pragma unroll
        for (int j = 0; j < 16; ++j) p[j] = q * S[j];
#pragma unroll
        for (int j = 0; j < 16; ++j)
#pragma unroll
            for (int o = 32; o > 0; o >>= 1) p[j] += __shfl_xor(p[j], o);
        if (lane == 0) {
#pragma unroll
            for (int j = 0; j < 16; ++j) part[t & 1][wave][j] = p[j];
        }
        __syncthreads();
        if (d < 16) out[(size_t)t * ostride + h * dv + vt * 16 + d] = part[t & 1][0][d] + part[t & 1][1][d] + part[t & 1][2][d] + part[t & 1][3][d];
    }
}

__global__ __launch_bounds__(256) void k_headnorm(const float* __restrict__ proj, const float* __restrict__ ro, const float* __restrict__ go, const float* __restrict__ rgain, const float* __restrict__ ggain, float* __restrict__ mixed) {
    const int t = blockIdx.x, tid = threadIdx.x, lane = tid & 63, wave = tid >> 6;
    const float* row = proj + (size_t)t * INW;
    for (int hh = 0; hh < 2; ++hh) {
        const int h = wave * 2 + hh;
        float v[4]; float s = 0.f;
#pragma unroll
        for (int j = 0; j < 4; ++j) { v[j] = ro[(size_t)t * 2048 + h * 256 + lane + 64 * j]; s += v[j]; }
        for (int o = 32; o > 0; o >>= 1) s += __shfl_xor(s, o);
        const float mu = s / 256.f; float q = 0.f;
#pragma unroll
        for (int j = 0; j < 4; ++j) { v[j] -= mu; q += v[j] * v[j]; }
        for (int o = 32; o > 0; o >>= 1) q += __shfl_xor(q, o);
        const float rs = 1.0f / sqrtf(q / 256.f + 1e-6f);
#pragma unroll
        for (int j = 0; j < 4; ++j) { const int c = h * 256 + lane + 64 * j; mixed[(size_t)t * D_ + c] = siluf(row[O_RG + c]) * (v[j] * rs * rgain[c]); }
    }
    {
        const int h = wave;
        float v[8]; float q = 0.f;
#pragma unroll
        for (int j = 0; j < 8; ++j) { v[j] = go[(size_t)t * 2048 + h * 512 + lane + 64 * j]; q += v[j] * v[j]; }
        for (int o = 32; o > 0; o >>= 1) q += __shfl_xor(q, o);
        const float rs = 1.0f / sqrtf(q / 512.f + 1e-6f);
#pragma unroll
        for (int j = 0; j < 8; ++j) { const int c = h * 512 + lane + 64 * j; mixed[(size_t)t * D_ + 2048 + c] = siluf(row[O_GG + c]) * (v[j] * rs * ggain[c]); }
    }
}

__global__ __launch_bounds__(256) void k_swiglu(float* __restrict__ G, const float* __restrict__ U, size_t n4) {
    for (size_t i = (size_t)blockIdx.x * 256 + threadIdx.x; i < n4; i += (size_t)gridDim.x * 256) {
        float4 g = ((float4*)G)[i]; const float4 u = ((const float4*)U)[i];
        g.x = siluf(g.x) * u.x; g.y = siluf(g.y) * u.y; g.z = siluf(g.z) * u.z; g.w = siluf(g.w) * u.w;
        ((float4*)G)[i] = g;
    }
}

inline void forward(void* const* d_in, float* out, float* ws, size_t ws_size, hipStream_t st) {
    const float* x = (const float*)d_in[0]; const int* pos = (const int*)d_in[1];
    const float* mix_norm = (const float*)d_in[2]; const float* w_in = (const float*)d_in[3];
    const float* gla_w_up = (const float*)d_in[4]; const float* gla_b = (const float*)d_in[5];
    const float* ret_gain = (const float*)d_in[6]; const float* gla_gain = (const float*)d_in[7];
    const float* w_out = (const float*)d_in[8]; const float* ffn_norm = (const float*)d_in[9];
    const float* w_gate = (const float*)d_in[10]; const float* w_up = (const float*)d_in[11]; const float* w_down = (const float*)d_in[12];
    const float* final_norm = (const float*)d_in[13];
    size_t o = 0;
    float* xn = ws + o; o += (size_t)T_ * D_;
    float* proj = ws + o; o += (size_t)T_ * INW;
    float* loga = ws + o; o += (size_t)T_ * 1024;
    float* ro = ws + o; o += (size_t)T_ * 2048;
    float* go = ws + o; o += (size_t)T_ * 2048;
    float* mixed = ws + o; o += (size_t)T_ * D_;
    float* xa = ws + o; o += (size_t)T_ * D_;
    float* xb = ws + o; o += (size_t)T_ * D_;
    float* G = ws + o; o += (size_t)T_ * FF_;
    if (o * 4 > ws_size) { fprintf(stderr, "naive: ws too small: need %zu have %zu\n", o * 4, ws_size); return; }
    const float* xc = x;
    for (int l = 0; l < 2; ++l) {
        k_rmsnorm<<<T_, 256, 0, st>>>(xc, mix_norm + (size_t)l * D_, xn);
        k_sgemm<0><<<dim3((INW + 127) / 128, T_ / 128), 256, 0, st>>>(xn, w_in + (size_t)l * D_ * INW, proj, nullptr, T_, INW, D_);
        k_rotary<<<(T_ * 2048) / 256, 256, 0, st>>>(proj, pos);
        k_gate<<<T_, 256, 0, st>>>(proj, gla_w_up + (size_t)l * 16 * 1024, gla_b + (size_t)l * 1024, loga);
        k_recur<0><<<dim3(16, 8), 256, 0, st>>>(proj, O_RQ, O_RK, O_RV, 256, nullptr, 1.0f, 1.0f / 16.0f, ro, 2048);
        k_recur<1><<<dim3(32, 4), 256, 0, st>>>(proj, O_GQ, O_GK, O_GV, 512, loga, 1.0f / 16.0f, 1.0f, go, 2048);
        k_headnorm<<<T_, 256, 0, st>>>(proj, ro, go, ret_gain + (size_t)l * 2048, gla_gain + (size_t)l * 2048, mixed);
        k_sgemm<1><<<dim3(D_ / 128, T_ / 128), 256, 0, st>>>(mixed, w_out + (size_t)l * D_ * D_, xa, xc, T_, D_, D_);
        k_rmsnorm<<<T_, 256, 0, st>>>(xa, ffn_norm + (size_t)l * D_, xn);
        k_sgemm<0><<<dim3(FF_ / 128, T_ / 128), 256, 0, st>>>(xn, w_gate + (size_t)l * D_ * FF_, G, nullptr, T_, FF_, D_);
        k_sgemm<2><<<dim3(FF_ / 128, T_ / 128), 256, 0, st>>>(xn, w_up + (size_t)l * D_ * FF_, G, nullptr, T_, FF_, D_);
        k_sgemm<1><<<dim3(D_ / 128, T_ / 128), 256, 0, st>>>(G, w_down + (size_t)l * FF_ * D_, xb, xa, T_, D_, FF_);
        xc = xb;
    }
    k_rmsnorm<<<T_, 256, 0, st>>>(xc, final_norm, out);
}
}

extern "C" void kernel_launch(void* const* d_in, const int* in_sizes, int n_in, void* d_out, int out_size, void* d_ws, size_t ws_size, hipStream_t stream) {
    nv::forward(d_in, (float*)d_out, (float*)d_ws, ws_size, stream);
}
```

```cpp
#include <hip/hip_runtime.h>
#include <cstdio>
#include <cstdint>
#include <cstring>
#define MK_DEBUG 0
#define MK_SPLIT 1
#define MK_DBG_ONELAUNCH 0
namespace pg8 {
#define PG8_LAS __attribute__((address_space(3)))
typedef unsigned short bf16_t;
typedef short bf16x8 __attribute__((ext_vector_type(8)));
typedef float f32x4 __attribute__((ext_vector_type(4)));
typedef unsigned u32x4 __attribute__((ext_vector_type(4)));
constexpr int BM = 256, BK = 64, HALF = 128, HTB = HALF * BK * 2  , STAGE_BYTES = 8 * HTB, NXCD = 8, WGM = 8;

__host__ __device__ __forceinline__ int lds_byte(int r, int c) { const int st = (r >> 4) * 2 + (c >> 5), rr = r & 15, cc = c & 31, ob = rr * 64 + cc * 2; return st * 1024 + (ob ^ (((ob >> 9) & 1) << 5)); }
__host__ __device__ __forceinline__ void stage_rc(int b, int& R, int& C) { const int st = b / 1024, sb = b % 1024, swz = sb ^ (((sb >> 9) & 1) << 5); R = (st >> 1) * 16 + swz / 64; C = (st & 1) * 32 + (swz % 64) / 2; }
__host__ __device__ __forceinline__ int perm32(int rho) { const int n = rho >> 4, i = rho & 15; return 8 * (i >> 2) + 4 * n + (i & 3); }

struct Unit { int pm, pn, sw; };
struct Gemm { const bf16_t* A; const bf16_t* Bt; int K; };

struct StaticOrder {
    int nM, nN, nwg, G, c;
    __host__ __device__ void init(int nM_, int nN_, int G_, int c_) { nM = nM_; nN = nN_; nwg = nM * nN; G = G_; c = c_; }
    __host__ __device__ bool next(int i, Unit& u) const {
        const long L = (long)i * G + c; if (L >= nwg) return false;
        int wgid = (int)L; { const int q = nwg / NXCD, r = nwg % NXCD, xcd = wgid % NXCD, off = wgid / NXCD; wgid = (xcd < r ? xcd * (q + 1) : r * (q + 1) + (xcd - r) * q) + off; }
        const int nig = WGM * nN, gid = wgid / nig, fm = gid * WGM, gsz = (nM - fm) < WGM ? (nM - fm) : WGM;
        u.pm = fm + ((wgid % nig) % gsz); u.pn = (wgid % nig) / gsz; u.sw = 0; return true;
    }
    __device__ __forceinline__ void a_ready(const Unit&) const {}
    __device__ __forceinline__ void done(const Unit&) const {}
};


typedef __bf16 bf16x2v __attribute__((ext_vector_type(2)));
__device__ __forceinline__ unsigned cvt_pk_bf16(float lo, float hi) { bf16x2v v; v[0] = (__bf16)lo; v[1] = (__bf16)hi; return __builtin_bit_cast(unsigned, v); }
__device__ __forceinline__ u32x4 pack8(const f32x4 a, const f32x4 b) { u32x4 w; w.x = cvt_pk_bf16(a[0], a[1]); w.y = cvt_pk_bf16(a[2], a[3]); w.z = cvt_pk_bf16(b[0], b[1]); w.w = cvt_pk_bf16(b[2], b[3]); return w; }
__device__ __forceinline__ float rs_of(float ss) { return 1.0f / sqrtf(ss * (1.0f / 4096.0f) + 1e-6f); }
__device__ __forceinline__ f32x4 silu4(const f32x4 v) { f32x4 o; o[0] = v[0] / (1.0f + __expf(-v[0])); o[1] = v[1] / (1.0f + __expf(-v[1])); o[2] = v[2] / (1.0f + __expf(-v[2])); o[3] = v[3] / (1.0f + __expf(-v[3])); return o; }

constexpr int TT = 8192;

struct EpiProj {
    static constexpr bool PERM = true, AFTER_DRAIN = false;
    const float* ss;
    const float* rot;
    bf16_t *qr, *kr, *vrt, *srg, *gq, *gk, *vgt, *sgg;
    __device__ __forceinline__ void operator()(const f32x4 (&acc)[2][2][4][2], const Unit& u, int wr, int wc, int fr, int fq) const {
        const int pn = u.pn;
        if (u.sw) {
            bf16_t* dst = (pn < 24) ? vrt + (size_t)(pn - 16) * 256 * TT : vgt + (size_t)(pn - 40) * 256 * TT;
            const int tc0 = u.pm * BM + wc * 32 + 8 * fq;
            f32x4 rs[2][2];
#pragma unroll
            for (int bj = 0; bj < 2; ++bj)
#pragma unroll
                for (int n = 0; n < 2; ++n) { const f32x4 s = *(const f32x4*)(ss + tc0 + bj * HALF + 4 * n); rs[bj][n] = (f32x4){rs_of(s[0]), rs_of(s[1]), rs_of(s[2]), rs_of(s[3])}; }
#pragma unroll
            for (int ai = 0; ai < 2; ++ai)
#pragma unroll
                for (int m = 0; m < 4; ++m) { bf16_t* rowp = dst + (size_t)(ai * HALF + wr * 64 + m * 16 + fr) * TT + tc0;
#pragma unroll
                    for (int bj = 0; bj < 2; ++bj) *(u32x4*)(rowp + bj * HALF) = pack8(acc[ai][bj][m][0] * rs[bj][0], acc[ai][bj][m][1] * rs[bj][1]); }
            return;
        }
        const int t0 = u.pm * BM + wr * 64 + fr;
        const int cl = wc * 32 + 8 * fq;
        if (pn < 16) {
            const int h = pn & 7; const bool isk = pn >= 8; bf16_t* dst = (isk ? kr : qr) + h * 256;
            const float lg = log2f(1.0f - exp2f(-5.0f - (float)h));
#pragma unroll
            for (int ai = 0; ai < 2; ++ai)
#pragma unroll
                for (int m = 0; m < 4; ++m) { const int t = t0 + ai * HALF + m * 16; const float ip1 = (float)((t & 127) + 1);
                    const float sc = rs_of(ss[t]) * (isk ? exp2f(-ip1 * lg) * 0.0625f : exp2f(ip1 * lg));
                    f32x4 o1[2], o2[2];
#pragma unroll
                    for (int n = 0; n < 2; ++n) { const f32x4 c4 = *(const f32x4*)(rot + (size_t)t * 128 + cl + 4 * n), s4 = *(const f32x4*)(rot + (size_t)TT * 128 + (size_t)t * 128 + cl + 4 * n);
                        const f32x4 a = acc[ai][0][m][n], b = acc[ai][1][m][n]; o1[n] = (a * c4 - b * s4) * sc; o2[n] = (a * s4 + b * c4) * sc; }
                    bf16_t* rowp = dst + (size_t)t * 2048 + cl;
                    *(u32x4*)(rowp) = pack8(o1[0], o1[1]); *(u32x4*)(rowp + HALF) = pack8(o2[0], o2[1]); }
            return;
        }
        bf16_t* dst; int ld; float sc = 1.0f; bool act = false;
        if (pn < 32) { dst = srg + (pn - 24) * 256; ld = 2048; act = true; }
        else if (pn < 36) { dst = gq + (pn - 32) * 256; ld = 1024; sc = 0.0625f; }
        else if (pn < 40) { dst = gk + (pn - 36) * 256; ld = 1024; }
        else { dst = sgg + (pn - 48) * 256; ld = 2048; act = true; }
#pragma unroll
        for (int ai = 0; ai < 2; ++ai)
#pragma unroll
            for (int m = 0; m < 4; ++m) { const int t = t0 + ai * HALF + m * 16; const float s = rs_of(ss[t]) * sc; bf16_t* rowp = dst + (size_t)t * ld + cl;
#pragma unroll
                for (int bj = 0; bj < 2; ++bj) { f32x4 v0 = acc[ai][bj][m][0] * s, v1 = acc[ai][bj][m][1] * s; if (act) { v0 = silu4(v0); v1 = silu4(v1); }
                    *(u32x4*)(rowp + bj * HALF) = pack8(v0, v1); } }
    }
};

struct EpiRes {
    static constexpr bool PERM = true, AFTER_DRAIN = false;
    const float* xin; float* xout; bf16_t* xb; float* ssout;
    __device__ __forceinline__ void operator()(const f32x4 (&acc)[2][2][4][2], const Unit& u, int wr, int wc, int fr, int fq) const {
        const int t0 = u.pm * BM + wr * 64 + fr, c0 = u.pn * BM + wc * 32 + 8 * fq;
#pragma unroll
        for (int ai = 0; ai < 2; ++ai)
#pragma unroll
            for (int m = 0; m < 4; ++m) { const int t = t0 + ai * HALF + m * 16; const size_t off = (size_t)t * 4096 + c0; float sq = 0.f;
#pragma unroll
                for (int bj = 0; bj < 2; ++bj) { f32x4 o[2];
#pragma unroll
                    for (int n = 0; n < 2; ++n) { const f32x4 xi = *(const f32x4*)(xin + off + bj * HALF + 4 * n); o[n] = xi + acc[ai][bj][m][n];
                        *(f32x4*)(xout + off + bj * HALF + 4 * n) = o[n]; sq += (o[n][0] * o[n][0] + o[n][1] * o[n][1]) + (o[n][2] * o[n][2] + o[n][3] * o[n][3]); }
                    *(u32x4*)(xb + off + bj * HALF) = pack8(o[0], o[1]); }
                sq += __shfl_xor(sq, 16); sq += __shfl_xor(sq, 32);
                if (fq == 0) atomicAdd(ssout + t, sq); }
    }
};

struct EpiSwiGLU {
    static constexpr bool PERM = true, AFTER_DRAIN = false;
    const float* ss; bf16_t* h;
    __device__ __forceinline__ void operator()(const f32x4 (&acc)[2][2][4][2], const Unit& u, int wr, int wc, int fr, int fq) const {
        const int t0 = u.pm * BM + wr * 64 + fr, c0 = u.pn * HALF + wc * 32 + 8 * fq;
#pragma unroll
        for (int ai = 0; ai < 2; ++ai)
#pragma unroll
            for (int m = 0; m < 4; ++m) { const int t = t0 + ai * HALF + m * 16; const float s = rs_of(ss[t]); f32x4 o[2];
#pragma unroll
                for (int n = 0; n < 2; ++n) { const f32x4 g = silu4(acc[ai][0][m][n] * s), uu = acc[ai][1][m][n] * s; o[n] = g * uu; }
                *(u32x4*)(h + (size_t)t * 11008 + c0) = pack8(o[0], o[1]); }
    }
};
struct ProjOrder : StaticOrder {
    __host__ __device__ bool next(int i, Unit& u) const { if (!StaticOrder::next(i, u)) return false; u.sw = ((u.pn >= 16 && u.pn < 24) || (u.pn >= 40 && u.pn < 48)) ? 1 : 0; return true; }
};
template <class Epi, class Sched, bool ALIGN_EPI = false, bool SP2 = false>
__device__ __forceinline__ void gemm_phase(PG8_LAS unsigned char* lds, const Gemm g, const Sched& S, const Epi& E) {
    int tid = threadIdx.x; asm volatile("" : "+v"(tid));
    const int wid = __builtin_amdgcn_readfirstlane(tid >> 6), lane = tid & 63, wr = wid >> 2, wc = wid & 3, fr = lane & 15, fq = lane >> 4;
    const int K = g.K, nt = K / BK;
    unsigned voffA[2], voffB[2];
#pragma unroll
    for (int i = 0; i < 2; ++i) { int R, C; stage_rc(tid * 16 + i * 8192, R, C); const int Rb = Epi::PERM ? ((R & ~31) + perm32(R & 31)) : R;
        voffA[i] = (unsigned)(R * K + C) * 2u; voffB[i] = (unsigned)(Rb * K + C) * 2u; }
    const size_t kstep = (size_t)(BK * 2);
    const size_t hstep = (size_t)HALF * K * 2;
    const size_t tstep = 2 * hstep;
    const unsigned ldsw = (unsigned)wid * 1024u;
    const int aoff = lds_byte(wr * 64 + fr, fq * 8), boff = lds_byte(wc * 32 + fr, fq * 8);
#define PG8_SA(b, h) (((b) * 2 + (h)) * HTB)
#define PG8_SB(b, h) ((4 + (b) * 2 + (h)) * HTB)
#define PG8_STAGE(bufoff, gbase, voff) do { _Pragma("unroll") for (int _i = 0; _i < 2; ++_i) \
        __builtin_amdgcn_global_load_lds((const unsigned*)((const char*)(gbase) + (voff)[_i]), (PG8_LAS unsigned*)(lds + (bufoff) + ldsw + _i * 8192), 16, 0, 0); } while (0)
#define PG8_LDA(dst, b, h) do { _Pragma("unroll") for (int m = 0; m < 4; ++m) _Pragma("unroll") for (int k = 0; k < 2; ++k) dst[m][k] = *(const PG8_LAS bf16x8*)(lds + PG8_SA(b, h) + aoff + m * 2048 + k * 1024); } while (0)
#define PG8_LDB(dst, b, h) do { _Pragma("unroll") for (int n = 0; n < 2; ++n) _Pragma("unroll") for (int k = 0; k < 2; ++k) dst[n][k] = *(const PG8_LAS bf16x8*)(lds + PG8_SB(b, h) + boff + n * 2048 + k * 1024); } while (0)
#define PG8_MMA(ai, bj, At, Bt) do { __builtin_amdgcn_s_setprio(1); _Pragma("unroll") for (int m = 0; m < 4; ++m) _Pragma("unroll") for (int n = 0; n < 2; ++n) _Pragma("unroll") for (int k = 0; k < 2; ++k) \
        acc[ai][bj][m][n] = __builtin_amdgcn_mfma_f32_16x16x32_bf16(Bt[n][k], At[m][k], acc[ai][bj][m][n], 0, 0, 0); __builtin_amdgcn_s_setprio(0); } while (0)
#define PG8_WAIT_V(n) asm volatile("s_waitcnt vmcnt(" #n ")" ::: "memory")
#define PG8_WAIT_L(n) asm volatile("s_waitcnt lgkmcnt(" #n ")" ::: "memory")
#define PG8_BAR __builtin_amdgcn_s_barrier()
#define PG8_SCHED __builtin_amdgcn_sched_barrier(0)
    Unit cur, nxt; int ui = 0;
    if (!S.next(0, cur)) return;
    f32x4 acc[2][2][4][2];
#pragma unroll
    for (int a = 0; a < 2; ++a)
#pragma unroll
        for (int b = 0; b < 2; ++b)
#pragma unroll
            for (int m = 0; m < 4; ++m)
#pragma unroll
                for (int n = 0; n < 2; ++n) acc[a][b][m][n] = (f32x4){0.f, 0.f, 0.f, 0.f};
    bf16x8 At[4][2], B0[2][2], B1[2][2];
    const char* cA = cur.sw ? (const char*)g.Bt + (size_t)cur.pn * tstep : (const char*)g.A + (size_t)cur.pm * tstep; const char* cB = cur.sw ? (const char*)g.A + (size_t)cur.pm * tstep : (const char*)g.Bt + (size_t)cur.pn * tstep;
    S.a_ready(cur);
    if constexpr (SP2) {
        PG8_STAGE(PG8_SB(0, 0), cB, voffB); PG8_STAGE(PG8_SB(0, 1), cB + hstep, voffB); PG8_STAGE(PG8_SA(0, 0), cA, voffA); PG8_STAGE(PG8_SA(0, 1), cA + hstep, voffA);
        if (wr == 1) PG8_BAR;
        PG8_WAIT_V(2); PG8_BAR;
        PG8_STAGE(PG8_SB(1, 0), cB + kstep, voffB); PG8_STAGE(PG8_SA(1, 0), cA + kstep, voffA); PG8_STAGE(PG8_SB(1, 1), cB + hstep + kstep, voffB);
        PG8_WAIT_V(6); PG8_BAR;
    } else {
        PG8_STAGE(PG8_SB(0, 0), cB, voffB); PG8_STAGE(PG8_SA(0, 0), cA, voffA); PG8_STAGE(PG8_SB(0, 1), cB + hstep, voffB); PG8_STAGE(PG8_SA(0, 1), cA + hstep, voffA);
        if (wr == 1) PG8_BAR;
        PG8_WAIT_V(4); PG8_BAR;
        PG8_STAGE(PG8_SB(1, 0), cB + kstep, voffB); PG8_STAGE(PG8_SA(1, 0), cA + kstep, voffA); PG8_STAGE(PG8_SB(1, 1), cB + hstep + kstep, voffB);
        PG8_WAIT_V(6); PG8_BAR;
    }
    for (;;) {
        const bool has_next = S.next(ui + 1, nxt);
        const char* nA = has_next ? (nxt.sw ? (const char*)g.Bt + (size_t)nxt.pn * tstep : (const char*)g.A + (size_t)nxt.pm * tstep) : cA; const char* nB = has_next ? (nxt.sw ? (const char*)g.A + (size_t)nxt.pm * tstep : (const char*)g.Bt + (size_t)nxt.pn * tstep) : cB;
        for (int t = 0; t < nt; t += 2) {
            const bool last = (t == nt - 2);
            const char* a1 = cA + (size_t)(t + 1) * kstep;
            const char* a2 = last ? nA : cA + (size_t)(t + 2) * kstep; const char* b2 = last ? nB : cB + (size_t)(t + 2) * kstep;
            const char* a3 = a2 + kstep; const char* b3 = b2 + kstep;
            if (last && has_next) S.a_ready(nxt);
            if constexpr (SP2) {
            PG8_LDB(B0, 0, 0); PG8_LDB(B1, 0, 1); PG8_SCHED; PG8_LDA(At, 0, 0); PG8_STAGE(PG8_SA(1, 1), a1 + hstep, voffA);
            PG8_WAIT_V(8); PG8_WAIT_L(0); PG8_BAR; PG8_MMA(0, 0, At, B0); PG8_MMA(0, 1, At, B1); PG8_BAR; PG8_SCHED;
            PG8_LDA(At, 0, 1); PG8_STAGE(PG8_SB(0, 0), b2, voffB); PG8_STAGE(PG8_SB(0, 1), b2 + hstep, voffB); PG8_STAGE(PG8_SA(0, 0), a2, voffA);
            PG8_WAIT_V(8); PG8_WAIT_L(0); PG8_BAR; PG8_MMA(1, 0, At, B0); PG8_MMA(1, 1, At, B1); PG8_BAR; PG8_SCHED;
            PG8_LDB(B0, 1, 0); PG8_LDB(B1, 1, 1); PG8_SCHED; PG8_LDA(At, 1, 0); PG8_STAGE(PG8_SA(0, 1), a2 + hstep, voffA);
            PG8_WAIT_V(8); PG8_WAIT_L(0); PG8_BAR; PG8_MMA(0, 0, At, B0); PG8_MMA(0, 1, At, B1); PG8_BAR; PG8_SCHED;
            PG8_LDA(At, 1, 1); PG8_STAGE(PG8_SB(1, 0), b3, voffB); PG8_STAGE(PG8_SB(1, 1), b3 + hstep, voffB); PG8_STAGE(PG8_SA(1, 0), a3, voffA);
            PG8_WAIT_V(8); PG8_WAIT_L(0); PG8_BAR; PG8_MMA(1, 0, At, B0); PG8_MMA(1, 1, At, B1); PG8_BAR; PG8_SCHED;
            } else {
            PG8_LDB(B0, 0, 0); PG8_SCHED; PG8_LDA(At, 0, 0); PG8_STAGE(PG8_SA(1, 1), a1 + hstep, voffA);
            PG8_WAIT_L(8); PG8_BAR; PG8_WAIT_L(0); PG8_MMA(0, 0, At, B0); PG8_BAR; PG8_SCHED;
            PG8_LDB(B1, 0, 1); PG8_STAGE(PG8_SB(0, 0), b2, voffB);
            PG8_BAR; PG8_WAIT_L(0); PG8_MMA(0, 1, At, B1); PG8_BAR;
            PG8_LDA(At, 0, 1); PG8_STAGE(PG8_SA(0, 0), a2, voffA);
            PG8_BAR; PG8_WAIT_L(0); PG8_MMA(1, 0, At, B0); PG8_BAR; PG8_SCHED;
            PG8_STAGE(PG8_SB(0, 1), b2 + hstep, voffB);
            PG8_WAIT_V(6); PG8_BAR; PG8_MMA(1, 1, At, B1); PG8_BAR;
            PG8_LDB(B0, 1, 0); PG8_SCHED; PG8_LDA(At, 1, 0); PG8_STAGE(PG8_SA(0, 1), a2 + hstep, voffA);
            PG8_WAIT_L(8); PG8_BAR; PG8_WAIT_L(0); PG8_MMA(0, 0, At, B0); PG8_BAR; PG8_SCHED;
            PG8_LDB(B1, 1, 1); PG8_STAGE(PG8_SB(1, 0), b3, voffB);
            PG8_BAR; PG8_WAIT_L(0); PG8_MMA(0, 1, At, B1); PG8_BAR;
            PG8_LDA(At, 1, 1); PG8_STAGE(PG8_SA(1, 0), a3, voffA);
            PG8_BAR; PG8_WAIT_L(0); PG8_MMA(1, 0, At, B0); PG8_BAR; PG8_SCHED;
            PG8_STAGE(PG8_SB(1, 1), b3 + hstep, voffB);
            PG8_WAIT_V(6); PG8_BAR; PG8_MMA(1, 1, At, B1); PG8_BAR;
            }
        }
        if constexpr (ALIGN_EPI) { if (wr == 0) PG8_BAR; }
        if constexpr (!Epi::AFTER_DRAIN) { E(acc, cur, wr, wc, fr, fq); S.done(cur); }
        if (!has_next) break;
#pragma unroll
        for (int a = 0; a < 2; ++a)
#pragma unroll
            for (int b = 0; b < 2; ++b)
#pragma unroll
                for (int m = 0; m < 4; ++m)
#pragma unroll
                    for (int n = 0; n < 2; ++n) acc[a][b][m][n] = (f32x4){0.f, 0.f, 0.f, 0.f};
        cur = nxt; cA = nA; cB = nB; ++ui;
        if constexpr (ALIGN_EPI) { if (wr == 1) PG8_BAR; }
    }
    PG8_WAIT_V(0);
    if constexpr (!ALIGN_EPI) { if (wr == 0) PG8_BAR; }
    PG8_BAR;
    if constexpr (Epi::AFTER_DRAIN) { E.fused(acc, cur, wr, wc, fr, fq, lds, wid, lane); S.done(cur); }
#undef PG8_SA
#undef PG8_SB
#undef PG8_STAGE
#undef PG8_LDA
#undef PG8_LDB
#undef PG8_MMA
#undef PG8_WAIT_V
#undef PG8_WAIT_L
#undef PG8_BAR
#undef PG8_SCHED
}
}

#define GAS __attribute__((address_space(1)))
#define LAS __attribute__((address_space(3)))
typedef unsigned short bf16_t;
typedef short bf16x8 __attribute__((ext_vector_type(8)));
typedef float f32x4 __attribute__((ext_vector_type(4)));
typedef float f32x2 __attribute__((ext_vector_type(2)));
typedef unsigned u32x4 __attribute__((ext_vector_type(4)));
typedef unsigned u32x2 __attribute__((ext_vector_type(2)));
#define LDS_WAIT() asm volatile("s_waitcnt lgkmcnt(0)" ::: "memory")
#define VM_WAIT() asm volatile("s_waitcnt vmcnt(0)" ::: "memory")

namespace mk {
using pg8::cvt_pk_bf16; using pg8::pack8; using pg8::rs_of;
constexpr int T = 8192, D = 4096, INW = 14352, NPROJ = 14336, FF = 11008;
constexpr int NWAVES = 8, NTHR = 512;
constexpr int LDS_BYTES = 147456;
constexpr int LDSCTL_OFF = 140 * 1024;
constexpr int CW_TMO = 0, CW_BAR = 4096, CW_SS = 8192  , CW_CHK = 65536  ;
constexpr size_t CTL_ZERO_BYTES = 512 * 1024;
constexpr int N_PHASES = 18;

struct Args {
    const float* x; const int* pos; const float* mix_norm; const float* w_in; const float* gla_w_up; const float* gla_b; const float* ret_gain; const float* gla_gain;
    const float* w_out; const float* ffn_norm; const float* w_gate; const float* w_up; const float* w_down; const float* final_norm;
    float* out; unsigned* ctl;
    bf16_t* win_t[2]; bf16_t* wga_t[2]; bf16_t* wout_t[2]; bf16_t* wgu_t[2]; bf16_t* wd_t[2];
    bf16_t* xb; float* rot; float* ga; float* lam;
    bf16_t *qr, *kr, *krt, *vrt, *srg, *gq, *gk, *qg, *kg, *kgt, *vgt, *sgg, *kvr, *kvg, *mixed, *h;
    bf16_t* dbgp; float* dbgo;
    int ph_lo, ph_hi, cvt_mask, cvt_layers;
};

__device__ __forceinline__ float wave_sum(float v) {
#pragma unroll
    for (int o = 1; o < 64; o <<= 1) v += __shfl_xor(v, o);
    return v;
}
__device__ __forceinline__ float bf_lo(unsigned w) { return __uint_as_float(w << 16); }
__device__ __forceinline__ float bf_hi(unsigned w) { return __uint_as_float(w & 0xffff0000u); }
__device__ __forceinline__ float silu1(float v) { return v / (1.0f + __expf(-v)); }

#define XB_TMO      128
#define XB_XCNT(j)  (256  + 64 * (j))
#define XB_XSUB(j)  (1280 + 64 * (j))
#define XB_XGEN(j)  (2304 + 64 * (j))
#define XB_TOP      3328
#define XB_TOPGEN   3392
#define XCD_BAR_WORDS 3456
#define XB_SPIN_CAP (1u << 18)

__device__ __forceinline__ unsigned xb_ld(unsigned* p)              { return __hip_atomic_load(p, __ATOMIC_RELAXED, __HIP_MEMORY_SCOPE_AGENT); }
__device__ __forceinline__ unsigned xb_add(unsigned* p, unsigned v) { return __hip_atomic_fetch_add(p, v, __ATOMIC_RELAXED, __HIP_MEMORY_SCOPE_AGENT); }
__device__ __forceinline__ unsigned xb_xcc_id() { return (unsigned)__builtin_amdgcn_s_getreg((3 << 11) | 20) & 0xFu; }
#define XB_SPIN(cond, bar) do { unsigned _sp = 0; while (cond) { __builtin_amdgcn_s_sleep(1); \
    if ((++_sp & 255u) == 0u) { if (xb_ld(&(bar)[XB_TMO])) break; if (_sp > XB_SPIN_CAP) { atomicAdd(&(bar)[XB_TMO], 1u); break; } } } } while (0)

struct XcdBarrier {
    unsigned* bar; unsigned x;
    volatile LAS unsigned* st;
};

__device__ __forceinline__ XcdBarrier xcd_barrier_post(unsigned* bar, volatile LAS unsigned* st) {
    XcdBarrier b; b.bar = bar; b.x = xb_xcc_id(); b.st = st;
    if (threadIdx.x == 0) (void)xb_add(&bar[XB_XCNT(b.x)], 1u);
    return b;
}
__device__ __forceinline__ void xcd_barrier_complete(unsigned* bar, unsigned x, unsigned& nloc, unsigned& nx) {
    const unsigned G = gridDim.x * gridDim.y * gridDim.z;
    unsigned sum, cnt, mine, sp = 0u;
    for (;;) {
        sum = 0u; cnt = 0u; mine = 0u;
#pragma unroll
        for (unsigned j = 0; j < 16; ++j) { const unsigned c = xb_ld(&bar[XB_XCNT(j)]); sum += c; cnt += (c > 0u) ? 1u : 0u; mine = (j == x) ? c : mine; }
        if (sum == G) break;
        __builtin_amdgcn_s_sleep(1);
        if ((++sp & 255u) == 0u) { if (xb_ld(&bar[XB_TMO])) break; if (sp > XB_SPIN_CAP) { atomicAdd(&bar[XB_TMO], 1u); break; } }
    }
    nloc = mine > 0u ? mine : 1u; nx = cnt > 0u ? cnt : 1u;
}

__device__ __forceinline__ void xcd_barrier(const XcdBarrier& b) {
    asm volatile("s_waitcnt vmcnt(0)" ::: "memory");
    __syncthreads();
    if (threadIdx.x == 0) {
        unsigned* bar = b.bar;
        __builtin_amdgcn_s_waitcnt(0);
        unsigned nloc = b.st[0], nx = b.st[1];
        if (nloc == 0u) { xcd_barrier_complete(bar, b.x, nloc, nx); b.st[0] = nloc; b.st[1] = nx; }
        const unsigned old = xb_add(&bar[XB_XSUB(b.x)], 1u);
        const unsigned gen = old / nloc;
        if (old + 1u == (gen + 1u) * nloc) {
            __builtin_amdgcn_fence(__ATOMIC_RELEASE, "agent");
            asm volatile("s_waitcnt vmcnt(0)" ::: "memory");
            const unsigned og = xb_add(&bar[XB_TOP], 1u);
            const unsigned tg = og / nx;
            if (og + 1u == (tg + 1u) * nx) xb_add(&bar[XB_TOPGEN], 1u);
            else XB_SPIN(xb_ld(&bar[XB_TOPGEN]) == tg, bar);
            __builtin_amdgcn_fence(__ATOMIC_ACQUIRE, "agent");
            xb_add(&bar[XB_XGEN(b.x)], 1u);
            asm volatile("s_waitcnt vmcnt(0)" ::: "memory");
        } else {
            XB_SPIN(xb_ld(&bar[XB_XGEN(b.x)]) == gen, bar);
            __builtin_amdgcn_fence(__ATOMIC_ACQUIRE, "agent");
            asm volatile("s_waitcnt vmcnt(0)" ::: "memory");
        }
    }
    __syncthreads();
}

__device__ __forceinline__ void cvt_item(const float* W, int ldn, int k0, int n0, const float* gain, bf16_t* WT, size_t dst_row0, int K, LAS float* scr, int lane) {
    const int kr = lane >> 4, c4 = (lane & 15) * 4;
    f32x4 v[16];
#pragma unroll
    for (int i = 0; i < 16; ++i) v[i] = *(const f32x4*)(W + (size_t)(k0 + 4 * i + kr) * ldn + n0 + c4);
#pragma unroll
    for (int i = 0; i < 16; ++i) { const float g = gain ? gain[k0 + 4 * i + kr] : 1.0f; LAS float* p = scr + (4 * i + kr) * 65 + c4; p[0] = v[i][0] * g; p[1] = v[i][1] * g; p[2] = v[i][2] * g; p[3] = v[i][3] * g; }
    LDS_WAIT(); asm volatile("" ::: "memory");
    const int c = lane >> 3, nn = lane & 7;
#pragma unroll
    for (int j = 0; j < 8; ++j) { const int n = nn + 8 * j; const LAS float* s = scr + (8 * c) * 65 + n;
        u32x4 o; o.x = cvt_pk_bf16(s[0 * 65], s[1 * 65]); o.y = cvt_pk_bf16(s[2 * 65], s[3 * 65]); o.z = cvt_pk_bf16(s[4 * 65], s[5 * 65]); o.w = cvt_pk_bf16(s[6 * 65], s[7 * 65]);
        *(u32x4*)(WT + (dst_row0 + n) * (size_t)K + k0 + 8 * c) = o; }
    LDS_WAIT(); asm volatile("" ::: "memory");
}
template <class AT> __device__ __forceinline__ void p0_prologue(const AT& a, LAS unsigned char* lds, int tid, int lane, int wave, int bid, int G) {
    LAS float* scr = (LAS float*)(lds + wave * 16640);
    const int gw = bid * NWAVES + wave, NGW = G * NWAVES;
    constexpr int I_IN = 64 * 224, I_OUT = 64 * 64, I_G = 64 * 172, I_D = 172 * 64, I_LAYER = I_IN + I_OUT + 2 * I_G + I_D;
    const int nitems = a.cvt_layers * I_LAYER;
    for (int it = gw; it < nitems; it += NGW) {
        const int l = it / I_LAYER; int r = it - l * I_LAYER;
        if (r < I_IN) { if (a.cvt_mask & 1) { const int kb = r / 224, nb = r - kb * 224; cvt_item(a.w_in + (size_t)l * D * INW, INW, 64 * kb, 64 * nb, a.mix_norm + l * D, a.win_t[l], (size_t)(64 * nb), D, scr, lane); } continue; } r -= I_IN;
        if (r < I_OUT) { if (a.cvt_mask & 2) { const int kb = r / 64, nb = r - kb * 64; cvt_item(a.w_out + (size_t)l * D * D, D, 64 * kb, 64 * nb, nullptr, a.wout_t[l], (size_t)(64 * nb), D, scr, lane); } continue; } r -= I_OUT;
        if (r < 2 * I_G) { if (a.cvt_mask & 4) { const int up = r >= I_G ? 1 : 0; r -= up * I_G; const int kb = r / 172, nb = r - kb * 172, n0 = 64 * nb;
            cvt_item((up ? a.w_up : a.w_gate) + (size_t)l * D * FF, FF, 64 * kb, n0, a.ffn_norm + l * D, a.wgu_t[l], (size_t)((n0 >> 7) * 256 + up * 128 + (n0 & 127)), D, scr, lane); } continue; } r -= 2 * I_G;
        if (a.cvt_mask & 8) { const int kb = r / 64, nb = r - kb * 64; cvt_item(a.w_down + (size_t)l * FF * D, D, 64 * kb, 64 * nb, nullptr, a.wd_t[l], (size_t)(64 * nb), FF, scr, lane); }
    }
    if (a.cvt_mask & 1) for (int i = bid * NTHR + tid; i < a.cvt_layers * 16 * D; i += G * NTHR) { const int l = i / (16 * D), r = i - l * 16 * D, j = r / D, k = r - j * D;
        const float v = a.w_in[(size_t)l * D * INW + (size_t)k * INW + NPROJ + j] * a.mix_norm[l * D + k]; a.wga_t[l][r] = (bf16_t)(cvt_pk_bf16(v, 0.f) & 0xffffu); }
    float* ss0 = (float*)(a.ctl + CW_SS);
    for (int m = gw; m < T; m += NGW) { const f32x4* xr = (const f32x4*)(a.x + (size_t)m * D) + lane; u32x2* o8 = (u32x2*)(a.xb + (size_t)m * D) + lane; float s = 0.f;
#pragma unroll
        for (int j = 0; j < 16; ++j) { const f32x4 v = xr[64 * j]; s += (v[0] * v[0] + v[1] * v[1]) + (v[2] * v[2] + v[3] * v[3]); u32x2 w; w.x = cvt_pk_bf16(v[0], v[1]); w.y = cvt_pk_bf16(v[2], v[3]); o8[64 * j] = w; }
        s = wave_sum(s); if (lane == 0) ss0[m] = s; }
    for (int i = bid * NTHR + tid; i < T * 128; i += G * NTHR) { const int t = i >> 7, k = i & 127;
        const float inv_freq = powf(10000.0f, -(float)k / 128.0f); const float ang = (float)a.pos[t] * inv_freq;
        const double rev = (double)ang * 0.15915494309189533577; const float fr = (float)(rev - floor(rev));
        a.rot[i] = __builtin_amdgcn_cosf(fr); a.rot[(size_t)T * 128 + i] = __builtin_amdgcn_sinf(fr); }
}

template <class AT> __device__ __forceinline__ void ga_stage(const AT& a, int l, const float* ss, LAS unsigned char* lds, int tid, int lane, int wave, int bid, int G) {
    LAS float* red = (LAS float*)lds;
    for (int tb = bid; tb < T / 32; tb += G) {
        f32x4 acc[2] = {(f32x4){0.f, 0.f, 0.f, 0.f}, (f32x4){0.f, 0.f, 0.f, 0.f}};
        const bf16_t* xa = a.xb + (size_t)(tb * 32 + (lane & 15)) * D + wave * 512 + 8 * (lane >> 4);
        const bf16_t* wb = a.wga_t[l] + (size_t)(lane & 15) * D + wave * 512 + 8 * (lane >> 4);
#pragma unroll 4
        for (int ks = 0; ks < 16; ++ks) { const bf16x8 b = *(const bf16x8*)(wb + 32 * ks);
            const bf16x8 a0 = *(const bf16x8*)(xa + 32 * ks), a1 = *(const bf16x8*)(xa + (size_t)16 * D + 32 * ks);
            acc[0] = __builtin_amdgcn_mfma_f32_16x16x32_bf16(a0, b, acc[0], 0, 0, 0); acc[1] = __builtin_amdgcn_mfma_f32_16x16x32_bf16(a1, b, acc[1], 0, 0, 0); }
        *(LAS f32x4*)(red + ((wave * 2 + 0) * 64 + lane) * 4) = acc[0]; *(LAS f32x4*)(red + ((wave * 2 + 1) * 64 + lane) * 4) = acc[1];
        __syncthreads();
        { const int mt = tid >> 8, ln = (tid >> 2) & 63, rg = tid & 3; float s = 0.f;
#pragma unroll
          for (int w = 0; w < 8; ++w) s += red[((w * 2 + mt) * 64 + ln) * 4 + rg];
          const int tok = tb * 32 + 16 * mt + (ln >> 4) * 4 + rg, j = ln & 15;
          a.ga[(size_t)tok * 16 + j] = s * rs_of(ss[tok]); }
        __syncthreads();
    }
}

template <class AT> __device__ __forceinline__ void prep_phase(const AT& a, int l, LAS unsigned char* lds, int tid, int lane, int wave, int bid, int G) {
    for (int u = bid; u < 512; u += G) { const int c = u >> 3, h = u & 7, t0 = c * 128;
#pragma unroll 1
        for (int k = 0; k < 4; ++k) { const int task = tid + 512 * k, dp = task & 127, q = task >> 7;
            unsigned w[8];
#pragma unroll
            for (int i = 0; i < 8; ++i) w[i] = *(const unsigned*)(a.kr + (size_t)(t0 + 8 * q + i) * 2048 + h * 256 + 2 * dp);
            u32x4 lo, hi;
            lo.x = (w[0] & 0xffffu) | (w[1] << 16); lo.y = (w[2] & 0xffffu) | (w[3] << 16); lo.z = (w[4] & 0xffffu) | (w[5] << 16); lo.w = (w[6] & 0xffffu) | (w[7] << 16);
            hi.x = (w[0] >> 16) | (w[1] & 0xffff0000u); hi.y = (w[2] >> 16) | (w[3] & 0xffff0000u); hi.z = (w[4] >> 16) | (w[5] & 0xffff0000u); hi.w = (w[6] >> 16) | (w[7] & 0xffff0000u);
            bf16_t* dst = a.krt + (size_t)(h * 256 + 2 * dp) * T + t0 + 8 * q;
            *(u32x4*)dst = lo; *(u32x4*)(dst + T) = hi; } }
    LAS float* la = (LAS float*)lds;
    LAS float* tot = (LAS float*)(lds + 131072);
    const float* wup = a.gla_w_up + (size_t)l * 16 * 1024; const float* gb = a.gla_b + l * 1024;
    for (int u = bid; u < 256; u += G) { const int h = u >> 6, c = u & 63, t0 = c * 128, d = tid & 255, half = tid >> 8, ch = h * 256 + d;
        float wv[16];
#pragma unroll
        for (int r = 0; r < 16; ++r) wv[r] = wup[r * 1024 + ch];
        const float bb = gb[ch]; float sum = 0.f;
        for (int tt = 0; tt < 64; ++tt) { const int t = t0 + half * 64 + tt; const float* g = a.ga + (size_t)t * 16; float z = bb;
#pragma unroll
            for (int r = 0; r < 16; ++r) z = fmaf(g[r], wv[r], z);
            const float ls = (fminf(z, 0.f) - log1pf(__expf(-fabsf(z)))) * 0.0625f; la[(half * 64 + tt) * 256 + d] = ls; sum += ls; }
        if (half == 0) tot[d] = sum;
        __syncthreads();
        float cum = half ? tot[d] : 0.f;
        unsigned pk[4] = {0u, 0u, 0u, 0u};
        for (int tt = 0; tt < 64; ++tt) { const int t = t0 + half * 64 + tt; cum += la[(half * 64 + tt) * 256 + d];
            const float eq = __expf(cum), ek = __expf(-cum);
            const float qv = __uint_as_float((unsigned)a.gq[(size_t)t * 1024 + ch] << 16) * eq, kv = __uint_as_float((unsigned)a.gk[(size_t)t * 1024 + ch] << 16) * ek;
            const unsigned qb = cvt_pk_bf16(qv, 0.f) & 0xffffu, kb = cvt_pk_bf16(kv, 0.f) & 0xffffu;
            a.qg[(size_t)t * 1024 + ch] = (bf16_t)qb; a.kg[(size_t)t * 1024 + ch] = (bf16_t)kb;
            const int e = tt & 7; if (e & 1) pk[e >> 1] |= kb << 16; else pk[e >> 1] = kb;
            if (e == 7) { u32x4 o; o.x = pk[0]; o.y = pk[1]; o.z = pk[2]; o.w = pk[3]; *(u32x4*)(a.kgt + (size_t)ch * T + t - 7) = o; } }
        if (half) a.lam[c * 1024 + ch] = __expf(cum);
        __syncthreads();
    }
}

template <class AT> __device__ __forceinline__ void m1_phase(const AT& a, int lane, int wave, int bid, int G) {
    const int wd = wave & 1, wv = wave >> 1, lr = lane & 15, lq = lane >> 4;
    for (int su = bid; su < 1024; su += G) {
        const bf16_t *Kt, *Vt; bf16_t* out; int c;
        if (su < 512) { const int h = su >> 6; c = su & 63; Kt = a.krt + (size_t)(h * 256) * T; Vt = a.vrt + (size_t)(h * 256) * T; out = a.kvr + (size_t)(h * 64 + c) * 65536; }
        else { const int s = su - 512, h = s >> 7, vh = s & 1; c = (s >> 1) & 63; Kt = a.kgt + (size_t)(h * 256) * T; Vt = a.vgt + (size_t)(h * 512 + vh * 256) * T; out = a.kvg + (size_t)(h * 64 + c) * 131072 + (size_t)vh * 65536; }
        const int t0 = c * 128;
        f32x4 acc[8][4];
#pragma unroll
        for (int i = 0; i < 8; ++i)
#pragma unroll
            for (int j = 0; j < 4; ++j) acc[i][j] = (f32x4){0.f, 0.f, 0.f, 0.f};
        const bf16_t* kp = Kt + (size_t)(128 * wd + lr) * T + t0 + 8 * lq; const bf16_t* vp = Vt + (size_t)(64 * wv + lr) * T + t0 + 8 * lq;
#pragma unroll 1
        for (int ks = 0; ks < 4; ++ks) { bf16x8 X[8], Y[4];
#pragma unroll
            for (int i = 0; i < 8; ++i) X[i] = *(const bf16x8*)(kp + (size_t)(16 * i) * T + 32 * ks);
#pragma unroll
            for (int j = 0; j < 4; ++j) Y[j] = *(const bf16x8*)(vp + (size_t)(16 * j) * T + 32 * ks);
#pragma unroll
            for (int i = 0; i < 8; ++i)
#pragma unroll
                for (int j = 0; j < 4; ++j) acc[i][j] = __builtin_amdgcn_mfma_f32_16x16x32_bf16(X[i], Y[j], acc[i][j], 0, 0, 0); }
#pragma unroll
        for (int i = 0; i < 8; ++i)
#pragma unroll
            for (int j = 0; j < 4; ++j) { u32x2 w; w.x = cvt_pk_bf16(acc[i][j][0], acc[i][j][1]); w.y = cvt_pk_bf16(acc[i][j][2], acc[i][j][3]);
                *(u32x2*)(out + (size_t)(64 * wv + 16 * j + lr) * 256 + 128 * wd + 16 * i + 4 * lq) = w; }
    }
}

template <class AT> __device__ __forceinline__ void m2_phase(const AT& a, int tid, int bid, int G) {
    for (int vec = bid * NTHR + tid; vec < 131072; vec += G * NTHR) {
        bf16_t* base; size_t cstride; const float* lamp = nullptr; float lsc = 0.f;
        if (vec < 65536) { const int h = vec >> 13, rem = vec & 8191; base = a.kvr + (size_t)(h * 64) * 65536 + (size_t)rem * 8; cstride = 65536; lsc = exp2f(128.0f * log2f(1.0f - exp2f(-5.0f - (float)h))); }
        else { const int v2 = vec - 65536, h = v2 >> 14, rem = v2 & 16383; base = a.kvg + (size_t)(h * 64) * 131072 + (size_t)rem * 8; cstride = 131072; lamp = a.lam + h * 256 + 8 * (rem & 31); }
        float st[8];
#pragma unroll
        for (int e = 0; e < 8; ++e) st[e] = 0.f;
#pragma unroll 8
        for (int c = 0; c < 64; ++c) { u32x4* p = (u32x4*)(base + (size_t)c * cstride); const u32x4 kv = *p;
            u32x4 o; o.x = cvt_pk_bf16(st[0], st[1]); o.y = cvt_pk_bf16(st[2], st[3]); o.z = cvt_pk_bf16(st[4], st[5]); o.w = cvt_pk_bf16(st[6], st[7]); *p = o;
            float lm[8];
            if (lamp) { const f32x4 l0 = *(const f32x4*)(lamp + c * 1024), l1 = *(const f32x4*)(lamp + c * 1024 + 4); lm[0] = l0[0]; lm[1] = l0[1]; lm[2] = l0[2]; lm[3] = l0[3]; lm[4] = l1[0]; lm[5] = l1[1]; lm[6] = l1[2]; lm[7] = l1[3]; }
            else {
#pragma unroll
                for (int e = 0; e < 8; ++e) lm[e] = lsc; }
            st[0] = lm[0] * (st[0] + bf_lo(kv.x)); st[1] = lm[1] * (st[1] + bf_hi(kv.x)); st[2] = lm[2] * (st[2] + bf_lo(kv.y)); st[3] = lm[3] * (st[3] + bf_hi(kv.y));
            st[4] = lm[4] * (st[4] + bf_lo(kv.z)); st[5] = lm[5] * (st[5] + bf_hi(kv.z)); st[6] = lm[6] * (st[6] + bf_lo(kv.w)); st[7] = lm[7] * (st[7] + bf_hi(kv.w)); }
    }
}

template <int CT, bool LNORM>
__device__ __forceinline__ void m3_unit(LAS unsigned char* lds, const bf16_t* Q, int ldq, const bf16_t* Kk, const bf16_t* VT, const bf16_t* ST, const bf16_t* gate, const float* gain, bf16_t* mixed, int t0, int tid, int lane, int wave, bf16_t* dbgp = nullptr, float* dbgo = nullptr) {
    constexpr int DV = CT * 128;
    LAS unsigned char* QL = lds; LAS unsigned char* PL = lds + 65536; LAS f32x2* STATS = (LAS f32x2*)(lds + 98304);
    const int lr = lane & 15, lq = lane >> 4;
#pragma unroll
    for (int i = 0; i < 8; ++i) { const int idx = tid + 512 * i, row = idx >> 5, ch = idx & 31;
        const u32x4 v = *(const u32x4*)(Q + (size_t)(t0 + row) * ldq + ch * 8); *(LAS u32x4*)(QL + row * 512 + ((ch ^ (row & 15)) << 4)) = v; }
    bf16x8 Kf[8];
#pragma unroll
    for (int ks = 0; ks < 8; ++ks) Kf[ks] = *(const bf16x8*)(Kk + (size_t)(t0 + 16 * wave + lr) * ldq + 32 * ks + 8 * lq);
    __syncthreads();
#pragma unroll
    for (int rt = 0; rt < 8; ++rt) { f32x4 p = (f32x4){0.f, 0.f, 0.f, 0.f}; const int row = 16 * rt + lr;
        if (rt >= wave) {
#pragma unroll
            for (int ks = 0; ks < 8; ++ks) { const bf16x8 qf = *(const LAS bf16x8*)(QL + row * 512 + (((4 * ks + lq) ^ lr) << 4)); p = __builtin_amdgcn_mfma_f32_16x16x32_bf16(Kf[ks], qf, p, 0, 0, 0); }
            if (rt == wave) {
#pragma unroll
                for (int r = 0; r < 4; ++r) if (4 * lq + r > lr) p[r] = 0.f; } }
        u32x2 w; w.x = cvt_pk_bf16(p[0], p[1]); w.y = cvt_pk_bf16(p[2], p[3]);
        *(LAS u32x2*)(PL + row * 256 + ((((2 * wave + (lq >> 1)) ^ lr) << 4) + ((lq & 1) << 3))) = w; }
    __syncthreads();
#if MK_DEBUG
    if (dbgp) for (int idx = tid; idx < 128 * 16; idx += NTHR) { const int row = idx >> 4, ch = idx & 15; *(u32x4*)(dbgp + row * 128 + ch * 8) = *(const LAS u32x4*)(PL + row * 256 + ((ch ^ (row & 15)) << 4)); }
#endif
    f32x4 acc[8][CT];
#pragma unroll
    for (int rt = 0; rt < 8; ++rt)
#pragma unroll
        for (int ct = 0; ct < CT; ++ct) acc[rt][ct] = (f32x4){0.f, 0.f, 0.f, 0.f};
    const int vb = wave * 16 * CT;
    { const bf16_t* vp = VT + (size_t)(vb + lr) * T + t0 + 8 * lq;
#pragma unroll 1
      for (int ks = 0; ks < 4; ++ks) { bf16x8 Vf[CT];
#pragma unroll
          for (int ct = 0; ct < CT; ++ct) Vf[ct] = *(const bf16x8*)(vp + (size_t)(16 * ct) * T + 32 * ks);
#pragma unroll
          for (int rt = 0; rt < 8; ++rt) { const bf16x8 pf = *(const LAS bf16x8*)(PL + (16 * rt + lr) * 256 + (((4 * ks + lq) ^ lr) << 4));
#pragma unroll
              for (int ct = 0; ct < CT; ++ct) acc[rt][ct] = __builtin_amdgcn_mfma_f32_16x16x32_bf16(Vf[ct], pf, acc[rt][ct], 0, 0, 0); } } }
    { const bf16_t* sp = ST + (size_t)(vb + lr) * 256 + 8 * lq;
#pragma unroll 1
      for (int ks = 0; ks < 8; ++ks) { bf16x8 Sf[CT];
#pragma unroll
          for (int ct = 0; ct < CT; ++ct) Sf[ct] = *(const bf16x8*)(sp + (size_t)(16 * ct) * 256 + 32 * ks);
#pragma unroll
          for (int rt = 0; rt < 8; ++rt) { const bf16x8 qf = *(const LAS bf16x8*)(QL + (16 * rt + lr) * 512 + (((4 * ks + lq) ^ lr) << 4));
#pragma unroll
              for (int ct = 0; ct < CT; ++ct) acc[rt][ct] = __builtin_amdgcn_mfma_f32_16x16x32_bf16(Sf[ct], qf, acc[rt][ct], 0, 0, 0); } } }
#if MK_DEBUG
    if (dbgo) {
#pragma unroll
        for (int rt = 0; rt < 8; ++rt)
#pragma unroll
            for (int ct = 0; ct < CT; ++ct) *(f32x4*)(dbgo + (size_t)(16 * rt + lr) * 2048 + vb + 16 * ct + 4 * lq) = acc[rt][ct]; }
#endif
#pragma unroll
    for (int rt = 0; rt < 8; ++rt) { float s1 = 0.f, s2 = 0.f;
#pragma unroll
        for (int ct = 0; ct < CT; ++ct)
#pragma unroll
            for (int r = 0; r < 4; ++r) { const float x = acc[rt][ct][r]; s1 += x; s2 += x * x; }
        s1 += __shfl_xor(s1, 16); s1 += __shfl_xor(s1, 32); s2 += __shfl_xor(s2, 16); s2 += __shfl_xor(s2, 32);
        if (lq == 0) STATS[(16 * rt + lr) * 8 + wave] = (f32x2){s1, s2}; }
    __syncthreads();
#pragma unroll
    for (int rt = 0; rt < 8; ++rt) { const int row = 16 * rt + lr; float s1 = 0.f, s2 = 0.f;
#pragma unroll
        for (int w = 0; w < 8; ++w) { const f32x2 s = STATS[row * 8 + w]; s1 += s[0]; s2 += s[1]; }
        const float mean = LNORM ? s1 * (1.0f / DV) : 0.f; const float var = s2 * (1.0f / DV) - mean * mean; const float rstd = 1.0f / sqrtf(var + 1e-6f);
        const size_t to = (size_t)(t0 + row);
#pragma unroll
        for (int ct = 0; ct < CT; ++ct) { const int col = vb + 16 * ct + 4 * lq; const u32x2 g = *(const u32x2*)(gate + to * 2048 + col); const f32x4 gn = *(const f32x4*)(gain + col);
            const f32x4 x = acc[rt][ct]; u32x2 w;
            w.x = cvt_pk_bf16((x[0] - mean) * rstd * gn[0] * bf_lo(g.x), (x[1] - mean) * rstd * gn[1] * bf_hi(g.x));
            w.y = cvt_pk_bf16((x[2] - mean) * rstd * gn[2] * bf_lo(g.y), (x[3] - mean) * rstd * gn[3] * bf_hi(g.y));
            *(u32x2*)(mixed + to * 4096 + col) = w; } }
    __syncthreads();
}
template <class AT> __device__ __forceinline__ void m3_phase(const AT& a, int l, LAS unsigned char* lds, int tid, int lane, int wave, int bid, int G) {
    for (int u = bid; u < 256; u += G) { const int h = u >> 6, c = u & 63;
        m3_unit<4, false>(lds, a.qg + h * 256, 1024, a.kg + h * 256, a.vgt + (size_t)(h * 512) * T, a.kvg + (size_t)(h * 64 + c) * 131072, a.sgg + h * 512, a.gla_gain + l * 2048 + h * 512, a.mixed + 2048 + h * 512, c * 128, tid, lane, wave); }
    for (int u = bid; u < 512; u += G) { const int h = u >> 6, c = u & 63;
        m3_unit<2, true>(lds, a.qr + h * 256, 2048, a.kr + h * 256, a.vrt + (size_t)(h * 256) * T, a.kvr + (size_t)(h * 64 + c) * 65536, a.srg + h * 256, a.ret_gain + l * 2048 + h * 256, a.mixed + h * 256, c * 128, tid, lane, wave,
#if MK_DEBUG
            a.dbgp ? a.dbgp + (size_t)(h * 64 + c) * 16384 : nullptr, a.dbgo ? a.dbgo + (size_t)(c * 128) * 2048 + h * 256 : nullptr
#else
            nullptr, nullptr
#endif
            ); }
}

template <class AT> __device__ __forceinline__ void final_phase(const AT& a, const float* ss, int tid, int bid, int G) {
    for (size_t i = (size_t)bid * NTHR + tid; i < (size_t)T * D / 4; i += (size_t)G * NTHR) { const int t = (int)(i >> 10), c4 = (int)(i & 1023);
        const f32x4 v = ((const f32x4*)a.out)[i], g = ((const f32x4*)a.final_norm)[c4]; const float r = rs_of(ss[t]); ((f32x4*)a.out)[i] = v * r * g; }
}

#ifndef MK_PH
#define MK_PH 1023
#endif
typedef const Args __attribute__((address_space(4))) CArgs;
#define KARGS() ({ const CArgs* p_ = (const CArgs*)__builtin_amdgcn_kernarg_segment_ptr(); asm volatile("" : "+s"(p_)); p_; })
__global__ void __launch_bounds__(NTHR, 2) mk_fwd(Args args_unused) {
    extern __shared__ __attribute__((aligned(16))) unsigned char lds_raw[];
    LAS unsigned char* lds = (LAS unsigned char*)lds_raw;
    const int bid = blockIdx.x, G = gridDim.x;
    volatile LAS unsigned* MISC = (volatile LAS unsigned*)(lds + LDSCTL_OFF);
    if (threadIdx.x < 64) MISC[threadIdx.x] = 0u;
#define LANEIDS() int tid = threadIdx.x; asm volatile("" : "+v"(tid)); const int lane = tid & 63, wave = __builtin_amdgcn_readfirstlane(tid >> 6); (void)lane; (void)wave
    __syncthreads();
    XcdBarrier bar = xcd_barrier_post(KARGS()->ctl + CW_BAR, MISC + 8);
#define IN(k) (KARGS()->ph_lo <= (k) && (k) < KARGS()->ph_hi)
#define SEAM(k) do { if (IN(k) && IN((k) + 1)) xcd_barrier(bar); } while (0)
#define SSB() ((float*)(KARGS()->ctl + CW_SS))

    if (MK_PH & 256) if (IN(0)) { LANEIDS(); p0_prologue(*KARGS(), lds, tid, lane, wave, bid, G); }
    SEAM(0);
    for (int l = 0; l < 2; ++l) {
        const int pb = 1 + 8 * l;
        if (MK_PH & 1) if (IN(pb + 0)) {
            const CArgs& a = *KARGS(); const float* ss_in = SSB() + (size_t)(2 * l) * T;
            { LANEIDS(); ga_stage(a, l, ss_in, lds, tid, lane, wave, bid, G); }
            pg8::Gemm g{a.xb, a.win_t[l], D}; pg8::ProjOrder S; S.init(T / 256, NPROJ / 256, G, bid);
            pg8::EpiProj E{ss_in, a.rot, a.qr, a.kr, a.vrt, a.srg, a.gq, a.gk, a.vgt, a.sgg};
            pg8::gemm_phase<pg8::EpiProj, pg8::ProjOrder, true, true>(lds, g, S, E);
        }
        SEAM(pb + 0);
        if (MK_PH & 2) if (IN(pb + 1)) { LANEIDS(); prep_phase(*KARGS(), l, lds, tid, lane, wave, bid, G); }
        SEAM(pb + 1);
        if (MK_PH & 4) if (IN(pb + 2)) { LANEIDS(); m1_phase(*KARGS(), lane, wave, bid, G); }
        SEAM(pb + 2);
        if (MK_PH & 8) if (IN(pb + 3)) { LANEIDS(); m2_phase(*KARGS(), tid, bid, G); }
        SEAM(pb + 3);
        if (MK_PH & 16) if (IN(pb + 4)) { LANEIDS(); m3_phase(*KARGS(), l, lds, tid, lane, wave, bid, G); }
        SEAM(pb + 4);
        if (MK_PH & 32) if (IN(pb + 5)) {
            const CArgs& a = *KARGS(); float* ss_mid = SSB() + (size_t)(2 * l + 1) * T;
            pg8::Gemm g{a.mixed, a.wout_t[l], D}; pg8::StaticOrder S; S.init(T / 256, D / 256, G, bid);
            pg8::EpiRes E{l == 0 ? a.x : a.out, a.out, a.xb, ss_mid};
            pg8::gemm_phase<pg8::EpiRes, pg8::StaticOrder, true, true>(lds, g, S, E);
        }
        SEAM(pb + 5);
        if (MK_PH & 64) if (IN(pb + 6)) {
            const CArgs& a = *KARGS(); const float* ss_mid = SSB() + (size_t)(2 * l + 1) * T;
            pg8::Gemm g{a.xb, a.wgu_t[l], D}; pg8::StaticOrder S; S.init(T / 256, 2 * FF / 256, G, bid);
            pg8::EpiSwiGLU E{ss_mid, a.h};
            pg8::gemm_phase<pg8::EpiSwiGLU, pg8::StaticOrder, true, true>(lds, g, S, E);
        }
        SEAM(pb + 6);
        if (MK_PH & 128) if (IN(pb + 7)) {
            const CArgs& a = *KARGS(); float* ss_out = SSB() + (size_t)(2 * l + 2) * T;
            pg8::Gemm g{a.h, a.wd_t[l], FF}; pg8::StaticOrder S; S.init(T / 256, D / 256, G, bid);
            pg8::EpiRes E{a.out, a.out, a.xb, ss_out};
            pg8::gemm_phase<pg8::EpiRes, pg8::StaticOrder, true, true>(lds, g, S, E);
        }
        SEAM(pb + 7);
    }
    if (MK_PH & 512) if (IN(17)) { LANEIDS(); final_phase(*KARGS(), SSB() + (size_t)4 * T, tid, bid, G); }
#undef IN
#undef SEAM
}

struct Layout { size_t off; size_t take(size_t bytes) { const size_t o = off; off += (bytes + 255) & ~(size_t)255; return o; } };
static size_t build_args(Args& a, void* const* d_in, void* d_out, unsigned char* ws, size_t base, int cvt_mask, int cvt_layers) {
    a.x = (const float*)d_in[0]; a.pos = (const int*)d_in[1]; a.mix_norm = (const float*)d_in[2]; a.w_in = (const float*)d_in[3]; a.gla_w_up = (const float*)d_in[4]; a.gla_b = (const float*)d_in[5];
    a.ret_gain = (const float*)d_in[6]; a.gla_gain = (const float*)d_in[7]; a.w_out = (const float*)d_in[8]; a.ffn_norm = (const float*)d_in[9]; a.w_gate = (const float*)d_in[10]; a.w_up = (const float*)d_in[11];
    a.w_down = (const float*)d_in[12]; a.final_norm = (const float*)d_in[13]; a.out = (float*)d_out;
    Layout L{base};
    a.ctl = (unsigned*)(ws + L.take(CTL_ZERO_BYTES));
    for (int l = 0; l < 2; ++l) { const bool on = l < cvt_layers;
        a.win_t[l] = (bf16_t*)(ws + ((on && (cvt_mask & 1)) ? L.take((size_t)NPROJ * D * 2) : L.off)); a.wga_t[l] = (bf16_t*)(ws + ((on && (cvt_mask & 1)) ? L.take((size_t)16 * D * 2) : L.off));
        a.wout_t[l] = (bf16_t*)(ws + ((on && (cvt_mask & 2)) ? L.take((size_t)D * D * 2) : L.off)); a.wgu_t[l] = (bf16_t*)(ws + ((on && (cvt_mask & 4)) ? L.take((size_t)2 * FF * D * 2) : L.off));
        a.wd_t[l] = (bf16_t*)(ws + ((on && (cvt_mask & 8)) ? L.take((size_t)D * FF * 2) : L.off)); }
    a.xb = (bf16_t*)(ws + L.take((size_t)T * D * 2)); a.rot = (float*)(ws + L.take((size_t)T * 128 * 4 * 2)); a.ga = (float*)(ws + L.take((size_t)T * 16 * 4)); a.lam = (float*)(ws + L.take((size_t)64 * 1024 * 4));
    a.mixed = (bf16_t*)(ws + L.take((size_t)T * D * 2));
    const size_t ov0 = L.off;
    a.qr = (bf16_t*)(ws + L.take((size_t)T * 2048 * 2)); a.kr = (bf16_t*)(ws + L.take((size_t)T * 2048 * 2)); a.krt = (bf16_t*)(ws + L.take((size_t)T * 2048 * 2)); a.vrt = (bf16_t*)(ws + L.take((size_t)T * 2048 * 2));
    a.srg = (bf16_t*)(ws + L.take((size_t)T * 2048 * 2)); a.gq = (bf16_t*)(ws + L.take((size_t)T * 1024 * 2)); a.gk = (bf16_t*)(ws + L.take((size_t)T * 1024 * 2)); a.qg = (bf16_t*)(ws + L.take((size_t)T * 1024 * 2));
    a.kg = (bf16_t*)(ws + L.take((size_t)T * 1024 * 2)); a.kgt = (bf16_t*)(ws + L.take((size_t)T * 1024 * 2)); a.vgt = (bf16_t*)(ws + L.take((size_t)T * 2048 * 2)); a.sgg = (bf16_t*)(ws + L.take((size_t)T * 2048 * 2));
    a.kvr = (bf16_t*)(ws + L.take((size_t)8 * 64 * 65536 * 2)); a.kvg = (bf16_t*)(ws + L.take((size_t)4 * 64 * 131072 * 2));
    a.h = (bf16_t*)(ws + ov0);
    if (L.off < ov0 + (size_t)T * FF * 2) L.off = ov0 + (size_t)T * FF * 2;
    a.cvt_mask = cvt_mask; a.cvt_layers = cvt_layers;
    return L.off;
}
static int g_grid = 0;
static bool setup_once() {
    if (g_grid) return g_grid > 0;
    int dev = 0, cus = 0, per_cu = 0;
    if (hipGetDevice(&dev) != hipSuccess || hipDeviceGetAttribute(&cus, hipDeviceAttributeMultiprocessorCount, dev) != hipSuccess) { fprintf(stderr, "mk: device query failed\n"); g_grid = -1; return false; }
    if (hipFuncSetAttribute((const void*)mk_fwd, hipFuncAttributeMaxDynamicSharedMemorySize, LDS_BYTES) != hipSuccess) { fprintf(stderr, "mk: hipFuncSetAttribute failed\n"); g_grid = -1; return false; }
    if (hipOccupancyMaxActiveBlocksPerMultiprocessor(&per_cu, (const void*)mk_fwd, NTHR, LDS_BYTES) != hipSuccess || per_cu < 1) { fprintf(stderr, "mk: occupancy query says %d blocks per CU\n", per_cu); (void)hipGetLastError(); }
    g_grid = cus;
    return true;
}
static void launch_range(Args a, int lo, int hi, hipStream_t stream) {
    (void)hipMemsetAsync((char*)a.ctl + (size_t)CW_BAR * 4, 0, (size_t)XCD_BAR_WORDS * 4, stream);
    a.ph_lo = lo; a.ph_hi = hi;
    hipLaunchKernelGGL(mk_fwd, dim3(g_grid), dim3(NTHR), LDS_BYTES, stream, a);
    const hipError_t e = hipPeekAtLastError(); if (e != hipSuccess) fprintf(stderr, "mk: launch [%d,%d) failed: %s\n", lo, hi, hipGetErrorName(e));
}
}
#if MK_DEBUG
namespace nv {
constexpr int T_ = 8192, D_ = 4096, INW = 14352, FF_ = 11008;
constexpr int O_RQ = 0, O_RK = 2048, O_RV = 4096, O_RG = 6144, O_GQ = 8192, O_GK = 9216, O_GV = 10240, O_GG = 12288, O_GA = 14336;

__global__ __launch_bounds__(256) void k_rmsnorm(const float* __restrict__ x, const float* __restrict__ g, float* __restrict__ out) {
    const int row = blockIdx.x; const float* xr = x + (size_t)row * D_;
    float s = 0.f;
    for (int i = threadIdx.x; i < D_; i += 256) { const float v = xr[i]; s += v * v; }
    __shared__ float red[4];
    for (int o = 32; o > 0; o >>= 1) s += __shfl_xor(s, o);
    if ((threadIdx.x & 63) == 0) red[threadIdx.x >> 6] = s;
    __syncthreads();
    s = red[0] + red[1] + red[2] + red[3];
    const float r = 1.0f / sqrtf(s / (float)D_ + 1e-6f);
    for (int i = threadIdx.x; i < D_; i += 256) out[(size_t)row * D_ + i] = xr[i] * r * g[i];
}

template <int EPI>
__global__ __launch_bounds__(256) void k_sgemm(const float* __restrict__ A, const float* __restrict__ B, float* __restrict__ C, const float* __restrict__ R, int M, int N, int K) {
    __shared__ float As[16][132];
    __shared__ float Bs[16][132];
    const int bm = blockIdx.y * 128, bn = blockIdx.x * 128;
    const int tid = threadIdx.x, tx = tid & 15, ty = tid >> 4;
    float acc[8][8];
#pragma unroll
    for (int i = 0; i < 8; ++i)
#pragma unroll
        for (int j = 0; j < 8; ++j) acc[i][j] = 0.f;
    for (int k0 = 0; k0 < K; k0 += 16) {
#pragma unroll
        for (int i = 0; i < 2; ++i) {
            const int idx = tid + i * 256, r = idx >> 2, c4 = (idx & 3) * 4;
            const float4 v = *(const float4*)&A[(size_t)(bm + r) * K + k0 + c4];
            As[c4 + 0][r] = v.x; As[c4 + 1][r] = v.y; As[c4 + 2][r] = v.z; As[c4 + 3][r] = v.w;
        }
#pragma unroll
        for (int i = 0; i < 2; ++i) {
            const int idx = tid + i * 256, kr = idx >> 5, c4 = (idx & 31) * 4;
            float4 v = make_float4(0.f, 0.f, 0.f, 0.f);
            if (bn + c4 < N) v = *(const float4*)&B[(size_t)(k0 + kr) * N + bn + c4];
            *(float4*)&Bs[kr][c4] = v;
        }
        __syncthreads();
#pragma unroll
        for (int kk = 0; kk < 16; ++kk) {
            float a[8], b[8];
            const float4 a0 = *(const float4*)&As[kk][ty * 8], a1 = *(const float4*)&As[kk][ty * 8 + 4];
            const float4 b0 = *(const float4*)&Bs[kk][tx * 8], b1 = *(const float4*)&Bs[kk][tx * 8 + 4];
            a[0] = a0.x; a[1] = a0.y; a[2] = a0.z; a[3] = a0.w; a[4] = a1.x; a[5] = a1.y; a[6] = a1.z; a[7] = a1.w;
            b[0] = b0.x; b[1] = b0.y; b[2] = b0.z; b[3] = b0.w; b[4] = b1.x; b[5] = b1.y; b[6] = b1.z; b[7] = b1.w;
#pragma unroll
            for (int i = 0; i < 8; ++i)
#pragma unroll
                for (int j = 0; j < 8; ++j) acc[i][j] = fmaf(a[i], b[j], acc[i][j]);
        }
        __syncthreads();
    }
#pragma unroll
    for (int i = 0; i < 8; ++i) {
        const int r = bm + ty * 8 + i;
#pragma unroll
        for (int j4 = 0; j4 < 2; ++j4) {
            const int c = bn + tx * 8 + j4 * 4;
            if (c < N) {
                float4 v = make_float4(acc[i][j4 * 4 + 0], acc[i][j4 * 4 + 1], acc[i][j4 * 4 + 2], acc[i][j4 * 4 + 3]);
                if (EPI == 1) { const float4 rr = *(const float4*)&R[(size_t)r * N + c]; v.x += rr.x; v.y += rr.y; v.z += rr.z; v.w += rr.w; }
                if (EPI == 2) { const float4 gg = *(const float4*)&C[(size_t)r * N + c]; v.x *= gg.x / (1.0f + __expf(-gg.x)); v.y *= gg.y / (1.0f + __expf(-gg.y)); v.z *= gg.z / (1.0f + __expf(-gg.z)); v.w *= gg.w / (1.0f + __expf(-gg.w)); }
                *(float4*)&C[(size_t)r * N + c] = v;
            }
        }
    }
}

__device__ __forceinline__ float siluf(float x) { return x / (1.0f + __expf(-x)); }

__global__ __launch_bounds__(256) void k_rotary(float* __restrict__ proj, const int* __restrict__ pos) {
    const size_t gid = (size_t)blockIdx.x * 256 + threadIdx.x;
    const int i = (int)(gid & 127), h = (int)((gid >> 7) & 7), w = (int)((gid >> 10) & 1); const int t = (int)(gid >> 11);
    if (t >= T_) return;
    const float inv_freq = powf(10000.0f, -(float)i / 128.0f);
    const float ang = (float)pos[t] * inv_freq;
    const double rev = (double)ang * 0.15915494309189533577;
    const float fr = (float)(rev - floor(rev));
    const float c = __builtin_amdgcn_cosf(fr), s = __builtin_amdgcn_sinf(fr);
    float* p = proj + (size_t)t * INW + (w ? O_RK : O_RQ) + h * 256 + i;
    const float t1 = p[0], t2 = p[128];
    p[0] = t1 * c - t2 * s; p[128] = t1 * s + t2 * c;
}

__global__ __launch_bounds__(256) void k_gate(const float* __restrict__ proj, const float* __restrict__ wup, const float* __restrict__ b, float* __restrict__ loga) {
    const int t = blockIdx.x;
    const float* ga = proj + (size_t)t * INW + O_GA;
    for (int c = threadIdx.x; c < 1024; c += 256) {
        float z = b[c];
#pragma unroll
        for (int r = 0; r < 16; ++r) z = fmaf(ga[r], wup[r * 1024 + c], z);
        const float ls = fminf(z, 0.f) - log1pf(expf(-fabsf(z)));
        loga[(size_t)t * 1024 + c] = ls * (1.0f / 16.0f);
    }
}

template <int GLA>
__global__ __launch_bounds__(256) void k_recur(const float* __restrict__ proj, int qoff, int koff, int voff, int dv, const float* __restrict__ loga, float qs, float ks, float* __restrict__ out, int ostride) {
    const int vt = blockIdx.x, h = blockIdx.y, d = threadIdx.x, lane = d & 63, wave = d >> 6;
    float S[16];
#pragma unroll
    for (int j = 0; j < 16; ++j) S[j] = 0.f;
    const float gamma = 1.0f - exp2f(-5.0f - (float)h);
    __shared__ float part[2][4][16];
    for (int t = 0; t < T_; ++t) {
        const float* row = proj + (size_t)t * INW;
        const float q = row[qoff + h * 256 + d] * qs, k = row[koff + h * 256 + d] * ks;
        const float a = GLA ? expf(loga[(size_t)t * 1024 + h * 256 + d]) : gamma;
        float p[16];
#pragma unroll
        for (int j4 = 0; j4 < 4; ++j4) {
            const float4 v = *(const float4*)&row[voff + h * dv + vt * 16 + j4 * 4];
            S[j4 * 4 + 0] = a * S[j4 * 4 + 0] + k * v.x; S[j4 * 4 + 1] = a * S[j4 * 4 + 1] + k * v.y;
            S[j4 * 4 + 2] = a * S[j4 * 4 + 2] + k * v.z; S[j4 * 4 + 3] = a * S[j4 * 4 + 3] + k * v.w;
        }
#pragma unroll
        for (int j = 0; j < 16; ++j) p[j] = q * S[j];
#pragma unroll
        for (int j = 0; j < 16; ++j)
#pragma unroll
            for (int o = 32; o > 0; o >>= 1) p[j] += __shfl_xor(p[j], o);
        if (lane == 0) {
#pragma unroll
            for (int j = 0; j < 16; ++j) part[t & 1][wave][j] = p[j];
        }
        __syncthreads();
        if (d < 16) out[(size_t)t * ostride + h * dv + vt * 16 + d] = part[t & 1][0][d] + part[t & 1][1][d] + part[t & 1][2][d] + part[t & 1][3][d];
    }
}

__global__ __launch_bounds__(256) void k_headnorm(const float* __restrict__ proj, const float* __restrict__ ro, const float* __restrict__ go, const float* __restrict__ rgain, const float* __restrict__ ggain, float* __restrict__ mixed) {
    const int t = blockIdx.x, tid = threadIdx.x, lane = tid & 63, wave = tid >> 6;
    const float* row = proj + (size_t)t * INW;
    for (int hh = 0; hh < 2; ++hh) {
        const int h = wave * 2 + hh;
        float v[4]; float s = 0.f;
#pragma unroll
        for (int j = 0; j < 4; ++j) { v[j] = ro[(size_t)t * 2048 + h * 256 + lane + 64 * j]; s += v[j]; }
        for (int o = 32; o > 0; o >>= 1) s += __shfl_xor(s, o);
        const float mu = s / 256.f; float q = 0.f;
#pragma unroll
        for (int j = 0; j < 4; ++j) { v[j] -= mu; q += v[j] * v[j]; }
        for (int o = 32; o > 0; o >>= 1) q += __shfl_xor(q, o);
        const float rs = 1.0f / sqrtf(q / 256.f + 1e-6f);
#pragma unroll
        for (int j = 0; j < 4; ++j) { const int c = h * 256 + lane + 64 * j; mixed[(size_t)t * D_ + c] = siluf(row[O_RG + c]) * (v[j] * rs * rgain[c]); }
    }
    {
        const int h = wave;
        float v[8]; float q = 0.f;
#pragma unroll
        for (int j = 0; j < 8; ++j) { v[j] = go[(size_t)t * 2048 + h * 512 + lane + 64 * j]; q += v[j] * v[j]; }
        for (int o = 32; o > 0; o >>= 1) q += __shfl_xor(q, o);
        const float rs = 1.0f / sqrtf(q / 512.f + 1e-6f);
#pragma unroll
        for (int j = 0; j < 8; ++j) { const int c = h * 512 + lane + 64 * j; mixed[(size_t)t * D_ + 2048 + c] = siluf(row[O_GG + c]) * (v[j] * rs * ggain[c]); }
    }
}

__global__ __launch_bounds__(256) void k_swiglu(float* __restrict__ G, const float* __restrict__ U, size_t n4) {
    for (size_t i = (size_t)blockIdx.x * 256 + threadIdx.x; i < n4; i += (size_t)gridDim.x * 256) {
        float4 g = ((float4*)G)[i]; const float4 u = ((const float4*)U)[i];
        g.x = siluf(g.x) * u.x; g.y = siluf(g.y) * u.y; g.z = siluf(g.z) * u.z; g.w = siluf(g.w) * u.w;
        ((float4*)G)[i] = g;
    }
}

inline void forward(void* const* d_in, float* out, float* ws, size_t ws_size, hipStream_t st) {
    const float* x = (const float*)d_in[0]; const int* pos = (const int*)d_in[1];
    const float* mix_norm = (const float*)d_in[2]; const float* w_in = (const float*)d_in[3];
    const float* gla_w_up = (const float*)d_in[4]; const float* gla_b = (const float*)d_in[5];
    const float* ret_gain = (const float*)d_in[6]; const float* gla_gain = (const float*)d_in[7];
    const float* w_out = (const float*)d_in[8]; const float* ffn_norm = (const float*)d_in[9];
    const float* w_gate = (const float*)d_in[10]; const float* w_up = (const float*)d_in[11]; const float* w_down = (const float*)d_in[12];
    const float* final_norm = (const float*)d_in[13];
    size_t o = 0;
    float* xn = ws + o; o += (size_t)T_ * D_;
    float* proj = ws + o; o += (size_t)T_ * INW;
    float* loga = ws + o; o += (size_t)T_ * 1024;
    float* ro = ws + o; o += (size_t)T_ * 2048;
    float* go = ws + o; o += (size_t)T_ * 2048;
    float* mixed = ws + o; o += (size_t)T_ * D_;
    float* xa = ws + o; o += (size_t)T_ * D_;
    float* xb = ws + o; o += (size_t)T_ * D_;
    float* G = ws + o; o += (size_t)T_ * FF_;
    if (o * 4 > ws_size) { fprintf(stderr, "naive: ws too small: need %zu have %zu\n", o * 4, ws_size); return; }
    const float* xc = x;
    for (int l = 0; l < 2; ++l) {
        k_rmsnorm<<<T_, 256, 0, st>>>(xc, mix_norm + (size_t)l * D_, xn);
        k_sgemm<0><<<dim3((INW + 127) / 128, T_ / 128), 256, 0, st>>>(xn, w_in + (size_t)l * D_ * INW, proj, nullptr, T_, INW, D_);
        k_rotary<<<(T_ * 2048) / 256, 256, 0, st>>>(proj, pos);
        k_gate<<<T_, 256, 0, st>>>(proj, gla_w_up + (size_t)l * 16 * 1024, gla_b + (size_t)l * 1024, loga);
        k_recur<0><<<dim3(16, 8), 256, 0, st>>>(proj, O_RQ, O_RK, O_RV, 256, nullptr, 1.0f, 1.0f / 16.0f, ro, 2048);
        k_recur<1><<<dim3(32, 4), 256, 0, st>>>(proj, O_GQ, O_GK, O_GV, 512, loga, 1.0f / 16.0f, 1.0f, go, 2048);
        k_headnorm<<<T_, 256, 0, st>>>(proj, ro, go, ret_gain + (size_t)l * 2048, gla_gain + (size_t)l * 2048, mixed);
        k_sgemm<1><<<dim3(D_ / 128, T_ / 128), 256, 0, st>>>(mixed, w_out + (size_t)l * D_ * D_, xa, xc, T_, D_, D_);
        k_rmsnorm<<<T_, 256, 0, st>>>(xa, ffn_norm + (size_t)l * D_, xn);
        k_sgemm<0><<<dim3(FF_ / 128, T_ / 128), 256, 0, st>>>(xn, w_gate + (size_t)l * D_ * FF_, G, nullptr, T_, FF_, D_);
        k_sgemm<2><<<dim3(FF_ / 128, T_ / 128), 256, 0, st>>>(xn, w_up + (size_t)l * D_ * FF_, G, nullptr, T_, FF_, D_);
        k_sgemm<1><<<dim3(D_ / 128, T_ / 128), 256, 0, st>>>(G, w_down + (size_t)l * FF_ * D_, xb, xa, T_, D_, FF_);
        xc = xb;
    }
    k_rmsnorm<<<T_, 256, 0, st>>>(xc, final_norm, out);
}
}
#endif
#if MK_DEBUG
namespace dbg {
typedef unsigned short bf16_t;
constexpr int T = 8192, INW = 14352;
__device__ __forceinline__ float bf(bf16_t v) { return __uint_as_float((unsigned)v << 16); }
__device__ __forceinline__ void acc2(float* slot, float se, float sb) {
    for (int o = 32; o > 0; o >>= 1) { se += __shfl_xor(se, o); sb += __shfl_xor(sb, o); }
    if ((threadIdx.x & 63) == 0) { atomicAdd(slot, se); atomicAdd(slot + 1, sb); }
}
__global__ void k_cmp_bf16(const bf16_t* got, int gld, int transposed, const float* ref, int rld, int roff, int rows, int cols, int mode, float scale, float* slot) {
    float se = 0.f, sb = 0.f;
    for (size_t i = (size_t)blockIdx.x * blockDim.x + threadIdx.x; i < (size_t)rows * cols; i += (size_t)gridDim.x * blockDim.x) {
        const int r = (int)(i / cols), c = (int)(i % cols);
        float e = ref[(size_t)r * rld + roff + c] * scale;
        if (mode == 1) e = e / (1.0f + expf(-e));
        if (mode == 2 || mode == 3) { const int h = c >> 8; const float lg = log2f(1.0f - exp2f(-5.0f - (float)h)); const float ip1 = (float)((r & 127) + 1); e *= (mode == 2) ? exp2f(ip1 * lg) : exp2f(-ip1 * lg) * 0.0625f; }
        const float g = transposed ? bf(got[(size_t)c * gld + r]) : bf(got[(size_t)r * gld + c]);
        const float d = g - e; se += (d == d) ? d * d : 1e30f; sb += e * e;
    }
    acc2(slot, se, sb);
}
__global__ void k_cmp_f32(const float* got, int gld, const float* ref, int rld, int roff, int rows, int cols, float* slot) {
    float se = 0.f, sb = 0.f;
    for (size_t i = (size_t)blockIdx.x * blockDim.x + threadIdx.x; i < (size_t)rows * cols; i += (size_t)gridDim.x * blockDim.x) {
        const int r = (int)(i / cols), c = (int)(i % cols);
        const float e = ref[(size_t)r * rld + roff + c], g = got[(size_t)r * gld + c]; const float d = g - e; se += (d == d) ? d * d : 1e30f; sb += e * e; }
    acc2(slot, se, sb);
}
__global__ void k_cmp_tr(const bf16_t* a, int ald, const bf16_t* b, int bld, int rows, int cols, float* slot) {
    float se = 0.f, sb = 0.f;
    for (size_t i = (size_t)blockIdx.x * blockDim.x + threadIdx.x; i < (size_t)rows * cols; i += (size_t)gridDim.x * blockDim.x) {
        const int r = (int)(i / cols), c = (int)(i % cols); const float e = bf(a[(size_t)r * ald + c]), g = bf(b[(size_t)c * bld + r]); const float d = g - e; se += (d == d) ? d * d : 1e30f; sb += e * e; }
    acc2(slot, se, sb);
}
__global__ void k_cmp_ss(const float* ss, const float* ref, int rld, float* slot) {
    const int t = blockIdx.x; float s = 0.f; for (int i = threadIdx.x; i < 4096; i += 256) { const float v = ref[(size_t)t * rld + i]; s += v * v; }
    __shared__ float red[4]; for (int o = 32; o > 0; o >>= 1) s += __shfl_xor(s, o); if ((threadIdx.x & 63) == 0) red[threadIdx.x >> 6] = s; __syncthreads();
    if (threadIdx.x == 0) { const float e = red[0] + red[1] + red[2] + red[3], d = ss[t] - e; atomicAdd(slot, (d == d) ? d * d : 1e30f); atomicAdd(slot + 1, e * e); }
}
__global__ void k_cmp_gla(const bf16_t* qg, const bf16_t* kg, const float* lam, const float* proj, const float* loga, float* slot_q, float* slot_k, float* slot_l) {
    const int c = blockIdx.x, ch = blockIdx.y * 256 + threadIdx.x; float cum = 0.f, seq = 0.f, sbq = 0.f, sek = 0.f, sbk = 0.f;
    for (int tt = 0; tt < 128; ++tt) { const int t = c * 128 + tt; cum += loga[(size_t)t * 1024 + ch];
        const float eq = proj[(size_t)t * INW + 8192 + ch] * 0.0625f * expf(cum), ek = proj[(size_t)t * INW + 9216 + ch] * expf(-cum);
        float d = bf(qg[(size_t)t * 1024 + ch]) - eq; seq += (d == d) ? d * d : 1e30f; sbq += eq * eq; d = bf(kg[(size_t)t * 1024 + ch]) - ek; sek += (d == d) ? d * d : 1e30f; sbk += ek * ek; }
    const float el = expf(cum), dl = lam[c * 1024 + ch] - el;
    acc2(slot_q, seq, sbq); acc2(slot_k, sek, sbk); acc2(slot_l, (dl == dl) ? dl * dl : 1e30f, el * el);
}
__global__ void k_cmp_kv(const bf16_t* kb, int ldk, const bf16_t* vt, const bf16_t* kv, int DV, float* slot) {
    const int c = blockIdx.x, h = blockIdx.y, t0 = c * 128; float se = 0.f, sb = 0.f;
    for (int idx = threadIdx.x; idx < DV * 256; idx += 256) { const int v = idx >> 8, d = idx & 255; float e = 0.f;
        for (int j = 0; j < 128; ++j) e += bf(vt[(size_t)(h * DV + v) * T + t0 + j]) * bf(kb[(size_t)(t0 + j) * ldk + h * 256 + d]);
        const float g = bf(kv[((size_t)(h * 64 + c) * DV + v) * 256 + d]); const float dd = g - e; se += (dd == dd) ? dd * dd : 1e30f; sb += e * e; }
    acc2(slot, se, sb);
}
__global__ void k_cmp_s(const bf16_t* kb, int ldk, const bf16_t* vt, const bf16_t* sbuf, const float* lam, int DV, float* slot) {
    const int h = blockIdx.y; const int idx = blockIdx.x * 256 + threadIdx.x; const int v = idx >> 8, d = idx & 255; float se = 0.f, sb = 0.f, st = 0.f;
    const float lret = exp2f(128.0f * log2f(1.0f - exp2f(-5.0f - (float)h)));
    for (int c = 0; c < 64; ++c) { const float g = bf(sbuf[((size_t)(h * 64 + c) * DV + v) * 256 + d]); const float dd = g - st; se += (dd == dd) ? dd * dd : 1e30f; sb += st * st;
        float e = 0.f; for (int j = 0; j < 128; ++j) e += bf(vt[(size_t)(h * DV + v) * T + c * 128 + j]) * bf(kb[(size_t)(c * 128 + j) * ldk + h * 256 + d]);
        st = (lam ? lam[c * 1024 + h * 256 + d] : lret) * (st + e); }
    acc2(slot, se, sb);
}
__global__ void k_cmp_p(const bf16_t* q, const bf16_t* k, const bf16_t* pd, float* slot) {
    const int c = blockIdx.x, h = blockIdx.y, t0 = c * 128; float se[4] = {0.f, 0.f, 0.f, 0.f}, sb[4] = {0.f, 0.f, 0.f, 0.f};
    for (int idx = threadIdx.x; idx < 16384; idx += 256) { const int i = idx >> 7, j = idx & 127; float e = 0.f;
        for (int d = 0; d < 256; ++d) e += bf(q[(size_t)(t0 + i) * 2048 + h * 256 + d]) * bf(k[(size_t)(t0 + j) * 2048 + h * 256 + d]);
        const int cls = (j > i) ? 3 : ((i >> 4) != (j >> 4)) ? 0 : (j < i) ? 1 : 2;
        const float g = bf(pd[(size_t)(h * 64 + c) * 16384 + idx]); const float ee = (cls == 3) ? 0.f : e; const float dd = g - ee;
#pragma unroll
        for (int z = 0; z < 4; ++z) if (cls == z) { se[z] += (dd == dd) ? dd * dd : 1e30f; sb[z] += (z == 3) ? e * e : ee * ee; } }
#pragma unroll
    for (int z = 0; z < 4; ++z) acc2(slot + 2 * z, se[z], sb[z]);
}
__global__ void k_cmp_o(const bf16_t* q, const bf16_t* pd, const bf16_t* vt, const bf16_t* sbuf, const float* od, float* slot) {
    const int t = blockIdx.x, h = blockIdx.y, v = threadIdx.x, c = t >> 7, i = t & 127; float e = 0.f;
    for (int j = 0; j < 128; ++j) e += bf(pd[(size_t)(h * 64 + c) * 16384 + i * 128 + j]) * bf(vt[(size_t)(h * 256 + v) * T + c * 128 + j]);
    for (int d = 0; d < 256; ++d) e += bf(q[(size_t)t * 2048 + h * 256 + d]) * bf(sbuf[((size_t)(h * 64 + c) * 256 + v) * 256 + d]);
    const float g = od[(size_t)t * 2048 + h * 256 + v]; const float dd = g - e; acc2(slot, (dd == dd) ? dd * dd : 1e30f, e * e);
}
__global__ void k_decide(const float* slots, int n, const float* tol, float* code) {
    if (threadIdx.x || blockIdx.x) return; float cd = 9900.0f;
    for (int i = 0; i < n; ++i) { const float se = slots[2 * i], sb = slots[2 * i + 1]; const float rel = sqrtf(se / fmaxf(sb, 1e-30f));
        if (!(rel < tol[i]) || !(sb > 0.f)) { int b = (rel == rel && rel > 0.f) ? (int)floorf(2.0f * log10f(fmaxf(rel, 1e-3f) / 1e-3f)) : 20; b = b < 0 ? 0 : (b > 20 ? 20 : b); cd = (float)(10 + i) * powf(10.0f, (float)(2 + b)); break; } }
    *code = cd;
}
__global__ void k_fill_code(float* out, size_t n, const float* code) { const float c = *code; for (size_t i = (size_t)blockIdx.x * blockDim.x + threadIdx.x; i < n; i += (size_t)gridDim.x * blockDim.x) out[i] = c; }
}

extern "C" void kernel_launch(void* const* d_in, const int* in_sizes, int n_in, void* d_out, int out_size, void* d_ws, size_t ws_size, hipStream_t stream) {
    using namespace nv;
    if (!mk::setup_once()) return;
    hipStream_t st = stream; float* ws = (float*)d_ws;
    const float* x = (const float*)d_in[0]; const int* pos = (const int*)d_in[1]; const float* mix_norm = (const float*)d_in[2]; const float* w_in = (const float*)d_in[3];
    const float* gla_w_up = (const float*)d_in[4]; const float* gla_b = (const float*)d_in[5]; const float* ret_gain = (const float*)d_in[6]; const float* gla_gain = (const float*)d_in[7];
    const float* w_out = (const float*)d_in[8]; const float* ffn_norm = (const float*)d_in[9]; const float* w_gate = (const float*)d_in[10]; const float* w_up = (const float*)d_in[11]; const float* w_down = (const float*)d_in[12];
#if MK_DEBUG == 1
    size_t o = 0;
    float* xn = ws + o; o += (size_t)T_ * D_; float* proj = ws + o; o += (size_t)T_ * INW; float* loga = ws + o; o += (size_t)T_ * 1024; float* ro = ws + o; o += (size_t)T_ * 2048; float* go = ws + o; o += (size_t)T_ * 2048;
    float* mixed = ws + o; o += (size_t)T_ * D_; float* xa = ws + o; o += (size_t)T_ * D_;
    mk::Args a{}; size_t need = mk::build_args(a, d_in, d_out, (unsigned char*)d_ws, o * 4, 3, 1);
    a.dbgp = (bf16_t*)((unsigned char*)d_ws + need); need += (size_t)8 * 64 * 16384 * 2; a.dbgo = (float*)((unsigned char*)d_ws + need); need += (size_t)T_ * 2048 * 4;
    if (need > ws_size) { fprintf(stderr, "dbg: ws too small %zu > %zu\n", need, ws_size); return; }
    (void)hipMemsetAsync(a.ctl, 0, mk::CTL_ZERO_BYTES, st);
    k_rmsnorm<<<T_, 256, 0, st>>>(x, mix_norm, xn);
    k_sgemm<0><<<dim3((INW + 127) / 128, T_ / 128), 256, 0, st>>>(xn, w_in, proj, nullptr, T_, INW, D_);
    k_rotary<<<(T_ * 2048) / 256, 256, 0, st>>>(proj, pos);
    k_gate<<<T_, 256, 0, st>>>(proj, gla_w_up, gla_b, loga);
    k_recur<0><<<dim3(16, 8), 256, 0, st>>>(proj, O_RQ, O_RK, O_RV, 256, nullptr, 1.0f, 1.0f / 16.0f, ro, 2048);
    k_recur<1><<<dim3(32, 4), 256, 0, st>>>(proj, O_GQ, O_GK, O_GV, 512, loga, 1.0f / 16.0f, 1.0f, go, 2048);
    k_headnorm<<<T_, 256, 0, st>>>(proj, ro, go, ret_gain, gla_gain, mixed);
    k_sgemm<1><<<dim3(D_ / 128, T_ / 128), 256, 0, st>>>(mixed, w_out, xa, x, T_, D_, D_);
    float* slots = (float*)(a.ctl + mk::CW_CHK); float* tol = slots + 128; float* code = slots + 256;
#if MK_DBG_ONELAUNCH
    mk::launch_range(a, 0, 7, st);
#else
    for (int p = 0; p < 4; ++p) mk::launch_range(a, p, p + 1, st);
    dbg::k_cmp_kv<<<dim3(64, 8), 256, 0, st>>>(a.kr, 2048, a.vrt, a.kvr, 256, slots + 2 * 15);
    dbg::k_cmp_kv<<<dim3(64, 4), 256, 0, st>>>(a.kg, 1024, a.vgt, a.kvg, 512, slots + 2 * 16);
    mk::launch_range(a, 4, 5, st);
    dbg::k_cmp_s<<<dim3(256, 8), 256, 0, st>>>(a.kr, 2048, a.vrt, a.kvr, nullptr, 256, slots + 2 * 17);
    dbg::k_cmp_s<<<dim3(512, 4), 256, 0, st>>>(a.kg, 1024, a.vgt, a.kvg, a.lam, 512, slots + 2 * 18);
    mk::launch_range(a, 5, 6, st); mk::launch_range(a, 6, 7, st);
#endif
    const float* ss0 = (const float*)(a.ctl + mk::CW_SS); const float* ss1 = ss0 + T_;
    int n = 0; float htol[64];
    dim3 cg(2048), cb(256);
    dbg::k_cmp_ss<<<T_, 256, 0, st>>>(ss0, x, D_, slots + 2 * n); htol[n++] = 1e-4f;
    dbg::k_cmp_bf16<<<cg, cb, 0, st>>>(a.qr, 2048, 0, proj, INW, O_RQ, T_, 2048, 2, 1.0f, slots + 2 * n); htol[n++] = 1e-2f;
    dbg::k_cmp_bf16<<<cg, cb, 0, st>>>(a.kr, 2048, 0, proj, INW, O_RK, T_, 2048, 3, 1.0f, slots + 2 * n); htol[n++] = 1e-2f;
    dbg::k_cmp_bf16<<<cg, cb, 0, st>>>(a.vrt, T_, 1, proj, INW, O_RV, T_, 2048, 0, 1.0f, slots + 2 * n); htol[n++] = 1e-2f;
    dbg::k_cmp_bf16<<<cg, cb, 0, st>>>(a.srg, 2048, 0, proj, INW, O_RG, T_, 2048, 1, 1.0f, slots + 2 * n); htol[n++] = 1e-2f;
    dbg::k_cmp_bf16<<<cg, cb, 0, st>>>(a.gq, 1024, 0, proj, INW, O_GQ, T_, 1024, 0, 0.0625f, slots + 2 * n); htol[n++] = 1e-2f;
    dbg::k_cmp_bf16<<<cg, cb, 0, st>>>(a.gk, 1024, 0, proj, INW, O_GK, T_, 1024, 0, 1.0f, slots + 2 * n); htol[n++] = 1e-2f;
    dbg::k_cmp_bf16<<<cg, cb, 0, st>>>(a.vgt, T_, 1, proj, INW, O_GV, T_, 2048, 0, 1.0f, slots + 2 * n); htol[n++] = 1e-2f;
    dbg::k_cmp_bf16<<<cg, cb, 0, st>>>(a.sgg, 2048, 0, proj, INW, O_GG, T_, 2048, 1, 1.0f, slots + 2 * n); htol[n++] = 1e-2f;
    dbg::k_cmp_f32<<<cg, cb, 0, st>>>(a.ga, 16, proj, INW, O_GA, T_, 16, slots + 2 * n); htol[n++] = 1e-2f;
    dbg::k_cmp_tr<<<cg, cb, 0, st>>>(a.kr, 2048, a.krt, T_, T_, 2048, slots + 2 * n); htol[n++] = 1e-6f;
    dbg::k_cmp_gla<<<dim3(64, 4), 256, 0, st>>>(a.qg, a.kg, a.lam, proj, loga, slots + 2 * n, slots + 2 * (n + 1), slots + 2 * (n + 2)); htol[n++] = 2e-2f; htol[n++] = 2e-2f; htol[n++] = 2e-2f;
    dbg::k_cmp_tr<<<cg, cb, 0, st>>>(a.kg, 1024, a.kgt, T_, T_, 1024, slots + 2 * n); htol[n++] = 1e-6f;
#if MK_DBG_ONELAUNCH
    for (int i = 0; i < 4; ++i) { unsigned one = 0x3f800000u; (void)hipMemsetD32Async((hipDeviceptr_t)(slots + 2 * (15 + i) + 1), (int)one, 1, st); }
#endif
    htol[n++] = 1e-2f; htol[n++] = 1e-2f; htol[n++] = 1e-2f; htol[n++] = 1e-2f;
    dbg::k_cmp_p<<<dim3(64, 8), 256, 0, st>>>(a.qr, a.kr, a.dbgp, slots + 2 * n); htol[n++] = 1e-2f; htol[n++] = 1e-2f; htol[n++] = 1e-2f; htol[n++] = 1e-2f;
    dbg::k_cmp_o<<<dim3(T_, 8), 256, 0, st>>>(a.qr, a.dbgp, a.vrt, a.kvr, a.dbgo, slots + 2 * n); htol[n++] = 1e-2f;
    dbg::k_cmp_bf16<<<cg, cb, 0, st>>>(a.mixed, 4096, 0, mixed, D_, 0, T_, 2048, 0, 1.0f, slots + 2 * n); htol[n++] = 3e-2f;
    dbg::k_cmp_bf16<<<cg, cb, 0, st>>>(a.mixed + 2048, 4096, 0, mixed, D_, 2048, T_, 2048, 0, 1.0f, slots + 2 * n); htol[n++] = 3e-2f;
    dbg::k_cmp_f32<<<cg, cb, 0, st>>>((const float*)d_out, D_, xa, D_, 0, T_, D_, slots + 2 * n); htol[n++] = 1e-2f;
    dbg::k_cmp_bf16<<<cg, cb, 0, st>>>(a.xb, 4096, 0, xa, D_, 0, T_, D_, 0, 1.0f, slots + 2 * n); htol[n++] = 1e-2f;
    dbg::k_cmp_ss<<<T_, 256, 0, st>>>(ss1, xa, D_, slots + 2 * n); htol[n++] = 1e-2f;
#else
    size_t o = 0;
    float* xn = ws + o; o += (size_t)T_ * D_; float* xa = ws + o; o += (size_t)T_ * D_; float* xb2 = ws + o; o += (size_t)T_ * D_; float* G = ws + o; o += (size_t)T_ * FF_;
    mk::Args a{}; const size_t need = mk::build_args(a, d_in, d_out, (unsigned char*)d_ws, o * 4, 12, 1);
    if (need > ws_size) { fprintf(stderr, "dbg: ws too small %zu > %zu\n", need, ws_size); return; }
    (void)hipMemsetAsync(a.ctl, 0, mk::CTL_ZERO_BYTES, st);
    (void)hipMemcpyAsync(xa, x, (size_t)T_ * D_ * 4, hipMemcpyDeviceToDevice, st);
    (void)hipMemcpyAsync(d_out, x, (size_t)T_ * D_ * 4, hipMemcpyDeviceToDevice, st);
    k_rmsnorm<<<T_, 256, 0, st>>>(xa, ffn_norm, xn);
    k_sgemm<0><<<dim3(FF_ / 128, T_ / 128), 256, 0, st>>>(xn, w_gate, G, nullptr, T_, FF_, D_);
    k_sgemm<2><<<dim3(FF_ / 128, T_ / 128), 256, 0, st>>>(xn, w_up, G, nullptr, T_, FF_, D_);
    k_sgemm<1><<<dim3(D_ / 128, T_ / 128), 256, 0, st>>>(G, w_down, xb2, xa, T_, D_, FF_);
    mk::launch_range(a, 0, 1, st);
    (void)hipMemcpyAsync((float*)(a.ctl + mk::CW_SS) + T_, (float*)(a.ctl + mk::CW_SS), (size_t)T_ * 4, hipMemcpyDeviceToDevice, st);
#if MK_DBG_ONELAUNCH
    mk::launch_range(a, 7, 9, st);
#else
    mk::launch_range(a, 7, 8, st); mk::launch_range(a, 8, 9, st);
#endif
    float* slots = (float*)(a.ctl + mk::CW_CHK); float* tol = slots + 128; float* code = slots + 256;
    const float* ss2 = (const float*)(a.ctl + mk::CW_SS) + 2 * T_;
    int n = 0; float htol[64]; dim3 cg(2048), cb(256);
    dbg::k_cmp_bf16<<<cg, cb, 0, st>>>(a.h, FF_, 0, G, FF_, 0, T_, FF_, 0, 1.0f, slots + 2 * n); htol[n++] = 2e-2f;
    dbg::k_cmp_f32<<<cg, cb, 0, st>>>((const float*)d_out, D_, xb2, D_, 0, T_, D_, slots + 2 * n); htol[n++] = 1e-2f;
    dbg::k_cmp_bf16<<<cg, cb, 0, st>>>(a.xb, 4096, 0, xb2, D_, 0, T_, D_, 0, 1.0f, slots + 2 * n); htol[n++] = 1e-2f;
    dbg::k_cmp_ss<<<T_, 256, 0, st>>>(ss2, xb2, D_, slots + 2 * n); htol[n++] = 1e-2f;
#endif
    for (int i = 0; i < n; ++i) { unsigned bits; memcpy(&bits, &htol[i], 4); (void)hipMemsetD32Async((hipDeviceptr_t)(tol + i), (int)bits, 1, st); }
    dbg::k_decide<<<1, 64, 0, st>>>(slots, n, tol, code);
    dbg::k_fill_code<<<2048, 256, 0, st>>>((float*)d_out, (size_t)T_ * D_, code);
}
#endif

#if !MK_DEBUG
extern "C" void kernel_launch(void* const* d_in, const int* in_sizes, int n_in, void* d_out, int out_size, void* d_ws, size_t ws_size, hipStream_t stream) {
    if (!mk::setup_once()) return;
    mk::Args a{};
    const size_t need = mk::build_args(a, d_in, d_out, (unsigned char*)d_ws, 0, 15, 2);
    if (need > ws_size || n_in != 14) { fprintf(stderr, "mk: workspace too small (%zu > %zu) or wrong input count %d\n", need, ws_size, n_in); return; }
    (void)hipMemsetAsync(d_ws, 0, mk::CTL_ZERO_BYTES, stream);
#if MK_SPLIT
    for (int p = 0; p < mk::N_PHASES; ++p) mk::launch_range(a, p, p + 1, stream);
#else
    mk::launch_range(a, 0, mk::N_PHASES, stream);
#endif
}
#endif
```

```cpp
#include <hip/hip_runtime.h>
#include <cstdio>
#include <cstdint>
#include <cstring>
#define MK_DEBUG 0
#define MK_SPLIT 0
#define MK_DBG_ONELAUNCH 0
namespace pg8 {
#define PG8_LAS __attribute__((address_space(3)))
typedef unsigned short bf16_t;
typedef short bf16x8 __attribute__((ext_vector_type(8)));
typedef float f32x4 __attribute__((ext_vector_type(4)));
typedef unsigned u32x4 __attribute__((ext_vector_type(4)));
constexpr int BM = 256, BK = 64, HALF = 128, HTB = HALF * BK * 2  , STAGE_BYTES = 8 * HTB, NXCD = 8, WGM = 8;

__host__ __device__ __forceinline__ int lds_byte(int r, int c) { const int st = (r >> 4) * 2 + (c >> 5), rr = r & 15, cc = c & 31, ob = rr * 64 + cc * 2; return st * 1024 + (ob ^ (((ob >> 9) & 1) << 5)); }
__host__ __device__ __forceinline__ void stage_rc(int b, int& R, int& C) { const int st = b / 1024, sb = b % 1024, swz = sb ^ (((sb >> 9) & 1) << 5); R = (st >> 1) * 16 + swz / 64; C = (st & 1) * 32 + (swz % 64) / 2; }
__host__ __device__ __forceinline__ int perm32(int rho) { const int n = rho >> 4, i = rho & 15; return 8 * (i >> 2) + 4 * n + (i & 3); }

struct Unit { int pm, pn, sw; };
struct Gemm { const bf16_t* A; const bf16_t* Bt; int K; };

struct StaticOrder {
    int nM, nN, nwg, G, c;
    __host__ __device__ void init(int nM_, int nN_, int G_, int c_) { nM = nM_; nN = nN_; nwg = nM * nN; G = G_; c = c_; }
    __host__ __device__ bool next(int i, Unit& u) const {
        const long L = (long)i * G + c; if (L >= nwg) return false;
        int wgid = (int)L; { const int q = nwg / NXCD, r = nwg % NXCD, xcd = wgid % NXCD, off = wgid / NXCD; wgid = (xcd < r ? xcd * (q + 1) : r * (q + 1) + (xcd - r) * q) + off; }
        const int nig = WGM * nN, gid = wgid / nig, fm = gid * WGM, gsz = (nM - fm) < WGM ? (nM - fm) : WGM;
        u.pm = fm + ((wgid % nig) % gsz); u.pn = (wgid % nig) / gsz; u.sw = 0; return true;
    }
    __device__ __forceinline__ void a_ready(const Unit&) const {}
    __device__ __forceinline__ void done(const Unit&) const {}
};


typedef __bf16 bf16x2v __attribute__((ext_vector_type(2)));
__device__ __forceinline__ unsigned cvt_pk_bf16(float lo, float hi) { bf16x2v v; v[0] = (__bf16)lo; v[1] = (__bf16)hi; return __builtin_bit_cast(unsigned, v); }
__device__ __forceinline__ u32x4 pack8(const f32x4 a, const f32x4 b) { u32x4 w; w.x = cvt_pk_bf16(a[0], a[1]); w.y = cvt_pk_bf16(a[2], a[3]); w.z = cvt_pk_bf16(b[0], b[1]); w.w = cvt_pk_bf16(b[2], b[3]); return w; }
__device__ __forceinline__ float rs_of(float ss) { return 1.0f / sqrtf(ss * (1.0f / 4096.0f) + 1e-6f); }
__device__ __forceinline__ f32x4 silu4(const f32x4 v) { f32x4 o; o[0] = v[0] / (1.0f + __expf(-v[0])); o[1] = v[1] / (1.0f + __expf(-v[1])); o[2] = v[2] / (1.0f + __expf(-v[2])); o[3] = v[3] / (1.0f + __expf(-v[3])); return o; }

constexpr int TT = 8192;

struct EpiProj {
    static constexpr bool PERM = true, AFTER_DRAIN = false;
    const float* ss;
    const float* rot;
    bf16_t *qr, *kr, *vrt, *srg, *gq, *gk, *vgt, *sgg;
    __device__ __forceinline__ void operator()(const f32x4 (&acc)[2][2][4][2], const Unit& u, int wr, int wc, int fr, int fq) const {
        const int pn = u.pn;
        if (u.sw) {
            bf16_t* dst = (pn < 24) ? vrt + (size_t)(pn - 16) * 256 * TT : vgt + (size_t)(pn - 40) * 256 * TT;
            const int tc0 = u.pm * BM + wc * 32 + 8 * fq;
            f32x4 rs[2][2];
#pragma unroll
            for (int bj = 0; bj < 2; ++bj)
#pragma unroll
                for (int n = 0; n < 2; ++n) { const f32x4 s = *(const f32x4*)(ss + tc0 + bj * HALF + 4 * n); rs[bj][n] = (f32x4){rs_of(s[0]), rs_of(s[1]), rs_of(s[2]), rs_of(s[3])}; }
#pragma unroll
            for (int ai = 0; ai < 2; ++ai)
#pragma unroll
                for (int m = 0; m < 4; ++m) { bf16_t* rowp = dst + (size_t)(ai * HALF + wr * 64 + m * 16 + fr) * TT + tc0;
#pragma unroll
                    for (int bj = 0; bj < 2; ++bj) *(u32x4*)(rowp + bj * HALF) = pack8(acc[ai][bj][m][0] * rs[bj][0], acc[ai][bj][m][1] * rs[bj][1]); }
            return;
        }
        const int t0 = u.pm * BM + wr * 64 + fr;
        const int cl = wc * 32 + 8 * fq;
        if (pn < 16) {
            const int h = pn & 7; const bool isk = pn >= 8; bf16_t* dst = (isk ? kr : qr) + h * 256;
            const float lg = log2f(1.0f - exp2f(-5.0f - (float)h));
#pragma unroll
            for (int ai = 0; ai < 2; ++ai)
#pragma unroll
                for (int m = 0; m < 4; ++m) { const int t = t0 + ai * HALF + m * 16; const float ip1 = (float)((t & 127) + 1);
                    const float sc = rs_of(ss[t]) * (isk ? exp2f(-ip1 * lg) * 0.0625f : exp2f(ip1 * lg));
                    f32x4 o1[2], o2[2];
#pragma unroll
                    for (int n = 0; n < 2; ++n) { const f32x4 c4 = *(const f32x4*)(rot + (size_t)t * 128 + cl + 4 * n), s4 = *(const f32x4*)(rot + (size_t)TT * 128 + (size_t)t * 128 + cl + 4 * n);
                        const f32x4 a = acc[ai][0][m][n], b = acc[ai][1][m][n]; o1[n] = (a * c4 - b * s4) * sc; o2[n] = (a * s4 + b * c4) * sc; }
                    bf16_t* rowp = dst + (size_t)t * 2048 + cl;
                    *(u32x4*)(rowp) = pack8(o1[0], o1[1]); *(u32x4*)(rowp + HALF) = pack8(o2[0], o2[1]); }
            return;
        }
        bf16_t* dst; int ld; float sc = 1.0f; bool act = false;
        if (pn < 32) { dst = srg + (pn - 24) * 256; ld = 2048; act = true; }
        else if (pn < 36) { dst = gq + (pn - 32) * 256; ld = 1024; sc = 0.0625f; }
        else if (pn < 40) { dst = gk + (pn - 36) * 256; ld = 1024; }
        else { dst = sgg + (pn - 48) * 256; ld = 2048; act = true; }
#pragma unroll
        for (int ai = 0; ai < 2; ++ai)
#pragma unroll
            for (int m = 0; m < 4; ++m) { const int t = t0 + ai * HALF + m * 16; const float s = rs_of(ss[t]) * sc; bf16_t* rowp = dst + (size_t)t * ld + cl;
#pragma unroll
                for (int bj = 0; bj < 2; ++bj) { f32x4 v0 = acc[ai][bj][m][0] * s, v1 = acc[ai][bj][m][1] * s; if (act) { v0 = silu4(v0); v1 = silu4(v1); }
                    *(u32x4*)(rowp + bj * HALF) = pack8(v0, v1); } }
    }
};

struct EpiRes {
    static constexpr bool PERM = true, AFTER_DRAIN = false;
    const float* xin; float* xout; bf16_t* xb; float* ssout;
    __device__ __forceinline__ void operator()(const f32x4 (&acc)[2][2][4][2], const Unit& u, int wr, int wc, int fr, int fq) const {
        const int t0 = u.pm * BM + wr * 64 + fr, c0 = u.pn * BM + wc * 32 + 8 * fq;
#pragma unroll
        for (int ai = 0; ai < 2; ++ai)
#pragma unroll
            for (int m = 0; m < 4; ++m) { const int t = t0 + ai * HALF + m * 16; const size_t off = (size_t)t * 4096 + c0; float sq = 0.f;
#pragma unroll
                for (int bj = 0; bj < 2; ++bj) { f32x4 o[2];
#pragma unroll
                    for (int n = 0; n < 2; ++n) { const f32x4 xi = *(const f32x4*)(xin + off + bj * HALF + 4 * n); o[n] = xi + acc[ai][bj][m][n];
                        *(f32x4*)(xout + off + bj * HALF + 4 * n) = o[n]; sq += (o[n][0] * o[n][0] + o[n][1] * o[n][1]) + (o[n][2] * o[n][2] + o[n][3] * o[n][3]); }
                    *(u32x4*)(xb + off + bj * HALF) = pack8(o[0], o[1]); }
                sq += __shfl_xor(sq, 16); sq += __shfl_xor(sq, 32);
                if (fq == 0) atomicAdd(ssout + t, sq); }
    }
};

struct EpiSwiGLU {
    static constexpr bool PERM = true, AFTER_DRAIN = false;
    const float* ss; bf16_t* h;
    __device__ __forceinline__ void operator()(const f32x4 (&acc)[2][2][4][2], const Unit& u, int wr, int wc, int fr, int fq) const {
        const int t0 = u.pm * BM + wr * 64 + fr, c0 = u.pn * HALF + wc * 32 + 8 * fq;
#pragma unroll
        for (int ai = 0; ai < 2; ++ai)
#pragma unroll
            for (int m = 0; m < 4; ++m) { const int t = t0 + ai * HALF + m * 16; const float s = rs_of(ss[t]); f32x4 o[2];
#pragma unroll
                for (int n = 0; n < 2; ++n) { const f32x4 g = silu4(acc[ai][0][m][n] * s), uu = acc[ai][1][m][n] * s; o[n] = g * uu; }
                *(u32x4*)(h + (size_t)t * 11008 + c0) = pack8(o[0], o[1]); }
    }
};
struct ProjOrder : StaticOrder {
    __host__ __device__ bool next(int i, Unit& u) const { if (!StaticOrder::next(i, u)) return false; u.sw = ((u.pn >= 16 && u.pn < 24) || (u.pn >= 40 && u.pn < 48)) ? 1 : 0; return true; }
};
template <class Epi, class Sched, bool ALIGN_EPI = false, bool SP2 = false>
__device__ __forceinline__ void gemm_phase(PG8_LAS unsigned char* lds, const Gemm g, const Sched& S, const Epi& E) {
    int tid = threadIdx.x; asm volatile("" : "+v"(tid));
    const int wid = __builtin_amdgcn_readfirstlane(tid >> 6), lane = tid & 63, wr = wid >> 2, wc = wid & 3, fr = lane & 15, fq = lane >> 4;
    const int K = g.K, nt = K / BK;
    unsigned voffA[2], voffB[2];
#pragma unroll
    for (int i = 0; i < 2; ++i) { int R, C; stage_rc(tid * 16 + i * 8192, R, C); const int Rb = Epi::PERM ? ((R & ~31) + perm32(R & 31)) : R;
        voffA[i] = (unsigned)(R * K + C) * 2u; voffB[i] = (unsigned)(Rb * K + C) * 2u; }
    const size_t kstep = (size_t)(BK * 2);
    const size_t hstep = (size_t)HALF * K * 2;
    const size_t tstep = 2 * hstep;
    const unsigned ldsw = (unsigned)wid * 1024u;
    const int aoff = lds_byte(wr * 64 + fr, fq * 8), boff = lds_byte(wc * 32 + fr, fq * 8);
#define PG8_SA(b, h) (((b) * 2 + (h)) * HTB)
#define PG8_SB(b, h) ((4 + (b) * 2 + (h)) * HTB)
#define PG8_STAGE(bufoff, gbase, voff) do { _Pragma("unroll") for (int _i = 0; _i < 2; ++_i) \
        __builtin_amdgcn_global_load_lds((const unsigned*)((const char*)(gbase) + (voff)[_i]), (PG8_LAS unsigned*)(lds + (bufoff) + ldsw + _i * 8192), 16, 0, 0); } while (0)
#define PG8_LDA(dst, b, h) do { _Pragma("unroll") for (int m = 0; m < 4; ++m) _Pragma("unroll") for (int k = 0; k < 2; ++k) dst[m][k] = *(const PG8_LAS bf16x8*)(lds + PG8_SA(b, h) + aoff + m * 2048 + k * 1024); } while (0)
#define PG8_LDB(dst, b, h) do { _Pragma("unroll") for (int n = 0; n < 2; ++n) _Pragma("unroll") for (int k = 0; k < 2; ++k) dst[n][k] = *(const PG8_LAS bf16x8*)(lds + PG8_SB(b, h) + boff + n * 2048 + k * 1024); } while (0)
#define PG8_MMA(ai, bj, At, Bt) do { __builtin_amdgcn_s_setprio(1); _Pragma("unroll") for (int m = 0; m < 4; ++m) _Pragma("unroll") for (int n = 0; n < 2; ++n) _Pragma("unroll") for (int k = 0; k < 2; ++k) \
        acc[ai][bj][m][n] = __builtin_amdgcn_mfma_f32_16x16x32_bf16(Bt[n][k], At[m][k], acc[ai][bj][m][n], 0, 0, 0); __builtin_amdgcn_s_setprio(0); } while (0)
#define PG8_WAIT_V(n) asm volatile("s_waitcnt vmcnt(" #n ")" ::: "memory")
#define PG8_WAIT_L(n) asm volatile("s_waitcnt lgkmcnt(" #n ")" ::: "memory")
#define PG8_BAR __builtin_amdgcn_s_barrier()
#define PG8_SCHED __builtin_amdgcn_sched_barrier(0)
    Unit cur, nxt; int ui = 0;
    if (!S.next(0, cur)) return;
    f32x4 acc[2][2][4][2];
#pragma unroll
    for (int a = 0; a < 2; ++a)
#pragma unroll
        for (int b = 0; b < 2; ++b)
#pragma unroll
            for (int m = 0; m < 4; ++m)
#pragma unroll
                for (int n = 0; n < 2; ++n) acc[a][b][m][n] = (f32x4){0.f, 0.f, 0.f, 0.f};
    bf16x8 At[4][2], B0[2][2], B1[2][2];
    const char* cA = cur.sw ? (const char*)g.Bt + (size_t)cur.pn * tstep : (const char*)g.A + (size_t)cur.pm * tstep; const char* cB = cur.sw ? (const char*)g.A + (size_t)cur.pm * tstep : (const char*)g.Bt + (size_t)cur.pn * tstep;
    S.a_ready(cur);
    if constexpr (SP2) {
        PG8_STAGE(PG8_SB(0, 0), cB, voffB); PG8_STAGE(PG8_SB(0, 1), cB + hstep, voffB); PG8_STAGE(PG8_SA(0, 0), cA, voffA); PG8_STAGE(PG8_SA(0, 1), cA + hstep, voffA);
        if (wr == 1) PG8_BAR;
        PG8_WAIT_V(2); PG8_BAR;
        PG8_STAGE(PG8_SB(1, 0), cB + kstep, voffB); PG8_STAGE(PG8_SA(1, 0), cA + kstep, voffA); PG8_STAGE(PG8_SB(1, 1), cB + hstep + kstep, voffB);
        PG8_WAIT_V(6); PG8_BAR;
    } else {
        PG8_STAGE(PG8_SB(0, 0), cB, voffB); PG8_STAGE(PG8_SA(0, 0), cA, voffA); PG8_STAGE(PG8_SB(0, 1), cB + hstep, voffB); PG8_STAGE(PG8_SA(0, 1), cA + hstep, voffA);
        if (wr == 1) PG8_BAR;
        PG8_WAIT_V(4); PG8_BAR;
        PG8_STAGE(PG8_SB(1, 0), cB + kstep, voffB); PG8_STAGE(PG8_SA(1, 0), cA + kstep, voffA); PG8_STAGE(PG8_SB(1, 1), cB + hstep + kstep, voffB);
        PG8_WAIT_V(6); PG8_BAR;
    }
    for (;;) {
        const bool has_next = S.next(ui + 1, nxt);
        const char* nA = has_next ? (nxt.sw ? (const char*)g.Bt + (size_t)nxt.pn * tstep : (const char*)g.A + (size_t)nxt.pm * tstep) : cA; const char* nB = has_next ? (nxt.sw ? (const char*)g.A + (size_t)nxt.pm * tstep : (const char*)g.Bt + (size_t)nxt.pn * tstep) : cB;
        for (int t = 0; t < nt; t += 2) {
            const bool last = (t == nt - 2);
            const char* a1 = cA + (size_t)(t + 1) * kstep;
            const char* a2 = last ? nA : cA + (size_t)(t + 2) * kstep; const char* b2 = last ? nB : cB + (size_t)(t + 2) * kstep;
            const char* a3 = a2 + kstep; const char* b3 = b2 + kstep;
            if (last && has_next) S.a_ready(nxt);
            if constexpr (SP2) {
            PG8_LDB(B0, 0, 0); PG8_LDB(B1, 0, 1); PG8_SCHED; PG8_LDA(At, 0, 0); PG8_STAGE(PG8_SA(1, 1), a1 + hstep, voffA);
            PG8_WAIT_V(8); PG8_WAIT_L(0); PG8_BAR; PG8_MMA(0, 0, At, B0); PG8_MMA(0, 1, At, B1); PG8_BAR; PG8_SCHED;
            PG8_LDA(At, 0, 1); PG8_STAGE(PG8_SB(0, 0), b2, voffB); PG8_STAGE(PG8_SB(0, 1), b2 + hstep, voffB); PG8_STAGE(PG8_SA(0, 0), a2, voffA);
            PG8_WAIT_V(8); PG8_WAIT_L(0); PG8_BAR; PG8_MMA(1, 0, At, B0); PG8_MMA(1, 1, At, B1); PG8_BAR; PG8_SCHED;
            PG8_LDB(B0, 1, 0); PG8_LDB(B1, 1, 1); PG8_SCHED; PG8_LDA(At, 1, 0); PG8_STAGE(PG8_SA(0, 1), a2 + hstep, voffA);
            PG8_WAIT_V(8); PG8_WAIT_L(0); PG8_BAR; PG8_MMA(0, 0, At, B0); PG8_MMA(0, 1, At, B1); PG8_BAR; PG8_SCHED;
            PG8_LDA(At, 1, 1); PG8_STAGE(PG8_SB(1, 0), b3, voffB); PG8_STAGE(PG8_SB(1, 1), b3 + hstep, voffB); PG8_STAGE(PG8_SA(1, 0), a3, voffA);
            PG8_WAIT_V(8); PG8_WAIT_L(0); PG8_BAR; PG8_MMA(1, 0, At, B0); PG8_MMA(1, 1, At, B1); PG8_BAR; PG8_SCHED;
            } else {
            PG8_LDB(B0, 0, 0); PG8_SCHED; PG8_LDA(At, 0, 0); PG8_STAGE(PG8_SA(1, 1), a1 + hstep, voffA);
            PG8_WAIT_L(8); PG8_BAR; PG8_WAIT_L(0); PG8_MMA(0, 0, At, B0); PG8_BAR; PG8_SCHED;
            PG8_LDB(B1, 0, 1); PG8_STAGE(PG8_SB(0, 0), b2, voffB);
            PG8_BAR; PG8_WAIT_L(0); PG8_MMA(0, 1, At, B1); PG8_BAR;
            PG8_LDA(At, 0, 1); PG8_STAGE(PG8_SA(0, 0), a2, voffA);
            PG8_BAR; PG8_WAIT_L(0); PG8_MMA(1, 0, At, B0); PG8_BAR; PG8_SCHED;
            PG8_STAGE(PG8_SB(0, 1), b2 + hstep, voffB);
            PG8_WAIT_V(6); PG8_BAR; PG8_MMA(1, 1, At, B1); PG8_BAR;
            PG8_LDB(B0, 1, 0); PG8_SCHED; PG8_LDA(At, 1, 0); PG8_STAGE(PG8_SA(0, 1), a2 + hstep, voffA);
            PG8_WAIT_L(8); PG8_BAR; PG8_WAIT_L(0); PG8_MMA(0, 0, At, B0); PG8_BAR; PG8_SCHED;
            PG8_LDB(B1, 1, 1); PG8_STAGE(PG8_SB(1, 0), b3, voffB);
            PG8_BAR; PG8_WAIT_L(0); PG8_MMA(0, 1, At, B1); PG8_BAR;
            PG8_LDA(At, 1, 1); PG8_STAGE(PG8_SA(1, 0), a3, voffA);
            PG8_BAR; PG8_WAIT_L(0); PG8_MMA(1, 0, At, B0); PG8_BAR; PG8_SCHED;
            PG8_STAGE(PG8_SB(1, 1), b3 + hstep, voffB);
            PG8_WAIT_V(6); PG8_BAR; PG8_MMA(1, 1, At, B1); PG8_BAR;
            }
        }
        if constexpr (ALIGN_EPI) { if (wr == 0) PG8_BAR; }
        if constexpr (!Epi::AFTER_DRAIN) { E(acc, cur, wr, wc, fr, fq); S.done(cur); }
        if (!has_next) break;
#pragma unroll
        for (int a = 0; a < 2; ++a)
#pragma unroll
            for (int b = 0; b < 2; ++b)
#pragma unroll
                for (int m = 0; m < 4; ++m)
#pragma unroll
                    for (int n = 0; n < 2; ++n) acc[a][b][m][n] = (f32x4){0.f, 0.f, 0.f, 0.f};
        cur = nxt; cA = nA; cB = nB; ++ui;
        if constexpr (ALIGN_EPI) { if (wr == 1) PG8_BAR; }
    }
    PG8_WAIT_V(0);
    if constexpr (!ALIGN_EPI) { if (wr == 0) PG8_BAR; }
    PG8_BAR;
    if constexpr (Epi::AFTER_DRAIN) { E.fused(acc, cur, wr, wc, fr, fq, lds, wid, lane); S.done(cur); }
#undef PG8_SA
#undef PG8_SB
#undef PG8_STAGE
#undef PG8_LDA
#undef PG8_LDB
#undef PG8_MMA
#undef PG8_WAIT_V
#undef PG8_WAIT_L
#undef PG8_BAR
#undef PG8_SCHED
}
}

#define GAS __attribute__((address_space(1)))
#define LAS __attribute__((address_space(3)))
typedef unsigned short bf16_t;
typedef short bf16x8 __attribute__((ext_vector_type(8)));
typedef float f32x4 __attribute__((ext_vector_type(4)));
typedef float f32x2 __attribute__((ext_vector_type(2)));
typedef unsigned u32x4 __attribute__((ext_vector_type(4)));
typedef unsigned u32x2 __attribute__((ext_vector_type(2)));
#define LDS_WAIT() asm volatile("s_waitcnt lgkmcnt(0)" ::: "memory")
#define VM_WAIT() asm volatile("s_waitcnt vmcnt(0)" ::: "memory")

namespace mk {
using pg8::cvt_pk_bf16; using pg8::pack8; using pg8::rs_of;
constexpr int T = 8192, D = 4096, INW = 14352, NPROJ = 14336, FF = 11008;
constexpr int NWAVES = 8, NTHR = 512;
constexpr int LDS_BYTES = 147456;
constexpr int LDSCTL_OFF = 140 * 1024;
constexpr int CW_TMO = 0, CW_BAR = 4096, CW_SS = 8192  , CW_CHK = 65536  ;
constexpr size_t CTL_ZERO_BYTES = 512 * 1024;
constexpr int N_PHASES = 18;

struct Args {
    const float* x; const int* pos; const float* mix_norm; const float* w_in; const float* gla_w_up; const float* gla_b; const float* ret_gain; const float* gla_gain;
    const float* w_out; const float* ffn_norm; const float* w_gate; const float* w_up; const float* w_down; const float* final_norm;
    float* out; unsigned* ctl;
    bf16_t* win_t[2]; bf16_t* wga_t[2]; bf16_t* wout_t[2]; bf16_t* wgu_t[2]; bf16_t* wd_t[2];
    bf16_t* xb; float* rot; float* ga; float* lam;
    bf16_t *qr, *kr, *krt, *vrt, *srg, *gq, *gk, *qg, *kg, *kgt, *vgt, *sgg, *kvr, *kvg, *mixed, *h;
    bf16_t* dbgp; float* dbgo;
    int ph_lo, ph_hi, cvt_mask, cvt_layers;
};

__device__ __forceinline__ float wave_sum(float v) {
#pragma unroll
    for (int o = 1; o < 64; o <<= 1) v += __shfl_xor(v, o);
    return v;
}
__device__ __forceinline__ float bf_lo(unsigned w) { return __uint_as_float(w << 16); }
__device__ __forceinline__ float bf_hi(unsigned w) { return __uint_as_float(w & 0xffff0000u); }
__device__ __forceinline__ float silu1(float v) { return v / (1.0f + __expf(-v)); }

#define XB_TMO      128
#define XB_XCNT(j)  (256  + 64 * (j))
#define XB_XSUB(j)  (1280 + 64 * (j))
#define XB_XGEN(j)  (2304 + 64 * (j))
#define XB_TOP      3328
#define XB_TOPGEN   3392
#define XCD_BAR_WORDS 3456
#define XB_SPIN_CAP (1u << 18)

__device__ __forceinline__ unsigned xb_ld(unsigned* p)              { return __hip_atomic_load(p, __ATOMIC_RELAXED, __HIP_MEMORY_SCOPE_AGENT); }
__device__ __forceinline__ unsigned xb_add(unsigned* p, unsigned v) { return __hip_atomic_fetch_add(p, v, __ATOMIC_RELAXED, __HIP_MEMORY_SCOPE_AGENT); }
__device__ __forceinline__ unsigned xb_xcc_id() { return (unsigned)__builtin_amdgcn_s_getreg((3 << 11) | 20) & 0xFu; }
#define XB_SPIN(cond, bar) do { unsigned _sp = 0; while (cond) { __builtin_amdgcn_s_sleep(1); \
    if ((++_sp & 255u) == 0u) { if (xb_ld(&(bar)[XB_TMO])) break; if (_sp > XB_SPIN_CAP) { atomicAdd(&(bar)[XB_TMO], 1u); break; } } } } while (0)

struct XcdBarrier {
    unsigned* bar; unsigned x;
    volatile LAS unsigned* st;
};

__device__ __forceinline__ XcdBarrier xcd_barrier_post(unsigned* bar, volatile LAS unsigned* st) {
    XcdBarrier b; b.bar = bar; b.x = xb_xcc_id(); b.st = st;
    if (threadIdx.x == 0) (void)xb_add(&bar[XB_XCNT(b.x)], 1u);
    return b;
}
__device__ __forceinline__ void xcd_barrier_complete(unsigned* bar, unsigned x, unsigned& nloc, unsigned& nx) {
    const unsigned G = gridDim.x * gridDim.y * gridDim.z;
    unsigned sum, cnt, mine, sp = 0u;
    for (;;) {
        sum = 0u; cnt = 0u; mine = 0u;
#pragma unroll
        for (unsigned j = 0; j < 16; ++j) { const unsigned c = xb_ld(&bar[XB_XCNT(j)]); sum += c; cnt += (c > 0u) ? 1u : 0u; mine = (j == x) ? c : mine; }
        if (sum == G) break;
        __builtin_amdgcn_s_sleep(1);
        if ((++sp & 255u) == 0u) { if (xb_ld(&bar[XB_TMO])) break; if (sp > XB_SPIN_CAP) { atomicAdd(&bar[XB_TMO], 1u); break; } }
    }
    nloc = mine > 0u ? mine : 1u; nx = cnt > 0u ? cnt : 1u;
}

__device__ __forceinline__ void xcd_barrier(const XcdBarrier& b) {
    asm volatile("s_waitcnt vmcnt(0)" ::: "memory");
    __syncthreads();
    if (threadIdx.x == 0) {
        unsigned* bar = b.bar;
        __builtin_amdgcn_s_waitcnt(0);
        unsigned nloc = b.st[0], nx = b.st[1];
        if (nloc == 0u) { xcd_barrier_complete(bar, b.x, nloc, nx); b.st[0] = nloc; b.st[1] = nx; }
        const unsigned old = xb_add(&bar[XB_XSUB(b.x)], 1u);
        const unsigned gen = old / nloc;
        if (old + 1u == (gen + 1u) * nloc) {
            __builtin_amdgcn_fence(__ATOMIC_RELEASE, "agent");
            asm volatile("s_waitcnt vmcnt(0)" ::: "memory");
            const unsigned og = xb_add(&bar[XB_TOP], 1u);
            const unsigned tg = og / nx;
            if (og + 1u == (tg + 1u) * nx) xb_add(&bar[XB_TOPGEN], 1u);
            else XB_SPIN(xb_ld(&bar[XB_TOPGEN]) == tg, bar);
            __builtin_amdgcn_fence(__ATOMIC_ACQUIRE, "agent");
            xb_add(&bar[XB_XGEN(b.x)], 1u);
            asm volatile("s_waitcnt vmcnt(0)" ::: "memory");
        } else {
            XB_SPIN(xb_ld(&bar[XB_XGEN(b.x)]) == gen, bar);
            __builtin_amdgcn_fence(__ATOMIC_ACQUIRE, "agent");
            asm volatile("s_waitcnt vmcnt(0)" ::: "memory");
        }
    }
    __syncthreads();
}

__device__ __forceinline__ void cvt_item(const float* W, int ldn, int k0, int n0, const float* gain, bf16_t* WT, size_t dst_row0, int K, LAS float* scr, int lane) {
    const int kr = lane >> 4, c4 = (lane & 15) * 4;
    f32x4 v[16];
#pragma unroll
    for (int i = 0; i < 16; ++i) v[i] = *(const f32x4*)(W + (size_t)(k0 + 4 * i + kr) * ldn + n0 + c4);
#pragma unroll
    for (int i = 0; i < 16; ++i) { const float g = gain ? gain[k0 + 4 * i + kr] : 1.0f; LAS float* p = scr + (4 * i + kr) * 65 + c4; p[0] = v[i][0] * g; p[1] = v[i][1] * g; p[2] = v[i][2] * g; p[3] = v[i][3] * g; }
    LDS_WAIT(); asm volatile("" ::: "memory");
    const int c = lane >> 3, nn = lane & 7;
#pragma unroll
    for (int j = 0; j < 8; ++j) { const int n = nn + 8 * j; const LAS float* s = scr + (8 * c) * 65 + n;
        u32x4 o; o.x = cvt_pk_bf16(s[0 * 65], s[1 * 65]); o.y = cvt_pk_bf16(s[2 * 65], s[3 * 65]); o.z = cvt_pk_bf16(s[4 * 65], s[5 * 65]); o.w = cvt_pk_bf16(s[6 * 65], s[7 * 65]);
        *(u32x4*)(WT + (dst_row0 + n) * (size_t)K + k0 + 8 * c) = o; }
    LDS_WAIT(); asm volatile("" ::: "memory");
}
template <class AT> __device__ __forceinline__ void p0_prologue(const AT& a, LAS unsigned char* lds, int tid, int lane, int wave, int bid, int G) {
    LAS float* scr = (LAS float*)(lds + wave * 16640);
    const int gw = bid * NWAVES + wave, NGW = G * NWAVES;
    constexpr int I_IN = 64 * 224, I_OUT = 64 * 64, I_G = 64 * 172, I_D = 172 * 64, I_LAYER = I_IN + I_OUT + 2 * I_G + I_D;
    const int nitems = a.cvt_layers * I_LAYER;
    for (int it = gw; it < nitems; it += NGW) {
        const int l = it / I_LAYER; int r = it - l * I_LAYER;
        if (r < I_IN) { if (a.cvt_mask & 1) { const int kb = r / 224, nb = r - kb * 224; cvt_item(a.w_in + (size_t)l * D * INW, INW, 64 * kb, 64 * nb, a.mix_norm + l * D, a.win_t[l], (size_t)(64 * nb), D, scr, lane); } continue; } r -= I_IN;
        if (r < I_OUT) { if (a.cvt_mask & 2) { const int kb = r / 64, nb = r - kb * 64; cvt_item(a.w_out + (size_t)l * D * D, D, 64 * kb, 64 * nb, nullptr, a.wout_t[l], (size_t)(64 * nb), D, scr, lane); } continue; } r -= I_OUT;
        if (r < 2 * I_G) { if (a.cvt_mask & 4) { const int up = r >= I_G ? 1 : 0; r -= up * I_G; const int kb = r / 172, nb = r - kb * 172, n0 = 64 * nb;
            cvt_item((up ? a.w_up : a.w_gate) + (size_t)l * D * FF, FF, 64 * kb, n0, a.ffn_norm + l * D, a.wgu_t[l], (size_t)((n0 >> 7) * 256 + up * 128 + (n0 & 127)), D, scr, lane); } continue; } r -= 2 * I_G;
        if (a.cvt_mask & 8) { const int kb = r / 64, nb = r - kb * 64; cvt_item(a.w_down + (size_t)l * FF * D, D, 64 * kb, 64 * nb, nullptr, a.wd_t[l], (size_t)(64 * nb), FF, scr, lane); }
    }
    if (a.cvt_mask & 1) for (int i = bid * NTHR + tid; i < a.cvt_layers * 16 * D; i += G * NTHR) { const int l = i / (16 * D), r = i - l * 16 * D, j = r / D, k = r - j * D;
        const float v = a.w_in[(size_t)l * D * INW + (size_t)k * INW + NPROJ + j] * a.mix_norm[l * D + k]; a.wga_t[l][r] = (bf16_t)(cvt_pk_bf16(v, 0.f) & 0xffffu); }
    float* ss0 = (float*)(a.ctl + CW_SS);
    for (int m = gw; m < T; m += NGW) { const f32x4* xr = (const f32x4*)(a.x + (size_t)m * D) + lane; u32x2* o8 = (u32x2*)(a.xb + (size_t)m * D) + lane; float s = 0.f;
#pragma unroll
        for (int j = 0; j < 16; ++j) { const f32x4 v = xr[64 * j]; s += (v[0] * v[0] + v[1] * v[1]) + (v[2] * v[2] + v[3] * v[3]); u32x2 w; w.x = cvt_pk_bf16(v[0], v[1]); w.y = cvt_pk_bf16(v[2], v[3]); o8[64 * j] = w; }
        s = wave_sum(s); if (lane == 0) ss0[m] = s; }
    for (int i = bid * NTHR + tid; i < T * 128; i += G * NTHR) { const int t = i >> 7, k = i & 127;
        const float inv_freq = powf(10000.0f, -(float)k / 128.0f); const float ang = (float)a.pos[t] * inv_freq;
        const double rev = (double)ang * 0.15915494309189533577; const float fr = (float)(rev - floor(rev));
        a.rot[i] = __builtin_amdgcn_cosf(fr); a.rot[(size_t)T * 128 + i] = __builtin_amdgcn_sinf(fr); }
}

template <class AT> __device__ __forceinline__ void ga_stage(const AT& a, int l, const float* ss, LAS unsigned char* lds, int tid, int lane, int wave, int bid, int G) {
    LAS float* red = (LAS float*)lds;
    for (int tb = bid; tb < T / 32; tb += G) {
        f32x4 acc[2] = {(f32x4){0.f, 0.f, 0.f, 0.f}, (f32x4){0.f, 0.f, 0.f, 0.f}};
        const bf16_t* xa = a.xb + (size_t)(tb * 32 + (lane & 15)) * D + wave * 512 + 8 * (lane >> 4);
        const bf16_t* wb = a.wga_t[l] + (size_t)(lane & 15) * D + wave * 512 + 8 * (lane >> 4);
#pragma unroll 4
        for (int ks = 0; ks < 16; ++ks) { const bf16x8 b = *(const bf16x8*)(wb + 32 * ks);
            const bf16x8 a0 = *(const bf16x8*)(xa + 32 * ks), a1 = *(const bf16x8*)(xa + (size_t)16 * D + 32 * ks);
            acc[0] = __builtin_amdgcn_mfma_f32_16x16x32_bf16(a0, b, acc[0], 0, 0, 0); acc[1] = __builtin_amdgcn_mfma_f32_16x16x32_bf16(a1, b, acc[1], 0, 0, 0); }
        *(LAS f32x4*)(red + ((wave * 2 + 0) * 64 + lane) * 4) = acc[0]; *(LAS f32x4*)(red + ((wave * 2 + 1) * 64 + lane) * 4) = acc[1];
        __syncthreads();
        { const int mt = tid >> 8, ln = (tid >> 2) & 63, rg = tid & 3; float s = 0.f;
#pragma unroll
          for (int w = 0; w < 8; ++w) s += red[((w * 2 + mt) * 64 + ln) * 4 + rg];
          const int tok = tb * 32 + 16 * mt + (ln >> 4) * 4 + rg, j = ln & 15;
          a.ga[(size_t)tok * 16 + j] = s * rs_of(ss[tok]); }
        __syncthreads();
    }
}

template <class AT> __device__ __forceinline__ void prep_phase(const AT& a, int l, LAS unsigned char* lds, int tid, int lane, int wave, int bid, int G) {
    for (int u = bid; u < 512; u += G) { const int c = u >> 3, h = u & 7, t0 = c * 128;
#pragma unroll 1
        for (int k = 0; k < 4; ++k) { const int task = tid + 512 * k, dp = task & 127, q = task >> 7;
            unsigned w[8];
#pragma unroll
            for (int i = 0; i < 8; ++i) w[i] = *(const unsigned*)(a.kr + (size_t)(t0 + 8 * q + i) * 2048 + h * 256 + 2 * dp);
            u32x4 lo, hi;
            lo.x = (w[0] & 0xffffu) | (w[1] << 16); lo.y = (w[2] & 0xffffu) | (w[3] << 16); lo.z = (w[4] & 0xffffu) | (w[5] << 16); lo.w = (w[6] & 0xffffu) | (w[7] << 16);
            hi.x = (w[0] >> 16) | (w[1] & 0xffff0000u); hi.y = (w[2] >> 16) | (w[3] & 0xffff0000u); hi.z = (w[4] >> 16) | (w[5] & 0xffff0000u); hi.w = (w[6] >> 16) | (w[7] & 0xffff0000u);
            bf16_t* dst = a.krt + (size_t)(h * 256 + 2 * dp) * T + t0 + 8 * q;
            *(u32x4*)dst = lo; *(u32x4*)(dst + T) = hi; } }
    LAS float* la = (LAS float*)lds;
    LAS float* tot = (LAS float*)(lds + 131072);
    const float* wup = a.gla_w_up + (size_t)l * 16 * 1024; const float* gb = a.gla_b + l * 1024;
    for (int u = bid; u < 256; u += G) { const int h = u >> 6, c = u & 63, t0 = c * 128, d = tid & 255, half = tid >> 8, ch = h * 256 + d;
        float wv[16];
#pragma unroll
        for (int r = 0; r < 16; ++r) wv[r] = wup[r * 1024 + ch];
        const float bb = gb[ch]; float sum = 0.f;
        for (int tt = 0; tt < 64; ++tt) { const int t = t0 + half * 64 + tt; const float* g = a.ga + (size_t)t * 16; float z = bb;
#pragma unroll
            for (int r = 0; r < 16; ++r) z = fmaf(g[r], wv[r], z);
            const float ls = (fminf(z, 0.f) - log1pf(__expf(-fabsf(z)))) * 0.0625f; la[(half * 64 + tt) * 256 + d] = ls; sum += ls; }
        if (half == 0) tot[d] = sum;
        __syncthreads();
        float cum = half ? tot[d] : 0.f;
        unsigned pk[4] = {0u, 0u, 0u, 0u};
        for (int tt = 0; tt < 64; ++tt) { const int t = t0 + half * 64 + tt; cum += la[(half * 64 + tt) * 256 + d];
            const float eq = __expf(cum), ek = __expf(-cum);
            const float qv = __uint_as_float((unsigned)a.gq[(size_t)t * 1024 + ch] << 16) * eq, kv = __uint_as_float((unsigned)a.gk[(size_t)t * 1024 + ch] << 16) * ek;
            const unsigned qb = cvt_pk_bf16(qv, 0.f) & 0xffffu, kb = cvt_pk_bf16(kv, 0.f) & 0xffffu;
            a.qg[(size_t)t * 1024 + ch] = (bf16_t)qb; a.kg[(size_t)t * 1024 + ch] = (bf16_t)kb;
            const int e = tt & 7; if (e & 1) pk[e >> 1] |= kb << 16; else pk[e >> 1] = kb;
            if (e == 7) { u32x4 o; o.x = pk[0]; o.y = pk[1]; o.z = pk[2]; o.w = pk[3]; *(u32x4*)(a.kgt + (size_t)ch * T + t - 7) = o; } }
        if (half) a.lam[c * 1024 + ch] = __expf(cum);
        __syncthreads();
    }
}

template <class AT> __device__ __forceinline__ void m1_phase(const AT& a, int lane, int wave, int bid, int G) {
    const int wd = wave & 1, wv = wave >> 1, lr = lane & 15, lq = lane >> 4;
    for (int su = bid; su < 1024; su += G) {
        const bf16_t *Kt, *Vt; bf16_t* out; int c;
        if (su < 512) { const int h = su >> 6; c = su & 63; Kt = a.krt + (size_t)(h * 256) * T; Vt = a.vrt + (size_t)(h * 256) * T; out = a.kvr + (size_t)(h * 64 + c) * 65536; }
        else { const int s = su - 512, h = s >> 7, vh = s & 1; c = (s >> 1) & 63; Kt = a.kgt + (size_t)(h * 256) * T; Vt = a.vgt + (size_t)(h * 512 + vh * 256) * T; out = a.kvg + (size_t)(h * 64 + c) * 131072 + (size_t)vh * 65536; }
        const int t0 = c * 128;
        f32x4 acc[8][4];
#pragma unroll
        for (int i = 0; i < 8; ++i)
#pragma unroll
            for (int j = 0; j < 4; ++j) acc[i][j] = (f32x4){0.f, 0.f, 0.f, 0.f};
        const bf16_t* kp = Kt + (size_t)(128 * wd + lr) * T + t0 + 8 * lq; const bf16_t* vp = Vt + (size_t)(64 * wv + lr) * T + t0 + 8 * lq;
#pragma unroll 1
        for (int ks = 0; ks < 4; ++ks) { bf16x8 X[8], Y[4];
#pragma unroll
            for (int i = 0; i < 8; ++i) X[i] = *(const bf16x8*)(kp + (size_t)(16 * i) * T + 32 * ks);
#pragma unroll
            for (int j = 0; j < 4; ++j) Y[j] = *(const bf16x8*)(vp + (size_t)(16 * j) * T + 32 * ks);
#pragma unroll
            for (int i = 0; i < 8; ++i)
#pragma unroll
                for (int j = 0; j < 4; ++j) acc[i][j] = __builtin_amdgcn_mfma_f32_16x16x32_bf16(X[i], Y[j], acc[i][j], 0, 0, 0); }
#pragma unroll
        for (int i = 0; i < 8; ++i)
#pragma unroll
            for (int j = 0; j < 4; ++j) { u32x2 w; w.x = cvt_pk_bf16(acc[i][j][0], acc[i][j][1]); w.y = cvt_pk_bf16(acc[i][j][2], acc[i][j][3]);
                *(u32x2*)(out + (size_t)(64 * wv + 16 * j + lr) * 256 + 128 * wd + 16 * i + 4 * lq) = w; }
    }
}

template <class AT> __device__ __forceinline__ void m2_phase(const AT& a, int tid, int bid, int G) {
    for (int vec = bid * NTHR + tid; vec < 131072; vec += G * NTHR) {
        bf16_t* base; size_t cstride; const float* lamp = nullptr; float lsc = 0.f;
        if (vec < 65536) { const int h = vec >> 13, rem = vec & 8191; base = a.kvr + (size_t)(h * 64) * 65536 + (size_t)rem * 8; cstride = 65536; lsc = exp2f(128.0f * log2f(1.0f - exp2f(-5.0f - (float)h))); }
        else { const int v2 = vec - 65536, h = v2 >> 14, rem = v2 & 16383; base = a.kvg + (size_t)(h * 64) * 131072 + (size_t)rem * 8; cstride = 131072; lamp = a.lam + h * 256 + 8 * (rem & 31); }
        float st[8];
#pragma unroll
        for (int e = 0; e < 8; ++e) st[e] = 0.f;
#pragma unroll 8
        for (int c = 0; c < 64; ++c) { u32x4* p = (u32x4*)(base + (size_t)c * cstride); const u32x4 kv = *p;
            u32x4 o; o.x = cvt_pk_bf16(st[0], st[1]); o.y = cvt_pk_bf16(st[2], st[3]); o.z = cvt_pk_bf16(st[4], st[5]); o.w = cvt_pk_bf16(st[6], st[7]); *p = o;
            float lm[8];
            if (lamp) { const f32x4 l0 = *(const f32x4*)(lamp + c * 1024), l1 = *(const f32x4*)(lamp + c * 1024 + 4); lm[0] = l0[0]; lm[1] = l0[1]; lm[2] = l0[2]; lm[3] = l0[3]; lm[4] = l1[0]; lm[5] = l1[1]; lm[6] = l1[2]; lm[7] = l1[3]; }
            else {
#pragma unroll
                for (int e = 0; e < 8; ++e) lm[e] = lsc; }
            st[0] = lm[0] * (st[0] + bf_lo(kv.x)); st[1] = lm[1] * (st[1] + bf_hi(kv.x)); st[2] = lm[2] * (st[2] + bf_lo(kv.y)); st[3] = lm[3] * (st[3] + bf_hi(kv.y));
            st[4] = lm[4] * (st[4] + bf_lo(kv.z)); st[5] = lm[5] * (st[5] + bf_hi(kv.z)); st[6] = lm[6] * (st[6] + bf_lo(kv.w)); st[7] = lm[7] * (st[7] + bf_hi(kv.w)); }
    }
}

template <int CT, bool LNORM>
__device__ __forceinline__ void m3_unit(LAS unsigned char* lds, const bf16_t* Q, int ldq, const bf16_t* Kk, const bf16_t* VT, const bf16_t* ST, const bf16_t* gate, const float* gain, bf16_t* mixed, int t0, int tid, int lane, int wave, bf16_t* dbgp = nullptr, float* dbgo = nullptr) {
    constexpr int DV = CT * 128;
    LAS unsigned char* QL = lds; LAS unsigned char* PL = lds + 65536; LAS f32x2* STATS = (LAS f32x2*)(lds + 98304);
    const int lr = lane & 15, lq = lane >> 4;
#pragma unroll
    for (int i = 0; i < 8; ++i) { const int idx = tid + 512 * i, row = idx >> 5, ch = idx & 31;
        const u32x4 v = *(const u32x4*)(Q + (size_t)(t0 + row) * ldq + ch * 8); *(LAS u32x4*)(QL + row * 512 + ((ch ^ (row & 15)) << 4)) = v; }
    bf16x8 Kf[8];
#pragma unroll
    for (int ks = 0; ks < 8; ++ks) Kf[ks] = *(const bf16x8*)(Kk + (size_t)(t0 + 16 * wave + lr) * ldq + 32 * ks + 8 * lq);
    __syncthreads();
#pragma unroll
    for (int rt = 0; rt < 8; ++rt) { f32x4 p = (f32x4){0.f, 0.f, 0.f, 0.f}; const int row = 16 * rt + lr;
        if (rt >= wave) {
#pragma unroll
            for (int ks = 0; ks < 8; ++ks) { const bf16x8 qf = *(const LAS bf16x8*)(QL + row * 512 + (((4 * ks + lq) ^ lr) << 4)); p = __builtin_amdgcn_mfma_f32_16x16x32_bf16(Kf[ks], qf, p, 0, 0, 0); }
            if (rt == wave) {
#pragma unroll
                for (int r = 0; r < 4; ++r) if (4 * lq + r > lr) p[r] = 0.f; } }
        u32x2 w; w.x = cvt_pk_bf16(p[0], p[1]); w.y = cvt_pk_bf16(p[2], p[3]);
        *(LAS u32x2*)(PL + row * 256 + ((((2 * wave + (lq >> 1)) ^ lr) << 4) + ((lq & 1) << 3))) = w; }
    __syncthreads();
#if MK_DEBUG
    if (dbgp) for (int idx = tid; idx < 128 * 16; idx += NTHR) { const int row = idx >> 4, ch = idx & 15; *(u32x4*)(dbgp + row * 128 + ch * 8) = *(const LAS u32x4*)(PL + row * 256 + ((ch ^ (row & 15)) << 4)); }
#endif
    f32x4 acc[8][CT];
#pragma unroll
    for (int rt = 0; rt < 8; ++rt)
#pragma unroll
        for (int ct = 0; ct < CT; ++ct) acc[rt][ct] = (f32x4){0.f, 0.f, 0.f, 0.f};
    const int vb = wave * 16 * CT;
    { const bf16_t* vp = VT + (size_t)(vb + lr) * T + t0 + 8 * lq;
#pragma unroll 1
      for (int ks = 0; ks < 4; ++ks) { bf16x8 Vf[CT];
#pragma unroll
          for (int ct = 0; ct < CT; ++ct) Vf[ct] = *(const bf16x8*)(vp + (size_t)(16 * ct) * T + 32 * ks);
#pragma unroll
          for (int rt = 0; rt < 8; ++rt) { const bf16x8 pf = *(const LAS bf16x8*)(PL + (16 * rt + lr) * 256 + (((4 * ks + lq) ^ lr) << 4));
#pragma unroll
              for (int ct = 0; ct < CT; ++ct) acc[rt][ct] = __builtin_amdgcn_mfma_f32_16x16x32_bf16(Vf[ct], pf, acc[rt][ct], 0, 0, 0); } } }
    { const bf16_t* sp = ST + (size_t)(vb + lr) * 256 + 8 * lq;
#pragma unroll 1
      for (int ks = 0; ks < 8; ++ks) { bf16x8 Sf[CT];
#pragma unroll
          for (int ct = 0; ct < CT; ++ct) Sf[ct] = *(const bf16x8*)(sp + (size_t)(16 * ct) * 256 + 32 * ks);
#pragma unroll
          for (int rt = 0; rt < 8; ++rt) { const bf16x8 qf = *(const LAS bf16x8*)(QL + (16 * rt + lr) * 512 + (((4 * ks + lq) ^ lr) << 4));
#pragma unroll
              for (int ct = 0; ct < CT; ++ct) acc[rt][ct] = __builtin_amdgcn_mfma_f32_16x16x32_bf16(Sf[ct], qf, acc[rt][ct], 0, 0, 0); } } }
#if MK_DEBUG
    if (dbgo) {
#pragma unroll
        for (int rt = 0; rt < 8; ++rt)
#pragma unroll
            for (int ct = 0; ct < CT; ++ct) *(f32x4*)(dbgo + (size_t)(16 * rt + lr) * 2048 + vb + 16 * ct + 4 * lq) = acc[rt][ct]; }
#endif
#pragma unroll
    for (int rt = 0; rt < 8; ++rt) { float s1 = 0.f, s2 = 0.f;
#pragma unroll
        for (int ct = 0; ct < CT; ++ct)
#pragma unroll
            for (int r = 0; r < 4; ++r) { const float x = acc[rt][ct][r]; s1 += x; s2 += x * x; }
        s1 += __shfl_xor(s1, 16); s1 += __shfl_xor(s1, 32); s2 += __shfl_xor(s2, 16); s2 += __shfl_xor(s2, 32);
        if (lq == 0) STATS[(16 * rt + lr) * 8 + wave] = (f32x2){s1, s2}; }
    __syncthreads();
#pragma unroll
    for (int rt = 0; rt < 8; ++rt) { const int row = 16 * rt + lr; float s1 = 0.f, s2 = 0.f;
#pragma unroll
        for (int w = 0; w < 8; ++w) { const f32x2 s = STATS[row * 8 + w]; s1 += s[0]; s2 += s[1]; }
        const float mean = LNORM ? s1 * (1.0f / DV) : 0.f; const float var = s2 * (1.0f / DV) - mean * mean; const float rstd = 1.0f / sqrtf(var + 1e-6f);
        const size_t to = (size_t)(t0 + row);
#pragma unroll
        for (int ct = 0; ct < CT; ++ct) { const int col = vb + 16 * ct + 4 * lq; const u32x2 g = *(const u32x2*)(gate + to * 2048 + col); const f32x4 gn = *(const f32x4*)(gain + col);
            const f32x4 x = acc[rt][ct]; u32x2 w;
            w.x = cvt_pk_bf16((x[0] - mean) * rstd * gn[0] * bf_lo(g.x), (x[1] - mean) * rstd * gn[1] * bf_hi(g.x));
            w.y = cvt_pk_bf16((x[2] - mean) * rstd * gn[2] * bf_lo(g.y), (x[3] - mean) * rstd * gn[3] * bf_hi(g.y));
            *(u32x2*)(mixed + to * 4096 + col) = w; } }
    __syncthreads();
}
template <class AT> __device__ __forceinline__ void m3_phase(const AT& a, int l, LAS unsigned char* lds, int tid, int lane, int wave, int bid, int G) {
    for (int u = bid; u < 256; u += G) { const int h = u >> 6, c = u & 63;
        m3_unit<4, false>(lds, a.qg + h * 256, 1024, a.kg + h * 256, a.vgt + (size_t)(h * 512) * T, a.kvg + (size_t)(h * 64 + c) * 131072, a.sgg + h * 512, a.gla_gain + l * 2048 + h * 512, a.mixed + 2048 + h * 512, c * 128, tid, lane, wave); }
    for (int u = bid; u < 512; u += G) { const int h = u >> 6, c = u & 63;
        m3_unit<2, true>(lds, a.qr + h * 256, 2048, a.kr + h * 256, a.vrt + (size_t)(h * 256) * T, a.kvr + (size_t)(h * 64 + c) * 65536, a.srg + h * 256, a.ret_gain + l * 2048 + h * 256, a.mixed + h * 256, c * 128, tid, lane, wave,
#if MK_DEBUG
            a.dbgp ? a.dbgp + (size_t)(h * 64 + c) * 16384 : nullptr, a.dbgo ? a.dbgo + (size_t)(c * 128) * 2048 + h * 256 : nullptr
#else
            nullptr, nullptr
#endif
            ); }
}

template <class AT> __device__ __forceinline__ void final_phase(const AT& a, const float* ss, int tid, int bid, int G) {
    for (size_t i = (size_t)bid * NTHR + tid; i < (size_t)T * D / 4; i += (size_t)G * NTHR) { const int t = (int)(i >> 10), c4 = (int)(i & 1023);
        const f32x4 v = ((const f32x4*)a.out)[i], g = ((const f32x4*)a.final_norm)[c4]; const float r = rs_of(ss[t]); ((f32x4*)a.out)[i] = v * r * g; }
}

#ifndef MK_PH
#define MK_PH 1023
#endif
typedef const Args __attribute__((address_space(4))) CArgs;
#define KARGS() ({ const CArgs* p_ = (const CArgs*)__builtin_amdgcn_kernarg_segment_ptr(); asm volatile("" : "+s"(p_)); p_; })
__global__ void __launch_bounds__(NTHR, 2) mk_fwd(Args args_unused) {
    extern __shared__ __attribute__((aligned(16))) unsigned char lds_raw[];
    LAS unsigned char* lds = (LAS unsigned char*)lds_raw;
    const int bid = blockIdx.x, G = gridDim.x;
    volatile LAS unsigned* MISC = (volatile LAS unsigned*)(lds + LDSCTL_OFF);
    if (threadIdx.x < 64) MISC[threadIdx.x] = 0u;
#define LANEIDS() int tid = threadIdx.x; asm volatile("" : "+v"(tid)); const int lane = tid & 63, wave = __builtin_amdgcn_readfirstlane(tid >> 6); (void)lane; (void)wave
    __syncthreads();
    XcdBarrier bar = xcd_barrier_post(KARGS()->ctl + CW_BAR, MISC + 8);
#define IN(k) (KARGS()->ph_lo <= (k) && (k) < KARGS()->ph_hi)
#define SEAM(k) do { if (IN(k) && IN((k) + 1)) xcd_barrier(bar); } while (0)
#define SSB() ((float*)(KARGS()->ctl + CW_SS))

    if (MK_PH & 256) if (IN(0)) { LANEIDS(); p0_prologue(*KARGS(), lds, tid, lane, wave, bid, G); }
    SEAM(0);
    for (int l = 0; l < 2; ++l) {
        const int pb = 1 + 8 * l;
        if (MK_PH & 1) if (IN(pb + 0)) {
            const CArgs& a = *KARGS(); const float* ss_in = SSB() + (size_t)(2 * l) * T;
            { LANEIDS(); ga_stage(a, l, ss_in, lds, tid, lane, wave, bid, G); }
            pg8::Gemm g{a.xb, a.win_t[l], D}; pg8::ProjOrder S; S.init(T / 256, NPROJ / 256, G, bid);
            pg8::EpiProj E{ss_in, a.rot, a.qr, a.kr, a.vrt, a.srg, a.gq, a.gk, a.vgt, a.sgg};
            pg8::gemm_phase<pg8::EpiProj, pg8::ProjOrder, true, true>(lds, g, S, E);
        }
        SEAM(pb + 0);
        if (MK_PH & 2) if (IN(pb + 1)) { LANEIDS(); prep_phase(*KARGS(), l, lds, tid, lane, wave, bid, G); }
        SEAM(pb + 1);
        if (MK_PH & 4) if (IN(pb + 2)) { LANEIDS(); m1_phase(*KARGS(), lane, wave, bid, G); }
        SEAM(pb + 2);
        if (MK_PH & 8) if (IN(pb + 3)) { LANEIDS(); m2_phase(*KARGS(), tid, bid, G); }
        SEAM(pb + 3);
        if (MK_PH & 16) if (IN(pb + 4)) { LANEIDS(); m3_phase(*KARGS(), l, lds, tid, lane, wave, bid, G); }
        SEAM(pb + 4);
        if (MK_PH & 32) if (IN(pb + 5)) {
            const CArgs& a = *KARGS(); float* ss_mid = SSB() + (size_t)(2 * l + 1) * T;
            pg8::Gemm g{a.mixed, a.wout_t[l], D}; pg8::StaticOrder S; S.init(T / 256, D / 256, G, bid);
            pg8::EpiRes E{l == 0 ? a.x : a.out, a.out, a.xb, ss_mid};
            pg8::gemm_phase<pg8::EpiRes, pg8::StaticOrder, true, true>(lds, g, S, E);
        }
        SEAM(pb + 5);
        if (MK_PH & 64) if (IN(pb + 6)) {
            const CArgs& a = *KARGS(); const float* ss_mid = SSB() + (size_t)(2 * l + 1) * T;
            pg8::Gemm g{a.xb, a.wgu_t[l], D}; pg8::StaticOrder S; S.init(T / 256, 2 * FF / 256, G, bid);
            pg8::EpiSwiGLU E{ss_mid, a.h};
            pg8::gemm_phase<pg8::EpiSwiGLU, pg8::StaticOrder, true, true>(lds, g, S, E);
        }
        SEAM(pb + 6);
        if (MK_PH & 128) if (IN(pb + 7)) {
            const CArgs& a = *KARGS(); float* ss_out = SSB() + (size_t)(2 * l + 2) * T;
            pg8::Gemm g{a.h, a.wd_t[l], FF}; pg8::StaticOrder S; S.init(T / 256, D / 256, G, bid);
            pg8::EpiRes E{a.out, a.out, a.xb, ss_out};
            pg8::gemm_phase<pg8::EpiRes, pg8::StaticOrder, true, true>(lds, g, S, E);
        }
        SEAM(pb + 7);
    }
    if (MK_PH & 512) if (IN(17)) { LANEIDS(); final_phase(*KARGS(), SSB() + (size_t)4 * T, tid, bid, G); }
#undef IN
#undef SEAM
}

struct Layout { size_t off; size_t take(size_t bytes) { const size_t o = off; off += (bytes + 255) & ~(size_t)255; return o; } };
static size_t build_args(Args& a, void* const* d_in, void* d_out, unsigned char* ws, size_t base, int cvt_mask, int cvt_layers) {
    a.x = (const float*)d_in[0]; a.pos = (const int*)d_in[1]; a.mix_norm = (const float*)d_in[2]; a.w_in = (const float*)d_in[3]; a.gla_w_up = (const float*)d_in[4]; a.gla_b = (const float*)d_in[5];
    a.ret_gain = (const float*)d_in[6]; a.gla_gain = (const float*)d_in[7]; a.w_out = (const float*)d_in[8]; a.ffn_norm = (const float*)d_in[9]; a.w_gate = (const float*)d_in[10]; a.w_up = (const float*)d_in[11];
    a.w_down = (const float*)d_in[12]; a.final_norm = (const float*)d_in[13]; a.out = (float*)d_out;
    Layout L{base};
    a.ctl = (unsigned*)(ws + L.take(CTL_ZERO_BYTES));
    for (int l = 0; l < 2; ++l) { const bool on = l < cvt_layers;
        a.win_t[l] = (bf16_t*)(ws + ((on && (cvt_mask & 1)) ? L.take((size_t)NPROJ * D * 2) : L.off)); a.wga_t[l] = (bf16_t*)(ws + ((on && (cvt_mask & 1)) ? L.take((size_t)16 * D * 2) : L.off));
        a.wout_t[l] = (bf16_t*)(ws + ((on && (cvt_mask & 2)) ? L.take((size_t)D * D * 2) : L.off)); a.wgu_t[l] = (bf16_t*)(ws + ((on && (cvt_mask & 4)) ? L.take((size_t)2 * FF * D * 2) : L.off));
        a.wd_t[l] = (bf16_t*)(ws + ((on && (cvt_mask & 8)) ? L.take((size_t)D * FF * 2) : L.off)); }
    a.xb = (bf16_t*)(ws + L.take((size_t)T * D * 2)); a.rot = (float*)(ws + L.take((size_t)T * 128 * 4 * 2)); a.ga = (float*)(ws + L.take((size_t)T * 16 * 4)); a.lam = (float*)(ws + L.take((size_t)64 * 1024 * 4));
    a.mixed = (bf16_t*)(ws + L.take((size_t)T * D * 2));
    const size_t ov0 = L.off;
    a.qr = (bf16_t*)(ws + L.take((size_t)T * 2048 * 2)); a.kr = (bf16_t*)(ws + L.take((size_t)T * 2048 * 2)); a.krt = (bf16_t*)(ws + L.take((size_t)T * 2048 * 2)); a.vrt = (bf16_t*)(ws + L.take((size_t)T * 2048 * 2));
    a.srg = (bf16_t*)(ws + L.take((size_t)T * 2048 * 2)); a.gq = (bf16_t*)(ws + L.take((size_t)T * 1024 * 2)); a.gk = (bf16_t*)(ws + L.take((size_t)T * 1024 * 2)); a.qg = (bf16_t*)(ws + L.take((size_t)T * 1024 * 2));
    a.kg = (bf16_t*)(ws + L.take((size_t)T * 1024 * 2)); a.kgt = (bf16_t*)(ws + L.take((size_t)T * 1024 * 2)); a.vgt = (bf16_t*)(ws + L.take((size_t)T * 2048 * 2)); a.sgg = (bf16_t*)(ws + L.take((size_t)T * 2048 * 2));
    a.kvr = (bf16_t*)(ws + L.take((size_t)8 * 64 * 65536 * 2)); a.kvg = (bf16_t*)(ws + L.take((size_t)4 * 64 * 131072 * 2));
    a.h = (bf16_t*)(ws + ov0);
    if (L.off < ov0 + (size_t)T * FF * 2) L.off = ov0 + (size_t)T * FF * 2;
    a.cvt_mask = cvt_mask; a.cvt_layers = cvt_layers;
    return L.off;
}
static int g_grid = 0;
static bool setup_once() {
    if (g_grid) return g_grid > 0;
    int dev = 0, cus = 0, per_cu = 0;
    if (hipGetDevice(&dev) != hipSuccess || hipDeviceGetAttribute(&cus, hipDeviceAttributeMultiprocessorCount, dev) != hipSuccess) { fprintf(stderr, "mk: device query failed\n"); g_grid = -1; return false; }
    if (hipFuncSetAttribute((const void*)mk_fwd, hipFuncAttributeMaxDynamicSharedMemorySize, LDS_BYTES) != hipSuccess) { fprintf(stderr, "mk: hipFuncSetAttribute failed\n"); g_grid = -1; return false; }
    if (hipOccupancyMaxActiveBlocksPerMultiprocessor(&per_cu, (const void*)mk_fwd, NTHR, LDS_BYTES) != hipSuccess || per_cu < 1) { fprintf(stderr, "mk: occupancy query says %d blocks per CU\n", per_cu); (void)hipGetLastError(); }
    g_grid = cus;
    return true;
}
static void launch_range(Args a, int lo, int hi, hipStream_t stream) {
    (void)hipMemsetAsync((char*)a.ctl + (size_t)CW_BAR * 4, 0, (size_t)XCD_BAR_WORDS * 4, stream);
    a.ph_lo = lo; a.ph_hi = hi;
    hipLaunchKernelGGL(mk_fwd, dim3(g_grid), dim3(NTHR), LDS_BYTES, stream, a);
    const hipError_t e = hipPeekAtLastError(); if (e != hipSuccess) fprintf(stderr, "mk: launch [%d,%d) failed: %s\n", lo, hi, hipGetErrorName(e));
}
}
#if MK_DEBUG
namespace nv {
constexpr int T_ = 8192, D_ = 4096, INW = 14352, FF_ = 11008;
constexpr int O_RQ = 0, O_RK = 2048, O_RV = 4096, O_RG = 6144, O_GQ = 8192, O_GK = 9216, O_GV = 10240, O_GG = 12288, O_GA = 14336;

__global__ __launch_bounds__(256) void k_rmsnorm(const float* __restrict__ x, const float* __restrict__ g, float* __restrict__ out) {
    const int row = blockIdx.x; const float* xr = x + (size_t)row * D_;
    float s = 0.f;
    for (int i = threadIdx.x; i < D_; i += 256) { const float v = xr[i]; s += v * v; }
    __shared__ float red[4];
    for (int o = 32; o > 0; o >>= 1) s += __shfl_xor(s, o);
    if ((threadIdx.x & 63) == 0) red[threadIdx.x >> 6] = s;
    __syncthreads();
    s = red[0] + red[1] + red[2] + red[3];
    const float r = 1.0f / sqrtf(s / (float)D_ + 1e-6f);
    for (int i = threadIdx.x; i < D_; i += 256) out[(size_t)row * D_ + i] = xr[i] * r * g[i];
}

template <int EPI>
__global__ __launch_bounds__(256) void k_sgemm(const float* __restrict__ A, const float* __restrict__ B, float* __restrict__ C, const float* __restrict__ R, int M, int N, int K) {
    __shared__ float As[16][132];
    __shared__ float Bs[16][132];
    const int bm = blockIdx.y * 128, bn = blockIdx.x * 128;
    const int tid = threadIdx.x, tx = tid & 15, ty = tid >> 4;
    float acc[8][8];
#pragma unroll
    for (int i = 0; i < 8; ++i)
#pragma unroll
        for (int j = 0; j < 8; ++j) acc[i][j] = 0.f;
    for (int k0 = 0; k0 < K; k0 += 16) {
#pragma unroll
        for (int i = 0; i < 2; ++i) {
            const int idx = tid + i * 256, r = idx >> 2, c4 = (idx & 3) * 4;
            const float4 v = *(const float4*)&A[(size_t)(bm + r) * K + k0 + c4];
            As[c4 + 0][r] = v.x; As[c4 + 1][r] = v.y; As[c4 + 2][r] = v.z; As[c4 + 3][r] = v.w;
        }
#pragma unroll
        for (int i = 0; i < 2; ++i) {
            const int idx = tid + i * 256, kr = idx >> 5, c4 = (idx & 31) * 4;
            float4 v = make_float4(0.f, 0.f, 0.f, 0.f);
            if (bn + c4 < N) v = *(const float4*)&B[(size_t)(k0 + kr) * N + bn + c4];
            *(float4*)&Bs[kr][c4] = v;
        }
        __syncthreads();
#pragma unroll
        for (int kk = 0; kk < 16; ++kk) {
            float a[8], b[8];
            const float4 a0 = *(const float4*)&As[kk][ty * 8], a1 = *(const float4*)&As[kk][ty * 8 + 4];
            const float4 b0 = *(const float4*)&Bs[kk][tx * 8], b1 = *(const float4*)&Bs[kk][tx * 8 + 4];
            a[0] = a0.x; a[1] = a0.y; a[2] = a0.z; a[3] = a0.w; a[4] = a1.x; a[5] = a1.y; a[6] = a1.z; a[7] = a1.w;
            b[0] = b0.x; b[1] = b0.y; b[2] = b0.z; b[3] = b0.w; b[4] = b1.x; b[5] = b1.y; b[6] = b1.z; b[7] = b1.w;
#pragma unroll
            for (int i = 0; i < 8; ++i)
#pragma unroll
                for (int j = 0; j < 8; ++j) acc[i][j] = fmaf(a[i], b[j], acc[i][j]);
        }
        __syncthreads();
    }
#pragma unroll
    for (int i = 0; i < 8; ++i) {
        const int r = bm + ty * 8 + i;
#pragma unroll
        for (int j4 = 0; j4 < 2; ++j4) {
            const int c = bn + tx * 8 + j4 * 4;
            if (c < N) {
                float4 v = make_float4(acc[i][j4 * 4 + 0], acc[i][j4 * 4 + 1], acc[i][j4 * 4 + 2], acc[i][j4 * 4 + 3]);
                if (EPI == 1) { const float4 rr = *(const float4*)&R[(size_t)r * N + c]; v.x += rr.x; v.y += rr.y; v.z += rr.z; v.w += rr.w; }
                if (EPI == 2) { const float4 gg = *(const float4*)&C[(size_t)r * N + c]; v.x *= gg.x / (1.0f + __expf(-gg.x)); v.y *= gg.y / (1.0f + __expf(-gg.y)); v.z *= gg.z / (1.0f + __expf(-gg.z)); v.w *= gg.w / (1.0f + __expf(-gg.w)); }
                *(float4*)&C[(size_t)r * N + c] = v;
            }
        }
    }
}

__device__ __forceinline__ float siluf(float x) { return x / (1.0f + __expf(-x)); }

__global__ __launch_bounds__(256) void k_rotary(float* __restrict__ proj, const int* __restrict__ pos) {
    const size_t gid = (size_t)blockIdx.x * 256 + threadIdx.x;
    const int i = (int)(gid & 127), h = (int)((gid >> 7) & 7), w = (int)((gid >> 10) & 1); const int t = (int)(gid >> 11);
    if (t >= T_) return;
    const float inv_freq = powf(10000.0f, -(float)i / 128.0f);
    const float ang = (float)pos[t] * inv_freq;
    const double rev = (double)ang * 0.15915494309189533577;
    const float fr = (float)(rev - floor(rev));
    const float c = __builtin_amdgcn_cosf(fr), s = __builtin_amdgcn_sinf(fr);
    float* p = proj + (size_t)t * INW + (w ? O_RK : O_RQ) + h * 256 + i;
    const float t1 = p[0], t2 = p[128];
    p[0] = t1 * c - t2 * s; p[128] = t1 * s + t2 * c;
}

__global__ __launch_bounds__(256) void k_gate(const float* __restrict__ proj, const float* __restrict__ wup, const float* __restrict__ b, float* __restrict__ loga) {
    const int t = blockIdx.x;
    const float* ga = proj + (size_t)t * INW + O_GA;
    for (int c = threadIdx.x; c < 1024; c += 256) {
        float z = b[c];
#pragma unroll
        for (int r = 0; r < 16; ++r) z = fmaf(ga[r], wup[r * 1024 + c], z);
        const float ls = fminf(z, 0.f) - log1pf(expf(-fabsf(z)));
        loga[(size_t)t * 1024 + c] = ls * (1.0f / 16.0f);
    }
}

template <int GLA>
__global__ __launch_bounds__(256) void k_recur(const float* __restrict__ proj, int qoff, int koff, int voff, int dv, const float* __restrict__ loga, float qs, float ks, float* __restrict__ out, int ostride) {
    const int vt = blockIdx.x, h = blockIdx.y, d = threadIdx.x, lane = d & 63, wave = d >> 6;
    float S[16];
#pragma unroll
    for (int j = 0; j < 16; ++j) S[j] = 0.f;
    const float gamma = 1.0f - exp2f(-5.0f - (float)h);
    __shared__ float part[2][4][16];
    for (int t = 0; t < T_; ++t) {
        const float* row = proj + (size_t)t * INW;
        const float q = row[qoff + h * 256 + d] * qs, k = row[koff + h * 256 + d] * ks;
        const float a = GLA ? expf(loga[(size_t)t * 1024 + h * 256 + d]) : gamma;
        float p[16];
#pragma unroll
        for (int j4 = 0; j4 < 4; ++j4) {
            const float4 v = *(const float4*)&row[voff + h * dv + vt * 16 + j4 * 4];
            S[j4 * 4 + 0] = a * S[j4 * 4 + 0] + k * v.x; S[j4 * 4 + 1] = a * S[j4 * 4 + 1] + k * v.y;
            S[j4 * 4 + 2] = a * S[j4 * 4 + 2] + k * v.z; S[j4 * 4 + 3] = a * S[j4 * 4 + 3] + k * v.w;
        }
#pragma unroll
        for (int j = 0; j < 16; ++j) p[j] = q * S[j];
#pragma unroll
        for (int j = 0; j < 16; ++j)
#pragma unroll
            for (int o = 32; o > 0; o >>= 1) p[j] += __shfl_xor(p[j], o);
        if (lane == 0) {
#pragma unroll
            for (int j = 0; j < 16; ++j) part[t & 1][wave][j] = p[j];
        }
        __syncthreads();
        if (d < 16) out[(size_t)t * ostride + h * dv + vt * 16 + d] = part[t & 1][0][d] + part[t & 1][1][d] + part[t & 1][2][d] + part[t & 1][3][d];
    }
}

__global__ __launch_bounds__(256) void k_headnorm(const float* __restrict__ proj, const float* __restrict__ ro, const float* __restrict__ go, const float* __restrict__ rgain, const float* __restrict__ ggain, float* __restrict__ mixed) {
    const int t = blockIdx.x, tid = threadIdx.x, lane = tid & 63, wave = tid >> 6;
    const float* row = proj + (size_t)t * INW;
    for (int hh = 0; hh < 2; ++hh) {
        const int h = wave * 2 + hh;
        float v[4]; float s = 0.f;
#pragma unroll
        for (int j = 0; j < 4; ++j) { v[j] = ro[(size_t)t * 2048 + h * 256 + lane + 64 * j]; s += v[j]; }
        for (int o = 32; o > 0; o >>= 1) s += __shfl_xor(s, o);
        const float mu = s / 256.f; float q = 0.f;
#pragma unroll
        for (int j = 0; j < 4; ++j) { v[j] -= mu; q += v[j] * v[j]; }
        for (int o = 32; o > 0; o >>= 1) q += __shfl_xor(q, o);
        const float rs = 1.0f / sqrtf(q / 256.f + 1e-6f);
#pragma unroll
        for (int j = 0; j < 4; ++j) { const int c = h * 256 + lane + 64 * j; mixed[(size_t)t * D_ + c] = siluf(row[O_RG + c]) * (v[j] * rs * rgain[c]); }
    }
    {
        const int h = wave;
        float v[8]; float q = 0.f;
#pragma unroll
        for (int j = 0; j < 8; ++j) { v[j] = go[(size_t)t * 2048 + h * 512 + lane + 64 * j]; q += v[j] * v[j]; }
        for (int o = 32; o > 0; o >>= 1) q += __shfl_xor(q, o);
        const float rs = 1.0f / sqrtf(q / 512.f + 1e-6f);
#pragma unroll
        for (int j = 0; j < 8; ++j) { const int c = h * 512 + lane + 64 * j; mixed[(size_t)t * D_ + 2048 + c] = siluf(row[O_GG + c]) * (v[j] * rs * ggain[c]); }
    }
}

__global__ __launch_bounds__(256) void k_swiglu(float* __restrict__ G, const float* __restrict__ U, size_t n4) {
    for (size_t i = (size_t)blockIdx.x * 256 + threadIdx.x; i < n4; i += (size_t)gridDim.x * 256) {
        float4 g = ((float4*)G)[i]; const float4 u = ((const float4*)U)[i];
        g.x = siluf(g.x) * u.x; g.y = siluf(g.y) * u.y; g.z = siluf(g.z) * u.z; g.w = siluf(g.w) * u.w;
        ((float4*)G)[i] = g;
    }
}

inline void forward(void* const* d_in, float* out, float* ws, size_t ws_size, hipStream_t st) {
    const float* x = (const float*)d_in[0]; const int* pos = (const int*)d_in[1];
    const float* mix_norm = (const float*)d_in[2]; const float* w_in = (const float*)d_in[3];
    const float* gla_w_up = (const float*)d_in[4]; const float* gla_b = (const float*)d_in[5];
    const float* ret_gain = (const float*)d_in[6]; const float* gla_gain = (const float*)d_in[7];
    const float* w_out = (const float*)d_in[8]; const float* ffn_norm = (const float*)d_in[9];
    const float* w_gate = (const float*)d_in[10]; const float* w_up = (const float*)d_in[11]; const float* w_down = (const float*)d_in[12];
    const float* final_norm = (const float*)d_in[13];
    size_t o = 0;
    float* xn = ws + o; o += (size_t)T_ * D_;
    float* proj = ws + o; o += (size_t)T_ * INW;
    float* loga = ws + o; o += (size_t)T_ * 1024;
    float* ro = ws + o; o += (size_t)T_ * 2048;
    float* go = ws + o; o += (size_t)T_ * 2048;
    float* mixed = ws + o; o += (size_t)T_ * D_;
    float* xa = ws + o; o += (size_t)T_ * D_;
    float* xb = ws + o; o += (size_t)T_ * D_;
    float* G = ws + o; o += (size_t)T_ * FF_;
    if (o * 4 > ws_size) { fprintf(stderr, "naive: ws too small: need %zu have %zu\n", o * 4, ws_size); return; }
    const float* xc = x;
    for (int l = 0; l < 2; ++l) {
        k_rmsnorm<<<T_, 256, 0, st>>>(xc, mix_norm + (size_t)l * D_, xn);
        k_sgemm<0><<<dim3((INW + 127) / 128, T_ / 128), 256, 0, st>>>(xn, w_in + (size_t)l * D_ * INW, proj, nullptr, T_, INW, D_);
        k_rotary<<<(T_ * 2048) / 256, 256, 0, st>>>(proj, pos);
        k_gate<<<T_, 256, 0, st>>>(proj, gla_w_up + (size_t)l * 16 * 1024, gla_b + (size_t)l * 1024, loga);
        k_recur<0><<<dim3(16, 8), 256, 0, st>>>(proj, O_RQ, O_RK, O_RV, 256, nullptr, 1.0f, 1.0f / 16.0f, ro, 2048);
        k_recur<1><<<dim3(32, 4), 256, 0, st>>>(proj, O_GQ, O_GK, O_GV, 512, loga, 1.0f / 16.0f, 1.0f, go, 2048);
        k_headnorm<<<T_, 256, 0, st>>>(proj, ro, go, ret_gain + (size_t)l * 2048, gla_gain + (size_t)l * 2048, mixed);
        k_sgemm<1><<<dim3(D_ / 128, T_ / 128), 256, 0, st>>>(mixed, w_out + (size_t)l * D_ * D_, xa, xc, T_, D_, D_);
        k_rmsnorm<<<T_, 256, 0, st>>>(xa, ffn_norm + (size_t)l * D_, xn);
        k_sgemm<0><<<dim3(FF_ / 128, T_ / 128), 256, 0, st>>>(xn, w_gate + (size_t)l * D_ * FF_, G, nullptr, T_, FF_, D_);
        k_sgemm<2><<<dim3(FF_ / 128, T_ / 128), 256, 0, st>>>(xn, w_up + (size_t)l * D_ * FF_, G, nullptr, T_, FF_, D_);
        k_sgemm<1><<<dim3(D_ / 128, T_ / 128), 256, 0, st>>>(G, w_down + (size_t)l * FF_ * D_, xb, xa, T_, D_, FF_);
        xc = xb;
    }
    k_rmsnorm<<<T_, 256, 0, st>>>(xc, final_norm, out);
}
}
#endif
#if MK_DEBUG
namespace dbg {
typedef unsigned short bf16_t;
constexpr int T = 8192, INW = 14352;
__device__ __forceinline__ float bf(bf16_t v) { return __uint_as_float((unsigned)v << 16); }
__device__ __forceinline__ void acc2(float* slot, float se, float sb) {
    for (int o = 32; o > 0; o >>= 1) { se += __shfl_xor(se, o); sb += __shfl_xor(sb, o); }
    if ((threadIdx.x & 63) == 0) { atomicAdd(slot, se); atomicAdd(slot + 1, sb); }
}
__global__ void k_cmp_bf16(const bf16_t* got, int gld, int transposed, const float* ref, int rld, int roff, int rows, int cols, int mode, float scale, float* slot) {
    float se = 0.f, sb = 0.f;
    for (size_t i = (size_t)blockIdx.x * blockDim.x + threadIdx.x; i < (size_t)rows * cols; i += (size_t)gridDim.x * blockDim.x) {
        const int r = (int)(i / cols), c = (int)(i % cols);
        float e = ref[(size_t)r * rld + roff + c] * scale;
        if (mode == 1) e = e / (1.0f + expf(-e));
        if (mode == 2 || mode == 3) { const int h = c >> 8; const float lg = log2f(1.0f - exp2f(-5.0f - (float)h)); const float ip1 = (float)((r & 127) + 1); e *= (mode == 2) ? exp2f(ip1 * lg) : exp2f(-ip1 * lg) * 0.0625f; }
        const float g = transposed ? bf(got[(size_t)c * gld + r]) : bf(got[(size_t)r * gld + c]);
        const float d = g - e; se += (d == d) ? d * d : 1e30f; sb += e * e;
    }
    acc2(slot, se, sb);
}
__global__ void k_cmp_f32(const float* got, int gld, const float* ref, int rld, int roff, int rows, int cols, float* slot) {
    float se = 0.f, sb = 0.f;
    for (size_t i = (size_t)blockIdx.x * blockDim.x + threadIdx.x; i < (size_t)rows * cols; i += (size_t)gridDim.x * blockDim.x) {
        const int r = (int)(i / cols), c = (int)(i % cols);
        const float e = ref[(size_t)r * rld + roff + c], g = got[(size_t)r * gld + c]; const float d = g - e; se += (d == d) ? d * d : 1e30f; sb += e * e; }
    acc2(slot, se, sb);
}
__global__ void k_cmp_tr(const bf16_t* a, int ald, const bf16_t* b, int bld, int rows, int cols, float* slot) {
    float se = 0.f, sb = 0.f;
    for (size_t i = (size_t)blockIdx.x * blockDim.x + threadIdx.x; i < (size_t)rows * cols; i += (size_t)gridDim.x * blockDim.x) {
        const int r = (int)(i / cols), c = (int)(i % cols); const float e = bf(a[(size_t)r * ald + c]), g = bf(b[(size_t)c * bld + r]); const float d = g - e; se += (d == d) ? d * d : 1e30f; sb += e * e; }
    acc2(slot, se, sb);
}
__global__ void k_cmp_ss(const float* ss, const float* ref, int rld, float* slot) {
    const int t = blockIdx.x; float s = 0.f; for (int i = threadIdx.x; i < 4096; i += 256) { const float v = ref[(size_t)t * rld + i]; s += v * v; }
    __shared__ float red[4]; for (int o = 32; o > 0; o >>= 1) s += __shfl_xor(s, o); if ((threadIdx.x & 63) == 0) red[threadIdx.x >> 6] = s; __syncthreads();
    if (threadIdx.x == 0) { const float e = red[0] + red[1] + red[2] + red[3], d = ss[t] - e; atomicAdd(slot, (d == d) ? d * d : 1e30f); atomicAdd(slot + 1, e * e); }
}
__global__ void k_cmp_gla(const bf16_t* qg, const bf16_t* kg, const float* lam, const float* proj, const float* loga, float* slot_q, float* slot_k, float* slot_l) {
    const int c = blockIdx.x, ch = blockIdx.y * 256 + threadIdx.x; float cum = 0.f, seq = 0.f, sbq = 0.f, sek = 0.f, sbk = 0.f;
    for (int tt = 0; tt < 128; ++tt) { const int t = c * 128 + tt; cum += loga[(size_t)t * 1024 + ch];
        const float eq = proj[(size_t)t * INW + 8192 + ch] * 0.0625f * expf(cum), ek = proj[(size_t)t * INW + 9216 + ch] * expf(-cum);
        float d = bf(qg[(size_t)t * 1024 + ch]) - eq; seq += (d == d) ? d * d : 1e30f; sbq += eq * eq; d = bf(kg[(size_t)t * 1024 + ch]) - ek; sek += (d == d) ? d * d : 1e30f; sbk += ek * ek; }
    const float el = expf(cum), dl = lam[c * 1024 + ch] - el;
    acc2(slot_q, seq, sbq); acc2(slot_k, sek, sbk); acc2(slot_l, (dl == dl) ? dl * dl : 1e30f, el * el);
}
__global__ void k_cmp_kv(const bf16_t* kb, int ldk, const bf16_t* vt, const bf16_t* kv, int DV, float* slot) {
    const int c = blockIdx.x, h = blockIdx.y, t0 = c * 128; float se = 0.f, sb = 0.f;
    for (int idx = threadIdx.x; idx < DV * 256; idx += 256) { const int v = idx >> 8, d = idx & 255; float e = 0.f;
        for (int j = 0; j < 128; ++j) e += bf(vt[(size_t)(h * DV + v) * T + t0 + j]) * bf(kb[(size_t)(t0 + j) * ldk + h * 256 + d]);
        const float g = bf(kv[((size_t)(h * 64 + c) * DV + v) * 256 + d]); const float dd = g - e; se += (dd == dd) ? dd * dd : 1e30f; sb += e * e; }
    acc2(slot, se, sb);
}
__global__ void k_cmp_s(const bf16_t* kb, int ldk, const bf16_t* vt, const bf16_t* sbuf, const float* lam, int DV, float* slot) {
    const int h = blockIdx.y; const int idx = blockIdx.x * 256 + threadIdx.x; const int v = idx >> 8, d = idx & 255; float se = 0.f, sb = 0.f, st = 0.f;
    const float lret = exp2f(128.0f * log2f(1.0f - exp2f(-5.0f - (float)h)));
    for (int c = 0; c < 64; ++c) { const float g = bf(sbuf[((size_t)(h * 64 + c) * DV + v) * 256 + d]); const float dd = g - st; se += (dd == dd) ? dd * dd : 1e30f; sb += st * st;
        float e = 0.f; for (int j = 0; j < 128; ++j) e += bf(vt[(size_t)(h * DV + v) * T + c * 128 + j]) * bf(kb[(size_t)(c * 128 + j) * ldk + h * 256 + d]);
        st = (lam ? lam[c * 1024 + h * 256 + d] : lret) * (st + e); }
    acc2(slot, se, sb);
}
__global__ void k_cmp_p(const bf16_t* q, const bf16_t* k, const bf16_t* pd, float* slot) {
    const int c = blockIdx.x, h = blockIdx.y, t0 = c * 128; float se[4] = {0.f, 0.f, 0.f, 0.f}, sb[4] = {0.f, 0.f, 0.f, 0.f};
    for (int idx = threadIdx.x; idx < 16384; idx += 256) { const int i = idx >> 7, j = idx & 127; float e = 0.f;
        for (int d = 0; d < 256; ++d) e += bf(q[(size_t)(t0 + i) * 2048 + h * 256 + d]) * bf(k[(size_t)(t0 + j) * 2048 + h * 256 + d]);
        const int cls = (j > i) ? 3 : ((i >> 4) != (j >> 4)) ? 0 : (j < i) ? 1 : 2;
        const float g = bf(pd[(size_t)(h * 64 + c) * 16384 + idx]); const float ee = (cls == 3) ? 0.f : e; const float dd = g - ee;
#pragma unroll
        for (int z = 0; z < 4; ++z) if (cls == z) { se[z] += (dd == dd) ? dd * dd : 1e30f; sb[z] += (z == 3) ? e * e : ee * ee; } }
#pragma unroll
    for (int z = 0; z < 4; ++z) acc2(slot + 2 * z, se[z], sb[z]);
}
__global__ void k_cmp_o(const bf16_t* q, const bf16_t* pd, const bf16_t* vt, const bf16_t* sbuf, const float* od, float* slot) {
    const int t = blockIdx.x, h = blockIdx.y, v = threadIdx.x, c = t >> 7, i = t & 127; float e = 0.f;
    for (int j = 0; j < 128; ++j) e += bf(pd[(size_t)(h * 64 + c) * 16384 + i * 128 + j]) * bf(vt[(size_t)(h * 256 + v) * T + c * 128 + j]);
    for (int d = 0; d < 256; ++d) e += bf(q[(size_t)t * 2048 + h * 256 + d]) * bf(sbuf[((size_t)(h * 64 + c) * 256 + v) * 256 + d]);
    const float g = od[(size_t)t * 2048 + h * 256 + v]; const float dd = g - e; acc2(slot, (dd == dd) ? dd * dd : 1e30f, e * e);
}
__global__ void k_decide(const float* slots, int n, const float* tol, float* code) {
    if (threadIdx.x || blockIdx.x) return; float cd = 9900.0f;
    for (int i = 0; i < n; ++i) { const float se = slots[2 * i], sb = slots[2 * i + 1]; const float rel = sqrtf(se / fmaxf(sb, 1e-30f));
        if (!(rel < tol[i]) || !(sb > 0.f)) { int b = (rel == rel && rel > 0.f) ? (int)floorf(2.0f * log10f(fmaxf(rel, 1e-3f) / 1e-3f)) : 20; b = b < 0 ? 0 : (b > 20 ? 20 : b); cd = (float)(10 + i) * powf(10.0f, (float)(2 + b)); break; } }
    *code = cd;
}
__global__ void k_fill_code(float* out, size_t n, const float* code) { const float c = *code; for (size_t i = (size_t)blockIdx.x * blockDim.x + threadIdx.x; i < n; i += (size_t)gridDim.x * blockDim.x) out[i] = c; }
}

extern "C" void kernel_launch(void* const* d_in, const int* in_sizes, int n_in, void* d_out, int out_size, void* d_ws, size_t ws_size, hipStream_t stream) {
    using namespace nv;
    if (!mk::setup_once()) return;
    hipStream_t st = stream; float* ws = (float*)d_ws;
    const float* x = (const float*)d_in[0]; const int* pos = (const int*)d_in[1]; const float* mix_norm = (const float*)d_in[2]; const float* w_in = (const float*)d_in[3];
    const float* gla_w_up = (const float*)d_in[4]; const float* gla_b = (const float*)d_in[5]; const float* ret_gain = (const float*)d_in[6]; const float* gla_gain = (const float*)d_in[7];
    const float* w_out = (const float*)d_in[8]; const float* ffn_norm = (const float*)d_in[9]; const float* w_gate = (const float*)d_in[10]; const float* w_up = (const float*)d_in[11]; const float* w_down = (const float*)d_in[12];
#if MK_DEBUG == 1
    size_t o = 0;
    float* xn = ws + o; o += (size_t)T_ * D_; float* proj = ws + o; o += (size_t)T_ * INW; float* loga = ws + o; o += (size_t)T_ * 1024; float* ro = ws + o; o += (size_t)T_ * 2048; float* go = ws + o; o += (size_t)T_ * 2048;
    float* mixed = ws + o; o += (size_t)T_ * D_; float* xa = ws + o; o += (size_t)T_ * D_;
    mk::Args a{}; size_t need = mk::build_args(a, d_in, d_out, (unsigned char*)d_ws, o * 4, 3, 1);
    a.dbgp = (bf16_t*)((unsigned char*)d_ws + need); need += (size_t)8 * 64 * 16384 * 2; a.dbgo = (float*)((unsigned char*)d_ws + need); need += (size_t)T_ * 2048 * 4;
    if (need > ws_size) { fprintf(stderr, "dbg: ws too small %zu > %zu\n", need, ws_size); return; }
    (void)hipMemsetAsync(a.ctl, 0, mk::CTL_ZERO_BYTES, st);
    k_rmsnorm<<<T_, 256, 0, st>>>(x, mix_norm, xn);
    k_sgemm<0><<<dim3((INW + 127) / 128, T_ / 128), 256, 0, st>>>(xn, w_in, proj, nullptr, T_, INW, D_);
    k_rotary<<<(T_ * 2048) / 256, 256, 0, st>>>(proj, pos);
    k_gate<<<T_, 256, 0, st>>>(proj, gla_w_up, gla_b, loga);
    k_recur<0><<<dim3(16, 8), 256, 0, st>>>(proj, O_RQ, O_RK, O_RV, 256, nullptr, 1.0f, 1.0f / 16.0f, ro, 2048);
    k_recur<1><<<dim3(32, 4), 256, 0, st>>>(proj, O_GQ, O_GK, O_GV, 512, loga, 1.0f / 16.0f, 1.0f, go, 2048);
    k_headnorm<<<T_, 256, 0, st>>>(proj, ro, go, ret_gain, gla_gain, mixed);
    k_sgemm<1><<<dim3(D_ / 128, T_ / 128), 256, 0, st>>>(mixed, w_out, xa, x, T_, D_, D_);
    float* slots = (float*)(a.ctl + mk::CW_CHK); float* tol = slots + 128; float* code = slots + 256;
#if MK_DBG_ONELAUNCH
    mk::launch_range(a, 0, 7, st);
#else
    for (int p = 0; p < 4; ++p) mk::launch_range(a, p, p + 1, st);
    dbg::k_cmp_kv<<<dim3(64, 8), 256, 0, st>>>(a.kr, 2048, a.vrt, a.kvr, 256, slots + 2 * 15);
    dbg::k_cmp_kv<<<dim3(64, 4), 256, 0, st>>>(a.kg, 1024, a.vgt, a.kvg, 512, slots + 2 * 16);
    mk::launch_range(a, 4, 5, st);
    dbg::k_cmp_s<<<dim3(256, 8), 256, 0, st>>>(a.kr, 2048, a.vrt, a.kvr, nullptr, 256, slots + 2 * 17);
    dbg::k_cmp_s<<<dim3(512, 4), 256, 0, st>>>(a.kg, 1024, a.vgt, a.kvg, a.lam, 512, slots + 2 * 18);
    mk::launch_range(a, 5, 6, st); mk::launch_range(a, 6, 7, st);
#endif
    const float* ss0 = (const float*)(a.ctl + mk::CW_SS); const float* ss1 = ss0 + T_;
    int n = 0; float htol[64];
    dim3 cg(2048), cb(256);
    dbg::k_cmp_ss<<<T_, 256, 0, st>>>(ss0, x, D_, slots + 2 * n); htol[n++] = 1e-4f;
    dbg::k_cmp_bf16<<<cg, cb, 0, st>>>(a.qr, 2048, 0, proj, INW, O_RQ, T_, 2048, 2, 1.0f, slots + 2 * n); htol[n++] = 1e-2f;
    dbg::k_cmp_bf16<<<cg, cb, 0, st>>>(a.kr, 2048, 0, proj, INW, O_RK, T_, 2048, 3, 1.0f, slots + 2 * n); htol[n++] = 1e-2f;
    dbg::k_cmp_bf16<<<cg, cb, 0, st>>>(a.vrt, T_, 1, proj, INW, O_RV, T_, 2048, 0, 1.0f, slots + 2 * n); htol[n++] = 1e-2f;
    dbg::k_cmp_bf16<<<cg, cb, 0, st>>>(a.srg, 2048, 0, proj, INW, O_RG, T_, 2048, 1, 1.0f, slots + 2 * n); htol[n++] = 1e-2f;
    dbg::k_cmp_bf16<<<cg, cb, 0, st>>>(a.gq, 1024, 0, proj, INW, O_GQ, T_, 1024, 0, 0.0625f, slots + 2 * n); htol[n++] = 1e-2f;
    dbg::k_cmp_bf16<<<cg, cb, 0, st>>>(a.gk, 1024, 0, proj, INW, O_GK, T_, 1024, 0, 1.0f, slots + 2 * n); htol[n++] = 1e-2f;
    dbg::k_cmp_bf16<<<cg, cb, 0, st>>>(a.vgt, T_, 1, proj, INW, O_GV, T_, 2048, 0, 1.0f, slots + 2 * n); htol[n++] = 1e-2f;
    dbg::k_cmp_bf16<<<cg, cb, 0, st>>>(a.sgg, 2048, 0, proj, INW, O_GG, T_, 2048, 1, 1.0f, slots + 2 * n); htol[n++] = 1e-2f;
    dbg::k_cmp_f32<<<cg, cb, 0, st>>>(a.ga, 16, proj, INW, O_GA, T_, 16, slots + 2 * n); htol[n++] = 1e-2f;
    dbg::k_cmp_tr<<<cg, cb, 0, st>>>(a.kr, 2048, a.krt, T_, T_, 2048, slots + 2 * n); htol[n++] = 1e-6f;
    dbg::k_cmp_gla<<<dim3(64, 4), 256, 0, st>>>(a.qg, a.kg, a.lam, proj, loga, slots + 2 * n, slots + 2 * (n + 1), slots + 2 * (n + 2)); htol[n++] = 2e-2f; htol[n++] = 2e-2f; htol[n++] = 2e-2f;
    dbg::k_cmp_tr<<<cg, cb, 0, st>>>(a.kg, 1024, a.kgt, T_, T_, 1024, slots + 2 * n); htol[n++] = 1e-6f;
#if MK_DBG_ONELAUNCH
    for (int i = 0; i < 4; ++i) { unsigned one = 0x3f800000u; (void)hipMemsetD32Async((hipDeviceptr_t)(slots + 2 * (15 + i) + 1), (int)one, 1, st); }
#endif
    htol[n++] = 1e-2f; htol[n++] = 1e-2f; htol[n++] = 1e-2f; htol[n++] = 1e-2f;
    dbg::k_cmp_p<<<dim3(64, 8), 256, 0, st>>>(a.qr, a.kr, a.dbgp, slots + 2 * n); htol[n++] = 1e-2f; htol[n++] = 1e-2f; htol[n++] = 1e-2f; htol[n++] = 1e-2f;
    dbg::k_cmp_o<<<dim3(T_, 8), 256, 0, st>>>(a.qr, a.dbgp, a.vrt, a.kvr, a.dbgo, slots + 2 * n); htol[n++] = 1e-2f;
    dbg::k_cmp_bf16<<<cg, cb, 0, st>>>(a.mixed, 4096, 0, mixed, D_, 0, T_, 2048, 0, 1.0f, slots + 2 * n); htol[n++] = 3e-2f;
    dbg::k_cmp_bf16<<<cg, cb, 0, st>>>(a.mixed + 2048, 4096, 0, mixed, D_, 2048, T_, 2048, 0, 1.0f, slots + 2 * n); htol[n++] = 3e-2f;
    dbg::k_cmp_f32<<<cg, cb, 0, st>>>((const float*)d_out, D_, xa, D_, 0, T_, D_, slots + 2 * n); htol[n++] = 1e-2f;
    dbg::k_cmp_bf16<<<cg, cb, 0, st>>>(a.xb, 4096, 0, xa, D_, 0, T_, D_, 0, 1.0f, slots + 2 * n); htol[n++] = 1e-2f;
    dbg::k_cmp_ss<<<T_, 256, 0, st>>>(ss1, xa, D_, slots + 2 * n); htol[n++] = 1e-2f;
#else
    size_t o = 0;
    float* xn = ws + o; o += (size_t)T_ * D_; float* xa = ws + o; o += (size_t)T_ * D_; float* xb2 = ws + o; o += (size_t)T_ * D_; float* G = ws + o; o += (size_t)T_ * FF_;
    mk::Args a{}; const size_t need = mk::build_args(a, d_in, d_out, (unsigned char*)d_ws, o * 4, 12, 1);
    if (need > ws_size) { fprintf(stderr, "dbg: ws too small %zu > %zu\n", need, ws_size); return; }
    (void)hipMemsetAsync(a.ctl, 0, mk::CTL_ZERO_BYTES, st);
    (void)hipMemcpyAsync(xa, x, (size_t)T_ * D_ * 4, hipMemcpyDeviceToDevice, st);
    (void)hipMemcpyAsync(d_out, x, (size_t)T_ * D_ * 4, hipMemcpyDeviceToDevice, st);
    k_rmsnorm<<<T_, 256, 0, st>>>(xa, ffn_norm, xn);
    k_sgemm<0><<<dim3(FF_ / 128, T_ / 128), 256, 0, st>>>(xn, w_gate, G, nullptr, T_, FF_, D_);
    k_sgemm<2><<<dim3(FF_ / 128, T_ / 128), 256, 0, st>>>(xn, w_up, G, nullptr, T_, FF_, D_);
    k_sgemm<1><<<dim3(D_ / 128, T_ / 128), 256, 0, st>>>(G, w_down, xb2, xa, T_, D_, FF_);
    mk::launch_range(a, 0, 1, st);
    (void)hipMemcpyAsync((float*)(a.ctl + mk::CW_SS) + T_, (float*)(a.ctl + mk::CW_SS), (size_t)T_ * 4, hipMemcpyDeviceToDevice, st);
#if MK_DBG_ONELAUNCH
    mk::launch_range(a, 7, 9, st);
#else
    mk::launch_range(a, 7, 8, st); mk::launch_range(a, 8, 9, st);
#endif
    float* slots = (float*)(a.ctl + mk::CW_CHK); float* tol = slots + 128; float* code = slots + 256;
    const float* ss2 = (const float*)(a.ctl + mk::CW_SS) + 2 * T_;
    int n = 0; float htol[64]; dim3 cg(2048), cb(256);
    dbg::k_cmp_bf16<<<cg, cb, 0, st>>>(a.h, FF_, 0, G, FF_, 0, T_, FF_, 0, 1.0f, slots + 2 * n); htol[n++] = 2e-2f;
    dbg::k_cmp_f32<<<cg, cb, 0, st>>>((const float*)d_out, D_, xb2, D_, 0, T_, D_, slots + 2 * n); htol[n++] = 1e-2f;
    dbg::k_cmp_bf16<<<cg, cb, 0, st>>>(a.xb, 4096, 0, xb2, D_, 0, T_, D_, 0, 1.0f, slots + 2 * n); htol[n++] = 1e-2f;
    dbg::k_cmp_ss<<<T_, 256, 0, st>>>(ss2, xb2, D_, slots + 2 * n); htol[n++] = 1e-2f;
#endif
    for (int i = 0; i < n; ++i) { unsigned bits; memcpy(&bits, &htol[i], 4); (void)hipMemsetD32Async((hipDeviceptr_t)(tol + i), (int)bits, 1, st); }
    dbg::k_decide<<<1, 64, 0, st>>>(slots, n, tol, code);
    dbg::k_fill_code<<<2048, 256, 0, st>>>((float*)d_out, (size_t)T_ * D_, code);
}
#endif

#if !MK_DEBUG
extern "C" void kernel_launch(void* const* d_in, const int* in_sizes, int n_in, void* d_out, int out_size, void* d_ws, size_t ws_size, hipStream_t stream) {
    if (!mk::setup_once()) return;
    mk::Args a{};
    const size_t need = mk::build_args(a, d_in, d_out, (unsigned char*)d_ws, 0, 15, 2);
    if (need > ws_size || n_in != 14) { fprintf(stderr, "mk: workspace too small (%zu > %zu) or wrong input count %d\n", need, ws_size, n_in); return; }
    (void)hipMemsetAsync(d_ws, 0, mk::CTL_ZERO_BYTES, stream);
#if MK_SPLIT
    for (int p = 0; p < mk::N_PHASES; ++p) mk::launch_range(a, p, p + 1, stream);
#else
    mk::launch_range(a, 0, mk::N_PHASES, stream);
#endif
}
#endif
```

```cpp
#include <hip/hip_runtime.h>
#include <cstdio>
#include <cstdint>
#include <cstring>
#define MK_DEBUG 0
#define MK_SPLIT 0
#define MK_DBG_ONELAUNCH 0
#define MK_TIMING 0
namespace pg8 {
#define PG8_LAS __attribute__((address_space(3)))
typedef unsigned short bf16_t;
typedef short bf16x8 __attribute__((ext_vector_type(8)));
typedef float f32x4 __attribute__((ext_vector_type(4)));
typedef unsigned u32x4 __attribute__((ext_vector_type(4)));
constexpr int BM = 256, BK = 64, HALF = 128, HTB = HALF * BK * 2  , STAGE_BYTES = 8 * HTB, NXCD = 8, WGM = 8;

__host__ __device__ __forceinline__ int lds_byte(int r, int c) { const int st = (r >> 4) * 2 + (c >> 5), rr = r & 15, cc = c & 31, ob = rr * 64 + cc * 2; return st * 1024 + (ob ^ (((ob >> 9) & 1) << 5)); }
__host__ __device__ __forceinline__ void stage_rc(int b, int& R, int& C) { const int st = b / 1024, sb = b % 1024, swz = sb ^ (((sb >> 9) & 1) << 5); R = (st >> 1) * 16 + swz / 64; C = (st & 1) * 32 + (swz % 64) / 2; }
__host__ __device__ __forceinline__ int perm32(int rho) { const int n = rho >> 4, i = rho & 15; return 8 * (i >> 2) + 4 * n + (i & 3); }

struct Unit { int pm, pn, sw; };
struct Gemm { const bf16_t* A; const bf16_t* Bt; int K; int a_pitch, a_kstep, b_pitch, b_kstep; };

struct StaticOrder {
    int nM, nN, nwg, G, c;
    __host__ __device__ void init(int nM_, int nN_, int G_, int c_) { nM = nM_; nN = nN_; nwg = nM * nN; G = G_; c = c_; }
    __host__ __device__ bool next(int i, Unit& u) const {
        const long L = (long)i * G + c; if (L >= nwg) return false;
        int wgid = (int)L; { const int q = nwg / NXCD, r = nwg % NXCD, xcd = wgid % NXCD, off = wgid / NXCD; wgid = (xcd < r ? xcd * (q + 1) : r * (q + 1) + (xcd - r) * q) + off; }
        const int nig = WGM * nN, gid = wgid / nig, fm = gid * WGM, gsz = (nM - fm) < WGM ? (nM - fm) : WGM;
        u.pm = fm + ((wgid % nig) % gsz); u.pn = (wgid % nig) / gsz; u.sw = 0; return true;
    }
    __device__ __forceinline__ void a_ready(const Unit&) const {}
    __device__ __forceinline__ void done(const Unit&) const {}
};

#ifndef MK_EPI_NT
#define MK_EPI_NT 0
#endif
#ifndef MK_G1_PROBE
#define MK_G1_PROBE 0
#endif
#define MK_PST16(p, v) do { if (!((MK_G1_PROBE == 1 || (MK_G1_PROBE == 3 && issw_) || (MK_G1_PROBE == 4 && !issw_) || (MK_G1_PROBE == 5 && (blockIdx.x & 1))) && probe)) MK_ST16(p, v); } while (0)
#ifndef MK_EPI_LASTWT
#define MK_EPI_LASTWT 0
#endif
#if MK_EPI_NT
#define MK_ST16(p, v) __builtin_nontemporal_store((v), (u32x4*)(p))
#elif MK_EPI_LASTWT
#define MK_ST16(p, v) do { const u32x4 v_ = (v); void* const p_ = (void*)(p); if (lastu) asm volatile("global_store_dwordx4 %0, %1, off sc1\n\ts_nop 1" :: "v"(p_), "v"(v_) : "memory"); else *(u32x4*)p_ = v_; } while (0)
#else
#define MK_ST16(p, v) (*(u32x4*)(p) = (v))
#endif
#ifndef MK_VT_BLK
#define MK_VT_BLK 0
#endif

typedef __bf16 bf16x2v __attribute__((ext_vector_type(2)));
__device__ __forceinline__ unsigned cvt_pk_bf16(float lo, float hi) { bf16x2v v; v[0] = (__bf16)lo; v[1] = (__bf16)hi; return __builtin_bit_cast(unsigned, v); }
__device__ __forceinline__ u32x4 pack8(const f32x4 a, const f32x4 b) { u32x4 w; w.x = cvt_pk_bf16(a[0], a[1]); w.y = cvt_pk_bf16(a[2], a[3]); w.z = cvt_pk_bf16(b[0], b[1]); w.w = cvt_pk_bf16(b[2], b[3]); return w; }
typedef unsigned long long u64;
__device__ __forceinline__ u64 ss_fix(float sq) { return (u64)(sq * 1048576.0f + 0.5f); }
__device__ __forceinline__ float rs_of(u64 ss) { return __builtin_amdgcn_rsqf((float)ss * (1.0f / (1048576.0f * 4096.0f)) + 1e-6f); }
__device__ __forceinline__ float silu1f(float v) { return v * __builtin_amdgcn_rcpf(1.0f + __builtin_amdgcn_exp2f(-1.44269504f * v)); }
__device__ __forceinline__ f32x4 silu4(const f32x4 v) { f32x4 o; o[0] = silu1f(v[0]); o[1] = silu1f(v[1]); o[2] = silu1f(v[2]); o[3] = silu1f(v[3]); return o; }

constexpr int TT = 8192;

struct EpiProj {
    static constexpr bool PERM = true, AFTER_DRAIN = false;
    const u64* ss;
    const int* pos;
    bf16_t *qr, *kr, *vrt, *srg, *gq, *gk, *vgt, *sgg;
    int probe;
    __device__ __forceinline__ void operator()(const f32x4 (&acc)[2][2][4][2], const Unit& u, int wr, int wc, int fr_, int fq_, bool lastu = false) const {
        int fr = fr_, fq = fq_; asm volatile("" : "+v"(fr), "+v"(fq));
        int pn = u.pn; asm volatile("" : "+s"(pn));
        const bool issw_ = (pn >= 16 && pn < 24) || (pn >= 40 && pn < 48); (void)issw_;
        if (issw_) {
#if MK_VT_BLK
            bf16_t* dst = ((pn < 24) ? vrt + (size_t)(pn - 16) * 65536 : vgt + (size_t)(pn - 40) * 65536) + (size_t)u.pm * (2048 * 256) + (wc * 32 + 8 * fq);
#else
            bf16_t* dst = (pn < 24) ? vrt + (size_t)(pn - 16) * 256 * TT : vgt + (size_t)(pn - 40) * 256 * TT;
#endif
            const int tc0 = u.pm * BM + wc * 32 + 8 * fq;
            f32x4 rs[2][2];
#pragma unroll
            for (int bj = 0; bj < 2; ++bj)
#pragma unroll
                for (int n = 0; n < 2; ++n) { const u64* sp = ss + tc0 + bj * HALF + 4 * n; rs[bj][n] = (f32x4){rs_of(sp[0]), rs_of(sp[1]), rs_of(sp[2]), rs_of(sp[3])}; }
#pragma unroll
            for (int ai = 0; ai < 2; ++ai)
#pragma unroll
                for (int m = 0; m < 4; ++m) {
#if MK_VT_BLK
                    bf16_t* rowp = dst + (ai * HALF + wr * 64 + m * 16 + fr) * 256;
#else
                    bf16_t* rowp = dst + (size_t)(ai * HALF + wr * 64 + m * 16 + fr) * TT + tc0;
#endif

#pragma unroll
                    for (int bj = 0; bj < 2; ++bj) MK_PST16(rowp + bj * HALF, pack8(acc[ai][bj][m][0] * rs[bj][0], acc[ai][bj][m][1] * rs[bj][1])); }
            return;
        }
        const int t0 = u.pm * BM + wr * 64 + fr;
        const int cl = wc * 32 + 8 * fq;
        if (pn < 16) {
            const int h = pn & 7; const bool isk = pn >= 8; bf16_t* dst = (isk ? kr : qr) + h * 256;
            const float lg = log2f(1.0f - exp2f(-5.0f - (float)h));
            float invf[2][4];
#pragma unroll
            for (int n = 0; n < 2; ++n)
#pragma unroll
                for (int j = 0; j < 4; ++j) invf[n][j] = exp2f(-(float)(cl + 4 * n + j) * (13.287712379549449f / 128.0f));
            u64 ssv[2][4]; int pv[2][4];
#pragma unroll
            for (int ai = 0; ai < 2; ++ai)
#pragma unroll
                for (int m = 0; m < 4; ++m) { ssv[ai][m] = ss[t0 + ai * HALF + m * 16]; pv[ai][m] = pos[t0 + ai * HALF + m * 16]; }
            asm volatile("" ::: "memory");
#pragma unroll
            for (int ai = 0; ai < 2; ++ai)
#pragma unroll
                for (int m = 0; m < 4; ++m) { const int t = t0 + ai * HALF + m * 16; const float ip1 = (float)((t & 255) + 1); const float posf = (float)pv[ai][m];
                    const float sc = rs_of(ssv[ai][m]) * (isk ? exp2f(-ip1 * lg) * 0.0625f : exp2f(ip1 * lg));
                    f32x4 o1[2], o2[2];
#pragma unroll
                    for (int n = 0; n < 2; ++n) { f32x4 c4, s4;
#pragma unroll
                        for (int j = 0; j < 4; ++j) { const float fr = __builtin_amdgcn_fractf((posf * invf[n][j]) * 0.15915494309189535f); if (MK_G1_PROBE == 2 && probe) { c4[j] = 1.0f; s4[j] = fr; } else { c4[j] = __builtin_amdgcn_cosf(fr); s4[j] = __builtin_amdgcn_sinf(fr); } }
                        const f32x4 a = acc[ai][0][m][n], b = acc[ai][1][m][n]; o1[n] = (a * c4 - b * s4) * sc; o2[n] = (a * s4 + b * c4) * sc; }
                    bf16_t* rowp = dst + (size_t)t * 2048 + cl;
                    MK_PST16(rowp, pack8(o1[0], o1[1])); MK_PST16(rowp + HALF, pack8(o2[0], o2[1])); }
            return;
        }
        bf16_t* dst; int ld; float sc = 1.0f; bool act = false;
        if (pn < 32) { dst = srg + (pn - 24) * 256; ld = 2048; act = true; }
        else if (pn < 36) { dst = gq + (pn - 32) * 256; ld = 1024; sc = 0.0625f; }
        else if (pn < 40) { dst = gk + (pn - 36) * 256; ld = 1024; }
        else { dst = sgg + (pn - 48) * 256; ld = 2048; act = true; }
        u64 ssv[2][4];
#pragma unroll
        for (int ai = 0; ai < 2; ++ai)
#pragma unroll
            for (int m = 0; m < 4; ++m) ssv[ai][m] = ss[t0 + ai * HALF + m * 16];
        asm volatile("" ::: "memory");
#pragma unroll
        for (int ai = 0; ai < 2; ++ai)
#pragma unroll
            for (int m = 0; m < 4; ++m) { const int t = t0 + ai * HALF + m * 16; const float s = rs_of(ssv[ai][m]) * sc; bf16_t* rowp = dst + (size_t)t * ld + cl;
#pragma unroll
                for (int bj = 0; bj < 2; ++bj) { f32x4 v0 = acc[ai][bj][m][0] * s, v1 = acc[ai][bj][m][1] * s; if (act && !(MK_G1_PROBE == 2 && probe)) { v0 = silu4(v0); v1 = silu4(v1); }
                    MK_PST16(rowp + bj * HALF, pack8(v0, v1)); } }
    }
};

struct EpiRes {
    static constexpr bool PERM = true, AFTER_DRAIN = false;
    bf16_t* xb; u64* ssout; u64* dup;
    __device__ __forceinline__ void operator()(const f32x4 (&acc)[2][2][4][2], const Unit& u, int wr, int wc, int fr_, int fq_, bool lastu = false) const {
        int fr = fr_, fq = fq_; asm volatile("" : "+v"(fr), "+v"(fq));
        const int t0 = u.pm * BM + wr * 64 + fr, c0 = u.pn * BM + wc * 32 + 8 * fq;
        u32x4 xi[2][4][2];
#pragma unroll
        for (int ai = 0; ai < 2; ++ai)
#pragma unroll
            for (int m = 0; m < 4; ++m)
#pragma unroll
                for (int bj = 0; bj < 2; ++bj) xi[ai][m][bj] = *(const u32x4*)(xb + (size_t)(t0 + ai * HALF + m * 16) * 4096 + c0 + bj * HALF);
        asm volatile("" ::: "memory");
#pragma unroll
        for (int ai = 0; ai < 2; ++ai) {
#pragma unroll
            for (int m = 0; m < 4; ++m) { const int t = t0 + ai * HALF + m * 16; bf16_t* rowp = xb + (size_t)t * 4096 + c0; float sq = 0.f;
#pragma unroll
                for (int bj = 0; bj < 2; ++bj) { const u32x4 x = xi[ai][m][bj];
                    f32x4 o0 = acc[ai][bj][m][0], o1 = acc[ai][bj][m][1];
                    o0[0] += __uint_as_float(x.x << 16); o0[1] += __uint_as_float(x.x & 0xffff0000u); o0[2] += __uint_as_float(x.y << 16); o0[3] += __uint_as_float(x.y & 0xffff0000u);
                    o1[0] += __uint_as_float(x.z << 16); o1[1] += __uint_as_float(x.z & 0xffff0000u); o1[2] += __uint_as_float(x.w << 16); o1[3] += __uint_as_float(x.w & 0xffff0000u);
                    sq += ((o0[0] * o0[0] + o0[1] * o0[1]) + (o0[2] * o0[2] + o0[3] * o0[3])) + ((o1[0] * o1[0] + o1[1] * o1[1]) + (o1[2] * o1[2] + o1[3] * o1[3]));
                    MK_ST16(rowp + bj * HALF, pack8(o0, o1)); }
                sq += __shfl_xor(sq, 16); sq += __shfl_xor(sq, 32);
                if (fq == 0) atomicAdd(ssout + t, ss_fix(sq));
#ifdef MK_DUP_ATOMICS
                if (fq == 0) atomicAdd(dup + t, ss_fix(sq));
#endif
                } }
    }
};

struct EpiSwiGLU {
    static constexpr bool PERM = true, AFTER_DRAIN = false;
    const u64* ss; bf16_t* h;
    __device__ __forceinline__ void operator()(const f32x4 (&acc)[2][2][4][2], const Unit& u, int wr, int wc, int fr_, int fq_, bool lastu = false) const {
        int fr = fr_, fq = fq_; asm volatile("" : "+v"(fr), "+v"(fq));
        const int t0 = u.pm * BM + wr * 64 + fr, c0 = u.pn * HALF + wc * 32 + 8 * fq;
        u64 ssv[2][4];
#pragma unroll
        for (int ai = 0; ai < 2; ++ai)
#pragma unroll
            for (int m = 0; m < 4; ++m) ssv[ai][m] = ss[t0 + ai * HALF + m * 16];
        asm volatile("" ::: "memory");
#pragma unroll
        for (int ai = 0; ai < 2; ++ai)
#pragma unroll
            for (int m = 0; m < 4; ++m) { const int t = t0 + ai * HALF + m * 16; const float s = rs_of(ssv[ai][m]); f32x4 o[2];
#pragma unroll
                for (int n = 0; n < 2; ++n) { const f32x4 g = silu4(acc[ai][0][m][n] * s), uu = acc[ai][1][m][n] * s; o[n] = g * uu; }
                MK_ST16(h + ((size_t)(c0 >> 6) * TT + t) * 64 + (c0 & 63), pack8(o[0], o[1])); }
    }
};
struct ProjOrder : StaticOrder {
    __host__ __device__ bool next(int i, Unit& u) const { if (!StaticOrder::next(i, u)) return false; u.sw = ((u.pn >= 16 && u.pn < 24) || (u.pn >= 40 && u.pn < 48)) ? 1 : 0; return true; }
};
template <class Epi, class Sched, bool ALIGN_EPI = false, bool SP2 = false>
__device__ __forceinline__ void gemm_phase(PG8_LAS unsigned char* lds, const Gemm g, const Sched& S, const Epi& E, int tid_in) {
    int tid = tid_in; asm volatile("" : "+v"(tid));
    const int wid = __builtin_amdgcn_readfirstlane(tid >> 6), lane = tid & 63, wr = wid >> 2, wc = wid & 3, fr = lane & 15, fq = lane >> 4;
    const int K = g.K, nt = K / BK;
    unsigned voffA[2], voffB[2];
#pragma unroll
    for (int i = 0; i < 2; ++i) { int R, C; stage_rc(tid * 16 + i * 8192, R, C); const int Rb = Epi::PERM ? ((R & ~31) + perm32(R & 31)) : R;
        voffA[i] = (unsigned)(R * g.a_pitch + C * 2); voffB[i] = (unsigned)(Rb * g.b_pitch + C * 2); }
    const size_t kstep = (size_t)g.b_kstep, kstepA = (size_t)g.a_kstep;
    const size_t hstep = (size_t)HALF * g.b_pitch, hstepA = (size_t)HALF * g.a_pitch;
    const size_t tstep = 2 * hstep, tstepA = 2 * hstepA;
    const unsigned ldsw = (unsigned)wid * 1024u;
    const int aoff = lds_byte(wr * 64 + fr, fq * 8), boff = lds_byte(wc * 32 + fr, fq * 8);
#define PG8_SA(b, h) (((b) * 2 + (h)) * HTB)
#define PG8_SB(b, h) ((4 + (b) * 2 + (h)) * HTB)
#define PG8_STAGE(bufoff, gbase, voff) do { _Pragma("unroll") for (int _i = 0; _i < 2; ++_i) \
        __builtin_amdgcn_global_load_lds((const unsigned*)((const char*)(gbase) + (voff)[_i]), (PG8_LAS unsigned*)(lds + (bufoff) + ldsw + _i * 8192), 16, 0, 0); } while (0)
#define PG8_LDA(dst, b, h) do { _Pragma("unroll") for (int m = 0; m < 4; ++m) _Pragma("unroll") for (int k = 0; k < 2; ++k) dst[m][k] = *(const PG8_LAS bf16x8*)(lds + PG8_SA(b, h) + aoff + m * 2048 + k * 1024); } while (0)
#define PG8_LDB(dst, b, h) do { _Pragma("unroll") for (int n = 0; n < 2; ++n) _Pragma("unroll") for (int k = 0; k < 2; ++k) dst[n][k] = *(const PG8_LAS bf16x8*)(lds + PG8_SB(b, h) + boff + n * 2048 + k * 1024); } while (0)
#define PG8_MMA(ai, bj, At, Bt) do { __builtin_amdgcn_s_setprio(1); _Pragma("unroll") for (int m = 0; m < 4; ++m) _Pragma("unroll") for (int n = 0; n < 2; ++n) _Pragma("unroll") for (int k = 0; k < 2; ++k) \
        acc[ai][bj][m][n] = __builtin_amdgcn_mfma_f32_16x16x32_bf16(Bt[n][k], At[m][k], acc[ai][bj][m][n], 0, 0, 0); __builtin_amdgcn_s_setprio(0); } while (0)
#define PG8_WAIT_V(n) asm volatile("s_waitcnt vmcnt(" #n ")" ::: "memory")
#define PG8_WAIT_L(n) asm volatile("s_waitcnt lgkmcnt(" #n ")" ::: "memory")
#define PG8_BAR __builtin_amdgcn_s_barrier()
#define PG8_SCHED __builtin_amdgcn_sched_barrier(0)
    Unit cur, nxt; int ui = 0;
    if (!S.next(0, cur)) return;
    f32x4 acc[2][2][4][2];
#pragma unroll
    for (int a = 0; a < 2; ++a)
#pragma unroll
        for (int b = 0; b < 2; ++b)
#pragma unroll
            for (int m = 0; m < 4; ++m)
#pragma unroll
                for (int n = 0; n < 2; ++n) acc[a][b][m][n] = (f32x4){0.f, 0.f, 0.f, 0.f};
    bf16x8 At[4][2], B0[2][2], B1[2][2];
    const char* cA = cur.sw ? (const char*)g.Bt + (size_t)cur.pn * tstep : (const char*)g.A + (size_t)cur.pm * tstepA; const char* cB = cur.sw ? (const char*)g.A + (size_t)cur.pm * tstep : (const char*)g.Bt + (size_t)cur.pn * tstep;
    S.a_ready(cur);
    if constexpr (SP2) {
        PG8_STAGE(PG8_SB(0, 0), cB, voffB); PG8_STAGE(PG8_SB(0, 1), cB + hstep, voffB); PG8_STAGE(PG8_SA(0, 0), cA, voffA); PG8_STAGE(PG8_SA(0, 1), cA + hstepA, voffA);
        if (wr == 1) PG8_BAR;
        PG8_WAIT_V(2); PG8_BAR;
        PG8_STAGE(PG8_SB(1, 0), cB + kstep, voffB); PG8_STAGE(PG8_SA(1, 0), cA + kstepA, voffA); PG8_STAGE(PG8_SB(1, 1), cB + hstep + kstep, voffB);
        PG8_WAIT_V(6); PG8_BAR;
    } else {
        PG8_STAGE(PG8_SB(0, 0), cB, voffB); PG8_STAGE(PG8_SA(0, 0), cA, voffA); PG8_STAGE(PG8_SB(0, 1), cB + hstep, voffB); PG8_STAGE(PG8_SA(0, 1), cA + hstepA, voffA);
        if (wr == 1) PG8_BAR;
        PG8_WAIT_V(4); PG8_BAR;
        PG8_STAGE(PG8_SB(1, 0), cB + kstep, voffB); PG8_STAGE(PG8_SA(1, 0), cA + kstepA, voffA); PG8_STAGE(PG8_SB(1, 1), cB + hstep + kstep, voffB);
        PG8_WAIT_V(6); PG8_BAR;
    }
    for (;;) {
        const bool has_next = S.next(ui + 1, nxt);
        const char* nA = has_next ? (nxt.sw ? (const char*)g.Bt + (size_t)nxt.pn * tstep : (const char*)g.A + (size_t)nxt.pm * tstepA) : cA; const char* nB = has_next ? (nxt.sw ? (const char*)g.A + (size_t)nxt.pm * tstep : (const char*)g.Bt + (size_t)nxt.pn * tstep) : cB;
        for (int t = 0; t < nt; t += 2) {
            const bool last = (t == nt - 2);
            const char* a1 = cA + (size_t)(t + 1) * kstepA;
            const char* a2 = last ? nA : cA + (size_t)(t + 2) * kstepA; const char* b2 = last ? nB : cB + (size_t)(t + 2) * kstep;
            const char* a3 = a2 + kstepA; const char* b3 = b2 + kstep;
            if (last && has_next) S.a_ready(nxt);
            if constexpr (SP2) {
            PG8_LDB(B0, 0, 0); PG8_LDB(B1, 0, 1); PG8_SCHED; PG8_LDA(At, 0, 0); PG8_STAGE(PG8_SA(1, 1), a1 + hstepA, voffA);
            PG8_WAIT_V(8); PG8_WAIT_L(0); PG8_BAR; PG8_MMA(0, 0, At, B0); PG8_MMA(0, 1, At, B1); PG8_BAR; PG8_SCHED;
            PG8_LDA(At, 0, 1); PG8_STAGE(PG8_SB(0, 0), b2, voffB); PG8_STAGE(PG8_SB(0, 1), b2 + hstep, voffB); PG8_STAGE(PG8_SA(0, 0), a2, voffA);
            PG8_WAIT_V(8); PG8_WAIT_L(0); PG8_BAR; PG8_MMA(1, 0, At, B0); PG8_MMA(1, 1, At, B1); PG8_BAR; PG8_SCHED;
            PG8_LDB(B0, 1, 0); PG8_LDB(B1, 1, 1); PG8_SCHED; PG8_LDA(At, 1, 0); PG8_STAGE(PG8_SA(0, 1), a2 + hstepA, voffA);
            PG8_WAIT_V(8); PG8_WAIT_L(0); PG8_BAR; PG8_MMA(0, 0, At, B0); PG8_MMA(0, 1, At, B1); PG8_BAR; PG8_SCHED;
            PG8_LDA(At, 1, 1); PG8_STAGE(PG8_SB(1, 0), b3, voffB); PG8_STAGE(PG8_SB(1, 1), b3 + hstep, voffB); PG8_STAGE(PG8_SA(1, 0), a3, voffA);
            PG8_WAIT_V(8); PG8_WAIT_L(0); PG8_BAR; PG8_MMA(1, 0, At, B0); PG8_MMA(1, 1, At, B1); PG8_BAR; PG8_SCHED;
            } else {
            PG8_LDB(B0, 0, 0); PG8_SCHED; PG8_LDA(At, 0, 0); PG8_STAGE(PG8_SA(1, 1), a1 + hstepA, voffA);
            PG8_WAIT_L(8); PG8_BAR; PG8_WAIT_L(0); PG8_MMA(0, 0, At, B0); PG8_BAR; PG8_SCHED;
            PG8_LDB(B1, 0, 1); PG8_STAGE(PG8_SB(0, 0), b2, voffB);
            PG8_BAR; PG8_WAIT_L(0); PG8_MMA(0, 1, At, B1); PG8_BAR;
            PG8_LDA(At, 0, 1); PG8_STAGE(PG8_SA(0, 0), a2, voffA);
            PG8_BAR; PG8_WAIT_L(0); PG8_MMA(1, 0, At, B0); PG8_BAR; PG8_SCHED;
            PG8_STAGE(PG8_SB(0, 1), b2 + hstep, voffB);
            PG8_WAIT_V(6); PG8_BAR; PG8_MMA(1, 1, At, B1); PG8_BAR;
            PG8_LDB(B0, 1, 0); PG8_SCHED; PG8_LDA(At, 1, 0); PG8_STAGE(PG8_SA(0, 1), a2 + hstepA, voffA);
            PG8_WAIT_L(8); PG8_BAR; PG8_WAIT_L(0); PG8_MMA(0, 0, At, B0); PG8_BAR; PG8_SCHED;
            PG8_LDB(B1, 1, 1); PG8_STAGE(PG8_SB(1, 0), b3, voffB);
            PG8_BAR; PG8_WAIT_L(0); PG8_MMA(0, 1, At, B1); PG8_BAR;
            PG8_LDA(At, 1, 1); PG8_STAGE(PG8_SA(1, 0), a3, voffA);
            PG8_BAR; PG8_WAIT_L(0); PG8_MMA(1, 0, At, B0); PG8_BAR; PG8_SCHED;
            PG8_STAGE(PG8_SB(1, 1), b3 + hstep, voffB);
            PG8_WAIT_V(6); PG8_BAR; PG8_MMA(1, 1, At, B1); PG8_BAR;
            }
        }
        if constexpr (ALIGN_EPI) { if (wr == 0) PG8_BAR; }
        if constexpr (!Epi::AFTER_DRAIN) { int te_ = tid_in; asm volatile("" : "+v"(te_)); E(acc, cur, wr, wc, te_ & 15, (te_ & 63) >> 4, !has_next); S.done(cur); }
        if (!has_next) break;
#pragma unroll
        for (int a = 0; a < 2; ++a)
#pragma unroll
            for (int b = 0; b < 2; ++b)
#pragma unroll
                for (int m = 0; m < 4; ++m)
#pragma unroll
                    for (int n = 0; n < 2; ++n) acc[a][b][m][n] = (f32x4){0.f, 0.f, 0.f, 0.f};
        cur = nxt; cA = nA; cB = nB; ++ui;
        if constexpr (ALIGN_EPI) { if (wr == 1) PG8_BAR; }
    }
    PG8_WAIT_V(0);
    if constexpr (!ALIGN_EPI) { if (wr == 0) PG8_BAR; }
    PG8_BAR;
    if constexpr (Epi::AFTER_DRAIN) { E.fused(acc, cur, wr, wc, fr, fq, lds, wid, lane); S.done(cur); }
#undef PG8_SA
#undef PG8_SB
#undef PG8_STAGE
#undef PG8_LDA
#undef PG8_LDB
#undef PG8_MMA
#undef PG8_WAIT_V
#undef PG8_WAIT_L
#undef PG8_BAR
#undef PG8_SCHED
}
}

#ifndef MK_WT_STORES
#define MK_WT_STORES 1
#endif
#define GAS __attribute__((address_space(1)))
#define LAS __attribute__((address_space(3)))
typedef unsigned short bf16_t;
typedef short bf16x8 __attribute__((ext_vector_type(8)));
typedef float f32x4 __attribute__((ext_vector_type(4)));
typedef float f32x2 __attribute__((ext_vector_type(2)));
typedef unsigned u32x4 __attribute__((ext_vector_type(4)));
typedef unsigned u32x2 __attribute__((ext_vector_type(2)));
#define LDS_WAIT() asm volatile("s_waitcnt lgkmcnt(0)" ::: "memory")
#define VM_WAIT() asm volatile("s_waitcnt vmcnt(0)" ::: "memory")

namespace mk {
using pg8::cvt_pk_bf16; using pg8::pack8; using pg8::rs_of; using pg8::u64; using pg8::ss_fix;
constexpr int T = 8192, D = 4096, INW = 14352, NPROJ = 14336, FF = 11008;
constexpr int NWAVES = 8, NTHR = 512;
constexpr int LDS_BYTES = 147456;
constexpr int LDSCTL_OFF = 140 * 1024;
constexpr int CW_TMO = 0, CW_BAR = 0  , CW_SS = 8192  , CW_CHK = 98304  , CW_TS = 96000  ;
constexpr size_t CTL_ZERO_BYTES = 512 * 1024, BAR_ZERO_BYTES = 16384;
constexpr int N_PHASES = 18;

struct Args {
    const float* x; const int* pos; const float* mix_norm; const float* w_in; const float* gla_w_up; const float* gla_b; const float* ret_gain; const float* gla_gain;
    const float* w_out; const float* ffn_norm; const float* w_gate; const float* w_up; const float* w_down; const float* final_norm;
    float* out; unsigned* ctl;
    bf16_t* win_t[2]; bf16_t* wga_t[2]; bf16_t* wout_t[2]; bf16_t* wgu_t[2]; bf16_t* wd_t[2];
    bf16_t* xb; float* rot; float* ga; float* lam;
    bf16_t *qr, *kr, *krt, *vrt, *srg, *gq, *gk, *qg, *kg, *kgt, *vgt, *sgg, *kvr, *kvg, *mixed, *h;
    bf16_t* dbgp; float* dbgo;
    int ph_lo, ph_hi, cvt_mask, cvt_layers;
};

__device__ __forceinline__ void st16_wt(void* p, u32x4 v) {
#if MK_WT_STORES
    asm volatile("global_store_dwordx4 %0, %1, off sc1\n\ts_nop 1" :: "v"(p), "v"(v) : "memory");
#else
    *(u32x4*)p = v;
#endif
}
__device__ __forceinline__ float wave_sum(float v) {
#pragma unroll
    for (int o = 1; o < 64; o <<= 1) v += __shfl_xor(v, o);
    return v;
}
__device__ __forceinline__ float bf_lo(unsigned w) { return __uint_as_float(w << 16); }
__device__ __forceinline__ float bf_hi(unsigned w) { return __uint_as_float(w & 0xffff0000u); }
__device__ __forceinline__ float silu1(float v) { return v / (1.0f + __expf(-v)); }

#define XB_TMO      128
#define XB_XCNT(j)  (256  + 64 * (j))
#define XB_XSUB(j)  (1280 + 64 * (j))
#define XB_XGEN(j)  (2304 + 64 * (j))
#define XB_TOP      3328
#define XB_TOPGEN   3392
#define XCD_BAR_WORDS 3456
#define XB_SPIN_CAP (1u << 18)

__device__ __forceinline__ unsigned xb_ld(unsigned* p)              { return __hip_atomic_load(p, __ATOMIC_RELAXED, __HIP_MEMORY_SCOPE_AGENT); }
__device__ __forceinline__ unsigned xb_add(unsigned* p, unsigned v) { return __hip_atomic_fetch_add(p, v, __ATOMIC_RELAXED, __HIP_MEMORY_SCOPE_AGENT); }
__device__ __forceinline__ unsigned xb_xcc_id() { return (unsigned)__builtin_amdgcn_s_getreg((3 << 11) | 20) & 0xFu; }
#define XB_SPIN(cond, bar) do { unsigned _sp = 0; while (cond) { __builtin_amdgcn_s_sleep(1); \
    if ((++_sp & 255u) == 0u) { if (xb_ld(&(bar)[XB_TMO])) break; if (_sp > XB_SPIN_CAP) { atomicAdd(&(bar)[XB_TMO], 1u); break; } } } } while (0)

struct XcdBarrier {
    unsigned* bar; unsigned x;
    volatile LAS unsigned* st;
    unsigned leader;
};

__device__ __forceinline__ XcdBarrier xcd_barrier_post(unsigned* bar, volatile LAS unsigned* st) {
    XcdBarrier b; b.bar = bar; b.x = xb_xcc_id(); b.st = st; b.leader = (threadIdx.x == 0) ? 1u : 0u;
    if (threadIdx.x == 0) (void)xb_add(&bar[XB_XCNT(b.x)], 1u);
    return b;
}
__device__ __forceinline__ void xcd_barrier_complete(unsigned* bar, unsigned x, unsigned& nloc, unsigned& nx) {
    const unsigned G = gridDim.x * gridDim.y * gridDim.z;
    unsigned sum, cnt, mine, sp = 0u;
    for (;;) {
        sum = 0u; cnt = 0u; mine = 0u;
#pragma unroll
        for (unsigned j = 0; j < 16; ++j) { const unsigned c = xb_ld(&bar[XB_XCNT(j)]); sum += c; cnt += (c > 0u) ? 1u : 0u; mine = (j == x) ? c : mine; }
        if (sum == G) break;
        __builtin_amdgcn_s_sleep(1);
        if ((++sp & 255u) == 0u) { if (xb_ld(&bar[XB_TMO])) break; if (sp > XB_SPIN_CAP) { atomicAdd(&bar[XB_TMO], 1u); break; } }
    }
    nloc = mine > 0u ? mine : 1u; nx = cnt > 0u ? cnt : 1u;
}

__device__ __forceinline__ void xcd_barrier(const XcdBarrier& b) {
    asm volatile("s_waitcnt vmcnt(0)" ::: "memory");
    __syncthreads();
    if (b.leader) {
        unsigned* bar = b.bar;
        __builtin_amdgcn_s_waitcnt(0);
        unsigned nloc = b.st[0], nx = b.st[1];
        if (nloc == 0u) { xcd_barrier_complete(bar, b.x, nloc, nx); b.st[0] = nloc; b.st[1] = nx; }
        const unsigned old = xb_add(&bar[XB_XSUB(b.x)], 1u);
        const unsigned gen = old / nloc;
        if (old + 1u == (gen + 1u) * nloc) {
            __builtin_amdgcn_fence(__ATOMIC_RELEASE, "agent");
            asm volatile("s_waitcnt vmcnt(0)" ::: "memory");
            const unsigned og = xb_add(&bar[XB_TOP], 1u);
            const unsigned tg = og / nx;
            if (og + 1u == (tg + 1u) * nx) xb_add(&bar[XB_TOPGEN], 1u);
            else XB_SPIN(xb_ld(&bar[XB_TOPGEN]) == tg, bar);
            __builtin_amdgcn_fence(__ATOMIC_ACQUIRE, "agent");
            xb_add(&bar[XB_XGEN(b.x)], 1u);
            asm volatile("s_waitcnt vmcnt(0)" ::: "memory");
        } else {
            XB_SPIN(xb_ld(&bar[XB_XGEN(b.x)]) == gen, bar);
            __builtin_amdgcn_fence(__ATOMIC_ACQUIRE, "agent");
            asm volatile("s_waitcnt vmcnt(0)" ::: "memory");
        }
    }
    __syncthreads();
}

#ifndef MK_M3_RDG
#define MK_M3_RDG 4
#endif
#ifndef MK_M3_RDR
#define MK_M3_RDR 6
#endif
#ifndef MK_M3_EPI
#define MK_M3_EPI 2
#endif
#ifndef MK_M1V2
#define MK_M1V2 1
#endif
#ifndef MK_M3_UNPAIR
#define MK_M3_UNPAIR 0
#endif
#ifndef MK_M3_PROBE
#define MK_M3_PROBE 0
#endif
#ifndef MK_M3_WT
#define MK_M3_WT 1
#endif
#ifndef MK_M3_NTST
#define MK_M3_NTST 0
#endif
#ifndef MK_M3_FLIP
#define MK_M3_FLIP 0
#endif
#ifndef MK_M3_GEARLY
#define MK_M3_GEARLY 0
#endif
#ifndef MK_M3_DEFER
#define MK_M3_DEFER 0
#endif
#ifndef MK_M2_WT
#define MK_M2_WT 1
#endif
#ifndef MK_MIX_WT
#define MK_MIX_WT 1
#endif
#ifndef MK_P0_TEST
#define MK_P0_TEST 0
#endif
#ifndef MK_NT
#define MK_NT 0
#endif
#if MK_NT
#define MK_NTLD(p) __builtin_nontemporal_load(p)
#else
#define MK_NTLD(p) (*(p))
#endif
#ifndef MK_BLK_WIN
#define MK_BLK_WIN 0
#endif
#ifndef MK_BLK_W
#define MK_BLK_W 0
#endif
struct CvtItem { const float* W; const float* gain; bf16_t* WT; size_t dst_row0; int ldn, K, k0, n0, valid, nblk; };
template <class AT> __device__ __forceinline__ CvtItem cvt_decode(const AT& a, int it, int nitems) {
    constexpr int I_IN = 64 * 224, I_OUT = 64 * 64, I_G = 64 * 172, I_D = 172 * 64, I_LAYER = I_IN + I_OUT + 2 * I_G + I_D;
    CvtItem c; c.valid = 0; c.W = nullptr; c.gain = nullptr; c.WT = nullptr; c.dst_row0 = 0; c.ldn = 0; c.K = 0; c.k0 = 0; c.n0 = 0; c.nblk = 0;
    if (it >= nitems) return c;
    const int l = it / I_LAYER; int r = it - l * I_LAYER;
#define CVT_KN(r_, NB_) const int kin_ = (r_) & 3, blk_ = (r_) >> 2, nb = blk_ % (NB_), kb = (blk_ / (NB_)) * 4 + kin_
    if (r < I_IN) { if (a.cvt_mask & 1) { CVT_KN(r, 224); c = CvtItem{a.w_in + (size_t)l * D * INW, a.mix_norm + l * D, a.win_t[l], (size_t)(64 * nb), INW, D, 64 * kb, 64 * nb, 1, MK_BLK_WIN ? NPROJ : 0}; } return c; } r -= I_IN;
    if (r < I_OUT) { if (a.cvt_mask & 2) { CVT_KN(r, 64); c = CvtItem{a.w_out + (size_t)l * D * D, (kb < 32 ? a.ret_gain + l * 2048 : a.gla_gain + l * 2048 - 2048)  , a.wout_t[l], (size_t)(64 * nb), D, D, 64 * kb, 64 * nb, 1, MK_BLK_W ? D : 0}; } return c; } r -= I_OUT;
    if (r < 2 * I_G) { if (a.cvt_mask & 4) { const int up = r >= I_G ? 1 : 0; r -= up * I_G; CVT_KN(r, 172); const int n0 = 64 * nb;
        c = CvtItem{(up ? a.w_up : a.w_gate) + (size_t)l * D * FF, a.ffn_norm + l * D, a.wgu_t[l], (size_t)((n0 >> 7) * 256 + up * 128 + (n0 & 127)), FF, D, 64 * kb, n0, 1, MK_BLK_W ? 2 * FF : 0}; } return c; } r -= 2 * I_G;
    if (a.cvt_mask & 8) { CVT_KN(r, 64); c = CvtItem{a.w_down + (size_t)l * FF * D, nullptr, a.wd_t[l], (size_t)(64 * nb), D, FF, 64 * kb, 64 * nb, 1, MK_BLK_W ? D : 0}; }
#undef CVT_KN
    return c;
}
__device__ __forceinline__ const char* uni_ptr(const char* p) { const unsigned long long x = (unsigned long long)p; const unsigned lo = __builtin_amdgcn_readfirstlane((unsigned)x), hi = __builtin_amdgcn_readfirstlane((unsigned)(x >> 32)); return (const char*)(((unsigned long long)hi << 32) | lo); }
__device__ __forceinline__ void cvt_issue(const CvtItem& c, f32x4 (&v)[16], float (&g)[16], int lane) {
    const int kr = lane >> 4, c4 = (lane & 15) * 4;
    if (c.valid) {
        const char* wb = (const char*)(c.W + (size_t)c.k0 * c.ldn + c.n0); const unsigned vo = (unsigned)((kr * c.ldn + c4) * 4), rstep = (unsigned)(4 * c.ldn * 4);
#pragma unroll
        for (int i = 0; i < 16; ++i) { v[i] = __builtin_nontemporal_load((const f32x4*)(uni_ptr(wb + (size_t)i * rstep) + vo)); g[i] = c.gain ? c.gain[c.k0 + 4 * i + kr] : 1.0f; } }
}
__device__ __forceinline__ void cvt_to_lds(const f32x4 (&v)[16], const float (&g)[16], LAS float* scr, int lane) {
    const int kr = lane >> 4, c4 = (lane & 15) * 4;
#pragma unroll
    for (int i = 0; i < 16; ++i) { LAS float* p = scr + (4 * i + kr) * 65 + c4; p[0] = v[i][0] * g[i]; p[1] = v[i][1] * g[i]; p[2] = v[i][2] * g[i]; p[3] = v[i][3] * g[i]; }
    LDS_WAIT(); asm volatile("" ::: "memory");
}
__device__ __forceinline__ void cvt_store(const CvtItem& c, LAS float* scr, int lane) {
    const int cc = lane >> 3, nn = lane & 7;
#pragma unroll
    for (int j = 0; j < 8; ++j) { const int n = nn + 8 * j; const LAS float* s = scr + (8 * cc) * 65 + n;
        u32x4 o; o.x = cvt_pk_bf16(s[0 * 65], s[1 * 65]); o.y = cvt_pk_bf16(s[2 * 65], s[3 * 65]); o.z = cvt_pk_bf16(s[4 * 65], s[5 * 65]); o.w = cvt_pk_bf16(s[6 * 65], s[7 * 65]);
        char* dp = c.nblk ? (char*)(c.WT + ((size_t)(c.k0 >> 6) * c.nblk + c.dst_row0 + n) * 64 + 8 * cc)
                          : (char*)uni_ptr((const char*)(c.WT + (c.dst_row0 + 8 * j) * (size_t)c.K + c.k0)) + (unsigned)((nn * c.K + 8 * cc) * 2);
        __builtin_nontemporal_store(o, (u32x4*)dp); }
    LDS_WAIT(); asm volatile("" ::: "memory");
}
template <class AT> __device__ __forceinline__ void p0_prologue(const AT& a, LAS unsigned char* lds, int tid, int lane, int wave, int bid, int G) {
    LAS float* scr = (LAS float*)(lds + wave * 16640);
    const int gw = bid * NWAVES + wave, NGW = G * NWAVES;
    constexpr int I_LAYER = 64 * 224 + 64 * 64 + 2 * 64 * 172 + 172 * 64;
    const int nitems = a.cvt_layers * I_LAYER;
    {
        f32x4 v0[16], v1[16]; float g0[16], g1[16];
        CvtItem c0 = cvt_decode(a, gw, nitems), c1 = cvt_decode(a, gw + NGW, nitems);
        cvt_issue(c0, v0, g0, lane); cvt_issue(c1, v1, g1, lane);
#pragma unroll 1
        for (int it = gw; it < nitems; it += 2 * NGW) {
            if (c0.valid) cvt_to_lds(v0, g0, scr, lane);
            const CvtItem n0 = cvt_decode(a, it + 2 * NGW, nitems); cvt_issue(n0, v0, g0, lane);
            if (c0.valid) cvt_store(c0, scr, lane);
            if (c1.valid) cvt_to_lds(v1, g1, scr, lane);
            const CvtItem n1 = cvt_decode(a, it + 3 * NGW, nitems); cvt_issue(n1, v1, g1, lane);
            if (c1.valid) cvt_store(c1, scr, lane);
            c0 = n0; c1 = n1;
        }
    }
    if (a.cvt_mask & 1) for (int i = bid * NTHR + tid; i < a.cvt_layers * 16 * D; i += G * NTHR) { const int l = i / (16 * D), r = i - l * 16 * D, j = r / D, k = r - j * D;
        const float v = a.w_in[(size_t)l * D * INW + (size_t)k * INW + NPROJ + j] * a.mix_norm[l * D + k]; a.wga_t[l][r] = (bf16_t)(cvt_pk_bf16(v, 0.f) & 0xffffu); }
    u64* ss0 = (u64*)(a.ctl + CW_SS);
    for (int i = bid * NTHR + tid; i < 4 * T; i += G * NTHR) ss0[T + i] = 0ull;
    {
        f32x4 xv[16];
        if (gw < T) { const f32x4* xr = (const f32x4*)(a.x + (size_t)gw * D) + lane;
#pragma unroll
            for (int j = 0; j < 16; ++j) xv[j] = xr[64 * j]; }
#pragma unroll 1
        for (int m = gw; m < T; m += NGW) { u32x2* o8 = (u32x2*)(a.xb + (size_t)m * D) + lane; float s = 0.f; u32x2 w[16];
#pragma unroll
            for (int j = 0; j < 16; ++j) { const f32x4 v = xv[j]; s += (v[0] * v[0] + v[1] * v[1]) + (v[2] * v[2] + v[3] * v[3]); w[j].x = cvt_pk_bf16(v[0], v[1]); w[j].y = cvt_pk_bf16(v[2], v[3]); }
            if (m + NGW < T) { const f32x4* xr = (const f32x4*)(a.x + (size_t)(m + NGW) * D) + lane;
#pragma unroll
                for (int j = 0; j < 16; ++j) xv[j] = xr[64 * j]; }
#pragma unroll
            for (int j = 0; j < 16; ++j) o8[64 * j] = w[j];
            s = wave_sum(s); if (lane == 0) ss0[m] = ss_fix(s); }
    }
}

template <class AT> __device__ __forceinline__ void ga_stage(const AT& a, int l, const u64* ss, LAS unsigned char* lds, int tid, int lane, int wave, int bid, int G) {
    LAS float* red = (LAS float*)lds;
    for (int tb = bid; tb < T / 32; tb += G) {
        f32x4 acc[2] = {(f32x4){0.f, 0.f, 0.f, 0.f}, (f32x4){0.f, 0.f, 0.f, 0.f}};
        const bf16_t* xa = a.xb + (size_t)(tb * 32 + (lane & 15)) * D + wave * 512 + 8 * (lane >> 4);
        const bf16_t* wb = a.wga_t[l] + (size_t)(lane & 15) * D + wave * 512 + 8 * (lane >> 4);
#pragma unroll 8
        for (int ks = 0; ks < 16; ++ks) { const bf16x8 b = *(const bf16x8*)(wb + 32 * ks);
            const bf16x8 a0 = *(const bf16x8*)(xa + 32 * ks), a1 = *(const bf16x8*)(xa + (size_t)16 * D + 32 * ks);
            acc[0] = __builtin_amdgcn_mfma_f32_16x16x32_bf16(a0, b, acc[0], 0, 0, 0); acc[1] = __builtin_amdgcn_mfma_f32_16x16x32_bf16(a1, b, acc[1], 0, 0, 0); }
        *(LAS f32x4*)(red + ((wave * 2 + 0) * 64 + lane) * 4) = acc[0]; *(LAS f32x4*)(red + ((wave * 2 + 1) * 64 + lane) * 4) = acc[1];
        __syncthreads();
        { const int mt = tid >> 8, ln = (tid >> 2) & 63, rg = tid & 3; float s = 0.f;
#pragma unroll
          for (int w = 0; w < 8; ++w) s += red[((w * 2 + mt) * 64 + ln) * 4 + rg];
          const int tok = tb * 32 + 16 * mt + (ln >> 4) * 4 + rg, j = ln & 15;
          a.ga[(size_t)tok * 16 + j] = s * rs_of(ss[tok]); }
        __syncthreads();
    }
}

__device__ __forceinline__ void gate_octet(float (&z)[8][8], const LAS float* gal, const LAS float* wl, const f32x4 b0, const f32x4 b1, int co, int tg) {
#pragma unroll
    for (int e = 0; e < 8; ++e) { z[e][0] = b0[0]; z[e][1] = b0[1]; z[e][2] = b0[2]; z[e][3] = b0[3]; z[e][4] = b1[0]; z[e][5] = b1[1]; z[e][6] = b1[2]; z[e][7] = b1[3]; }
#pragma unroll 2
    for (int r = 0; r < 16; ++r) { const f32x4 w0 = *(const LAS f32x4*)(wl + r * 256 + 8 * co), w1 = *(const LAS f32x4*)(wl + r * 256 + 8 * co + 4);
#pragma unroll
        for (int e = 0; e < 8; ++e) { const float g = gal[(8 * tg + e) * 16 + r];
            z[e][0] = fmaf(g, w0[0], z[e][0]); z[e][1] = fmaf(g, w0[1], z[e][1]); z[e][2] = fmaf(g, w0[2], z[e][2]); z[e][3] = fmaf(g, w0[3], z[e][3]);
            z[e][4] = fmaf(g, w1[0], z[e][4]); z[e][5] = fmaf(g, w1[1], z[e][5]); z[e][6] = fmaf(g, w1[2], z[e][6]); z[e][7] = fmaf(g, w1[3], z[e][7]); } }
#pragma unroll
    for (int j = 0; j < 8; ++j) { float run = 0.f;
#pragma unroll
        for (int e = 0; e < 8; ++e) { const float zz = z[e][j]; run += (fminf(zz, 0.f) - 0.69314718f * __builtin_amdgcn_logf(1.0f + __builtin_amdgcn_exp2f(-1.44269504f * fabsf(zz)))) * 0.0625f; z[e][j] = run; }
        if (j & 1) __builtin_amdgcn_sched_barrier(0); }
}
template <class AT> __device__ __forceinline__ void prep_phase(const AT& a, int l, LAS unsigned char* lds, int tid, int lane, int wave, int bid, int G) {
    LAS float* galA = (LAS float*)lds;
    LAS float* galB = (LAS float*)(lds + 8192);
    LAS float* tot = (LAS float*)(lds + 16384);
    LAS float* wl = (LAS float*)(lds + 32768);
    const float* wup = a.gla_w_up + (size_t)l * 16 * 1024; const float* gb = a.gla_b + l * 1024;
    for (int u = bid; u < 256; u += G) { const int h = u >> 6, c = u & 63, t0 = c * 128;
        u32x4 qin[8], kin[8]; f32x4 b0, b1;
        {
            int tz = tid; asm volatile("" : "+v"(tz)); const int co = tz & 31, tg = tz >> 5, ch = h * 256 + 8 * co;
            const unsigned rowoff = (unsigned)(((t0 + 8 * tg) * 1024 + ch) * 2);
            const f32x4 gB = *(const f32x4*)((const char*)(a.ga + (size_t)t0 * 16) + (unsigned)(tz * 16));
            f32x4 gA = (f32x4){0.f, 0.f, 0.f, 0.f}; if (c & 1) gA = *(const f32x4*)((const char*)(a.ga + (size_t)(t0 - 128) * 16) + (unsigned)(tz * 16));
            const unsigned wo = (unsigned)(((tz >> 6) * 1024 + 4 * (tz & 63)) * 4);
            const f32x4 wv0 = *(const f32x4*)((const char*)(wup + h * 256) + wo), wv1 = *(const f32x4*)((const char*)(wup + h * 256 + 8 * 1024) + wo);
            b0 = *(const f32x4*)((const char*)(gb + h * 256) + (unsigned)(co * 32)); b1 = *(const f32x4*)((const char*)(gb + h * 256 + 4) + (unsigned)(co * 32));
#pragma unroll
            for (int e = 0; e < 8; ++e) { qin[e] = *(const u32x4*)((const char*)a.gq + (rowoff + (unsigned)(e * 2048))); kin[e] = *(const u32x4*)((const char*)a.gk + (rowoff + (unsigned)(e * 2048))); }
            *(LAS f32x4*)(galB + tz * 4) = gB; *(LAS f32x4*)(galA + tz * 4) = gA;
            *(LAS f32x4*)(wl + (tz >> 6) * 256 + 4 * (tz & 63)) = wv0; *(LAS f32x4*)(wl + (8 + (tz >> 6)) * 256 + 4 * (tz & 63)) = wv1;
        }
        __syncthreads();
        int tz2 = tid; asm volatile("" : "+v"(tz2)); const int co = tz2 & 31, tg = tz2 >> 5, ch = h * 256 + 8 * co;
        const unsigned rowoff = (unsigned)(((t0 + 8 * tg) * 1024 + ch) * 2);
        float z[8][8]; float base[8];
#pragma unroll
        for (int j = 0; j < 8; ++j) base[j] = 0.f;
        if (c & 1) {
            gate_octet(z, galA, wl, b0, b1, co, tg);
#pragma unroll
            for (int j = 0; j < 8; ++j) tot[tg * 256 + 8 * co + j] = z[7][j];
            __syncthreads();
            for (int g2 = 0; g2 < 16; ++g2) { const f32x4 t0v = *(const LAS f32x4*)(tot + g2 * 256 + 8 * co), t1v = *(const LAS f32x4*)(tot + g2 * 256 + 8 * co + 4);
                base[0] += t0v[0]; base[1] += t0v[1]; base[2] += t0v[2]; base[3] += t0v[3]; base[4] += t1v[0]; base[5] += t1v[1]; base[6] += t1v[2]; base[7] += t1v[3]; }
            __syncthreads();
        }
        gate_octet(z, galB, wl, b0, b1, co, tg);
#pragma unroll
        for (int j = 0; j < 8; ++j) tot[tg * 256 + 8 * co + j] = z[7][j];
        __syncthreads();
        float off[8];
#pragma unroll
        for (int j = 0; j < 8; ++j) off[j] = base[j];
        for (int g2 = 0; g2 < tg; ++g2) { const f32x4 t0v = *(const LAS f32x4*)(tot + g2 * 256 + 8 * co), t1v = *(const LAS f32x4*)(tot + g2 * 256 + 8 * co + 4);
            off[0] += t0v[0]; off[1] += t0v[1]; off[2] += t0v[2]; off[3] += t0v[3]; off[4] += t1v[0]; off[5] += t1v[1]; off[6] += t1v[2]; off[7] += t1v[3]; }
#pragma unroll
        for (int e = 0; e < 8; ++e) { float qv[8], kv[8];
            const unsigned qw[4] = {qin[e].x, qin[e].y, qin[e].z, qin[e].w}, kw[4] = {kin[e].x, kin[e].y, kin[e].z, kin[e].w};
#pragma unroll
            for (int j = 0; j < 8; ++j) { const float cum = z[e][j] + off[j]; const float eq = __builtin_amdgcn_exp2f(1.44269504f * cum), ek = __builtin_amdgcn_rcpf(eq);
                const float qf = (j & 1) ? bf_hi(qw[j >> 1]) : bf_lo(qw[j >> 1]), kf = (j & 1) ? bf_hi(kw[j >> 1]) : bf_lo(kw[j >> 1]); qv[j] = qf * eq; kv[j] = kf * ek; }
            u32x4 qo, ko; qo.x = cvt_pk_bf16(qv[0], qv[1]); qo.y = cvt_pk_bf16(qv[2], qv[3]); qo.z = cvt_pk_bf16(qv[4], qv[5]); qo.w = cvt_pk_bf16(qv[6], qv[7]);
            ko.x = cvt_pk_bf16(kv[0], kv[1]); ko.y = cvt_pk_bf16(kv[2], kv[3]); ko.z = cvt_pk_bf16(kv[4], kv[5]); ko.w = cvt_pk_bf16(kv[6], kv[7]);
            if (MK_MIX_WT) { __builtin_amdgcn_raw_buffer_store_b128(qo, __builtin_amdgcn_make_buffer_rsrc((void*)a.qg, 0, 0x7ffffff0, 0x00020000), rowoff + (unsigned)(e * 2048), 0, 16); __builtin_amdgcn_raw_buffer_store_b128(ko, __builtin_amdgcn_make_buffer_rsrc((void*)a.kg, 0, 0x7ffffff0, 0x00020000), rowoff + (unsigned)(e * 2048), 0, 16); }
            else { *(u32x4*)((char*)a.qg + (rowoff + (unsigned)(e * 2048))) = qo; *(u32x4*)((char*)a.kg + (rowoff + (unsigned)(e * 2048))) = ko; }
            __builtin_amdgcn_sched_barrier(0); }
        if ((c & 1) && tg == 15) {
#pragma unroll
            for (int j = 0; j < 8; ++j) a.lam[(c >> 1) * 1024 + ch + j] = __builtin_amdgcn_exp2f(1.44269504f * (z[7][j] + off[j])); }
        __syncthreads();
    }
}

template <class AT> __device__ __forceinline__ void m1_phase(const AT& a, LAS unsigned char* lds, int tid, int wave, int bid, int G) {
    const int nsu = bid < 512 ? (512 - bid + G - 1) / G : 0, npass = 4 * nsu;
    if (npass == 0) return;
    f32x4 acc[8][4];
#pragma unroll
    for (int i = 0; i < 8; ++i)
#pragma unroll
        for (int j = 0; j < 4; ++j) acc[i][j] = (f32x4){0.f, 0.f, 0.f, 0.f};
    u32x2 w[8];
#define M1_DECODE(p_) const int su_ = bid + ((p_) >> 2) * G; const bf16_t *Ks, *Vt; int ldk, c2; \
        if (su_ < 256) { const int h = su_ >> 5; c2 = su_ & 31; Ks = a.kr + h * 256; ldk = 2048; Vt = MK_VT_BLK ? a.vrt + ((size_t)c2 * 2048 + h * 256) * 256 : a.vrt + (size_t)(h * 256) * T; } \
        else { const int s_ = su_ - 256, vh = (s_ >> 3) & 1, ix_ = (s_ & 7) | ((s_ >> 4) << 3), h = ix_ >> 5; c2 = ix_ & 31;     Ks = a.kg + h * 256; ldk = 1024; Vt = MK_VT_BLK ? a.vgt + ((size_t)c2 * 2048 + h * 512 + vh * 256) * 256 : a.vgt + (size_t)(h * 512 + vh * 256) * T; } \
        const int tk = c2 * 256 + ((p_) & 3) * 64
#define M1_ISSUE(p_, half_) do { M1_DECODE(p_); int tz = tid; asm volatile("" : "+v"(tz)); \
        { const int ln = tz & 63; const char* vbase = (const char*)(Vt + (MK_VT_BLK ? ((p_) & 3) * 64 : tk)); \
          _Pragma("unroll") for (int i = 0; i < 4; ++i) { const int r = 32 * wave + 8 * i + (ln >> 3), c = (ln & 7) ^ (4 * (i & 1) + (ln >> 4)); \
            __builtin_amdgcn_global_load_lds((const unsigned*)(vbase + (unsigned)((r * (MK_VT_BLK ? 256 : T) + c * 8) * 2)), (LAS unsigned*)(lds + 65536 + (half_) * 32768 + (4 * wave + i) * 1024), 16, 0, 0); } } \
        { const int dq = tz & 63, q = tz >> 6; const char* kbase = (const char*)(Ks + (size_t)tk * ldk); const unsigned kof = (unsigned)((8 * q * ldk + 4 * dq) * 2); \
          _Pragma("unroll") for (int i = 0; i < 8; ++i) w[i] = *(const u32x2*)(kbase + (kof + (unsigned)(i * ldk * 2))); } } while (0)
#define M1_KEL(i_) ((dd & 2) ? ((dd & 1) ? (w[i_].y >> 16) : (w[i_].y & 0xffffu)) : ((dd & 1) ? (w[i_].x >> 16) : (w[i_].x & 0xffffu)))
#define M1_STASH(half_) do { int tz = tid; asm volatile("" : "+v"(tz)); \
        { const int dq = tz & 63, q = tz >> 6; _Pragma("unroll") for (int dd = 0; dd < 4; ++dd) { u32x4 o; \
            o.x = M1_KEL(0) | (M1_KEL(1) << 16); o.y = M1_KEL(2) | (M1_KEL(3) << 16); o.z = M1_KEL(4) | (M1_KEL(5) << 16); o.w = M1_KEL(6) | (M1_KEL(7) << 16); \
            const int d = 4 * dq + dd, r = (d & ~31) + 16 * ((d >> 2) & 1) + 4 * ((d >> 3) & 3) + (d & 3); \
            *(LAS u32x4*)(lds + r * 256 + (((8 * (half_) + q) ^ (r & 15)) << 4)) = o; } } \
        asm volatile("s_waitcnt vmcnt(0)" ::: "memory"); } while (0)
#define M1_COMPUTE(half_) do { int tz = tid; asm volatile("" : "+v"(tz)); const int lr = tz & 15, lq = (tz & 63) >> 4, wd = wave & 1, wv = wave >> 1; \
        LAS unsigned char* kb = lds + (128 * wd + lr) * 256 + (((lq ^ lr) & 3) << 4); LAS unsigned char* vb = lds + 65536 + (half_) * 32768 + (64 * wv + lr) * 128; \
        _Pragma("unroll") for (int kk = 0; kk < 2; ++kk) { const int o = ((2 * (half_) + kk) ^ (lr >> 2)) << 6, ov = ((4 * kk + lq) ^ (lr >> 1)) << 4; bf16x8 Y[4]; \
            _Pragma("unroll") for (int j = 0; j < 4; ++j) Y[j] = *(const LAS bf16x8*)(vb + ov + j * 2048); \
            _Pragma("unroll") for (int ih = 0; ih < 2; ++ih) { bf16x8 X[4]; \
                _Pragma("unroll") for (int i = 0; i < 4; ++i) X[i] = *(const LAS bf16x8*)(kb + o + (4 * ih + i) * 4096); \
                _Pragma("unroll") for (int i = 0; i < 4; ++i) { _Pragma("unroll") for (int j = 0; j < 4; ++j) acc[4 * ih + i][j] = __builtin_amdgcn_mfma_f32_16x16x32_bf16(X[i], Y[j], acc[4 * ih + i][j], 0, 0, 0); } \
                asm volatile("" ::: "memory"); } } } while (0)
    M1_ISSUE(0, 0); M1_STASH(0);
    __syncthreads();
#pragma unroll 1
    for (int p = 0; p < npass; p += 2) {
        M1_ISSUE(p + 1, 1);
        M1_COMPUTE(0);
        M1_STASH(1);
        __syncthreads();
        const bool more = p + 2 < npass;
        if (more) M1_ISSUE(p + 2, 0);
        M1_COMPUTE(1);
        if (more) M1_STASH(0);
        if ((p & 3) == 2) {
            const int su = bid + (p >> 2) * G; bf16_t* out;
            if (su < 256) { const int h = su >> 5, c2 = su & 31; out = a.kvr + (size_t)(h * 32 + c2) * 65536; }
            else { const int s_ = su - 256, vh = (s_ >> 3) & 1, ix_ = (s_ & 7) | ((s_ >> 4) << 3), h = ix_ >> 5, c2 = ix_ & 31; out = a.kvg + (size_t)(h * 32 + c2) * 131072 + (size_t)vh * 65536; }
            int tz = tid; asm volatile("" : "+v"(tz)); const int lr = tz & 15, lq = (tz & 63) >> 4, wd = wave & 1, wv = wave >> 1;
            bf16_t* op = out + (size_t)((64 * wv + lr) * 256 + 128 * wd + 8 * lq); const auto ors = __builtin_amdgcn_make_buffer_rsrc((void*)out, 0, 0x7ffffff0, 0x00020000); const unsigned oo = (unsigned)(((64 * wv + lr) * 256 + 128 * wd + 8 * lq) * 2); (void)op;
#pragma unroll
            for (int i2 = 0; i2 < 4; ++i2)
#pragma unroll
                for (int j = 0; j < 4; ++j) { u32x4 w4; w4.x = cvt_pk_bf16(acc[2 * i2][j][0], acc[2 * i2][j][1]); w4.y = cvt_pk_bf16(acc[2 * i2][j][2], acc[2 * i2][j][3]);
                    w4.z = cvt_pk_bf16(acc[2 * i2 + 1][j][0], acc[2 * i2 + 1][j][1]); w4.w = cvt_pk_bf16(acc[2 * i2 + 1][j][2], acc[2 * i2 + 1][j][3]); if (MK_MIX_WT) __builtin_amdgcn_raw_buffer_store_b128(w4, ors, oo + (unsigned)(((16 * j) * 256 + 32 * i2) * 2), 0, 16); else *(u32x4*)(op + (16 * j) * 256 + 32 * i2) = w4; }
#pragma unroll
            for (int i = 0; i < 8; ++i)
#pragma unroll
                for (int j = 0; j < 4; ++j) acc[i][j] = (f32x4){0.f, 0.f, 0.f, 0.f};
        }
        __syncthreads();
    }
#undef M1_DECODE
#undef M1_ISSUE
#undef M1_KEL
#undef M1_STASH
#undef M1_COMPUTE
}
template <class AT> __device__ __forceinline__ void m2_phase(const AT& a, int tid, int bid, int G) {
    for (int blk = bid; blk < 256; blk += G) { const int vec = blk * NTHR + tid;
        bf16_t* base; size_t cstride; const float* lamp = nullptr; float lsc = 0.f;
        if (vec < 65536) { const int h = vec >> 13, rem = vec & 8191; base = a.kvr + (size_t)(h * 32) * 65536 + (size_t)rem * 8; cstride = 65536; lsc = exp2f(256.0f * log2f(1.0f - exp2f(-5.0f - (float)h))); }
        else { const int v2 = vec - 65536, h = v2 >> 14, rem = v2 & 16383; base = a.kvg + (size_t)(h * 32) * 131072 + (size_t)rem * 8; cstride = 131072; lamp = a.lam + h * 256 + 8 * (rem & 31); }
        const auto srs = __builtin_amdgcn_make_buffer_rsrc((void*)(blk < 128 ? a.kvr + (size_t)((blk >> 4) * 32) * 65536 : a.kvg + (size_t)(((blk - 128) >> 5) * 32) * 131072), 0, 0x7ffffff0, 0x00020000);
        const unsigned soff = (unsigned)((blk < 128 ? (vec & 8191) : ((vec - 65536) & 16383)) * 16), sstep = (unsigned)(blk < 128 ? 65536 * 2 : 131072 * 2);
        float st[8]; float z0 = 0.f; asm volatile("" : "+v"(z0));
#pragma unroll
        for (int e = 0; e < 8; ++e) st[e] = z0;
        u32x4 kv[2][4]; f32x4 l0[2][4], l1[2][4];
#define M2_LOAD(B, c0_) do { _Pragma("unroll") for (int j = 0; j < 4; ++j) kv[B][j] = MK_NTLD((const u32x4*)(base + (size_t)((c0_) + j) * cstride)); \
            if (lamp) { _Pragma("unroll") for (int j = 0; j < 4; ++j) { l0[B][j] = *(const f32x4*)(lamp + ((c0_) + j) * 1024); l1[B][j] = *(const f32x4*)(lamp + ((c0_) + j) * 1024 + 4); } } \
            else { _Pragma("unroll") for (int j = 0; j < 4; ++j) { l0[B][j] = (f32x4){lsc, lsc, lsc, lsc}; l1[B][j] = l0[B][j]; } } } while (0)
        M2_LOAD(0, 0);
#pragma unroll
        for (int b = 0; b < 8; ++b) { const int c0 = 4 * b, B = b & 1;
            if (b < 7) M2_LOAD((b + 1) & 1, c0 + 4);
#pragma unroll
            for (int j = 0; j < 4; ++j) {
                u32x4 o; o.x = cvt_pk_bf16(st[0], st[1]); o.y = cvt_pk_bf16(st[2], st[3]); o.z = cvt_pk_bf16(st[4], st[5]); o.w = cvt_pk_bf16(st[6], st[7]); if (MK_M2_WT) __builtin_amdgcn_raw_buffer_store_b128(o, srs, soff + (unsigned)(c0 + j) * sstep, 0, 16); else *(u32x4*)(base + (size_t)(c0 + j) * cstride) = o;
                st[0] = l0[B][j][0] * (st[0] + bf_lo(kv[B][j].x)); st[1] = l0[B][j][1] * (st[1] + bf_hi(kv[B][j].x)); st[2] = l0[B][j][2] * (st[2] + bf_lo(kv[B][j].y)); st[3] = l0[B][j][3] * (st[3] + bf_hi(kv[B][j].y));
                st[4] = l1[B][j][0] * (st[4] + bf_lo(kv[B][j].z)); st[5] = l1[B][j][1] * (st[5] + bf_hi(kv[B][j].z)); st[6] = l1[B][j][2] * (st[6] + bf_lo(kv[B][j].w)); st[7] = l1[B][j][3] * (st[7] + bf_hi(kv[B][j].w)); }
            asm volatile("" ::: "memory");
        }
#undef M2_LOAD
    }
}

#define M3_LANE() int tz_ = tid; asm volatile("" : "+v"(tz_)); const int lr = tz_ & 15, lq = (tz_ & 63) >> 4; (void)lr; (void)lq
#define M3_BASES() LAS unsigned char* qb4[4]; LAS unsigned char* pb4[4]; _Pragma("unroll") for (int b = 0; b < 4; ++b) { const int o_ = ((b ^ (lr >> 2)) << 6) + (((lq ^ lr) & 3) << 4); qb4[b] = QL + lr * 512 + o_; }
#define M3_PBASES() do { int tp_ = tid; asm volatile("" : "+v"(tp_)); const int lr_ = tp_ & 15, lq_ = (tp_ & 63) >> 4; _Pragma("unroll") for (int b = 0; b < 4; ++b) pb4[b] = PL + lr_ * 512 + (((b ^ (lr_ >> 2)) << 6) + (((lq_ ^ lr_) & 3) << 4)); } while (0)
#define QFRAG(rt, ks) (*(const LAS bf16x8*)(qb4[(ks) & 3] + (rt) * 8192 + ((ks) >> 2) * 256))
#define PFRAG(rt, ks) (*(const LAS bf16x8*)(pb4[(ks) & 3] + (rt) * 8192 + ((ks) >> 2) * 256))
struct M3Pend { u32x4 w[2][8]; bf16_t* mixed; int t0; int lpr; };
__device__ __forceinline__ void m3_flush(M3Pend& pd, int tid, int wave) {
    if (pd.lpr) {
        int tf_ = tid; asm volatile("" : "+v"(tf_)); const int ln = tf_ & 63, sh = (pd.lpr == 64) ? 6 : 5, rpi = 64 >> sh, ni = 8 >> (6 - sh), rsub = ln >> sh, c8 = ln & (pd.lpr - 1);
        const auto rs = __builtin_amdgcn_make_buffer_rsrc((void*)pd.mixed, 0, 0x7ffffff0, 0x00020000);
#pragma unroll
        for (int pass = 0; pass < 2; ++pass)
#pragma unroll
            for (int i = 0; i < 8; ++i) if (i < ni) { const int rl = wave * 8 + i * rpi + rsub;
                __builtin_amdgcn_raw_buffer_store_b128(pd.w[pass][i], rs, (unsigned)(((pd.t0 + 64 * pass + rl) * 4096 + 8 * c8) * 2), 0, MK_M3_WT ? 16 : 0); }
        pd.lpr = 0;
    }
}
template <int CT, bool LNORM, int NB, int RD, bool INPEND>
__device__ __forceinline__ void m3_unit(LAS unsigned char* lds, const bf16_t* Q, int ldq, const bf16_t* Kk, const bf16_t* VT, const bf16_t* ST, const bf16_t* gate, const float* gain, bf16_t* mixed, int t0, int tk0, int tid, int wave, M3Pend& pend, int probe = 0) {
    constexpr int DV = CT * 128, NP = 4 * NB;
    LAS unsigned char* QL = lds; LAS unsigned char* PL = lds + 65536; LAS f32x2* STATS = (LAS f32x2*)(lds + 131072);
    const int vb = wave * 16 * CT;
    bf16x8 ring[RD][CT];
#define M3_LOADV(ks, R) do { _Pragma("unroll") for (int ct = 0; ct < CT; ++ct) R[ct] = *(const bf16x8*)(VT + (MK_VT_BLK ? 0 : tk0) + (vo + (unsigned)((16 * ct) * (MK_VT_BLK ? 256 : T) + 32 * (ks)))); } while (0)
#define M3_LOADS(ks, R) do { _Pragma("unroll") for (int ct = 0; ct < CT; ++ct) R[ct] = *(const bf16x8*)(ST + (so + (unsigned)((16 * ct) * 256 + 32 * (ks)))); } while (0)
#define M3_LOADSTEP(k, R) do { if ((k) < 8) M3_LOADS((k), R); else if ((k) < NP + 8) M3_LOADV((k) - 8, R); } while (0)
    {
        M3_LANE(); M3_BASES();
#pragma unroll
        for (int i = 0; i < 8; ++i) { const int idx = tz_ + 512 * i, row = idx >> 5, ch = idx & 31;
            const u32x4 v = *(const u32x4*)(Q + (size_t)(t0 + row) * ldq + ch * 8); *(LAS u32x4*)(QL + row * 512 + ((ch ^ (row & 15)) << 4)) = v; }
        bf16x8 Kf[NB][8];
#pragma unroll
        for (int kb = 0; kb < NB; ++kb)
#pragma unroll
            for (int ks = 0; ks < 8; ++ks) Kf[kb][ks] = *(const bf16x8*)(Kk + (size_t)(tk0 + 128 * kb + 16 * wave + lr) * ldq + 32 * ks + 8 * lq);
        if constexpr (INPEND) { if (MK_M3_DEFER) m3_flush(pend, tid, wave); }
        { const unsigned vo = (unsigned)((vb + lr) * (MK_VT_BLK ? 256 : T) + 8 * lq), so = (unsigned)((vb + lr) * 256 + 8 * lq);
#pragma unroll
            for (int j = 0; j < RD - 1; ++j) M3_LOADSTEP(j, ring[j]); }
        __syncthreads();
#pragma unroll
        for (int kb = 0; kb < NB; ++kb) { const bool diag = (kb == NB - 1);
#pragma unroll
            for (int rt = 0; rt < 8; ++rt) { f32x4 p = (f32x4){0.f, 0.f, 0.f, 0.f};
                if (!diag || rt >= wave) {
#pragma unroll
                    for (int ks = 0; ks < 8; ++ks) { const bf16x8 qf = QFRAG(rt, ks); p = __builtin_amdgcn_mfma_f32_16x16x32_bf16(Kf[kb][ks], qf, p, 0, 0, 0); }
                    if (diag && rt == wave) {
#pragma unroll
                        for (int r = 0; r < 4; ++r) if (4 * lq + r > lr) p[r] = 0.f; } }
                u32x2 w; w.x = cvt_pk_bf16(p[0], p[1]); w.y = cvt_pk_bf16(p[2], p[3]);
                *(LAS u32x2*)(PL + (16 * rt + lr) * 512 + ((((16 * kb + 2 * wave + (lq >> 1)) ^ lr) << 4) + ((lq & 1) << 3))) = w; } }
        __syncthreads();
    }
#if MK_M3_EPI == 2
    constexpr int LPR_ = DV / 8, RPI_ = 64 / LPR_, NI_ = 8 / RPI_; constexpr bool GEARLY = MK_M3_GEARLY && CT == 2;
    u32x4 gvE0[NI_], gvE1[NI_];
    if constexpr (GEARLY) { int tg_ = tid; asm volatile("" : "+v"(tg_)); const int ln_ = tg_ & 63;
#pragma unroll
        for (int i = 0; i < NI_; ++i) { const int rl = wave * 8 + i * RPI_ + ln_ / LPR_;
            gvE0[i] = *(const u32x4*)(gate + ((unsigned)((t0 + rl) * 2048 + 8 * (ln_ % LPR_)))); gvE1[i] = *(const u32x4*)(gate + ((unsigned)((t0 + 64 + rl) * 2048 + 8 * (ln_ % LPR_)))); } }
#endif
    f32x4 acc[8][CT];
#pragma unroll
    for (int rt = 0; rt < 8; ++rt)
#pragma unroll
        for (int ct = 0; ct < CT; ++ct) acc[rt][ct] = (f32x4){0.f, 0.f, 0.f, 0.f};
    {
        M3_LANE(); M3_BASES();
        const unsigned vo = (unsigned)((vb + lr) * (MK_VT_BLK ? 256 : T) + 8 * lq), so = (unsigned)((vb + lr) * 256 + 8 * lq);
#define M3_MMA(R, FRAG) do { _Pragma("unroll") for (int rt = 0; rt < 8; ++rt) { const bf16x8 bfr = FRAG; \
            _Pragma("unroll") for (int ct = 0; ct < CT; ++ct) acc[rt][ct] = __builtin_amdgcn_mfma_f32_16x16x32_bf16(R[ct], bfr, acc[rt][ct], 0, 0, 0); } asm volatile("" ::: "memory"); } while (0)
#define M3_NEXT(k) do { if (!(MK_M3_PROBE >= 2 && probe)) M3_LOADSTEP((k) + RD - 1, ring[((k) + RD - 1) % RD]); } while (0)
#define M3_STEP(k) do { if ((k) < NP + 8) { if ((k) == 8) M3_PBASES(); M3_NEXT(k); if ((k) < 8) M3_MMA(ring[(k) % RD], QFRAG(rt, (k) & 7)); else M3_MMA(ring[(k) % RD], PFRAG(rt, ((k) - 8) & 7)); } } while (0)
        M3_STEP(0); M3_STEP(1); M3_STEP(2); M3_STEP(3); M3_STEP(4); M3_STEP(5); M3_STEP(6); M3_STEP(7);
        M3_STEP(8); M3_STEP(9); M3_STEP(10); M3_STEP(11); M3_STEP(12); M3_STEP(13); M3_STEP(14); M3_STEP(15);
#undef M3_STEP
#undef M3_NEXT
#undef M3_MMA
    }
#if MK_M3_EPI == 0
    {
        M3_LANE();
#pragma unroll
        for (int rt = 0; rt < 8; ++rt) { float s1 = 0.f, s2 = 0.f;
#pragma unroll
            for (int ct = 0; ct < CT; ++ct)
#pragma unroll
                for (int r = 0; r < 4; ++r) { const float x = acc[rt][ct][r]; s1 += x; s2 += x * x; }
            s1 += __shfl_xor(s1, 16); s1 += __shfl_xor(s1, 32); s2 += __shfl_xor(s2, 16); s2 += __shfl_xor(s2, 32);
            if (lq == 0) STATS[(16 * rt + lr) * 8 + wave] = (f32x2){s1, s2}; }
        __syncthreads();
    }
#pragma unroll
    for (int rt = 0; rt < 8; ++rt) { M3_LANE(); const int row = 16 * rt + lr;
        float s1 = 0.f, s2 = 0.f;
#pragma unroll
        for (int w = 0; w < 8; ++w) { const f32x2 s = STATS[row * 8 + w]; s1 += s[0]; s2 += s[1]; }
        const float mean = LNORM ? s1 * (1.0f / DV) : 0.f; const float var = s2 * (1.0f / DV) - mean * mean; const float rstd = 1.0f / sqrtf(var + 1e-6f);
        const size_t to = (size_t)(t0 + row);
#pragma unroll
        for (int ct = 0; ct < CT; ++ct) { const int col = vb + 16 * ct + 4 * lq; const u32x2 g = *(const u32x2*)(gate + to * 2048 + col);
            const f32x4 x = acc[rt][ct]; u32x2 w;
            w.x = cvt_pk_bf16((x[0] - mean) * rstd * bf_lo(g.x), (x[1] - mean) * rstd * bf_hi(g.x));
            w.y = cvt_pk_bf16((x[2] - mean) * rstd * bf_lo(g.y), (x[3] - mean) * rstd * bf_hi(g.y));
            *(u32x2*)(mixed + to * 4096 + col) = w; }
        asm volatile("" ::: "memory"); }
#elif MK_M3_EPI == 1
    {
        M3_LANE();
        const unsigned go = (unsigned)((t0 + lr) * 2048 + vb + 4 * lq), mo = (unsigned)((t0 + lr) * 4096 + vb + 4 * lq);
        u32x2 g0[4][CT], g1[4][CT];
#define M3_GLOAD(G, HB) do { _Pragma("unroll") for (int r4 = 0; r4 < 4; ++r4) { _Pragma("unroll") for (int ct = 0; ct < CT; ++ct) G[r4][ct] = (MK_M3_PROBE && probe) ? (u32x2){0x3f803f80u, 0x3f803f80u} : *(const u32x2*)(gate + (go + (unsigned)((16 * (4 * (HB) + r4)) * 2048 + 16 * ct))); } } while (0)
#define M3_GFOLD(G, HB) do { _Pragma("unroll") for (int r4 = 0; r4 < 4; ++r4) { _Pragma("unroll") for (int ct = 0; ct < CT; ++ct) { f32x4& x = acc[4 * (HB) + r4][ct]; \
            x[0] *= bf_lo(G[r4][ct].x); x[1] *= bf_hi(G[r4][ct].x); x[2] *= bf_lo(G[r4][ct].y); x[3] *= bf_hi(G[r4][ct].y); } } } while (0)
#define M3_ROWS(G, HB) do { _Pragma("unroll") for (int r4 = 0; r4 < 4; ++r4) { const int rt = 4 * (HB) + r4, row = 16 * rt + lr; float s1 = 0.f, s2 = 0.f; \
            _Pragma("unroll") for (int w = 0; w < 8; ++w) { const f32x2 s = STATS[row * 8 + w]; s1 += s[0]; s2 += s[1]; } \
            const float mean = LNORM ? s1 * (1.0f / DV) : 0.f; const float var = s2 * (1.0f / DV) - mean * mean; const float rstd = 1.0f / sqrtf(var + 1e-6f); \
            _Pragma("unroll") for (int ct = 0; ct < CT; ++ct) { const f32x4 x = acc[rt][ct]; u32x2 w; \
                if (LNORM) { w.x = cvt_pk_bf16((x[0] - mean) * rstd * bf_lo(G[r4][ct].x), (x[1] - mean) * rstd * bf_hi(G[r4][ct].x)); w.y = cvt_pk_bf16((x[2] - mean) * rstd * bf_lo(G[r4][ct].y), (x[3] - mean) * rstd * bf_hi(G[r4][ct].y)); } \
                else { w.x = cvt_pk_bf16(x[0] * rstd, x[1] * rstd); w.y = cvt_pk_bf16(x[2] * rstd, x[3] * rstd); } \
                if (!(MK_M3_PROBE && probe)) *(u32x2*)(mixed + (mo + (unsigned)((16 * rt) * 4096 + 16 * ct))) = w; } } } while (0)
        __builtin_amdgcn_sched_barrier(0);
        M3_GLOAD(g0, 0);
#pragma unroll
        for (int rt = 0; rt < 8; ++rt) { float s1 = 0.f, s2 = 0.f;
#pragma unroll
            for (int ct = 0; ct < CT; ++ct)
#pragma unroll
                for (int r = 0; r < 4; ++r) { const float x = acc[rt][ct][r]; s1 += x; s2 += x * x; }
            s1 += __shfl_xor(s1, 16); s1 += __shfl_xor(s1, 32); s2 += __shfl_xor(s2, 16); s2 += __shfl_xor(s2, 32);
            if (lq == 0) STATS[(16 * rt + lr) * 8 + wave] = (f32x2){s1, s2}; }
        asm volatile("" ::: "memory");
        if (!LNORM) M3_GFOLD(g0, 0);
        M3_GLOAD(g1, 1);
        __syncthreads();
        M3_ROWS(g0, 0);
        asm volatile("" ::: "memory");
        if (!LNORM) M3_GFOLD(g1, 1);
        M3_ROWS(g1, 1);
#undef M3_GLOAD
#undef M3_GFOLD
#undef M3_ROWS
    }
#else
    {
        constexpr int LPR = DV / 8, RPI = 64 / LPR, NI = 8 / RPI;
        LAS unsigned char* OT = lds;
        u32x4 gv0[NI], gv1[NI];
        const auto mixrs = __builtin_amdgcn_make_buffer_rsrc((void*)mixed, 0, 0x7ffffff0, 0x00020000);
#define M3_GROWS(G, PASS) do { int tg_ = tid; asm volatile("" : "+v"(tg_)); const int ln_ = tg_ & 63; _Pragma("unroll") for (int i = 0; i < NI; ++i) { const int rl = wave * 8 + i * RPI + ln_ / LPR; \
            G[i] = ((MK_M3_PROBE == 1 || MK_M3_PROBE == 2 || MK_M3_PROBE == 4) && probe) ? (u32x4){0x3f803f80u, 0x3f803f80u, 0x3f803f80u, 0x3f803f80u} : *(const u32x4*)(gate + ((unsigned)((t0 + 64 * (PASS) + rl) * 2048 + 8 * (ln_ % LPR)))); } } while (0)
#define M3_NORM(PASS) do { M3_LANE(); _Pragma("unroll") for (int r4 = 0; r4 < 4; ++r4) { const int rt = 4 * (PASS) + r4, row = 16 * rt + lr; float s1 = 0.f, s2 = 0.f; \
            _Pragma("unroll") for (int w = 0; w < 8; ++w) { const f32x2 sv = STATS[row * 8 + w]; s1 += sv[0]; s2 += sv[1]; } \
            const float mean = LNORM ? s1 * (1.0f / DV) : 0.f; const float var = s2 * (1.0f / DV) - mean * mean; const float rstd = 1.0f / sqrtf(var + 1e-6f); \
            _Pragma("unroll") for (int ct = 0; ct < CT; ++ct) { const f32x4 x = acc[rt][ct]; f32x4 y; y[0] = (x[0] - mean) * rstd; y[1] = (x[1] - mean) * rstd; y[2] = (x[2] - mean) * rstd; y[3] = (x[3] - mean) * rstd; \
                *(LAS f32x4*)(OT + (16 * r4 + lr) * (DV * 4) + ((((vb >> 2) + 4 * ct + lq) ^ lr) << 4)) = y; } } } while (0)
#define M3_OUT(G, PASS) do { int to_ = tid; asm volatile("" : "+v"(to_)); const int ln_ = to_ & 63, c8 = ln_ % LPR; _Pragma("unroll") for (int i = 0; i < NI; ++i) { const int rl = wave * 8 + i * RPI + ln_ / LPR; \
            const f32x4 ya = *(const LAS f32x4*)(OT + rl * (DV * 4) + (((2 * c8) ^ (rl & 15)) << 4)), yb = *(const LAS f32x4*)(OT + rl * (DV * 4) + (((2 * c8 + 1) ^ (rl & 15)) << 4)); \
            const u32x4 g = G[i]; u32x4 w; \
            w.x = cvt_pk_bf16(ya[0] * bf_lo(g.x), ya[1] * bf_hi(g.x)); w.y = cvt_pk_bf16(ya[2] * bf_lo(g.y), ya[3] * bf_hi(g.y)); \
            w.z = cvt_pk_bf16(yb[0] * bf_lo(g.z), yb[1] * bf_hi(g.z)); w.w = cvt_pk_bf16(yb[2] * bf_lo(g.w), yb[3] * bf_hi(g.w)); \
            if (MK_M3_DEFER) pend.w[PASS][i] = w; \
            else if (!((MK_M3_PROBE == 1 || MK_M3_PROBE == 2 || MK_M3_PROBE == 3) && probe)) { \
                if (MK_M3_PROBE == 5 && probe) *(u32x4*)((char*)mixed + (((unsigned)(((t0 + 64 * (PASS) + rl) * 4096 + 8 * c8) * 2)) & 0xfff0u)) = w;   \
                else if (MK_M3_WT) __builtin_amdgcn_raw_buffer_store_b128(w, mixrs, (unsigned)(((t0 + 64 * (PASS) + rl) * 4096 + 8 * c8) * 2), 0, 16  ); \
                else if (MK_M3_NTST) __builtin_nontemporal_store(w, (u32x4*)(mixed + ((unsigned)((t0 + 64 * (PASS) + rl) * 4096 + 8 * c8)))); \
                else *(u32x4*)(mixed + ((unsigned)((t0 + 64 * (PASS) + rl) * 4096 + 8 * c8))) = w; } } } while (0)
        __builtin_amdgcn_sched_barrier(0);
        if constexpr (GEARLY) {
#pragma unroll
            for (int i = 0; i < NI; ++i) { gv0[i] = gvE0[i]; gv1[i] = gvE1[i]; } }
        else M3_GROWS(gv0, 0);
        {   M3_LANE();
#pragma unroll
            for (int rt = 0; rt < 8; ++rt) { float s1 = 0.f, s2 = 0.f;
#pragma unroll
                for (int ct = 0; ct < CT; ++ct)
#pragma unroll
                    for (int r = 0; r < 4; ++r) { const float x = acc[rt][ct][r]; s1 += x; s2 += x * x; }
                s1 += __shfl_xor(s1, 16); s1 += __shfl_xor(s1, 32); s2 += __shfl_xor(s2, 16); s2 += __shfl_xor(s2, 32);
                if (lq == 0) STATS[(16 * rt + lr) * 8 + wave] = (f32x2){s1, s2}; } }
        __syncthreads();
        M3_NORM(0);
        if constexpr (!GEARLY) M3_GROWS(gv1, 1);
        __syncthreads();
        M3_OUT(gv0, 0);
        __syncthreads();
        M3_NORM(1);
        __syncthreads();
        M3_OUT(gv1, 1);
        if (MK_M3_DEFER) { pend.mixed = mixed; pend.t0 = t0; pend.lpr = LPR; }
#undef M3_GROWS
#undef M3_NORM
#undef M3_OUT
    }
#endif
    __syncthreads();
#undef M3_LOADV
#undef M3_LOADS
#undef M3_LOADSTEP
}
#undef QFRAG
#undef PFRAG
#undef M3_BASES
#undef M3_PBASES
#undef M3_LANE
template <class AT> __device__ __forceinline__ void m3_phase(const AT& a, int l, LAS unsigned char* lds, int tid, int lane, int wave, int bid, int G, int probe = 0) {
    bf16_t* const mixr = (MK_M3_PROBE == 5 && probe) ? a.h + (size_t)bid * 32768 : a.mixed;
    M3Pend pend; pend.lpr = 0; pend.mixed = nullptr; pend.t0 = 0;
    const bool flip = MK_M3_FLIP && ((bid >> 4) & 1);
#pragma unroll 1
    for (int s_ = 0; s_ < 2; ++s_) {
    if ((s_ == 0) != flip) {
    for (int u = bid; u < 256; u += G) { if (MK_M3_DEFER) m3_flush(pend, tid, wave); const int rh = MK_M3_UNPAIR ? (u & 1) : (u >> 3) & 1, idx = MK_M3_UNPAIR ? (u >> 1) : (u & 7) | ((u >> 4) << 3), h = idx >> 5, c2 = idx & 31, t0 = 256 * c2 + 128 * rh, tk0 = 256 * c2;
        if (rh) m3_unit<4, false, 2, MK_M3_RDG, false>(lds, a.qg + h * 256, 1024, a.kg + h * 256, (MK_VT_BLK ? a.vgt + ((size_t)c2 * 2048 + h * 512) * 256 : a.vgt + (size_t)(h * 512) * T), a.kvg + (size_t)(h * 32 + c2) * 131072, a.sgg + h * 512, a.gla_gain + l * 2048 + h * 512, ((MK_M3_PROBE == 5 && probe) ? mixr : a.mixed + 2048 + h * 512), t0, tk0, tid, wave, pend, probe);
        else    m3_unit<4, false, 1, MK_M3_RDG, false>(lds, a.qg + h * 256, 1024, a.kg + h * 256, (MK_VT_BLK ? a.vgt + ((size_t)c2 * 2048 + h * 512) * 256 : a.vgt + (size_t)(h * 512) * T), a.kvg + (size_t)(h * 32 + c2) * 131072, a.sgg + h * 512, a.gla_gain + l * 2048 + h * 512, ((MK_M3_PROBE == 5 && probe) ? mixr : a.mixed + 2048 + h * 512), t0, tk0, tid, wave, pend, probe); }
    } else {
    for (int u = bid; u < 512; u += G) { const int rh = (MK_M3_UNPAIR ? (u & 1) : (u >> 3) & 1) ^ 1  , idx = MK_M3_UNPAIR ? (u >> 1) : (u & 7) | ((u >> 4) << 3), h = idx >> 5, c2 = idx & 31, t0 = 256 * c2 + 128 * rh, tk0 = 256 * c2;
        if (rh) m3_unit<2, true, 2, MK_M3_RDR, true>(lds, a.qr + h * 256, 2048, a.kr + h * 256, (MK_VT_BLK ? a.vrt + ((size_t)c2 * 2048 + h * 256) * 256 : a.vrt + (size_t)(h * 256) * T), a.kvr + (size_t)(h * 32 + c2) * 65536, a.srg + h * 256, a.ret_gain + l * 2048 + h * 256, ((MK_M3_PROBE == 5 && probe) ? mixr : a.mixed + h * 256), t0, tk0, tid, wave, pend, probe);
        else    m3_unit<2, true, 1, MK_M3_RDR, true>(lds, a.qr + h * 256, 2048, a.kr + h * 256, (MK_VT_BLK ? a.vrt + ((size_t)c2 * 2048 + h * 256) * 256 : a.vrt + (size_t)(h * 256) * T), a.kvr + (size_t)(h * 32 + c2) * 65536, a.srg + h * 256, a.ret_gain + l * 2048 + h * 256, ((MK_M3_PROBE == 5 && probe) ? mixr : a.mixed + h * 256), t0, tk0, tid, wave, pend, probe); }
    }
    }
    if (MK_M3_DEFER) m3_flush(pend, tid, wave);
}

template <class AT> __device__ __forceinline__ void final_phase(const AT& a, const u64* ss, int tid, int bid, int G) {
    const size_t n8 = (size_t)T * D / 8, stride = (size_t)G * NTHR; const size_t i00 = (size_t)bid * NTHR + tid;
    const bool colfix = (stride & 511) == 0;
    f32x4 g0 = ((const f32x4*)a.final_norm)[2 * (int)(i00 & 511)], g1 = ((const f32x4*)a.final_norm)[2 * (int)(i00 & 511) + 1];
    u32x4 v[2][8]; u64 sv[2][8];
#define FIN_LOAD(B, i0_) do { _Pragma("unroll") for (int j = 0; j < 8; ++j) { const size_t i = (i0_) + j * stride; const bool ok = i < n8; \
        v[B][j] = ok ? MK_NTLD(((const u32x4*)a.xb) + i) : (u32x4){0u, 0u, 0u, 0u}; sv[B][j] = ok ? ss[i >> 9] : 0ull; } } while (0)
#define FIN_STORE(B, i0_) do { _Pragma("unroll") for (int j = 0; j < 8; ++j) { const size_t i = (i0_) + j * stride; if (i < n8) { \
        if (!colfix) { const int c8 = (int)(i & 511); g0 = ((const f32x4*)a.final_norm)[2 * c8]; g1 = ((const f32x4*)a.final_norm)[2 * c8 + 1]; } \
        const float r = rs_of(sv[B][j]); const u32x4 x = v[B][j]; \
        f32x4 o0, o1; o0[0] = bf_lo(x.x) * r * g0[0]; o0[1] = bf_hi(x.x) * r * g0[1]; o0[2] = bf_lo(x.y) * r * g0[2]; o0[3] = bf_hi(x.y) * r * g0[3]; \
        o1[0] = bf_lo(x.z) * r * g1[0]; o1[1] = bf_hi(x.z) * r * g1[1]; o1[2] = bf_lo(x.w) * r * g1[2]; o1[3] = bf_hi(x.w) * r * g1[3]; \
        ((f32x4*)a.out)[2 * i] = o0; ((f32x4*)a.out)[2 * i + 1] = o1; } } } while (0)
    if (i00 < n8) FIN_LOAD(0, i00);
#pragma unroll 1
    for (size_t i0 = i00; i0 < n8; i0 += 16 * stride) {
        const size_t i1 = i0 + 8 * stride, i2 = i0 + 16 * stride;
        if (i1 < n8) FIN_LOAD(1, i1);
        FIN_STORE(0, i0);
        if (i1 < n8) { if (i2 < n8) FIN_LOAD(0, i2); FIN_STORE(1, i1); }
    }
#undef FIN_LOAD
#undef FIN_STORE
}

#ifndef MK_PH
#define MK_PH 1023
#endif
#ifndef MK_SP2
#define MK_SP2 true
#endif
#ifndef MK_ALIGN
#define MK_ALIGN true
#endif
#ifndef MK_STAG_SHIFT
#define MK_STAG_SHIFT 6
#endif
#ifndef MK_STAG
#define MK_STAG 0
#endif
#define STAGGER() do { if (MK_STAG) { const unsigned long long t0_ = __builtin_amdgcn_s_memrealtime(); const unsigned long long w_ = (unsigned long long)(((bid >> MK_STAG_SHIFT) & 3) * MK_STAG); while (__builtin_amdgcn_s_memrealtime() - t0_ < w_) __builtin_amdgcn_s_sleep(8); } } while (0)
#ifndef MK_REP_P0
#define MK_REP_P0 1
#endif
#ifndef MK_REP_G1
#define MK_REP_G1 1
#endif
#ifndef MK_REP_PREP
#define MK_REP_PREP 1
#endif
#ifndef MK_REP_M1
#define MK_REP_M1 1
#endif
#ifndef MK_REP_M3
#define MK_REP_M3 1
#endif
#ifndef MK_REP_G3
#define MK_REP_G3 1
#endif
#ifndef MK_REP_M12
#define MK_REP_M12 1
#endif
#ifndef MK_REP_FIN
#define MK_REP_FIN 1
#endif
#ifndef MK_REP_G2
#define MK_REP_G2 1
#endif
#ifndef MK_REP_G4
#define MK_REP_G4 1
#endif
#define REPEAT(n, k) for (int rep_ = 0; rep_ < (n); ++rep_, ((rep_ < (n)) ? xcd_barrier(bar) : (void)0))
typedef const Args __attribute__((address_space(4))) CArgs;
#define KARGS() ({ const CArgs* p_ = (const CArgs*)__builtin_amdgcn_kernarg_segment_ptr(); asm volatile("" : "+s"(p_)); p_; })
__global__ void __launch_bounds__(NTHR, 2) mk_fwd(Args args_unused) {
    extern __shared__ __attribute__((aligned(16))) unsigned char lds_raw[];
    LAS unsigned char* lds = (LAS unsigned char*)lds_raw;
    const int bid = blockIdx.x, G = gridDim.x;
    volatile LAS unsigned* MISC = (volatile LAS unsigned*)(lds + LDSCTL_OFF);
    if (threadIdx.x < 64) MISC[threadIdx.x] = 0u;
    const int wave_s = __builtin_amdgcn_readfirstlane((int)(threadIdx.x >> 6));
#define MK_TID() ({ int w_ = wave_s; unsigned z_ = 0u; asm volatile("" : "+s"(w_), "+v"(z_)); (w_ << 6) | (int)__builtin_amdgcn_mbcnt_hi(~0u, __builtin_amdgcn_mbcnt_lo(~0u, z_)); })
#define LANEIDS() int tid = MK_TID(); asm volatile("" : "+v"(tid)); const int lane = tid & 63, wave = __builtin_amdgcn_readfirstlane(tid >> 6); (void)lane; (void)wave
    __syncthreads();
    (void)xcd_barrier_post(KARGS()->ctl + CW_BAR, MISC + 8);
#define bar (XcdBarrier{KARGS()->ctl + CW_BAR, xb_xcc_id(), MISC + 8, (MK_TID() == 0) ? 1u : 0u})
#if MK_SPLIT || MK_DEBUG
#define IN(k) (KARGS()->ph_lo <= (k) && (k) < KARGS()->ph_hi)
#else
#define IN(k) true
#endif
#if MK_TIMING
#define STAMP(k) do { if (blockIdx.x == 0 && threadIdx.x == 0) KARGS()->ctl[CW_TS + (k)] = (unsigned)__builtin_amdgcn_s_memrealtime(); } while (0)
#else
#define STAMP(k) do { } while (0)
#endif
#define SEAM(k) do { if (IN(k) && IN((k) + 1)) xcd_barrier(bar); STAMP((k) + 1); } while (0)
    STAMP(0);
#define SSB() ((u64*)(KARGS()->ctl + CW_SS))

    if (MK_PH & 256) if (IN(0)) REPEAT(MK_REP_P0, 0) { LANEIDS(); p0_prologue(*KARGS(), lds, tid, lane, wave, bid, G); }
    SEAM(0);
#ifdef MK_XBAR
    for (int xb_ = 0; xb_ < MK_XBAR; ++xb_) xcd_barrier(bar);
#endif
    for (int l = 0; l < 2; ++l) {
        const int pb = 1 + 8 * l;
        if (MK_PH & 1) if (IN(pb + 0)) REPEAT(MK_REP_G1, 1) {
            const CArgs& a = *KARGS(); const u64* ss_in = SSB() + (size_t)(2 * l) * T;
            { LANEIDS(); ga_stage(a, l, ss_in, lds, tid, lane, wave, bid, G); }
            pg8::Gemm g{a.xb, a.win_t[l], D, 2 * D, 128, 2 * D, 128}; pg8::ProjOrder S; S.init(T / 256, NPROJ / 256, G, bid);
            pg8::EpiProj E{ss_in, a.pos, a.qr, a.kr, a.vrt, a.srg, a.gq, a.gk, a.vgt, a.sgg, (MK_G1_PROBE && rep_ + 1 < MK_REP_G1) ? 1 : 0};
            STAGGER(); pg8::gemm_phase<pg8::EpiProj, pg8::ProjOrder, MK_ALIGN, MK_SP2>(lds, g, S, E, MK_TID());
        }
        SEAM(pb + 0);
        if (MK_PH & 2) if (IN(pb + 1)) REPEAT(MK_REP_PREP, 2) { LANEIDS(); prep_phase(*KARGS(), l, lds, tid, lane, wave, bid, G); }
        SEAM(pb + 1);
        for (int rep12 = 0; rep12 < MK_REP_M12; ++rep12) {
        if (rep12) xcd_barrier(bar);
        if (MK_PH & 4) if (IN(pb + 2)) REPEAT(MK_REP_M1, 3) { LANEIDS(); m1_phase(*KARGS(), lds, tid, wave, bid, G); }
        SEAM(pb + 2);
        if (MK_PH & 8) if (IN(pb + 3)) { LANEIDS(); m2_phase(*KARGS(), tid, bid, G); }
        }
        SEAM(pb + 3);
        if (MK_PH & 16) if (IN(pb + 4)) REPEAT(MK_REP_M3, 5) { LANEIDS(); m3_phase(*KARGS(), l, lds, tid, lane, wave, bid, G, (MK_M3_PROBE && rep_ + 1 < MK_REP_M3) ? 1 : 0); }
        SEAM(pb + 4);
        if (MK_PH & 32) if (IN(pb + 5)) REPEAT(MK_REP_G2, 6) {
            const CArgs& a = *KARGS(); u64* ss_mid = SSB() + (size_t)(2 * l + 1) * T;
            pg8::Gemm g{a.mixed, a.wout_t[l], D, 2 * D, 128, MK_BLK_W ? 128 : 2 * D, MK_BLK_W ? D * 128 : 128}; pg8::StaticOrder S; S.init(T / 256, D / 256, G, bid);
            const bool lastrep_ = (rep_ == MK_REP_G2 - 1); pg8::EpiRes E{lastrep_ ? a.xb : (bf16_t*)((char*)a.qr + (size_t)200 * 1048576), lastrep_ ? ss_mid : (u64*)(a.ctl + CW_CHK), (u64*)(a.ctl + CW_CHK)};
            STAGGER(); pg8::gemm_phase<pg8::EpiRes, pg8::StaticOrder, MK_ALIGN, MK_SP2>(lds, g, S, E, MK_TID());
        }
        SEAM(pb + 5);
#if MK_TIMING
        if (l == 0 && blockIdx.x == 0 && threadIdx.x == 0) { KARGS()->ctl[CW_TS + 32] = (unsigned)__builtin_amdgcn_s_memtime(); KARGS()->ctl[CW_TS + 33] = (unsigned)__builtin_amdgcn_s_memrealtime(); }
#endif
        if (MK_PH & 64) if (IN(pb + 6)) REPEAT(MK_REP_G3, 7) {
            const CArgs& a = *KARGS(); const u64* ss_mid = SSB() + (size_t)(2 * l + 1) * T;
            pg8::Gemm g{a.xb, a.wgu_t[l], D, 2 * D, 128, MK_BLK_W ? 128 : 2 * D, MK_BLK_W ? 2 * FF * 128 : 128}; pg8::StaticOrder S; S.init(T / 256, 2 * FF / 256, G, bid);
            pg8::EpiSwiGLU E{ss_mid, a.h};
            STAGGER(); pg8::gemm_phase<pg8::EpiSwiGLU, pg8::StaticOrder, MK_ALIGN, MK_SP2>(lds, g, S, E, MK_TID());
        }
#if MK_TIMING
        if (l == 0 && blockIdx.x == 0 && threadIdx.x == 0) { KARGS()->ctl[CW_TS + 34] = (unsigned)__builtin_amdgcn_s_memtime(); KARGS()->ctl[CW_TS + 35] = (unsigned)__builtin_amdgcn_s_memrealtime(); }
#endif
        SEAM(pb + 6);
        if (MK_PH & 128) if (IN(pb + 7)) REPEAT(MK_REP_G4, 8) {
            const CArgs& a = *KARGS(); u64* ss_out = SSB() + (size_t)(2 * l + 2) * T;
            pg8::Gemm g{a.h, a.wd_t[l], FF, 128, T * 128, MK_BLK_W ? 128 : 2 * FF, MK_BLK_W ? D * 128 : 128}  ; pg8::StaticOrder S; S.init(T / 256, D / 256, G, bid);
            const bool lastrep_ = (rep_ == MK_REP_G4 - 1); pg8::EpiRes E{lastrep_ ? a.xb : (bf16_t*)((char*)a.qr + (size_t)200 * 1048576), lastrep_ ? ss_out : (u64*)(a.ctl + CW_CHK), (u64*)(a.ctl + CW_CHK)};
            STAGGER(); pg8::gemm_phase<pg8::EpiRes, pg8::StaticOrder, MK_ALIGN, MK_SP2>(lds, g, S, E, MK_TID());
        }
        SEAM(pb + 7);
    }
    if (MK_PH & 512) if (IN(17)) REPEAT(MK_REP_FIN, 17) { LANEIDS(); final_phase(*KARGS(), SSB() + (size_t)4 * T, tid, bid, G); }
    STAMP(18);
#undef IN
#undef SEAM
}

#ifndef MK_WS_ALIGN
#define MK_WS_ALIGN 256
#endif
struct Layout { size_t off; size_t take(size_t bytes) { const size_t al = MK_WS_ALIGN; off = (off + al - 1) / al * al; const size_t o = off; off += bytes; return o; } };
static size_t build_args(Args& a, void* const* d_in, void* d_out, unsigned char* ws, size_t base, int cvt_mask, int cvt_layers) {
    a.x = (const float*)d_in[0]; a.pos = (const int*)d_in[1]; a.mix_norm = (const float*)d_in[2]; a.w_in = (const float*)d_in[3]; a.gla_w_up = (const float*)d_in[4]; a.gla_b = (const float*)d_in[5];
    a.ret_gain = (const float*)d_in[6]; a.gla_gain = (const float*)d_in[7]; a.w_out = (const float*)d_in[8]; a.ffn_norm = (const float*)d_in[9]; a.w_gate = (const float*)d_in[10]; a.w_up = (const float*)d_in[11];
    a.w_down = (const float*)d_in[12]; a.final_norm = (const float*)d_in[13]; a.out = (float*)d_out;
    Layout L{base};
    a.ctl = (unsigned*)(ws + L.take(CTL_ZERO_BYTES));
    for (int l = 0; l < 2; ++l) { const bool on = l < cvt_layers;
        a.win_t[l] = (bf16_t*)(ws + ((on && (cvt_mask & 1)) ? L.take((size_t)NPROJ * D * 2) : L.off)); a.wga_t[l] = (bf16_t*)(ws + ((on && (cvt_mask & 1)) ? L.take((size_t)16 * D * 2) : L.off));
        a.wout_t[l] = (bf16_t*)(ws + ((on && (cvt_mask & 2)) ? L.take((size_t)D * D * 2) : L.off)); a.wgu_t[l] = (bf16_t*)(ws + ((on && (cvt_mask & 4)) ? L.take((size_t)2 * FF * D * 2) : L.off));
        a.wd_t[l] = (bf16_t*)(ws + ((on && (cvt_mask & 8)) ? L.take((size_t)D * FF * 2) : L.off)); }
    a.xb = (bf16_t*)(ws + L.take((size_t)T * D * 2)); a.rot = nullptr; a.ga = (float*)(ws + L.take((size_t)T * 16 * 4)); a.lam = (float*)(ws + L.take((size_t)64 * 1024 * 4));
    a.mixed = (bf16_t*)(ws + L.take((size_t)T * D * 2));
    const size_t ov0 = L.off;
    a.qr = (bf16_t*)(ws + L.take((size_t)T * 2048 * 2)); a.kr = (bf16_t*)(ws + L.take((size_t)T * 2048 * 2)); a.krt = nullptr; a.vrt = (bf16_t*)(ws + L.take((size_t)T * 2048 * 2));
    a.srg = (bf16_t*)(ws + L.take((size_t)T * 2048 * 2)); a.gq = (bf16_t*)(ws + L.take((size_t)T * 1024 * 2)); a.gk = (bf16_t*)(ws + L.take((size_t)T * 1024 * 2)); a.qg = (bf16_t*)(ws + L.take((size_t)T * 1024 * 2));
    a.kg = (bf16_t*)(ws + L.take((size_t)T * 1024 * 2)); a.kgt = nullptr; a.vgt = (bf16_t*)(ws + L.take((size_t)T * 2048 * 2)); a.sgg = (bf16_t*)(ws + L.take((size_t)T * 2048 * 2));
    a.kvr = (bf16_t*)(ws + L.take((size_t)8 * 64 * 65536 * 2)); a.kvg = (bf16_t*)(ws + L.take((size_t)4 * 64 * 131072 * 2));
    a.h = (bf16_t*)(ws + ov0);
    if (L.off < ov0 + (size_t)T * FF * 2) L.off = ov0 + (size_t)T * FF * 2;
    a.cvt_mask = cvt_mask; a.cvt_layers = cvt_layers;
    return L.off;
}
static int g_grid = 0;
static bool setup_once() {
    if (g_grid) return g_grid > 0;
    int dev = 0, cus = 0, per_cu = 0;
    if (hipGetDevice(&dev) != hipSuccess || hipDeviceGetAttribute(&cus, hipDeviceAttributeMultiprocessorCount, dev) != hipSuccess) { fprintf(stderr, "mk: device query failed\n"); g_grid = -1; return false; }
    if (hipFuncSetAttribute((const void*)mk_fwd, hipFuncAttributeMaxDynamicSharedMemorySize, LDS_BYTES) != hipSuccess) { fprintf(stderr, "mk: hipFuncSetAttribute failed\n"); g_grid = -1; return false; }
    if (hipOccupancyMaxActiveBlocksPerMultiprocessor(&per_cu, (const void*)mk_fwd, NTHR, LDS_BYTES) != hipSuccess || per_cu < 1) { fprintf(stderr, "mk: occupancy query says %d blocks per CU\n", per_cu); (void)hipGetLastError(); }
    g_grid = cus;
    return true;
}
static void launch_range(Args a, int lo, int hi, hipStream_t stream, bool zero_bar = true) {
    if (zero_bar) (void)hipMemsetAsync((char*)a.ctl + (size_t)CW_BAR * 4, 0, (size_t)XCD_BAR_WORDS * 4, stream);
    a.ph_lo = lo; a.ph_hi = hi;
    hipLaunchKernelGGL(mk_fwd, dim3(g_grid), dim3(NTHR), LDS_BYTES, stream, a);
    const hipError_t e = hipPeekAtLastError(); if (e != hipSuccess) fprintf(stderr, "mk: launch [%d,%d) failed: %s\n", lo, hi, hipGetErrorName(e));
}
}
#if MK_DEBUG
namespace nv {
constexpr int T_ = 8192, D_ = 4096, INW = 14352, FF_ = 11008;
constexpr int O_RQ = 0, O_RK = 2048, O_RV = 4096, O_RG = 6144, O_GQ = 8192, O_GK = 9216, O_GV = 10240, O_GG = 12288, O_GA = 14336;

__global__ __launch_bounds__(256) void k_rmsnorm(const float* __restrict__ x, const float* __restrict__ g, float* __restrict__ out) {
    const int row = blockIdx.x; const float* xr = x + (size_t)row * D_;
    float s = 0.f;
    for (int i = threadIdx.x; i < D_; i += 256) { const float v = xr[i]; s += v * v; }
    __shared__ float red[4];
    for (int o = 32; o > 0; o >>= 1) s += __shfl_xor(s, o);
    if ((threadIdx.x & 63) == 0) red[threadIdx.x >> 6] = s;
    __syncthreads();
    s = red[0] + red[1] + red[2] + red[3];
    const float r = 1.0f / sqrtf(s / (float)D_ + 1e-6f);
    for (int i = threadIdx.x; i < D_; i += 256) out[(size_t)row * D_ + i] = xr[i] * r * g[i];
}

template <int EPI>
__global__ __launch_bounds__(256) void k_sgemm(const float* __restrict__ A, const float* __restrict__ B, float* __restrict__ C, const float* __restrict__ R, int M, int N, int K) {
    __shared__ float As[16][132];
    __shared__ float Bs[16][132];
    const int bm = blockIdx.y * 128, bn = blockIdx.x * 128;
    const int tid = threadIdx.x, tx = tid & 15, ty = tid >> 4;
    float acc[8][8];
#pragma unroll
    for (int i = 0; i < 8; ++i)
#pragma unroll
        for (int j = 0; j < 8; ++j) acc[i][j] = 0.f;
    for (int k0 = 0; k0 < K; k0 += 16) {
#pragma unroll
        for (int i = 0; i < 2; ++i) {
            const int idx = tid + i * 256, r = idx >> 2, c4 = (idx & 3) * 4;
            const float4 v = *(const float4*)&A[(size_t)(bm + r) * K + k0 + c4];
            As[c4 + 0][r] = v.x; As[c4 + 1][r] = v.y; As[c4 + 2][r] = v.z; As[c4 + 3][r] = v.w;
        }
#pragma unroll
        for (int i = 0; i < 2; ++i) {
            const int idx = tid + i * 256, kr = idx >> 5, c4 = (idx & 31) * 4;
            float4 v = make_float4(0.f, 0.f, 0.f, 0.f);
            if (bn + c4 < N) v = *(const float4*)&B[(size_t)(k0 + kr) * N + bn + c4];
            *(float4*)&Bs[kr][c4] = v;
        }
        __syncthreads();
#pragma unroll
        for (int kk = 0; kk < 16; ++kk) {
            float a[8], b[8];
            const float4 a0 = *(const float4*)&As[kk][ty * 8], a1 = *(const float4*)&As[kk][ty * 8 + 4];
            const float4 b0 = *(const float4*)&Bs[kk][tx * 8], b1 = *(const float4*)&Bs[kk][tx * 8 + 4];
            a[0] = a0.x; a[1] = a0.y; a[2] = a0.z; a[3] = a0.w; a[4] = a1.x; a[5] = a1.y; a[6] = a1.z; a[7] = a1.w;
            b[0] = b0.x; b[1] = b0.y; b[2] = b0.z; b[3] = b0.w; b[4] = b1.x; b[5] = b1.y; b[6] = b1.z; b[7] = b1.w;
#pragma unroll
            for (int i = 0; i < 8; ++i)
#pragma unroll
                for (int j = 0; j < 8; ++j) acc[i][j] = fmaf(a[i], b[j], acc[i][j]);
        }
        __syncthreads();
    }
#pragma unroll
    for (int i = 0; i < 8; ++i) {
        const int r = bm + ty * 8 + i;
#pragma unroll
        for (int j4 = 0; j4 < 2; ++j4) {
            const int c = bn + tx * 8 + j4 * 4;
            if (c < N) {
                float4 v = make_float4(acc[i][j4 * 4 + 0], acc[i][j4 * 4 + 1], acc[i][j4 * 4 + 2], acc[i][j4 * 4 + 3]);
                if (EPI == 1) { const float4 rr = *(const float4*)&R[(size_t)r * N + c]; v.x += rr.x; v.y += rr.y; v.z += rr.z; v.w += rr.w; }
                if (EPI == 2) { const float4 gg = *(const float4*)&C[(size_t)r * N + c]; v.x *= gg.x / (1.0f + __expf(-gg.x)); v.y *= gg.y / (1.0f + __expf(-gg.y)); v.z *= gg.z / (1.0f + __expf(-gg.z)); v.w *= gg.w / (1.0f + __expf(-gg.w)); }
                *(float4*)&C[(size_t)r * N + c] = v;
            }
        }
    }
}

__device__ __forceinline__ float siluf(float x) { return x / (1.0f + __expf(-x)); }

__global__ __launch_bounds__(256) void k_rotary(float* __restrict__ proj, const int* __restrict__ pos) {
    const size_t gid = (size_t)blockIdx.x * 256 + threadIdx.x;
    const int i = (int)(gid & 127), h = (int)((gid >> 7) & 7), w = (int)((gid >> 10) & 1); const int t = (int)(gid >> 11);
    if (t >= T_) return;
    const float inv_freq = powf(10000.0f, -(float)i / 128.0f);
    const float ang = (float)pos[t] * inv_freq;
    const double rev = (double)ang * 0.15915494309189533577;
    const float fr = (float)(rev - floor(rev));
    const float c = __builtin_amdgcn_cosf(fr), s = __builtin_amdgcn_sinf(fr);
    float* p = proj + (size_t)t * INW + (w ? O_RK : O_RQ) + h * 256 + i;
    const float t1 = p[0], t2 = p[128];
    p[0] = t1 * c - t2 * s; p[128] = t1 * s + t2 * c;
}

__global__ __launch_bounds__(256) void k_gate(const float* __restrict__ proj, const float* __restrict__ wup, const float* __restrict__ b, float* __restrict__ loga) {
    const int t = blockIdx.x;
    const float* ga = proj + (size_t)t * INW + O_GA;
    for (int c = threadIdx.x; c < 1024; c += 256) {
        float z = b[c];
#pragma unroll
        for (int r = 0; r < 16; ++r) z = fmaf(ga[r], wup[r * 1024 + c], z);
        const float ls = fminf(z, 0.f) - log1pf(expf(-fabsf(z)));
        loga[(size_t)t * 1024 + c] = ls * (1.0f / 16.0f);
    }
}

template <int GLA>
__global__ __launch_bounds__(256) void k_recur(const float* __restrict__ proj, int qoff, int koff, int voff, int dv, const float* __restrict__ loga, float qs, float ks, float* __restrict__ out, int ostride) {
    const int vt = blockIdx.x, h = blockIdx.y, d = threadIdx.x, lane = d & 63, wave = d >> 6;
    float S[16];
#pragma unroll
    for (int j = 0; j < 16; ++j) S[j] = 0.f;
    const float gamma = 1.0f - exp2f(-5.0f - (float)h);
    __shared__ float part[2][4][16];
    for (int t = 0; t < T_; ++t) {
        const float* row = proj + (size_t)t * INW;
        const float q = row[qoff + h * 256 + d] * qs, k = row[koff + h * 256 + d] * ks;
        const float a = GLA ? expf(loga[(size_t)t * 1024 + h * 256 + d]) : gamma;
        float p[16];
#pragma unroll
        for (int j4 = 0; j4 < 4; ++j4) {
            const float4 v = *(const float4*)&row[voff + h * dv + vt * 16 + j4 * 4];
            S[j4 * 4 + 0] = a * S[j4 * 4 + 0] + k * v.x; S[j4 * 4 + 1] = a * S[j4 * 4 + 1] + k * v.y;
            S[j4 * 4 + 2] = a * S[j4 * 4 + 2] + k * v.z; S[j4 * 4 + 3] = a * S[j4 * 4 + 3] + k * v.w;
        }
#pragma unroll
        for (int j = 0; j < 16; ++j) p[j] = q * S[j];
#pragma unroll
        for (int j = 0; j < 16; ++j)
#pragma unroll
            for (int o = 32; o > 0; o >>= 1) p[j] += __shfl_xor(p[j], o);
        if (lane == 0) {
#pragma unroll
            for (int j = 0; j < 16; ++j) part[t & 1][wave][j] = p[j];
        }
        __syncthreads();
        if (d < 16) out[(size_t)t * ostride + h * dv + vt * 16 + d] = part[t & 1][0][d] + part[t & 1][1][d] + part[t & 1][2][d] + part[t & 1][3][d];
    }
}

__global__ __launch_bounds__(256) void k_headnorm(const float* __restrict__ proj, const float* __restrict__ ro, const float* __restrict__ go, const float* __restrict__ rgain, const float* __restrict__ ggain, float* __restrict__ mixed) {
    const int t = blockIdx.x, tid = threadIdx.x, lane = tid & 63, wave = tid >> 6;
    const float* row = proj + (size_t)t * INW;
    for (int hh = 0; hh < 2; ++hh) {
        const int h = wave * 2 + hh;
        float v[4]; float s = 0.f;
#pragma unroll
        for (int j = 0; j < 4; ++j) { v[j] = ro[(size_t)t * 2048 + h * 256 + lane + 64 * j]; s += v[j]; }
        for (int o = 32; o > 0; o >>= 1) s += __shfl_xor(s, o);
        const float mu = s / 256.f; float q = 0.f;
#pragma unroll
        for (int j = 0; j < 4; ++j) { v[j] -= mu; q += v[j] * v[j]; }
        for (int o = 32; o > 0; o >>= 1) q += __shfl_xor(q, o);
        const float rs = 1.0f / sqrtf(q / 256.f + 1e-6f);
#pragma unroll
        for (int j = 0; j < 4; ++j) { const int c = h * 256 + lane + 64 * j; mixed[(size_t)t * D_ + c] = siluf(row[O_RG + c]) * (v[j] * rs * rgain[c]); }
    }
    {
        const int h = wave;
        float v[8]; float q = 0.f;
#pragma unroll
        for (int j = 0; j < 8; ++j) { v[j] = go[(size_t)t * 2048 + h * 512 + lane + 64 * j]; q += v[j] * v[j]; }
        for (int o = 32; o > 0; o >>= 1) q += __shfl_xor(q, o);
        const float rs = 1.0f / sqrtf(q / 512.f + 1e-6f);
#pragma unroll
        for (int j = 0; j < 8; ++j) { const int c = h * 512 + lane + 64 * j; mixed[(size_t)t * D_ + 2048 + c] = siluf(row[O_GG + c]) * (v[j] * rs * ggain[c]); }
    }
}

__global__ __launch_bounds__(256) void k_swiglu(float* __restrict__ G, const float* __restrict__ U, size_t n4) {
    for (size_t i = (size_t)blockIdx.x * 256 + threadIdx.x; i < n4; i += (size_t)gridDim.x * 256) {
        float4 g = ((float4*)G)[i]; const float4 u = ((const float4*)U)[i];
        g.x = siluf(g.x) * u.x; g.y = siluf(g.y) * u.y; g.z = siluf(g.z) * u.z; g.w = siluf(g.w) * u.w;
        ((float4*)G)[i] = g;
    }
}

inline void forward(void* const* d_in, float* out, float* ws, size_t ws_size, hipStream_t st) {
    const float* x = (const float*)d_in[0]; const int* pos = (const int*)d_in[1];
    const float* mix_norm = (const float*)d_in[2]; const float* w_in = (const float*)d_in[3];
    const float* gla_w_up = (const float*)d_in[4]; const float* gla_b = (const float*)d_in[5];
    const float* ret_gain = (const float*)d_in[6]; const float* gla_gain = (const float*)d_in[7];
    const float* w_out = (const float*)d_in[8]; const float* ffn_norm = (const float*)d_in[9];
    const float* w_gate = (const float*)d_in[10]; const float* w_up = (const float*)d_in[11]; const float* w_down = (const float*)d_in[12];
    const float* final_norm = (const float*)d_in[13];
    size_t o = 0;
    float* xn = ws + o; o += (size_t)T_ * D_;
    float* proj = ws + o; o += (size_t)T_ * INW;
    float* loga = ws + o; o += (size_t)T_ * 1024;
    float* ro = ws + o; o += (size_t)T_ * 2048;
    float* go = ws + o; o += (size_t)T_ * 2048;
    float* mixed = ws + o; o += (size_t)T_ * D_;
    float* xa = ws + o; o += (size_t)T_ * D_;
    float* xb = ws + o; o += (size_t)T_ * D_;
    float* G = ws + o; o += (size_t)T_ * FF_;
    if (o * 4 > ws_size) { fprintf(stderr, "naive: ws too small: need %zu have %zu\n", o * 4, ws_size); return; }
    const float* xc = x;
    for (int l = 0; l < 2; ++l) {
        k_rmsnorm<<<T_, 256, 0, st>>>(xc, mix_norm + (size_t)l * D_, xn);
        k_sgemm<0><<<dim3((INW + 127) / 128, T_ / 128), 256, 0, st>>>(xn, w_in + (size_t)l * D_ * INW, proj, nullptr, T_, INW, D_);
        k_rotary<<<(T_ * 2048) / 256, 256, 0, st>>>(proj, pos);
        k_gate<<<T_, 256, 0, st>>>(proj, gla_w_up + (size_t)l * 16 * 1024, gla_b + (size_t)l * 1024, loga);
        k_recur<0><<<dim3(16, 8), 256, 0, st>>>(proj, O_RQ, O_RK, O_RV, 256, nullptr, 1.0f, 1.0f / 16.0f, ro, 2048);
        k_recur<1><<<dim3(32, 4), 256, 0, st>>>(proj, O_GQ, O_GK, O_GV, 512, loga, 1.0f / 16.0f, 1.0f, go, 2048);
        k_headnorm<<<T_, 256, 0, st>>>(proj, ro, go, ret_gain + (size_t)l * 2048, gla_gain + (size_t)l * 2048, mixed);
        k_sgemm<1><<<dim3(D_ / 128, T_ / 128), 256, 0, st>>>(mixed, w_out + (size_t)l * D_ * D_, xa, xc, T_, D_, D_);
        k_rmsnorm<<<T_, 256, 0, st>>>(xa, ffn_norm + (size_t)l * D_, xn);
        k_sgemm<0><<<dim3(FF_ / 128, T_ / 128), 256, 0, st>>>(xn, w_gate + (size_t)l * D_ * FF_, G, nullptr, T_, FF_, D_);
        k_sgemm<2><<<dim3(FF_ / 128, T_ / 128), 256, 0, st>>>(xn, w_up + (size_t)l * D_ * FF_, G, nullptr, T_, FF_, D_);
        k_sgemm<1><<<dim3(D_ / 128, T_ / 128), 256, 0, st>>>(G, w_down + (size_t)l * FF_ * D_, xb, xa, T_, D_, FF_);
        xc = xb;
    }
    k_rmsnorm<<<T_, 256, 0, st>>>(xc, final_norm, out);
}
}
#endif
#if MK_DEBUG
namespace dbg {
typedef unsigned short bf16_t;
constexpr int T = 8192, INW = 14352;
__device__ __forceinline__ float bf(bf16_t v) { return __uint_as_float((unsigned)v << 16); }
__device__ __forceinline__ void acc2(float* slot, float se, float sb) {
    for (int o = 32; o > 0; o >>= 1) { se += __shfl_xor(se, o); sb += __shfl_xor(sb, o); }
    if ((threadIdx.x & 63) == 0) { atomicAdd(slot, se); atomicAdd(slot + 1, sb); }
}
__global__ void k_cmp_bf16(const bf16_t* got, int gld, int transposed, const float* ref, int rld, int roff, int rows, int cols, int mode, float scale, float* slot) {
    float se = 0.f, sb = 0.f;
    for (size_t i = (size_t)blockIdx.x * blockDim.x + threadIdx.x; i < (size_t)rows * cols; i += (size_t)gridDim.x * blockDim.x) {
        const int r = (int)(i / cols), c = (int)(i % cols);
        float e = ref[(size_t)r * rld + roff + c] * scale;
        if (mode == 1) e = e / (1.0f + expf(-e));
        if (mode == 2 || mode == 3) { const int h = c >> 8; const float lg = log2f(1.0f - exp2f(-5.0f - (float)h)); const float ip1 = (float)((r & 127) + 1); e *= (mode == 2) ? exp2f(ip1 * lg) : exp2f(-ip1 * lg) * 0.0625f; }
        const float g = transposed ? bf(got[(size_t)c * gld + r]) : bf(got[(size_t)r * gld + c]);
        const float d = g - e; se += (d == d) ? d * d : 1e30f; sb += e * e;
    }
    acc2(slot, se, sb);
}
__global__ void k_cmp_f32(const float* got, int gld, const float* ref, int rld, int roff, int rows, int cols, float* slot) {
    float se = 0.f, sb = 0.f;
    for (size_t i = (size_t)blockIdx.x * blockDim.x + threadIdx.x; i < (size_t)rows * cols; i += (size_t)gridDim.x * blockDim.x) {
        const int r = (int)(i / cols), c = (int)(i % cols);
        const float e = ref[(size_t)r * rld + roff + c], g = got[(size_t)r * gld + c]; const float d = g - e; se += (d == d) ? d * d : 1e30f; sb += e * e; }
    acc2(slot, se, sb);
}
__global__ void k_cmp_tr(const bf16_t* a, int ald, const bf16_t* b, int bld, int rows, int cols, float* slot) {
    float se = 0.f, sb = 0.f;
    for (size_t i = (size_t)blockIdx.x * blockDim.x + threadIdx.x; i < (size_t)rows * cols; i += (size_t)gridDim.x * blockDim.x) {
        const int r = (int)(i / cols), c = (int)(i % cols); const float e = bf(a[(size_t)r * ald + c]), g = bf(b[(size_t)c * bld + r]); const float d = g - e; se += (d == d) ? d * d : 1e30f; sb += e * e; }
    acc2(slot, se, sb);
}
__global__ void k_cmp_ss(const float* ss, const float* ref, int rld, float* slot) {
    const int t = blockIdx.x; float s = 0.f; for (int i = threadIdx.x; i < 4096; i += 256) { const float v = ref[(size_t)t * rld + i]; s += v * v; }
    __shared__ float red[4]; for (int o = 32; o > 0; o >>= 1) s += __shfl_xor(s, o); if ((threadIdx.x & 63) == 0) red[threadIdx.x >> 6] = s; __syncthreads();
    if (threadIdx.x == 0) { const float e = red[0] + red[1] + red[2] + red[3], d = ss[t] - e; atomicAdd(slot, (d == d) ? d * d : 1e30f); atomicAdd(slot + 1, e * e); }
}
__global__ void k_cmp_gla(const bf16_t* qg, const bf16_t* kg, const float* lam, const float* proj, const float* loga, float* slot_q, float* slot_k, float* slot_l) {
    const int c = blockIdx.x, ch = blockIdx.y * 256 + threadIdx.x; float cum = 0.f, seq = 0.f, sbq = 0.f, sek = 0.f, sbk = 0.f;
    for (int tt = 0; tt < 128; ++tt) { const int t = c * 128 + tt; cum += loga[(size_t)t * 1024 + ch];
        const float eq = proj[(size_t)t * INW + 8192 + ch] * 0.0625f * expf(cum), ek = proj[(size_t)t * INW + 9216 + ch] * expf(-cum);
        float d = bf(qg[(size_t)t * 1024 + ch]) - eq; seq += (d == d) ? d * d : 1e30f; sbq += eq * eq; d = bf(kg[(size_t)t * 1024 + ch]) - ek; sek += (d == d) ? d * d : 1e30f; sbk += ek * ek; }
    const float el = expf(cum), dl = lam[c * 1024 + ch] - el;
    acc2(slot_q, seq, sbq); acc2(slot_k, sek, sbk); acc2(slot_l, (dl == dl) ? dl * dl : 1e30f, el * el);
}
__global__ void k_cmp_kv(const bf16_t* kb, int ldk, const bf16_t* vt, const bf16_t* kv, int DV, float* slot) {
    const int c = blockIdx.x, h = blockIdx.y, t0 = c * 128; float se = 0.f, sb = 0.f;
    for (int idx = threadIdx.x; idx < DV * 256; idx += 256) { const int v = idx >> 8, d = idx & 255; float e = 0.f;
        for (int j = 0; j < 128; ++j) e += bf(vt[(size_t)(h * DV + v) * T + t0 + j]) * bf(kb[(size_t)(t0 + j) * ldk + h * 256 + d]);
        const float g = bf(kv[((size_t)(h * 64 + c) * DV + v) * 256 + d]); const float dd = g - e; se += (dd == dd) ? dd * dd : 1e30f; sb += e * e; }
    acc2(slot, se, sb);
}
__global__ void k_cmp_s(const bf16_t* kb, int ldk, const bf16_t* vt, const bf16_t* sbuf, const float* lam, int DV, float* slot) {
    const int h = blockIdx.y; const int idx = blockIdx.x * 256 + threadIdx.x; const int v = idx >> 8, d = idx & 255; float se = 0.f, sb = 0.f, st = 0.f;
    const float lret = exp2f(128.0f * log2f(1.0f - exp2f(-5.0f - (float)h)));
    for (int c = 0; c < 64; ++c) { const float g = bf(sbuf[((size_t)(h * 64 + c) * DV + v) * 256 + d]); const float dd = g - st; se += (dd == dd) ? dd * dd : 1e30f; sb += st * st;
        float e = 0.f; for (int j = 0; j < 128; ++j) e += bf(vt[(size_t)(h * DV + v) * T + c * 128 + j]) * bf(kb[(size_t)(c * 128 + j) * ldk + h * 256 + d]);
        st = (lam ? lam[c * 1024 + h * 256 + d] : lret) * (st + e); }
    acc2(slot, se, sb);
}
__global__ void k_cmp_p(const bf16_t* q, const bf16_t* k, const bf16_t* pd, float* slot) {
    const int c = blockIdx.x, h = blockIdx.y, t0 = c * 128; float se[4] = {0.f, 0.f, 0.f, 0.f}, sb[4] = {0.f, 0.f, 0.f, 0.f};
    for (int idx = threadIdx.x; idx < 16384; idx += 256) { const int i = idx >> 7, j = idx & 127; float e = 0.f;
        for (int d = 0; d < 256; ++d) e += bf(q[(size_t)(t0 + i) * 2048 + h * 256 + d]) * bf(k[(size_t)(t0 + j) * 2048 + h * 256 + d]);
        const int cls = (j > i) ? 3 : ((i >> 4) != (j >> 4)) ? 0 : (j < i) ? 1 : 2;
        const float g = bf(pd[(size_t)(h * 64 + c) * 16384 + idx]); const float ee = (cls == 3) ? 0.f : e; const float dd = g - ee;
#pragma unroll
        for (int z = 0; z < 4; ++z) if (cls == z) { se[z] += (dd == dd) ? dd * dd : 1e30f; sb[z] += (z == 3) ? e * e : ee * ee; } }
#pragma unroll
    for (int z = 0; z < 4; ++z) acc2(slot + 2 * z, se[z], sb[z]);
}
__global__ void k_cmp_o(const bf16_t* q, const bf16_t* pd, const bf16_t* vt, const bf16_t* sbuf, const float* od, float* slot) {
    const int t = blockIdx.x, h = blockIdx.y, v = threadIdx.x, c = t >> 7, i = t & 127; float e = 0.f;
    for (int j = 0; j < 128; ++j) e += bf(pd[(size_t)(h * 64 + c) * 16384 + i * 128 + j]) * bf(vt[(size_t)(h * 256 + v) * T + c * 128 + j]);
    for (int d = 0; d < 256; ++d) e += bf(q[(size_t)t * 2048 + h * 256 + d]) * bf(sbuf[((size_t)(h * 64 + c) * 256 + v) * 256 + d]);
    const float g = od[(size_t)t * 2048 + h * 256 + v]; const float dd = g - e; acc2(slot, (dd == dd) ? dd * dd : 1e30f, e * e);
}
__global__ void k_decide(const float* slots, int n, const float* tol, float* code) {
    if (threadIdx.x || blockIdx.x) return; float cd = 9900.0f;
    for (int i = 0; i < n; ++i) { const float se = slots[2 * i], sb = slots[2 * i + 1]; const float rel = sqrtf(se / fmaxf(sb, 1e-30f));
        if (!(rel < tol[i]) || !(sb > 0.f)) { int b = (rel == rel && rel > 0.f) ? (int)floorf(2.0f * log10f(fmaxf(rel, 1e-3f) / 1e-3f)) : 20; b = b < 0 ? 0 : (b > 20 ? 20 : b); cd = (float)(10 + i) * powf(10.0f, (float)(2 + b)); break; } }
    *code = cd;
}
__global__ void k_fill_code(float* out, size_t n, const float* code) { const float c = *code; for (size_t i = (size_t)blockIdx.x * blockDim.x + threadIdx.x; i < n; i += (size_t)gridDim.x * blockDim.x) out[i] = c; }
}

extern "C" void kernel_launch(void* const* d_in, const int* in_sizes, int n_in, void* d_out, int out_size, void* d_ws, size_t ws_size, hipStream_t stream) {
    using namespace nv;
    if (!mk::setup_once()) return;
    hipStream_t st = stream; float* ws = (float*)d_ws;
    const float* x = (const float*)d_in[0]; const int* pos = (const int*)d_in[1]; const float* mix_norm = (const float*)d_in[2]; const float* w_in = (const float*)d_in[3];
    const float* gla_w_up = (const float*)d_in[4]; const float* gla_b = (const float*)d_in[5]; const float* ret_gain = (const float*)d_in[6]; const float* gla_gain = (const float*)d_in[7];
    const float* w_out = (const float*)d_in[8]; const float* ffn_norm = (const float*)d_in[9]; const float* w_gate = (const float*)d_in[10]; const float* w_up = (const float*)d_in[11]; const float* w_down = (const float*)d_in[12];
#if MK_DEBUG == 1
    size_t o = 0;
    float* xn = ws + o; o += (size_t)T_ * D_; float* proj = ws + o; o += (size_t)T_ * INW; float* loga = ws + o; o += (size_t)T_ * 1024; float* ro = ws + o; o += (size_t)T_ * 2048; float* go = ws + o; o += (size_t)T_ * 2048;
    float* mixed = ws + o; o += (size_t)T_ * D_; float* xa = ws + o; o += (size_t)T_ * D_;
    mk::Args a{}; size_t need = mk::build_args(a, d_in, d_out, (unsigned char*)d_ws, o * 4, 3, 1);
    a.dbgp = (bf16_t*)((unsigned char*)d_ws + need); need += (size_t)8 * 64 * 16384 * 2; a.dbgo = (float*)((unsigned char*)d_ws + need); need += (size_t)T_ * 2048 * 4;
    if (need > ws_size) { fprintf(stderr, "dbg: ws too small %zu > %zu\n", need, ws_size); return; }
    (void)hipMemsetAsync(a.ctl, 0, mk::CTL_ZERO_BYTES, st);
    k_rmsnorm<<<T_, 256, 0, st>>>(x, mix_norm, xn);
    k_sgemm<0><<<dim3((INW + 127) / 128, T_ / 128), 256, 0, st>>>(xn, w_in, proj, nullptr, T_, INW, D_);
    k_rotary<<<(T_ * 2048) / 256, 256, 0, st>>>(proj, pos);
    k_gate<<<T_, 256, 0, st>>>(proj, gla_w_up, gla_b, loga);
    k_recur<0><<<dim3(16, 8), 256, 0, st>>>(proj, O_RQ, O_RK, O_RV, 256, nullptr, 1.0f, 1.0f / 16.0f, ro, 2048);
    k_recur<1><<<dim3(32, 4), 256, 0, st>>>(proj, O_GQ, O_GK, O_GV, 512, loga, 1.0f / 16.0f, 1.0f, go, 2048);
    k_headnorm<<<T_, 256, 0, st>>>(proj, ro, go, ret_gain, gla_gain, mixed);
    k_sgemm<1><<<dim3(D_ / 128, T_ / 128), 256, 0, st>>>(mixed, w_out, xa, x, T_, D_, D_);
    float* slots = (float*)(a.ctl + mk::CW_CHK); float* tol = slots + 128; float* code = slots + 256;
#if MK_DBG_ONELAUNCH
    mk::launch_range(a, 0, 7, st);
#else
    for (int p = 0; p < 4; ++p) mk::launch_range(a, p, p + 1, st);
    dbg::k_cmp_kv<<<dim3(64, 8), 256, 0, st>>>(a.kr, 2048, a.vrt, a.kvr, 256, slots + 2 * 15);
    dbg::k_cmp_kv<<<dim3(64, 4), 256, 0, st>>>(a.kg, 1024, a.vgt, a.kvg, 512, slots + 2 * 16);
    mk::launch_range(a, 4, 5, st);
    dbg::k_cmp_s<<<dim3(256, 8), 256, 0, st>>>(a.kr, 2048, a.vrt, a.kvr, nullptr, 256, slots + 2 * 17);
    dbg::k_cmp_s<<<dim3(512, 4), 256, 0, st>>>(a.kg, 1024, a.vgt, a.kvg, a.lam, 512, slots + 2 * 18);
    mk::launch_range(a, 5, 6, st); mk::launch_range(a, 6, 7, st);
#endif
    const float* ss0 = (const float*)(a.ctl + mk::CW_SS); const float* ss1 = ss0 + T_;
    int n = 0; float htol[64];
    dim3 cg(2048), cb(256);
    dbg::k_cmp_ss<<<T_, 256, 0, st>>>(ss0, x, D_, slots + 2 * n); htol[n++] = 1e-4f;
    dbg::k_cmp_bf16<<<cg, cb, 0, st>>>(a.qr, 2048, 0, proj, INW, O_RQ, T_, 2048, 2, 1.0f, slots + 2 * n); htol[n++] = 1e-2f;
    dbg::k_cmp_bf16<<<cg, cb, 0, st>>>(a.kr, 2048, 0, proj, INW, O_RK, T_, 2048, 3, 1.0f, slots + 2 * n); htol[n++] = 1e-2f;
    dbg::k_cmp_bf16<<<cg, cb, 0, st>>>(a.vrt, T_, 1, proj, INW, O_RV, T_, 2048, 0, 1.0f, slots + 2 * n); htol[n++] = 1e-2f;
    dbg::k_cmp_bf16<<<cg, cb, 0, st>>>(a.srg, 2048, 0, proj, INW, O_RG, T_, 2048, 1, 1.0f, slots + 2 * n); htol[n++] = 1e-2f;
    dbg::k_cmp_bf16<<<cg, cb, 0, st>>>(a.gq, 1024, 0, proj, INW, O_GQ, T_, 1024, 0, 0.0625f, slots + 2 * n); htol[n++] = 1e-2f;
    dbg::k_cmp_bf16<<<cg, cb, 0, st>>>(a.gk, 1024, 0, proj, INW, O_GK, T_, 1024, 0, 1.0f, slots + 2 * n); htol[n++] = 1e-2f;
    dbg::k_cmp_bf16<<<cg, cb, 0, st>>>(a.vgt, T_, 1, proj, INW, O_GV, T_, 2048, 0, 1.0f, slots + 2 * n); htol[n++] = 1e-2f;
    dbg::k_cmp_bf16<<<cg, cb, 0, st>>>(a.sgg, 2048, 0, proj, INW, O_GG, T_, 2048, 1, 1.0f, slots + 2 * n); htol[n++] = 1e-2f;
    dbg::k_cmp_f32<<<cg, cb, 0, st>>>(a.ga, 16, proj, INW, O_GA, T_, 16, slots + 2 * n); htol[n++] = 1e-2f;
    dbg::k_cmp_tr<<<cg, cb, 0, st>>>(a.kr, 2048, a.krt, T_, T_, 2048, slots + 2 * n); htol[n++] = 1e-6f;
    dbg::k_cmp_gla<<<dim3(64, 4), 256, 0, st>>>(a.qg, a.kg, a.lam, proj, loga, slots + 2 * n, slots + 2 * (n + 1), slots + 2 * (n + 2)); htol[n++] = 2e-2f; htol[n++] = 2e-2f; htol[n++] = 2e-2f;
    dbg::k_cmp_tr<<<cg, cb, 0, st>>>(a.kg, 1024, a.kgt, T_, T_, 1024, slots + 2 * n); htol[n++] = 1e-6f;
#if MK_DBG_ONELAUNCH
    for (int i = 0; i < 4; ++i) { unsigned one = 0x3f800000u; (void)hipMemsetD32Async((hipDeviceptr_t)(slots + 2 * (15 + i) + 1), (int)one, 1, st); }
#endif
    htol[n++] = 1e-2f; htol[n++] = 1e-2f; htol[n++] = 1e-2f; htol[n++] = 1e-2f;
    dbg::k_cmp_p<<<dim3(64, 8), 256, 0, st>>>(a.qr, a.kr, a.dbgp, slots + 2 * n); htol[n++] = 1e-2f; htol[n++] = 1e-2f; htol[n++] = 1e-2f; htol[n++] = 1e-2f;
    dbg::k_cmp_o<<<dim3(T_, 8), 256, 0, st>>>(a.qr, a.dbgp, a.vrt, a.kvr, a.dbgo, slots + 2 * n); htol[n++] = 1e-2f;
    dbg::k_cmp_bf16<<<cg, cb, 0, st>>>(a.mixed, 4096, 0, mixed, D_, 0, T_, 2048, 0, 1.0f, slots + 2 * n); htol[n++] = 3e-2f;
    dbg::k_cmp_bf16<<<cg, cb, 0, st>>>(a.mixed + 2048, 4096, 0, mixed, D_, 2048, T_, 2048, 0, 1.0f, slots + 2 * n); htol[n++] = 3e-2f;
    dbg::k_cmp_f32<<<cg, cb, 0, st>>>((const float*)d_out, D_, xa, D_, 0, T_, D_, slots + 2 * n); htol[n++] = 1e-2f;
    dbg::k_cmp_bf16<<<cg, cb, 0, st>>>(a.xb, 4096, 0, xa, D_, 0, T_, D_, 0, 1.0f, slots + 2 * n); htol[n++] = 1e-2f;
    dbg::k_cmp_ss<<<T_, 256, 0, st>>>(ss1, xa, D_, slots + 2 * n); htol[n++] = 1e-2f;
#else
    size_t o = 0;
    float* xn = ws + o; o += (size_t)T_ * D_; float* xa = ws + o; o += (size_t)T_ * D_; float* xb2 = ws + o; o += (size_t)T_ * D_; float* G = ws + o; o += (size_t)T_ * FF_;
    mk::Args a{}; const size_t need = mk::build_args(a, d_in, d_out, (unsigned char*)d_ws, o * 4, 12, 1);
    if (need > ws_size) { fprintf(stderr, "dbg: ws too small %zu > %zu\n", need, ws_size); return; }
    (void)hipMemsetAsync(a.ctl, 0, mk::CTL_ZERO_BYTES, st);
    (void)hipMemcpyAsync(xa, x, (size_t)T_ * D_ * 4, hipMemcpyDeviceToDevice, st);
    (void)hipMemcpyAsync(d_out, x, (size_t)T_ * D_ * 4, hipMemcpyDeviceToDevice, st);
    k_rmsnorm<<<T_, 256, 0, st>>>(xa, ffn_norm, xn);
    k_sgemm<0><<<dim3(FF_ / 128, T_ / 128), 256, 0, st>>>(xn, w_gate, G, nullptr, T_, FF_, D_);
    k_sgemm<2><<<dim3(FF_ / 128, T_ / 128), 256, 0, st>>>(xn, w_up, G, nullptr, T_, FF_, D_);
    k_sgemm<1><<<dim3(D_ / 128, T_ / 128), 256, 0, st>>>(G, w_down, xb2, xa, T_, D_, FF_);
    mk::launch_range(a, 0, 1, st);
    (void)hipMemcpyAsync((float*)(a.ctl + mk::CW_SS) + T_, (float*)(a.ctl + mk::CW_SS), (size_t)T_ * 4, hipMemcpyDeviceToDevice, st);
#if MK_DBG_ONELAUNCH
    mk::launch_range(a, 7, 9, st);
#else
    mk::launch_range(a, 7, 8, st); mk::launch_range(a, 8, 9, st);
#endif
    float* slots = (float*)(a.ctl + mk::CW_CHK); float* tol = slots + 128; float* code = slots + 256;
    const float* ss2 = (const float*)(a.ctl + mk::CW_SS) + 2 * T_;
    int n = 0; float htol[64]; dim3 cg(2048), cb(256);
    dbg::k_cmp_bf16<<<cg, cb, 0, st>>>(a.h, FF_, 0, G, FF_, 0, T_, FF_, 0, 1.0f, slots + 2 * n); htol[n++] = 2e-2f;
    dbg::k_cmp_f32<<<cg, cb, 0, st>>>((const float*)d_out, D_, xb2, D_, 0, T_, D_, slots + 2 * n); htol[n++] = 1e-2f;
    dbg::k_cmp_bf16<<<cg, cb, 0, st>>>(a.xb, 4096, 0, xb2, D_, 0, T_, D_, 0, 1.0f, slots + 2 * n); htol[n++] = 1e-2f;
    dbg::k_cmp_ss<<<T_, 256, 0, st>>>(ss2, xb2, D_, slots + 2 * n); htol[n++] = 1e-2f;
#endif
    for (int i = 0; i < n; ++i) { unsigned bits; memcpy(&bits, &htol[i], 4); (void)hipMemsetD32Async((hipDeviceptr_t)(tol + i), (int)bits, 1, st); }
    dbg::k_decide<<<1, 64, 0, st>>>(slots, n, tol, code);
    dbg::k_fill_code<<<2048, 256, 0, st>>>((float*)d_out, (size_t)T_ * D_, code);
}
#endif

#if MK_TIMING
__global__ void k_timing_out(const unsigned* ts, float* out, size_t n, int selA, int selB) {
    auto dur = [&](int sel) { unsigned d = 0; if (sel == 0) d = ts[1] - ts[0]; else if (sel == 9) d = ts[18] - ts[17]; else d = (ts[sel + 1] - ts[sel]) + (ts[sel + 9] - ts[sel + 8]); return (float)d * 0.01f; };
    float c1 = dur(selA), c2 = 200.0f * dur(selB);
    if (selA == 99) {
        const float mhz = (float)(ts[34] - ts[32]) / (float)(ts[35] - ts[33]) * 100.0f; c1 = floorf(mhz / 50.0f + 0.5f) * 50.0f - 1000.0f; c2 = 100000.0f + floorf((float)(ts[35] - ts[33]) * 0.01f / 50.0f + 0.5f) * 50.0f; }
    for (size_t i = (size_t)blockIdx.x * blockDim.x + threadIdx.x; i < n; i += (size_t)gridDim.x * blockDim.x) out[i] = (i == 0) ? c2 : c1;
}
#endif
#if !MK_DEBUG
extern "C" void kernel_launch(void* const* d_in, const int* in_sizes, int n_in, void* d_out, int out_size, void* d_ws, size_t ws_size, hipStream_t stream) {
    if (!mk::setup_once()) return;
    mk::Args a{};
    const size_t need = mk::build_args(a, d_in, d_out, (unsigned char*)d_ws, 0, 15, 2);
    if (need > ws_size || n_in != 14) { fprintf(stderr, "mk: workspace too small (%zu > %zu) or wrong input count %d\n", need, ws_size, n_in); return; }
    (void)hipMemsetAsync(d_ws, 0, MK_SPLIT ? mk::CTL_ZERO_BYTES : mk::BAR_ZERO_BYTES, stream);
#if MK_SPLIT
    for (int p = 0; p < mk::N_PHASES; ++p) mk::launch_range(a, p, p + 1, stream);
#else
    mk::launch_range(a, 0, mk::N_PHASES, stream, false);
#endif
#if MK_TIMING
    k_timing_out<<<2048, 256, 0, stream>>>(a.ctl + mk::CW_TS, (float*)d_out, (size_t)8192 * 4096, MK_TSEL_A, MK_TSEL_B);
#endif
}
#endif
```

```cpp
#include <hip/hip_runtime.h>
#include <cstdio>
#include <cstdint>
#include <cstring>
#define MK_DEBUG 0
#define MK_SPLIT 0
#define MK_DBG_ONELAUNCH 0
#define MK_TIMING 0
namespace pg8 {
#define PG8_LAS __attribute__((address_space(3)))
typedef unsigned short bf16_t;
typedef short bf16x8 __attribute__((ext_vector_type(8)));
typedef float f32x4 __attribute__((ext_vector_type(4)));
typedef unsigned u32x4 __attribute__((ext_vector_type(4)));
constexpr int BM = 256, BK = 64, HALF = 128, HTB = HALF * BK * 2  , STAGE_BYTES = 8 * HTB, NXCD = 8, WGM = 8;

__host__ __device__ __forceinline__ int lds_byte(int r, int c) { const int st = (r >> 4) * 2 + (c >> 5), rr = r & 15, cc = c & 31, ob = rr * 64 + cc * 2; return st * 1024 + (ob ^ (((ob >> 9) & 1) << 5)); }
__host__ __device__ __forceinline__ void stage_rc(int b, int& R, int& C) { const int st = b / 1024, sb = b % 1024, swz = sb ^ (((sb >> 9) & 1) << 5); R = (st >> 1) * 16 + swz / 64; C = (st & 1) * 32 + (swz % 64) / 2; }
__host__ __device__ __forceinline__ int perm32(int rho) { const int n = rho >> 4, i = rho & 15; return 8 * (i >> 2) + 4 * n + (i & 3); }

struct Unit { int pm, pn, sw; };
struct Gemm { const bf16_t* A; const bf16_t* Bt; int K; int a_pitch, a_kstep, b_pitch, b_kstep; };

struct StaticOrder {
    int nM, nN, nwg, G, c;
    __host__ __device__ void init(int nM_, int nN_, int G_, int c_) { nM = nM_; nN = nN_; nwg = nM * nN; G = G_; c = c_; }
    __host__ __device__ bool next(int i, Unit& u) const {
        const long L = (long)i * G + c; if (L >= nwg) return false;
        int wgid = (int)L; { const int q = nwg / NXCD, r = nwg % NXCD, xcd = wgid % NXCD, off = wgid / NXCD; wgid = (xcd < r ? xcd * (q + 1) : r * (q + 1) + (xcd - r) * q) + off; }
        const int nig = WGM * nN, gid = wgid / nig, fm = gid * WGM, gsz = (nM - fm) < WGM ? (nM - fm) : WGM;
        u.pm = fm + ((wgid % nig) % gsz); u.pn = (wgid % nig) / gsz; u.sw = 0; return true;
    }
    __device__ __forceinline__ void a_ready(const Unit&) const {}
    __device__ __forceinline__ void done(const Unit&) const {}
};

#ifndef MK_EPI_NT
#define MK_EPI_NT 0
#endif
#ifndef MK_G1_PROBE
#define MK_G1_PROBE 0
#endif
#define MK_PST16(p, v) do { if (!((MK_G1_PROBE == 1 || (MK_G1_PROBE == 3 && issw_) || (MK_G1_PROBE == 4 && !issw_) || (MK_G1_PROBE == 5 && (blockIdx.x & 1))) && probe)) MK_ST16(p, v); } while (0)
#ifndef MK_EPI_LASTWT
#define MK_EPI_LASTWT 0
#endif
#if MK_EPI_NT
#define MK_ST16(p, v) __builtin_nontemporal_store((v), (u32x4*)(p))
#elif MK_EPI_LASTWT
#define MK_ST16(p, v) do { const u32x4 v_ = (v); void* const p_ = (void*)(p); if (lastu) asm volatile("global_store_dwordx4 %0, %1, off sc1\n\ts_nop 1" :: "v"(p_), "v"(v_) : "memory"); else *(u32x4*)p_ = v_; } while (0)
#else
#define MK_ST16(p, v) (*(u32x4*)(p) = (v))
#endif
#ifndef MK_VT_BLK
#define MK_VT_BLK 0
#endif

typedef __bf16 bf16x2v __attribute__((ext_vector_type(2)));
__device__ __forceinline__ unsigned cvt_pk_bf16(float lo, float hi) { bf16x2v v; v[0] = (__bf16)lo; v[1] = (__bf16)hi; return __builtin_bit_cast(unsigned, v); }
__device__ __forceinline__ u32x4 pack8(const f32x4 a, const f32x4 b) { u32x4 w; w.x = cvt_pk_bf16(a[0], a[1]); w.y = cvt_pk_bf16(a[2], a[3]); w.z = cvt_pk_bf16(b[0], b[1]); w.w = cvt_pk_bf16(b[2], b[3]); return w; }
typedef unsigned long long u64;
__device__ __forceinline__ u64 ss_fix(float sq) { return (u64)(sq * 1048576.0f + 0.5f); }
__device__ __forceinline__ float rs_of(u64 ss) { return __builtin_amdgcn_rsqf((float)ss * (1.0f / (1048576.0f * 4096.0f)) + 1e-6f); }
__device__ __forceinline__ float silu1f(float v) { return v * __builtin_amdgcn_rcpf(1.0f + __builtin_amdgcn_exp2f(-1.44269504f * v)); }
__device__ __forceinline__ f32x4 silu4(const f32x4 v) { f32x4 o; o[0] = silu1f(v[0]); o[1] = silu1f(v[1]); o[2] = silu1f(v[2]); o[3] = silu1f(v[3]); return o; }

constexpr int TT = 8192;

struct EpiProj {
    static constexpr bool PERM = true, AFTER_DRAIN = false;
    const u64* ss;
    const int* pos;
    bf16_t *qr, *kr, *vrt, *srg, *gq, *gk, *vgt, *sgg;
    int probe;
    __device__ __forceinline__ void operator()(const f32x4 (&acc)[2][2][4][2], const Unit& u, int wr, int wc, int fr_, int fq_, bool lastu = false) const {
        int fr = fr_, fq = fq_; asm volatile("" : "+v"(fr), "+v"(fq));
        int pn = u.pn; asm volatile("" : "+s"(pn));
        const bool issw_ = (pn >= 16 && pn < 24) || (pn >= 40 && pn < 48); (void)issw_;
        if (issw_) {
#if MK_VT_BLK
            bf16_t* dst = ((pn < 24) ? vrt + (size_t)(pn - 16) * 65536 : vgt + (size_t)(pn - 40) * 65536) + (size_t)u.pm * (2048 * 256) + (wc * 32 + 8 * fq);
#else
            bf16_t* dst = (pn < 24) ? vrt + (size_t)(pn - 16) * 256 * TT : vgt + (size_t)(pn - 40) * 256 * TT;
#endif
            const int tc0 = u.pm * BM + wc * 32 + 8 * fq;
            f32x4 rs[2][2];
#pragma unroll
            for (int bj = 0; bj < 2; ++bj)
#pragma unroll
                for (int n = 0; n < 2; ++n) { const u64* sp = ss + tc0 + bj * HALF + 4 * n; rs[bj][n] = (f32x4){rs_of(sp[0]), rs_of(sp[1]), rs_of(sp[2]), rs_of(sp[3])}; }
#pragma unroll
            for (int ai = 0; ai < 2; ++ai)
#pragma unroll
                for (int m = 0; m < 4; ++m) {
#if MK_VT_BLK
                    bf16_t* rowp = dst + (ai * HALF + wr * 64 + m * 16 + fr) * 256;
#else
                    bf16_t* rowp = dst + (size_t)(ai * HALF + wr * 64 + m * 16 + fr) * TT + tc0;
#endif

#pragma unroll
                    for (int bj = 0; bj < 2; ++bj) MK_PST16(rowp + bj * HALF, pack8(acc[ai][bj][m][0] * rs[bj][0], acc[ai][bj][m][1] * rs[bj][1])); }
            return;
        }
        const int t0 = u.pm * BM + wr * 64 + fr;
        const int cl = wc * 32 + 8 * fq;
        if (pn < 16) {
            const int h = pn & 7; const bool isk = pn >= 8; bf16_t* dst = (isk ? kr : qr) + h * 256;
            const float lg = log2f(1.0f - exp2f(-5.0f - (float)h));
            float invf[2][4];
#pragma unroll
            for (int n = 0; n < 2; ++n)
#pragma unroll
                for (int j = 0; j < 4; ++j) invf[n][j] = exp2f(-(float)(cl + 4 * n + j) * (13.287712379549449f / 128.0f));
            u64 ssv[2][4]; int pv[2][4];
#pragma unroll
            for (int ai = 0; ai < 2; ++ai)
#pragma unroll
                for (int m = 0; m < 4; ++m) { ssv[ai][m] = ss[t0 + ai * HALF + m * 16]; pv[ai][m] = pos[t0 + ai * HALF + m * 16]; }
            asm volatile("" ::: "memory");
#pragma unroll
            for (int ai = 0; ai < 2; ++ai)
#pragma unroll
                for (int m = 0; m < 4; ++m) { const int t = t0 + ai * HALF + m * 16; const float ip1 = (float)((t & 255) + 1); const float posf = (float)pv[ai][m];
                    const float sc = rs_of(ssv[ai][m]) * (isk ? exp2f(-ip1 * lg) * 0.0625f : exp2f(ip1 * lg));
                    f32x4 o1[2], o2[2];
#pragma unroll
                    for (int n = 0; n < 2; ++n) { f32x4 c4, s4;
#pragma unroll
                        for (int j = 0; j < 4; ++j) { const float fr = __builtin_amdgcn_fractf((posf * invf[n][j]) * 0.15915494309189535f); if (MK_G1_PROBE == 2 && probe) { c4[j] = 1.0f; s4[j] = fr; } else { c4[j] = __builtin_amdgcn_cosf(fr); s4[j] = __builtin_amdgcn_sinf(fr); } }
                        const f32x4 a = acc[ai][0][m][n], b = acc[ai][1][m][n]; o1[n] = (a * c4 - b * s4) * sc; o2[n] = (a * s4 + b * c4) * sc; }
                    bf16_t* rowp = dst + (size_t)t * 2048 + cl;
                    MK_PST16(rowp, pack8(o1[0], o1[1])); MK_PST16(rowp + HALF, pack8(o2[0], o2[1])); }
            return;
        }
        bf16_t* dst; int ld; float sc = 1.0f; bool act = false;
        if (pn < 32) { dst = srg + (pn - 24) * 256; ld = 2048; act = true; }
        else if (pn < 36) { dst = gq + (pn - 32) * 256; ld = 1024; sc = 0.0625f; }
        else if (pn < 40) { dst = gk + (pn - 36) * 256; ld = 1024; }
        else { dst = sgg + (pn - 48) * 256; ld = 2048; act = true; }
        u64 ssv[2][4];
#pragma unroll
        for (int ai = 0; ai < 2; ++ai)
#pragma unroll
            for (int m = 0; m < 4; ++m) ssv[ai][m] = ss[t0 + ai * HALF + m * 16];
        asm volatile("" ::: "memory");
#pragma unroll
        for (int ai = 0; ai < 2; ++ai)
#pragma unroll
            for (int m = 0; m < 4; ++m) { const int t = t0 + ai * HALF + m * 16; const float s = rs_of(ssv[ai][m]) * sc; bf16_t* rowp = dst + (size_t)t * ld + cl;
#pragma unroll
                for (int bj = 0; bj < 2; ++bj) { f32x4 v0 = acc[ai][bj][m][0] * s, v1 = acc[ai][bj][m][1] * s; if (act && !(MK_G1_PROBE == 2 && probe)) { v0 = silu4(v0); v1 = silu4(v1); }
                    MK_PST16(rowp + bj * HALF, pack8(v0, v1)); } }
    }
};

struct EpiRes {
    static constexpr bool PERM = true, AFTER_DRAIN = false;
    bf16_t* xb; u64* ssout; u64* dup;
    __device__ __forceinline__ void operator()(const f32x4 (&acc)[2][2][4][2], const Unit& u, int wr, int wc, int fr_, int fq_, bool lastu = false) const {
        int fr = fr_, fq = fq_; asm volatile("" : "+v"(fr), "+v"(fq));
        const int t0 = u.pm * BM + wr * 64 + fr, c0 = u.pn * BM + wc * 32 + 8 * fq;
        u32x4 xi[2][4][2];
#pragma unroll
        for (int ai = 0; ai < 2; ++ai)
#pragma unroll
            for (int m = 0; m < 4; ++m)
#pragma unroll
                for (int bj = 0; bj < 2; ++bj) xi[ai][m][bj] = *(const u32x4*)(xb + (size_t)(t0 + ai * HALF + m * 16) * 4096 + c0 + bj * HALF);
        asm volatile("" ::: "memory");
#pragma unroll
        for (int ai = 0; ai < 2; ++ai) {
#pragma unroll
            for (int m = 0; m < 4; ++m) { const int t = t0 + ai * HALF + m * 16; bf16_t* rowp = xb + (size_t)t * 4096 + c0; float sq = 0.f;
#pragma unroll
                for (int bj = 0; bj < 2; ++bj) { const u32x4 x = xi[ai][m][bj];
                    f32x4 o0 = acc[ai][bj][m][0], o1 = acc[ai][bj][m][1];
                    o0[0] += __uint_as_float(x.x << 16); o0[1] += __uint_as_float(x.x & 0xffff0000u); o0[2] += __uint_as_float(x.y << 16); o0[3] += __uint_as_float(x.y & 0xffff0000u);
                    o1[0] += __uint_as_float(x.z << 16); o1[1] += __uint_as_float(x.z & 0xffff0000u); o1[2] += __uint_as_float(x.w << 16); o1[3] += __uint_as_float(x.w & 0xffff0000u);
                    sq += ((o0[0] * o0[0] + o0[1] * o0[1]) + (o0[2] * o0[2] + o0[3] * o0[3])) + ((o1[0] * o1[0] + o1[1] * o1[1]) + (o1[2] * o1[2] + o1[3] * o1[3]));
                    MK_ST16(rowp + bj * HALF, pack8(o0, o1)); }
                sq += __shfl_xor(sq, 16); sq += __shfl_xor(sq, 32);
                if (fq == 0) atomicAdd(ssout + t, ss_fix(sq));
#ifdef MK_DUP_ATOMICS
                if (fq == 0) atomicAdd(dup + t, ss_fix(sq));
#endif
                } }
    }
};

struct EpiSwiGLU {
    static constexpr bool PERM = true, AFTER_DRAIN = false;
    const u64* ss; bf16_t* h;
    __device__ __forceinline__ void operator()(const f32x4 (&acc)[2][2][4][2], const Unit& u, int wr, int wc, int fr_, int fq_, bool lastu = false) const {
        int fr = fr_, fq = fq_; asm volatile("" : "+v"(fr), "+v"(fq));
        const int t0 = u.pm * BM + wr * 64 + fr, c0 = u.pn * HALF + wc * 32 + 8 * fq;
        u64 ssv[2][4];
#pragma unroll
        for (int ai = 0; ai < 2; ++ai)
#pragma unroll
            for (int m = 0; m < 4; ++m) ssv[ai][m] = ss[t0 + ai * HALF + m * 16];
        asm volatile("" ::: "memory");
#pragma unroll
        for (int ai = 0; ai < 2; ++ai)
#pragma unroll
            for (int m = 0; m < 4; ++m) { const int t = t0 + ai * HALF + m * 16; const float s = rs_of(ssv[ai][m]); f32x4 o[2];
#pragma unroll
                for (int n = 0; n < 2; ++n) { const f32x4 g = silu4(acc[ai][0][m][n] * s), uu = acc[ai][1][m][n] * s; o[n] = g * uu; }
                MK_ST16(h + ((size_t)(c0 >> 6) * TT + t) * 64 + (c0 & 63), pack8(o[0], o[1])); }
    }
};
struct ProjOrder : StaticOrder {
    __host__ __device__ bool next(int i, Unit& u) const { if (!StaticOrder::next(i, u)) return false; u.sw = ((u.pn >= 16 && u.pn < 24) || (u.pn >= 40 && u.pn < 48)) ? 1 : 0; return true; }
};
template <class Epi, class Sched, bool ALIGN_EPI = false, bool SP2 = false>
__device__ __forceinline__ void gemm_phase(PG8_LAS unsigned char* lds, const Gemm g, const Sched& S, const Epi& E, int tid_in) {
    int tid = tid_in; asm volatile("" : "+v"(tid));
    const int wid = __builtin_amdgcn_readfirstlane(tid >> 6), lane = tid & 63, wr = wid >> 2, wc = wid & 3, fr = lane & 15, fq = lane >> 4;
    const int K = g.K, nt = K / BK;
    unsigned voffA[2], voffB[2];
#pragma unroll
    for (int i = 0; i < 2; ++i) { int R, C; stage_rc(tid * 16 + i * 8192, R, C); const int Rb = Epi::PERM ? ((R & ~31) + perm32(R & 31)) : R;
        voffA[i] = (unsigned)(R * g.a_pitch + C * 2); voffB[i] = (unsigned)(Rb * g.b_pitch + C * 2); }
    const size_t kstep = (size_t)g.b_kstep, kstepA = (size_t)g.a_kstep;
    const size_t hstep = (size_t)HALF * g.b_pitch, hstepA = (size_t)HALF * g.a_pitch;
    const size_t tstep = 2 * hstep, tstepA = 2 * hstepA;
    const unsigned ldsw = (unsigned)wid * 1024u;
    const int aoff = lds_byte(wr * 64 + fr, fq * 8), boff = lds_byte(wc * 32 + fr, fq * 8);
#define PG8_SA(b, h) (((b) * 2 + (h)) * HTB)
#define PG8_SB(b, h) ((4 + (b) * 2 + (h)) * HTB)
#define PG8_STAGE(bufoff, gbase, voff) do { _Pragma("unroll") for (int _i = 0; _i < 2; ++_i) \
        __builtin_amdgcn_global_load_lds((const unsigned*)((const char*)(gbase) + (voff)[_i]), (PG8_LAS unsigned*)(lds + (bufoff) + ldsw + _i * 8192), 16, 0, 0); } while (0)
#define PG8_LDA(dst, b, h) do { _Pragma("unroll") for (int m = 0; m < 4; ++m) _Pragma("unroll") for (int k = 0; k < 2; ++k) dst[m][k] = *(const PG8_LAS bf16x8*)(lds + PG8_SA(b, h) + aoff + m * 2048 + k * 1024); } while (0)
#define PG8_LDB(dst, b, h) do { _Pragma("unroll") for (int n = 0; n < 2; ++n) _Pragma("unroll") for (int k = 0; k < 2; ++k) dst[n][k] = *(const PG8_LAS bf16x8*)(lds + PG8_SB(b, h) + boff + n * 2048 + k * 1024); } while (0)
#define PG8_MMA(ai, bj, At, Bt) do { __builtin_amdgcn_s_setprio(1); _Pragma("unroll") for (int m = 0; m < 4; ++m) _Pragma("unroll") for (int n = 0; n < 2; ++n) _Pragma("unroll") for (int k = 0; k < 2; ++k) \
        acc[ai][bj][m][n] = __builtin_amdgcn_mfma_f32_16x16x32_bf16(Bt[n][k], At[m][k], acc[ai][bj][m][n], 0, 0, 0); __builtin_amdgcn_s_setprio(0); } while (0)
#define PG8_WAIT_V(n) asm volatile("s_waitcnt vmcnt(" #n ")" ::: "memory")
#define PG8_WAIT_L(n) asm volatile("s_waitcnt lgkmcnt(" #n ")" ::: "memory")
#define PG8_BAR __builtin_amdgcn_s_barrier()
#define PG8_SCHED __builtin_amdgcn_sched_barrier(0)
    Unit cur, nxt; int ui = 0;
    if (!S.next(0, cur)) return;
    f32x4 acc[2][2][4][2];
#pragma unroll
    for (int a = 0; a < 2; ++a)
#pragma unroll
        for (int b = 0; b < 2; ++b)
#pragma unroll
            for (int m = 0; m < 4; ++m)
#pragma unroll
                for (int n = 0; n < 2; ++n) acc[a][b][m][n] = (f32x4){0.f, 0.f, 0.f, 0.f};
    bf16x8 At[4][2], B0[2][2], B1[2][2];
    const char* cA = cur.sw ? (const char*)g.Bt + (size_t)cur.pn * tstep : (const char*)g.A + (size_t)cur.pm * tstepA; const char* cB = cur.sw ? (const char*)g.A + (size_t)cur.pm * tstep : (const char*)g.Bt + (size_t)cur.pn * tstep;
    S.a_ready(cur);
    if constexpr (SP2) {
        PG8_STAGE(PG8_SB(0, 0), cB, voffB); PG8_STAGE(PG8_SB(0, 1), cB + hstep, voffB); PG8_STAGE(PG8_SA(0, 0), cA, voffA); PG8_STAGE(PG8_SA(0, 1), cA + hstepA, voffA);
        if (wr == 1) PG8_BAR;
        PG8_WAIT_V(2); PG8_BAR;
        PG8_STAGE(PG8_SB(1, 0), cB + kstep, voffB); PG8_STAGE(PG8_SA(1, 0), cA + kstepA, voffA); PG8_STAGE(PG8_SB(1, 1), cB + hstep + kstep, voffB);
        PG8_WAIT_V(6); PG8_BAR;
    } else {
        PG8_STAGE(PG8_SB(0, 0), cB, voffB); PG8_STAGE(PG8_SA(0, 0), cA, voffA); PG8_STAGE(PG8_SB(0, 1), cB + hstep, voffB); PG8_STAGE(PG8_SA(0, 1), cA + hstepA, voffA);
        if (wr == 1) PG8_BAR;
        PG8_WAIT_V(4); PG8_BAR;
        PG8_STAGE(PG8_SB(1, 0), cB + kstep, voffB); PG8_STAGE(PG8_SA(1, 0), cA + kstepA, voffA); PG8_STAGE(PG8_SB(1, 1), cB + hstep + kstep, voffB);
        PG8_WAIT_V(6); PG8_BAR;
    }
    for (;;) {
        const bool has_next = S.next(ui + 1, nxt);
        const char* nA = has_next ? (nxt.sw ? (const char*)g.Bt + (size_t)nxt.pn * tstep : (const char*)g.A + (size_t)nxt.pm * tstepA) : cA; const char* nB = has_next ? (nxt.sw ? (const char*)g.A + (size_t)nxt.pm * tstep : (const char*)g.Bt + (size_t)nxt.pn * tstep) : cB;
        for (int t = 0; t < nt; t += 2) {
            const bool last = (t == nt - 2);
            const char* a1 = cA + (size_t)(t + 1) * kstepA;
            const char* a2 = last ? nA : cA + (size_t)(t + 2) * kstepA; const char* b2 = last ? nB : cB + (size_t)(t + 2) * kstep;
            const char* a3 = a2 + kstepA; const char* b3 = b2 + kstep;
            if (last && has_next) S.a_ready(nxt);
            if constexpr (SP2) {
            PG8_LDB(B0, 0, 0); PG8_LDB(B1, 0, 1); PG8_SCHED; PG8_LDA(At, 0, 0); PG8_STAGE(PG8_SA(1, 1), a1 + hstepA, voffA);
            PG8_WAIT_V(8); PG8_WAIT_L(0); PG8_BAR; PG8_MMA(0, 0, At, B0); PG8_MMA(0, 1, At, B1); PG8_BAR; PG8_SCHED;
            PG8_LDA(At, 0, 1); PG8_STAGE(PG8_SB(0, 0), b2, voffB); PG8_STAGE(PG8_SB(0, 1), b2 + hstep, voffB); PG8_STAGE(PG8_SA(0, 0), a2, voffA);
            PG8_WAIT_V(8); PG8_WAIT_L(0); PG8_BAR; PG8_MMA(1, 0, At, B0); PG8_MMA(1, 1, At, B1); PG8_BAR; PG8_SCHED;
            PG8_LDB(B0, 1, 0); PG8_LDB(B1, 1, 1); PG8_SCHED; PG8_LDA(At, 1, 0); PG8_STAGE(PG8_SA(0, 1), a2 + hstepA, voffA);
            PG8_WAIT_V(8); PG8_WAIT_L(0); PG8_BAR; PG8_MMA(0, 0, At, B0); PG8_MMA(0, 1, At, B1); PG8_BAR; PG8_SCHED;
            PG8_LDA(At, 1, 1); PG8_STAGE(PG8_SB(1, 0), b3, voffB); PG8_STAGE(PG8_SB(1, 1), b3 + hstep, voffB); PG8_STAGE(PG8_SA(1, 0), a3, voffA);
            PG8_WAIT_V(8); PG8_WAIT_L(0); PG8_BAR; PG8_MMA(1, 0, At, B0); PG8_MMA(1, 1, At, B1); PG8_BAR; PG8_SCHED;
            } else {
            PG8_LDB(B0, 0, 0); PG8_SCHED; PG8_LDA(At, 0, 0); PG8_STAGE(PG8_SA(1, 1), a1 + hstepA, voffA);
            PG8_WAIT_L(8); PG8_BAR; PG8_WAIT_L(0); PG8_MMA(0, 0, At, B0); PG8_BAR; PG8_SCHED;
            PG8_LDB(B1, 0, 1); PG8_STAGE(PG8_SB(0, 0), b2, voffB);
            PG8_BAR; PG8_WAIT_L(0); PG8_MMA(0, 1, At, B1); PG8_BAR;
            PG8_LDA(At, 0, 1); PG8_STAGE(PG8_SA(0, 0), a2, voffA);
            PG8_BAR; PG8_WAIT_L(0); PG8_MMA(1, 0, At, B0); PG8_BAR; PG8_SCHED;
            PG8_STAGE(PG8_SB(0, 1), b2 + hstep, voffB);
            PG8_WAIT_V(6); PG8_BAR; PG8_MMA(1, 1, At, B1); PG8_BAR;
            PG8_LDB(B0, 1, 0); PG8_SCHED; PG8_LDA(At, 1, 0); PG8_STAGE(PG8_SA(0, 1), a2 + hstepA, voffA);
            PG8_WAIT_L(8); PG8_BAR; PG8_WAIT_L(0); PG8_MMA(0, 0, At, B0); PG8_BAR; PG8_SCHED;
            PG8_LDB(B1, 1, 1); PG8_STAGE(PG8_SB(1, 0), b3, voffB);
            PG8_BAR; PG8_WAIT_L(0); PG8_MMA(0, 1, At, B1); PG8_BAR;
            PG8_LDA(At, 1, 1); PG8_STAGE(PG8_SA(1, 0), a3, voffA);
            PG8_BAR; PG8_WAIT_L(0); PG8_MMA(1, 0, At, B0); PG8_BAR; PG8_SCHED;
            PG8_STAGE(PG8_SB(1, 1), b3 + hstep, voffB);
            PG8_WAIT_V(6); PG8_BAR; PG8_MMA(1, 1, At, B1); PG8_BAR;
            }
        }
        if constexpr (ALIGN_EPI) { if (wr == 0) PG8_BAR; }
        if constexpr (!Epi::AFTER_DRAIN) { int te_ = tid_in; asm volatile("" : "+v"(te_)); E(acc, cur, wr, wc, te_ & 15, (te_ & 63) >> 4, !has_next); S.done(cur); }
        if (!has_next) break;
#pragma unroll
        for (int a = 0; a < 2; ++a)
#pragma unroll
            for (int b = 0; b < 2; ++b)
#pragma unroll
                for (int m = 0; m < 4; ++m)
#pragma unroll
                    for (int n = 0; n < 2; ++n) acc[a][b][m][n] = (f32x4){0.f, 0.f, 0.f, 0.f};
        cur = nxt; cA = nA; cB = nB; ++ui;
        if constexpr (ALIGN_EPI) { if (wr == 1) PG8_BAR; }
    }
    PG8_WAIT_V(0);
    if constexpr (!ALIGN_EPI) { if (wr == 0) PG8_BAR; }
    PG8_BAR;
    if constexpr (Epi::AFTER_DRAIN) { E.fused(acc, cur, wr, wc, fr, fq, lds, wid, lane); S.done(cur); }
#undef PG8_SA
#undef PG8_SB
#undef PG8_STAGE
#undef PG8_LDA
#undef PG8_LDB
#undef PG8_MMA
#undef PG8_WAIT_V
#undef PG8_WAIT_L
#undef PG8_BAR
#undef PG8_SCHED
}
}

#ifndef MK_WT_STORES
#define MK_WT_STORES 1
#endif
#define GAS __attribute__((address_space(1)))
#define LAS __attribute__((address_space(3)))
typedef unsigned short bf16_t;
typedef short bf16x8 __attribute__((ext_vector_type(8)));
typedef float f32x4 __attribute__((ext_vector_type(4)));
typedef float f32x2 __attribute__((ext_vector_type(2)));
typedef unsigned u32x4 __attribute__((ext_vector_type(4)));
typedef unsigned u32x2 __attribute__((ext_vector_type(2)));
#define LDS_WAIT() asm volatile("s_waitcnt lgkmcnt(0)" ::: "memory")
#define VM_WAIT() asm volatile("s_waitcnt vmcnt(0)" ::: "memory")

namespace mk {
using pg8::cvt_pk_bf16; using pg8::pack8; using pg8::rs_of; using pg8::u64; using pg8::ss_fix;
constexpr int T = 8192, D = 4096, INW = 14352, NPROJ = 14336, FF = 11008;
constexpr int NWAVES = 8, NTHR = 512;
constexpr int LDS_BYTES = 147456;
constexpr int LDSCTL_OFF = 140 * 1024;
constexpr int CW_TMO = 0, CW_BAR = 0  , CW_SS = 8192  , CW_CHK = 98304  , CW_TS = 96000  ;
constexpr size_t CTL_ZERO_BYTES = 512 * 1024, BAR_ZERO_BYTES = 16384;
constexpr int N_PHASES = 18;

struct Args {
    const float* x; const int* pos; const float* mix_norm; const float* w_in; const float* gla_w_up; const float* gla_b; const float* ret_gain; const float* gla_gain;
    const float* w_out; const float* ffn_norm; const float* w_gate; const float* w_up; const float* w_down; const float* final_norm;
    float* out; unsigned* ctl;
    bf16_t* win_t[2]; bf16_t* wga_t[2]; bf16_t* wout_t[2]; bf16_t* wgu_t[2]; bf16_t* wd_t[2];
    bf16_t* xb; float* rot; float* ga; float* lam;
    bf16_t *qr, *kr, *krt, *vrt, *srg, *gq, *gk, *qg, *kg, *kgt, *vgt, *sgg, *kvr, *kvg, *mixed, *h;
    bf16_t* dbgp; float* dbgo;
    int ph_lo, ph_hi, cvt_mask, cvt_layers;
};

__device__ __forceinline__ void st16_wt(void* p, u32x4 v) {
#if MK_WT_STORES
    asm volatile("global_store_dwordx4 %0, %1, off sc1\n\ts_nop 1" :: "v"(p), "v"(v) : "memory");
#else
    *(u32x4*)p = v;
#endif
}
__device__ __forceinline__ float wave_sum(float v) {
#pragma unroll
    for (int o = 1; o < 64; o <<= 1) v += __shfl_xor(v, o);
    return v;
}
__device__ __forceinline__ float bf_lo(unsigned w) { return __uint_as_float(w << 16); }
__device__ __forceinline__ float bf_hi(unsigned w) { return __uint_as_float(w & 0xffff0000u); }
__device__ __forceinline__ float silu1(float v) { return v / (1.0f + __expf(-v)); }

#define XB_TMO      128
#define XB_XCNT(j)  (256  + 64 * (j))
#define XB_XSUB(j)  (1280 + 64 * (j))
#define XB_XGEN(j)  (2304 + 64 * (j))
#define XB_TOP      3328
#define XB_TOPGEN   3392
#define XCD_BAR_WORDS 3456
#define XB_SPIN_CAP (1u << 18)

__device__ __forceinline__ unsigned xb_ld(unsigned* p)              { return __hip_atomic_load(p, __ATOMIC_RELAXED, __HIP_MEMORY_SCOPE_AGENT); }
__device__ __forceinline__ unsigned xb_add(unsigned* p, unsigned v) { return __hip_atomic_fetch_add(p, v, __ATOMIC_RELAXED, __HIP_MEMORY_SCOPE_AGENT); }
__device__ __forceinline__ unsigned xb_xcc_id() { return (unsigned)__builtin_amdgcn_s_getreg((3 << 11) | 20) & 0xFu; }
#define XB_SPIN(cond, bar) do { unsigned _sp = 0; while (cond) { __builtin_amdgcn_s_sleep(1); \
    if ((++_sp & 255u) == 0u) { if (xb_ld(&(bar)[XB_TMO])) break; if (_sp > XB_SPIN_CAP) { atomicAdd(&(bar)[XB_TMO], 1u); break; } } } } while (0)

struct XcdBarrier {
    unsigned* bar; unsigned x;
    volatile LAS unsigned* st;
    unsigned leader;
};

__device__ __forceinline__ XcdBarrier xcd_barrier_post(unsigned* bar, volatile LAS unsigned* st) {
    XcdBarrier b; b.bar = bar; b.x = xb_xcc_id(); b.st = st; b.leader = (threadIdx.x == 0) ? 1u : 0u;
    if (threadIdx.x == 0) (void)xb_add(&bar[XB_XCNT(b.x)], 1u);
    return b;
}
__device__ __forceinline__ void xcd_barrier_complete(unsigned* bar, unsigned x, unsigned& nloc, unsigned& nx) {
    const unsigned G = gridDim.x * gridDim.y * gridDim.z;
    unsigned sum, cnt, mine, sp = 0u;
    for (;;) {
        sum = 0u; cnt = 0u; mine = 0u;
#pragma unroll
        for (unsigned j = 0; j < 16; ++j) { const unsigned c = xb_ld(&bar[XB_XCNT(j)]); sum += c; cnt += (c > 0u) ? 1u : 0u; mine = (j == x) ? c : mine; }
        if (sum == G) break;
        __builtin_amdgcn_s_sleep(1);
        if ((++sp & 255u) == 0u) { if (xb_ld(&bar[XB_TMO])) break; if (sp > XB_SPIN_CAP) { atomicAdd(&bar[XB_TMO], 1u); break; } }
    }
    nloc = mine > 0u ? mine : 1u; nx = cnt > 0u ? cnt : 1u;
}

__device__ __forceinline__ void xcd_barrier(const XcdBarrier& b) {
    asm volatile("s_waitcnt vmcnt(0)" ::: "memory");
    __syncthreads();
    if (b.leader) {
        unsigned* bar = b.bar;
        __builtin_amdgcn_s_waitcnt(0);
        unsigned nloc = b.st[0], nx = b.st[1];
        if (nloc == 0u) { xcd_barrier_complete(bar, b.x, nloc, nx); b.st[0] = nloc; b.st[1] = nx; }
        const unsigned old = xb_add(&bar[XB_XSUB(b.x)], 1u);
        const unsigned gen = old / nloc;
        if (old + 1u == (gen + 1u) * nloc) {
            __builtin_amdgcn_fence(__ATOMIC_RELEASE, "agent");
            asm volatile("s_waitcnt vmcnt(0)" ::: "memory");
            const unsigned og = xb_add(&bar[XB_TOP], 1u);
            const unsigned tg = og / nx;
            if (og + 1u == (tg + 1u) * nx) xb_add(&bar[XB_TOPGEN], 1u);
            else XB_SPIN(xb_ld(&bar[XB_TOPGEN]) == tg, bar);
            __builtin_amdgcn_fence(__ATOMIC_ACQUIRE, "agent");
            xb_add(&bar[XB_XGEN(b.x)], 1u);
            asm volatile("s_waitcnt vmcnt(0)" ::: "memory");
        } else {
            XB_SPIN(xb_ld(&bar[XB_XGEN(b.x)]) == gen, bar);
            __builtin_amdgcn_fence(__ATOMIC_ACQUIRE, "agent");
            asm volatile("s_waitcnt vmcnt(0)" ::: "memory");
        }
    }
    __syncthreads();
}

#ifndef MK_M3_RDG
#define MK_M3_RDG 4
#endif
#ifndef MK_M3_RDR
#define MK_M3_RDR 6
#endif
#ifndef MK_M3_EPI
#define MK_M3_EPI 2
#endif
#ifndef MK_M1V2
#define MK_M1V2 1
#endif
#ifndef MK_M3_UNPAIR
#define MK_M3_UNPAIR 0
#endif
#ifndef MK_M3_PROBE
#define MK_M3_PROBE 0
#endif
#ifndef MK_M3_WT
#define MK_M3_WT 1
#endif
#ifndef MK_M3_NTST
#define MK_M3_NTST 0
#endif
#ifndef MK_M3_FLIP
#define MK_M3_FLIP 0
#endif
#ifndef MK_M3_GEARLY
#define MK_M3_GEARLY 0
#endif
#ifndef MK_M3_DEFER
#define MK_M3_DEFER 0
#endif
#ifndef MK_M2_WT
#define MK_M2_WT 1
#endif
#ifndef MK_MIX_WT
#define MK_MIX_WT 0
#endif
#ifndef MK_FIN_NT
#define MK_FIN_NT 1
#endif
#ifndef MK_XB_WT
#define MK_XB_WT 1
#endif
#ifndef MK_P0_TEST
#define MK_P0_TEST 0
#endif
#ifndef MK_NT
#define MK_NT 0
#endif
#if MK_NT
#define MK_NTLD(p) __builtin_nontemporal_load(p)
#else
#define MK_NTLD(p) (*(p))
#endif
#ifndef MK_BLK_WIN
#define MK_BLK_WIN 0
#endif
#ifndef MK_BLK_W
#define MK_BLK_W 0
#endif
struct CvtItem { const float* W; const float* gain; bf16_t* WT; size_t dst_row0; int ldn, K, k0, n0, valid, nblk; };
template <class AT> __device__ __forceinline__ CvtItem cvt_decode(const AT& a, int it, int nitems) {
    constexpr int I_IN = 64 * 224, I_OUT = 64 * 64, I_G = 64 * 172, I_D = 172 * 64, I_LAYER = I_IN + I_OUT + 2 * I_G + I_D;
    CvtItem c; c.valid = 0; c.W = nullptr; c.gain = nullptr; c.WT = nullptr; c.dst_row0 = 0; c.ldn = 0; c.K = 0; c.k0 = 0; c.n0 = 0; c.nblk = 0;
    if (it >= nitems) return c;
    const int l = it / I_LAYER; int r = it - l * I_LAYER;
#define CVT_KN(r_, NB_) const int kin_ = (r_) & 3, blk_ = (r_) >> 2, nb = blk_ % (NB_), kb = (blk_ / (NB_)) * 4 + kin_
    if (r < I_IN) { if (a.cvt_mask & 1) { CVT_KN(r, 224); c = CvtItem{a.w_in + (size_t)l * D * INW, a.mix_norm + l * D, a.win_t[l], (size_t)(64 * nb), INW, D, 64 * kb, 64 * nb, 1, MK_BLK_WIN ? NPROJ : 0}; } return c; } r -= I_IN;
    if (r < I_OUT) { if (a.cvt_mask & 2) { CVT_KN(r, 64); c = CvtItem{a.w_out + (size_t)l * D * D, (kb < 32 ? a.ret_gain + l * 2048 : a.gla_gain + l * 2048 - 2048)  , a.wout_t[l], (size_t)(64 * nb), D, D, 64 * kb, 64 * nb, 1, MK_BLK_W ? D : 0}; } return c; } r -= I_OUT;
    if (r < 2 * I_G) { if (a.cvt_mask & 4) { const int up = r >= I_G ? 1 : 0; r -= up * I_G; CVT_KN(r, 172); const int n0 = 64 * nb;
        c = CvtItem{(up ? a.w_up : a.w_gate) + (size_t)l * D * FF, a.ffn_norm + l * D, a.wgu_t[l], (size_t)((n0 >> 7) * 256 + up * 128 + (n0 & 127)), FF, D, 64 * kb, n0, 1, MK_BLK_W ? 2 * FF : 0}; } return c; } r -= 2 * I_G;
    if (a.cvt_mask & 8) { CVT_KN(r, 64); c = CvtItem{a.w_down + (size_t)l * FF * D, nullptr, a.wd_t[l], (size_t)(64 * nb), D, FF, 64 * kb, 64 * nb, 1, MK_BLK_W ? D : 0}; }
#undef CVT_KN
    return c;
}
__device__ __forceinline__ const char* uni_ptr(const char* p) { const unsigned long long x = (unsigned long long)p; const unsigned lo = __builtin_amdgcn_readfirstlane((unsigned)x), hi = __builtin_amdgcn_readfirstlane((unsigned)(x >> 32)); return (const char*)(((unsigned long long)hi << 32) | lo); }
__device__ __forceinline__ void cvt_issue(const CvtItem& c, f32x4 (&v)[16], float (&g)[16], int lane) {
    const int kr = lane >> 4, c4 = (lane & 15) * 4;
    if (c.valid) {
        const char* wb = (const char*)(c.W + (size_t)c.k0 * c.ldn + c.n0); const unsigned vo = (unsigned)((kr * c.ldn + c4) * 4), rstep = (unsigned)(4 * c.ldn * 4);
#pragma unroll
        for (int i = 0; i < 16; ++i) { v[i] = __builtin_nontemporal_load((const f32x4*)(uni_ptr(wb + (size_t)i * rstep) + vo)); g[i] = c.gain ? c.gain[c.k0 + 4 * i + kr] : 1.0f; } }
}
__device__ __forceinline__ void cvt_to_lds(const f32x4 (&v)[16], const float (&g)[16], LAS float* scr, int lane) {
    const int kr = lane >> 4, c4 = (lane & 15) * 4;
#pragma unroll
    for (int i = 0; i < 16; ++i) { LAS float* p = scr + (4 * i + kr) * 65 + c4; p[0] = v[i][0] * g[i]; p[1] = v[i][1] * g[i]; p[2] = v[i][2] * g[i]; p[3] = v[i][3] * g[i]; }
    LDS_WAIT(); asm volatile("" ::: "memory");
}
__device__ __forceinline__ void cvt_store(const CvtItem& c, LAS float* scr, int lane) {
    const int cc = lane >> 3, nn = lane & 7;
#pragma unroll
    for (int j = 0; j < 8; ++j) { const int n = nn + 8 * j; const LAS float* s = scr + (8 * cc) * 65 + n;
        u32x4 o; o.x = cvt_pk_bf16(s[0 * 65], s[1 * 65]); o.y = cvt_pk_bf16(s[2 * 65], s[3 * 65]); o.z = cvt_pk_bf16(s[4 * 65], s[5 * 65]); o.w = cvt_pk_bf16(s[6 * 65], s[7 * 65]);
        char* dp = c.nblk ? (char*)(c.WT + ((size_t)(c.k0 >> 6) * c.nblk + c.dst_row0 + n) * 64 + 8 * cc)
                          : (char*)uni_ptr((const char*)(c.WT + (c.dst_row0 + 8 * j) * (size_t)c.K + c.k0)) + (unsigned)((nn * c.K + 8 * cc) * 2);
        __builtin_nontemporal_store(o, (u32x4*)dp); }
    LDS_WAIT(); asm volatile("" ::: "memory");
}
template <class AT> __device__ __forceinline__ void p0_prologue(const AT& a, LAS unsigned char* lds, int tid, int lane, int wave, int bid, int G) {
    LAS float* scr = (LAS float*)(lds + wave * 16640);
    const int gw = bid * NWAVES + wave, NGW = G * NWAVES;
    constexpr int I_LAYER = 64 * 224 + 64 * 64 + 2 * 64 * 172 + 172 * 64;
    const int nitems = a.cvt_layers * I_LAYER;
    {
        f32x4 v0[16], v1[16]; float g0[16], g1[16];
        CvtItem c0 = cvt_decode(a, gw, nitems), c1 = cvt_decode(a, gw + NGW, nitems);
        cvt_issue(c0, v0, g0, lane); cvt_issue(c1, v1, g1, lane);
#pragma unroll 1
        for (int it = gw; it < nitems; it += 2 * NGW) {
            if (c0.valid) cvt_to_lds(v0, g0, scr, lane);
            const CvtItem n0 = cvt_decode(a, it + 2 * NGW, nitems); cvt_issue(n0, v0, g0, lane);
            if (c0.valid) cvt_store(c0, scr, lane);
            if (c1.valid) cvt_to_lds(v1, g1, scr, lane);
            const CvtItem n1 = cvt_decode(a, it + 3 * NGW, nitems); cvt_issue(n1, v1, g1, lane);
            if (c1.valid) cvt_store(c1, scr, lane);
            c0 = n0; c1 = n1;
        }
    }
    if (a.cvt_mask & 1) for (int i = bid * NTHR + tid; i < a.cvt_layers * 16 * D; i += G * NTHR) { const int l = i / (16 * D), r = i - l * 16 * D, j = r / D, k = r - j * D;
        const float v = a.w_in[(size_t)l * D * INW + (size_t)k * INW + NPROJ + j] * a.mix_norm[l * D + k]; a.wga_t[l][r] = (bf16_t)(cvt_pk_bf16(v, 0.f) & 0xffffu); }
    u64* ss0 = (u64*)(a.ctl + CW_SS);
    for (int i = bid * NTHR + tid; i < 4 * T; i += G * NTHR) ss0[T + i] = 0ull;
    {
        f32x4 xv[16];
        if (gw < T) { const f32x4* xr = (const f32x4*)(a.x + (size_t)gw * D) + lane;
#pragma unroll
            for (int j = 0; j < 16; ++j) xv[j] = xr[64 * j]; }
#pragma unroll 1
        for (int m = gw; m < T; m += NGW) { u32x2* o8 = (u32x2*)(a.xb + (size_t)m * D) + lane; float s = 0.f; u32x2 w[16];
#pragma unroll
            for (int j = 0; j < 16; ++j) { const f32x4 v = xv[j]; s += (v[0] * v[0] + v[1] * v[1]) + (v[2] * v[2] + v[3] * v[3]); w[j].x = cvt_pk_bf16(v[0], v[1]); w[j].y = cvt_pk_bf16(v[2], v[3]); }
            if (m + NGW < T) { const f32x4* xr = (const f32x4*)(a.x + (size_t)(m + NGW) * D) + lane;
#pragma unroll
                for (int j = 0; j < 16; ++j) xv[j] = xr[64 * j]; }
#pragma unroll
            for (int j = 0; j < 16; ++j) { if (MK_XB_WT) __builtin_amdgcn_raw_buffer_store_b64(w[j], __builtin_amdgcn_make_buffer_rsrc((void*)a.xb, 0, 0x7ffffff0, 0x00020000), (unsigned)(((size_t)m * D + 4 * (lane + 64 * j)) * 2), 0, 16); else o8[64 * j] = w[j]; }
            s = wave_sum(s); if (lane == 0) ss0[m] = ss_fix(s); }
    }
}

template <class AT> __device__ __forceinline__ void ga_stage(const AT& a, int l, const u64* ss, LAS unsigned char* lds, int tid, int lane, int wave, int bid, int G) {
    LAS float* red = (LAS float*)lds;
    for (int tb = bid; tb < T / 32; tb += G) {
        f32x4 acc[2] = {(f32x4){0.f, 0.f, 0.f, 0.f}, (f32x4){0.f, 0.f, 0.f, 0.f}};
        const bf16_t* xa = a.xb + (size_t)(tb * 32 + (lane & 15)) * D + wave * 512 + 8 * (lane >> 4);
        const bf16_t* wb = a.wga_t[l] + (size_t)(lane & 15) * D + wave * 512 + 8 * (lane >> 4);
#pragma unroll 8
        for (int ks = 0; ks < 16; ++ks) { const bf16x8 b = *(const bf16x8*)(wb + 32 * ks);
            const bf16x8 a0 = *(const bf16x8*)(xa + 32 * ks), a1 = *(const bf16x8*)(xa + (size_t)16 * D + 32 * ks);
            acc[0] = __builtin_amdgcn_mfma_f32_16x16x32_bf16(a0, b, acc[0], 0, 0, 0); acc[1] = __builtin_amdgcn_mfma_f32_16x16x32_bf16(a1, b, acc[1], 0, 0, 0); }
        *(LAS f32x4*)(red + ((wave * 2 + 0) * 64 + lane) * 4) = acc[0]; *(LAS f32x4*)(red + ((wave * 2 + 1) * 64 + lane) * 4) = acc[1];
        __syncthreads();
        { const int mt = tid >> 8, ln = (tid >> 2) & 63, rg = tid & 3; float s = 0.f;
#pragma unroll
          for (int w = 0; w < 8; ++w) s += red[((w * 2 + mt) * 64 + ln) * 4 + rg];
          const int tok = tb * 32 + 16 * mt + (ln >> 4) * 4 + rg, j = ln & 15;
          a.ga[(size_t)tok * 16 + j] = s * rs_of(ss[tok]); }
        __syncthreads();
    }
}

__device__ __forceinline__ void gate_octet(float (&z)[8][8], const LAS float* gal, const LAS float* wl, const f32x4 b0, const f32x4 b1, int co, int tg) {
#pragma unroll
    for (int e = 0; e < 8; ++e) { z[e][0] = b0[0]; z[e][1] = b0[1]; z[e][2] = b0[2]; z[e][3] = b0[3]; z[e][4] = b1[0]; z[e][5] = b1[1]; z[e][6] = b1[2]; z[e][7] = b1[3]; }
#pragma unroll 2
    for (int r = 0; r < 16; ++r) { const f32x4 w0 = *(const LAS f32x4*)(wl + r * 256 + 8 * co), w1 = *(const LAS f32x4*)(wl + r * 256 + 8 * co + 4);
#pragma unroll
        for (int e = 0; e < 8; ++e) { const float g = gal[(8 * tg + e) * 16 + r];
            z[e][0] = fmaf(g, w0[0], z[e][0]); z[e][1] = fmaf(g, w0[1], z[e][1]); z[e][2] = fmaf(g, w0[2], z[e][2]); z[e][3] = fmaf(g, w0[3], z[e][3]);
            z[e][4] = fmaf(g, w1[0], z[e][4]); z[e][5] = fmaf(g, w1[1], z[e][5]); z[e][6] = fmaf(g, w1[2], z[e][6]); z[e][7] = fmaf(g, w1[3], z[e][7]); } }
#pragma unroll
    for (int j = 0; j < 8; ++j) { float run = 0.f;
#pragma unroll
        for (int e = 0; e < 8; ++e) { const float zz = z[e][j]; run += (fminf(zz, 0.f) - 0.69314718f * __builtin_amdgcn_logf(1.0f + __builtin_amdgcn_exp2f(-1.44269504f * fabsf(zz)))) * 0.0625f; z[e][j] = run; }
        if (j & 1) __builtin_amdgcn_sched_barrier(0); }
}
template <class AT> __device__ __forceinline__ void prep_phase(const AT& a, int l, LAS unsigned char* lds, int tid, int lane, int wave, int bid, int G) {
    LAS float* galA = (LAS float*)lds;
    LAS float* galB = (LAS float*)(lds + 8192);
    LAS float* tot = (LAS float*)(lds + 16384);
    LAS float* wl = (LAS float*)(lds + 32768);
    const float* wup = a.gla_w_up + (size_t)l * 16 * 1024; const float* gb = a.gla_b + l * 1024;
    for (int u = bid; u < 256; u += G) { const int h = u >> 6, c = u & 63, t0 = c * 128;
        u32x4 qin[8], kin[8]; f32x4 b0, b1;
        {
            int tz = tid; asm volatile("" : "+v"(tz)); const int co = tz & 31, tg = tz >> 5, ch = h * 256 + 8 * co;
            const unsigned rowoff = (unsigned)(((t0 + 8 * tg) * 1024 + ch) * 2);
            const f32x4 gB = *(const f32x4*)((const char*)(a.ga + (size_t)t0 * 16) + (unsigned)(tz * 16));
            f32x4 gA = (f32x4){0.f, 0.f, 0.f, 0.f}; if (c & 1) gA = *(const f32x4*)((const char*)(a.ga + (size_t)(t0 - 128) * 16) + (unsigned)(tz * 16));
            const unsigned wo = (unsigned)(((tz >> 6) * 1024 + 4 * (tz & 63)) * 4);
            const f32x4 wv0 = *(const f32x4*)((const char*)(wup + h * 256) + wo), wv1 = *(const f32x4*)((const char*)(wup + h * 256 + 8 * 1024) + wo);
            b0 = *(const f32x4*)((const char*)(gb + h * 256) + (unsigned)(co * 32)); b1 = *(const f32x4*)((const char*)(gb + h * 256 + 4) + (unsigned)(co * 32));
#pragma unroll
            for (int e = 0; e < 8; ++e) { qin[e] = *(const u32x4*)((const char*)a.gq + (rowoff + (unsigned)(e * 2048))); kin[e] = *(const u32x4*)((const char*)a.gk + (rowoff + (unsigned)(e * 2048))); }
            *(LAS f32x4*)(galB + tz * 4) = gB; *(LAS f32x4*)(galA + tz * 4) = gA;
            *(LAS f32x4*)(wl + (tz >> 6) * 256 + 4 * (tz & 63)) = wv0; *(LAS f32x4*)(wl + (8 + (tz >> 6)) * 256 + 4 * (tz & 63)) = wv1;
        }
        __syncthreads();
        int tz2 = tid; asm volatile("" : "+v"(tz2)); const int co = tz2 & 31, tg = tz2 >> 5, ch = h * 256 + 8 * co;
        const unsigned rowoff = (unsigned)(((t0 + 8 * tg) * 1024 + ch) * 2);
        float z[8][8]; float base[8];
#pragma unroll
        for (int j = 0; j < 8; ++j) base[j] = 0.f;
        if (c & 1) {
            gate_octet(z, galA, wl, b0, b1, co, tg);
#pragma unroll
            for (int j = 0; j < 8; ++j) tot[tg * 256 + 8 * co + j] = z[7][j];
            __syncthreads();
            for (int g2 = 0; g2 < 16; ++g2) { const f32x4 t0v = *(const LAS f32x4*)(tot + g2 * 256 + 8 * co), t1v = *(const LAS f32x4*)(tot + g2 * 256 + 8 * co + 4);
                base[0] += t0v[0]; base[1] += t0v[1]; base[2] += t0v[2]; base[3] += t0v[3]; base[4] += t1v[0]; base[5] += t1v[1]; base[6] += t1v[2]; base[7] += t1v[3]; }
            __syncthreads();
        }
        gate_octet(z, galB, wl, b0, b1, co, tg);
#pragma unroll
        for (int j = 0; j < 8; ++j) tot[tg * 256 + 8 * co + j] = z[7][j];
        __syncthreads();
        float off[8];
#pragma unroll
        for (int j = 0; j < 8; ++j) off[j] = base[j];
        for (int g2 = 0; g2 < tg; ++g2) { const f32x4 t0v = *(const LAS f32x4*)(tot + g2 * 256 + 8 * co), t1v = *(const LAS f32x4*)(tot + g2 * 256 + 8 * co + 4);
            off[0] += t0v[0]; off[1] += t0v[1]; off[2] += t0v[2]; off[3] += t0v[3]; off[4] += t1v[0]; off[5] += t1v[1]; off[6] += t1v[2]; off[7] += t1v[3]; }
#pragma unroll
        for (int e = 0; e < 8; ++e) { float qv[8], kv[8];
            const unsigned qw[4] = {qin[e].x, qin[e].y, qin[e].z, qin[e].w}, kw[4] = {kin[e].x, kin[e].y, kin[e].z, kin[e].w};
#pragma unroll
            for (int j = 0; j < 8; ++j) { const float cum = z[e][j] + off[j]; const float eq = __builtin_amdgcn_exp2f(1.44269504f * cum), ek = __builtin_amdgcn_rcpf(eq);
                const float qf = (j & 1) ? bf_hi(qw[j >> 1]) : bf_lo(qw[j >> 1]), kf = (j & 1) ? bf_hi(kw[j >> 1]) : bf_lo(kw[j >> 1]); qv[j] = qf * eq; kv[j] = kf * ek; }
            u32x4 qo, ko; qo.x = cvt_pk_bf16(qv[0], qv[1]); qo.y = cvt_pk_bf16(qv[2], qv[3]); qo.z = cvt_pk_bf16(qv[4], qv[5]); qo.w = cvt_pk_bf16(qv[6], qv[7]);
            ko.x = cvt_pk_bf16(kv[0], kv[1]); ko.y = cvt_pk_bf16(kv[2], kv[3]); ko.z = cvt_pk_bf16(kv[4], kv[5]); ko.w = cvt_pk_bf16(kv[6], kv[7]);
            if (MK_MIX_WT) { __builtin_amdgcn_raw_buffer_store_b128(qo, __builtin_amdgcn_make_buffer_rsrc((void*)a.qg, 0, 0x7ffffff0, 0x00020000), rowoff + (unsigned)(e * 2048), 0, 16); __builtin_amdgcn_raw_buffer_store_b128(ko, __builtin_amdgcn_make_buffer_rsrc((void*)a.kg, 0, 0x7ffffff0, 0x00020000), rowoff + (unsigned)(e * 2048), 0, 16); }
            else { *(u32x4*)((char*)a.qg + (rowoff + (unsigned)(e * 2048))) = qo; *(u32x4*)((char*)a.kg + (rowoff + (unsigned)(e * 2048))) = ko; }
            __builtin_amdgcn_sched_barrier(0); }
        if ((c & 1) && tg == 15) {
#pragma unroll
            for (int j = 0; j < 8; ++j) a.lam[(c >> 1) * 1024 + ch + j] = __builtin_amdgcn_exp2f(1.44269504f * (z[7][j] + off[j])); }
        __syncthreads();
    }
}

template <class AT> __device__ __forceinline__ void m1_phase(const AT& a, LAS unsigned char* lds, int tid, int wave, int bid, int G) {
    const int nsu = bid < 512 ? (512 - bid + G - 1) / G : 0, npass = 4 * nsu;
    if (npass == 0) return;
    f32x4 acc[8][4];
#pragma unroll
    for (int i = 0; i < 8; ++i)
#pragma unroll
        for (int j = 0; j < 4; ++j) acc[i][j] = (f32x4){0.f, 0.f, 0.f, 0.f};
    u32x2 w[8];
#define M1_DECODE(p_) const int su_ = bid + ((p_) >> 2) * G; const bf16_t *Ks, *Vt; int ldk, c2; \
        if (su_ < 256) { const int h = su_ >> 5; c2 = su_ & 31; Ks = a.kr + h * 256; ldk = 2048; Vt = MK_VT_BLK ? a.vrt + ((size_t)c2 * 2048 + h * 256) * 256 : a.vrt + (size_t)(h * 256) * T; } \
        else { const int s_ = su_ - 256, vh = (s_ >> 3) & 1, ix_ = (s_ & 7) | ((s_ >> 4) << 3), h = ix_ >> 5; c2 = ix_ & 31;     Ks = a.kg + h * 256; ldk = 1024; Vt = MK_VT_BLK ? a.vgt + ((size_t)c2 * 2048 + h * 512 + vh * 256) * 256 : a.vgt + (size_t)(h * 512 + vh * 256) * T; } \
        const int tk = c2 * 256 + ((p_) & 3) * 64
#define M1_ISSUE(p_, half_) do { M1_DECODE(p_); int tz = tid; asm volatile("" : "+v"(tz)); \
        { const int ln = tz & 63; const char* vbase = (const char*)(Vt + (MK_VT_BLK ? ((p_) & 3) * 64 : tk)); \
          _Pragma("unroll") for (int i = 0; i < 4; ++i) { const int r = 32 * wave + 8 * i + (ln >> 3), c = (ln & 7) ^ (4 * (i & 1) + (ln >> 4)); \
            __builtin_amdgcn_global_load_lds((const unsigned*)(vbase + (unsigned)((r * (MK_VT_BLK ? 256 : T) + c * 8) * 2)), (LAS unsigned*)(lds + 65536 + (half_) * 32768 + (4 * wave + i) * 1024), 16, 0, 0); } } \
        { const int dq = tz & 63, q = tz >> 6; const char* kbase = (const char*)(Ks + (size_t)tk * ldk); const unsigned kof = (unsigned)((8 * q * ldk + 4 * dq) * 2); \
          _Pragma("unroll") for (int i = 0; i < 8; ++i) w[i] = *(const u32x2*)(kbase + (kof + (unsigned)(i * ldk * 2))); } } while (0)
#define M1_KEL(i_) ((dd & 2) ? ((dd & 1) ? (w[i_].y >> 16) : (w[i_].y & 0xffffu)) : ((dd & 1) ? (w[i_].x >> 16) : (w[i_].x & 0xffffu)))
#define M1_STASH(half_) do { int tz = tid; asm volatile("" : "+v"(tz)); \
        { const int dq = tz & 63, q = tz >> 6; _Pragma("unroll") for (int dd = 0; dd < 4; ++dd) { u32x4 o; \
            o.x = M1_KEL(0) | (M1_KEL(1) << 16); o.y = M1_KEL(2) | (M1_KEL(3) << 16); o.z = M1_KEL(4) | (M1_KEL(5) << 16); o.w = M1_KEL(6) | (M1_KEL(7) << 16); \
            const int d = 4 * dq + dd, r = (d & ~31) + 16 * ((d >> 2) & 1) + 4 * ((d >> 3) & 3) + (d & 3); \
            *(LAS u32x4*)(lds + r * 256 + (((8 * (half_) + q) ^ (r & 15)) << 4)) = o; } } \
        asm volatile("s_waitcnt vmcnt(0)" ::: "memory"); } while (0)
#define M1_COMPUTE(half_) do { int tz = tid; asm volatile("" : "+v"(tz)); const int lr = tz & 15, lq = (tz & 63) >> 4, wd = wave & 1, wv = wave >> 1; \
        LAS unsigned char* kb = lds + (128 * wd + lr) * 256 + (((lq ^ lr) & 3) << 4); LAS unsigned char* vb = lds + 65536 + (half_) * 32768 + (64 * wv + lr) * 128; \
        _Pragma("unroll") for (int kk = 0; kk < 2; ++kk) { const int o = ((2 * (half_) + kk) ^ (lr >> 2)) << 6, ov = ((4 * kk + lq) ^ (lr >> 1)) << 4; bf16x8 Y[4]; \
            _Pragma("unroll") for (int j = 0; j < 4; ++j) Y[j] = *(const LAS bf16x8*)(vb + ov + j * 2048); \
            _Pragma("unroll") for (int ih = 0; ih < 2; ++ih) { bf16x8 X[4]; \
                _Pragma("unroll") for (int i = 0; i < 4; ++i) X[i] = *(const LAS bf16x8*)(kb + o + (4 * ih + i) * 4096); \
                _Pragma("unroll") for (int i = 0; i < 4; ++i) { _Pragma("unroll") for (int j = 0; j < 4; ++j) acc[4 * ih + i][j] = __builtin_amdgcn_mfma_f32_16x16x32_bf16(X[i], Y[j], acc[4 * ih + i][j], 0, 0, 0); } \
                asm volatile("" ::: "memory"); } } } while (0)
    M1_ISSUE(0, 0); M1_STASH(0);
    __syncthreads();
#pragma unroll 1
    for (int p = 0; p < npass; p += 2) {
        M1_ISSUE(p + 1, 1);
        M1_COMPUTE(0);
        M1_STASH(1);
        __syncthreads();
        const bool more = p + 2 < npass;
        if (more) M1_ISSUE(p + 2, 0);
        M1_COMPUTE(1);
        if (more) M1_STASH(0);
        if ((p & 3) == 2) {
            const int su = bid + (p >> 2) * G; bf16_t* out;
            if (su < 256) { const int h = su >> 5, c2 = su & 31; out = a.kvr + (size_t)(h * 32 + c2) * 65536; }
            else { const int s_ = su - 256, vh = (s_ >> 3) & 1, ix_ = (s_ & 7) | ((s_ >> 4) << 3), h = ix_ >> 5, c2 = ix_ & 31; out = a.kvg + (size_t)(h * 32 + c2) * 131072 + (size_t)vh * 65536; }
            int tz = tid; asm volatile("" : "+v"(tz)); const int lr = tz & 15, lq = (tz & 63) >> 4, wd = wave & 1, wv = wave >> 1;
            bf16_t* op = out + (size_t)((64 * wv + lr) * 256 + 128 * wd + 8 * lq); const auto ors = __builtin_amdgcn_make_buffer_rsrc((void*)out, 0, 0x7ffffff0, 0x00020000); const unsigned oo = (unsigned)(((64 * wv + lr) * 256 + 128 * wd + 8 * lq) * 2); (void)op;
#pragma unroll
            for (int i2 = 0; i2 < 4; ++i2)
#pragma unroll
                for (int j = 0; j < 4; ++j) { u32x4 w4; w4.x = cvt_pk_bf16(acc[2 * i2][j][0], acc[2 * i2][j][1]); w4.y = cvt_pk_bf16(acc[2 * i2][j][2], acc[2 * i2][j][3]);
                    w4.z = cvt_pk_bf16(acc[2 * i2 + 1][j][0], acc[2 * i2 + 1][j][1]); w4.w = cvt_pk_bf16(acc[2 * i2 + 1][j][2], acc[2 * i2 + 1][j][3]); if (MK_MIX_WT) __builtin_amdgcn_raw_buffer_store_b128(w4, ors, oo + (unsigned)(((16 * j) * 256 + 32 * i2) * 2), 0, 16); else *(u32x4*)(op + (16 * j) * 256 + 32 * i2) = w4; }
#pragma unroll
            for (int i = 0; i < 8; ++i)
#pragma unroll
                for (int j = 0; j < 4; ++j) acc[i][j] = (f32x4){0.f, 0.f, 0.f, 0.f};
        }
        __syncthreads();
    }
#undef M1_DECODE
#undef M1_ISSUE
#undef M1_KEL
#undef M1_STASH
#undef M1_COMPUTE
}
template <class AT> __device__ __forceinline__ void m2_phase(const AT& a, int tid, int bid, int G) {
    for (int blk = bid; blk < 256; blk += G) { const int vec = blk * NTHR + tid;
        bf16_t* base; size_t cstride; const float* lamp = nullptr; float lsc = 0.f;
        if (vec < 65536) { const int h = vec >> 13, rem = vec & 8191; base = a.kvr + (size_t)(h * 32) * 65536 + (size_t)rem * 8; cstride = 65536; lsc = exp2f(256.0f * log2f(1.0f - exp2f(-5.0f - (float)h))); }
        else { const int v2 = vec - 65536, h = v2 >> 14, rem = v2 & 16383; base = a.kvg + (size_t)(h * 32) * 131072 + (size_t)rem * 8; cstride = 131072; lamp = a.lam + h * 256 + 8 * (rem & 31); }
        const auto srs = __builtin_amdgcn_make_buffer_rsrc((void*)(blk < 128 ? a.kvr + (size_t)((blk >> 4) * 32) * 65536 : a.kvg + (size_t)(((blk - 128) >> 5) * 32) * 131072), 0, 0x7ffffff0, 0x00020000);
        const unsigned soff = (unsigned)((blk < 128 ? (vec & 8191) : ((vec - 65536) & 16383)) * 16), sstep = (unsigned)(blk < 128 ? 65536 * 2 : 131072 * 2);
        float st[8]; float z0 = 0.f; asm volatile("" : "+v"(z0));
#pragma unroll
        for (int e = 0; e < 8; ++e) st[e] = z0;
        u32x4 kv[2][4]; f32x4 l0[2][4], l1[2][4];
#define M2_LOAD(B, c0_) do { _Pragma("unroll") for (int j = 0; j < 4; ++j) kv[B][j] = MK_NTLD((const u32x4*)(base + (size_t)((c0_) + j) * cstride)); \
            if (lamp) { _Pragma("unroll") for (int j = 0; j < 4; ++j) { l0[B][j] = *(const f32x4*)(lamp + ((c0_) + j) * 1024); l1[B][j] = *(const f32x4*)(lamp + ((c0_) + j) * 1024 + 4); } } \
            else { _Pragma("unroll") for (int j = 0; j < 4; ++j) { l0[B][j] = (f32x4){lsc, lsc, lsc, lsc}; l1[B][j] = l0[B][j]; } } } while (0)
        M2_LOAD(0, 0);
#pragma unroll
        for (int b = 0; b < 8; ++b) { const int c0 = 4 * b, B = b & 1;
            if (b < 7) M2_LOAD((b + 1) & 1, c0 + 4);
#pragma unroll
            for (int j = 0; j < 4; ++j) {
                u32x4 o; o.x = cvt_pk_bf16(st[0], st[1]); o.y = cvt_pk_bf16(st[2], st[3]); o.z = cvt_pk_bf16(st[4], st[5]); o.w = cvt_pk_bf16(st[6], st[7]); if (MK_M2_WT) __builtin_amdgcn_raw_buffer_store_b128(o, srs, soff + (unsigned)(c0 + j) * sstep, 0, 16); else *(u32x4*)(base + (size_t)(c0 + j) * cstride) = o;
                st[0] = l0[B][j][0] * (st[0] + bf_lo(kv[B][j].x)); st[1] = l0[B][j][1] * (st[1] + bf_hi(kv[B][j].x)); st[2] = l0[B][j][2] * (st[2] + bf_lo(kv[B][j].y)); st[3] = l0[B][j][3] * (st[3] + bf_hi(kv[B][j].y));
                st[4] = l1[B][j][0] * (st[4] + bf_lo(kv[B][j].z)); st[5] = l1[B][j][1] * (st[5] + bf_hi(kv[B][j].z)); st[6] = l1[B][j][2] * (st[6] + bf_lo(kv[B][j].w)); st[7] = l1[B][j][3] * (st[7] + bf_hi(kv[B][j].w)); }
            asm volatile("" ::: "memory");
        }
#undef M2_LOAD
    }
}

#define M3_LANE() int tz_ = tid; asm volatile("" : "+v"(tz_)); const int lr = tz_ & 15, lq = (tz_ & 63) >> 4; (void)lr; (void)lq
#define M3_BASES() LAS unsigned char* qb4[4]; LAS unsigned char* pb4[4]; _Pragma("unroll") for (int b = 0; b < 4; ++b) { const int o_ = ((b ^ (lr >> 2)) << 6) + (((lq ^ lr) & 3) << 4); qb4[b] = QL + lr * 512 + o_; }
#define M3_PBASES() do { int tp_ = tid; asm volatile("" : "+v"(tp_)); const int lr_ = tp_ & 15, lq_ = (tp_ & 63) >> 4; _Pragma("unroll") for (int b = 0; b < 4; ++b) pb4[b] = PL + lr_ * 512 + (((b ^ (lr_ >> 2)) << 6) + (((lq_ ^ lr_) & 3) << 4)); } while (0)
#define QFRAG(rt, ks) (*(const LAS bf16x8*)(qb4[(ks) & 3] + (rt) * 8192 + ((ks) >> 2) * 256))
#define PFRAG(rt, ks) (*(const LAS bf16x8*)(pb4[(ks) & 3] + (rt) * 8192 + ((ks) >> 2) * 256))
struct M3Pend { u32x4 w[2][8]; bf16_t* mixed; int t0; int lpr; };
__device__ __forceinline__ void m3_flush(M3Pend& pd, int tid, int wave) {
    if (pd.lpr) {
        int tf_ = tid; asm volatile("" : "+v"(tf_)); const int ln = tf_ & 63, sh = (pd.lpr == 64) ? 6 : 5, rpi = 64 >> sh, ni = 8 >> (6 - sh), rsub = ln >> sh, c8 = ln & (pd.lpr - 1);
        const auto rs = __builtin_amdgcn_make_buffer_rsrc((void*)pd.mixed, 0, 0x7ffffff0, 0x00020000);
#pragma unroll
        for (int pass = 0; pass < 2; ++pass)
#pragma unroll
            for (int i = 0; i < 8; ++i) if (i < ni) { const int rl = wave * 8 + i * rpi + rsub;
                __builtin_amdgcn_raw_buffer_store_b128(pd.w[pass][i], rs, (unsigned)(((pd.t0 + 64 * pass + rl) * 4096 + 8 * c8) * 2), 0, MK_M3_WT ? 16 : 0); }
        pd.lpr = 0;
    }
}
template <int CT, bool LNORM, int NB, int RD, bool INPEND>
__device__ __forceinline__ void m3_unit(LAS unsigned char* lds, const bf16_t* Q, int ldq, const bf16_t* Kk, const bf16_t* VT, const bf16_t* ST, const bf16_t* gate, const float* gain, bf16_t* mixed, int t0, int tk0, int tid, int wave, M3Pend& pend, int probe = 0) {
    constexpr int DV = CT * 128, NP = 4 * NB;
    LAS unsigned char* QL = lds; LAS unsigned char* PL = lds + 65536; LAS f32x2* STATS = (LAS f32x2*)(lds + 131072);
    const int vb = wave * 16 * CT;
    bf16x8 ring[RD][CT];
#define M3_LOADV(ks, R) do { _Pragma("unroll") for (int ct = 0; ct < CT; ++ct) R[ct] = *(const bf16x8*)(VT + (MK_VT_BLK ? 0 : tk0) + (vo + (unsigned)((16 * ct) * (MK_VT_BLK ? 256 : T) + 32 * (ks)))); } while (0)
#define M3_LOADS(ks, R) do { _Pragma("unroll") for (int ct = 0; ct < CT; ++ct) R[ct] = *(const bf16x8*)(ST + (so + (unsigned)((16 * ct) * 256 + 32 * (ks)))); } while (0)
#define M3_LOADSTEP(k, R) do { if ((k) < 8) M3_LOADS((k), R); else if ((k) < NP + 8) M3_LOADV((k) - 8, R); } while (0)
    {
        M3_LANE(); M3_BASES();
#pragma unroll
        for (int i = 0; i < 8; ++i) { const int idx = tz_ + 512 * i, row = idx >> 5, ch = idx & 31;
            const u32x4 v = *(const u32x4*)(Q + (size_t)(t0 + row) * ldq + ch * 8); *(LAS u32x4*)(QL + row * 512 + ((ch ^ (row & 15)) << 4)) = v; }
        bf16x8 Kf[NB][8];
#pragma unroll
        for (int kb = 0; kb < NB; ++kb)
#pragma unroll
            for (int ks = 0; ks < 8; ++ks) Kf[kb][ks] = *(const bf16x8*)(Kk + (size_t)(tk0 + 128 * kb + 16 * wave + lr) * ldq + 32 * ks + 8 * lq);
        if constexpr (INPEND) { if (MK_M3_DEFER) m3_flush(pend, tid, wave); }
        { const unsigned vo = (unsigned)((vb + lr) * (MK_VT_BLK ? 256 : T) + 8 * lq), so = (unsigned)((vb + lr) * 256 + 8 * lq);
#pragma unroll
            for (int j = 0; j < RD - 1; ++j) M3_LOADSTEP(j, ring[j]); }
        __syncthreads();
#pragma unroll
        for (int kb = 0; kb < NB; ++kb) { const bool diag = (kb == NB - 1);
#pragma unroll
            for (int rt = 0; rt < 8; ++rt) { f32x4 p = (f32x4){0.f, 0.f, 0.f, 0.f};
                if (!diag || rt >= wave) {
#pragma unroll
                    for (int ks = 0; ks < 8; ++ks) { const bf16x8 qf = QFRAG(rt, ks); p = __builtin_amdgcn_mfma_f32_16x16x32_bf16(Kf[kb][ks], qf, p, 0, 0, 0); }
                    if (diag && rt == wave) {
#pragma unroll
                        for (int r = 0; r < 4; ++r) if (4 * lq + r > lr) p[r] = 0.f; } }
                u32x2 w; w.x = cvt_pk_bf16(p[0], p[1]); w.y = cvt_pk_bf16(p[2], p[3]);
                *(LAS u32x2*)(PL + (16 * rt + lr) * 512 + ((((16 * kb + 2 * wave + (lq >> 1)) ^ lr) << 4) + ((lq & 1) << 3))) = w; } }
        __syncthreads();
    }
#if MK_M3_EPI == 2
    constexpr int LPR_ = DV / 8, RPI_ = 64 / LPR_, NI_ = 8 / RPI_; constexpr bool GEARLY = MK_M3_GEARLY && CT == 2;
    u32x4 gvE0[NI_], gvE1[NI_];
    if constexpr (GEARLY) { int tg_ = tid; asm volatile("" : "+v"(tg_)); const int ln_ = tg_ & 63;
#pragma unroll
        for (int i = 0; i < NI_; ++i) { const int rl = wave * 8 + i * RPI_ + ln_ / LPR_;
            gvE0[i] = *(const u32x4*)(gate + ((unsigned)((t0 + rl) * 2048 + 8 * (ln_ % LPR_)))); gvE1[i] = *(const u32x4*)(gate + ((unsigned)((t0 + 64 + rl) * 2048 + 8 * (ln_ % LPR_)))); } }
#endif
    f32x4 acc[8][CT];
#pragma unroll
    for (int rt = 0; rt < 8; ++rt)
#pragma unroll
        for (int ct = 0; ct < CT; ++ct) acc[rt][ct] = (f32x4){0.f, 0.f, 0.f, 0.f};
    {
        M3_LANE(); M3_BASES();
        const unsigned vo = (unsigned)((vb + lr) * (MK_VT_BLK ? 256 : T) + 8 * lq), so = (unsigned)((vb + lr) * 256 + 8 * lq);
#define M3_MMA(R, FRAG) do { _Pragma("unroll") for (int rt = 0; rt < 8; ++rt) { const bf16x8 bfr = FRAG; \
            _Pragma("unroll") for (int ct = 0; ct < CT; ++ct) acc[rt][ct] = __builtin_amdgcn_mfma_f32_16x16x32_bf16(R[ct], bfr, acc[rt][ct], 0, 0, 0); } asm volatile("" ::: "memory"); } while (0)
#define M3_NEXT(k) do { if (!(MK_M3_PROBE >= 2 && probe)) M3_LOADSTEP((k) + RD - 1, ring[((k) + RD - 1) % RD]); } while (0)
#define M3_STEP(k) do { if ((k) < NP + 8) { if ((k) == 8) M3_PBASES(); M3_NEXT(k); if ((k) < 8) M3_MMA(ring[(k) % RD], QFRAG(rt, (k) & 7)); else M3_MMA(ring[(k) % RD], PFRAG(rt, ((k) - 8) & 7)); } } while (0)
        M3_STEP(0); M3_STEP(1); M3_STEP(2); M3_STEP(3); M3_STEP(4); M3_STEP(5); M3_STEP(6); M3_STEP(7);
        M3_STEP(8); M3_STEP(9); M3_STEP(10); M3_STEP(11); M3_STEP(12); M3_STEP(13); M3_STEP(14); M3_STEP(15);
#undef M3_STEP
#undef M3_NEXT
#undef M3_MMA
    }
#if MK_M3_EPI == 0
    {
        M3_LANE();
#pragma unroll
        for (int rt = 0; rt < 8; ++rt) { float s1 = 0.f, s2 = 0.f;
#pragma unroll
            for (int ct = 0; ct < CT; ++ct)
#pragma unroll
                for (int r = 0; r < 4; ++r) { const float x = acc[rt][ct][r]; s1 += x; s2 += x * x; }
            s1 += __shfl_xor(s1, 16); s1 += __shfl_xor(s1, 32); s2 += __shfl_xor(s2, 16); s2 += __shfl_xor(s2, 32);
            if (lq == 0) STATS[(16 * rt + lr) * 8 + wave] = (f32x2){s1, s2}; }
        __syncthreads();
    }
#pragma unroll
    for (int rt = 0; rt < 8; ++rt) { M3_LANE(); const int row = 16 * rt + lr;
        float s1 = 0.f, s2 = 0.f;
#pragma unroll
        for (int w = 0; w < 8; ++w) { const f32x2 s = STATS[row * 8 + w]; s1 += s[0]; s2 += s[1]; }
        const float mean = LNORM ? s1 * (1.0f / DV) : 0.f; const float var = s2 * (1.0f / DV) - mean * mean; const float rstd = 1.0f / sqrtf(var + 1e-6f);
        const size_t to = (size_t)(t0 + row);
#pragma unroll
        for (int ct = 0; ct < CT; ++ct) { const int col = vb + 16 * ct + 4 * lq; const u32x2 g = *(const u32x2*)(gate + to * 2048 + col);
            const f32x4 x = acc[rt][ct]; u32x2 w;
            w.x = cvt_pk_bf16((x[0] - mean) * rstd * bf_lo(g.x), (x[1] - mean) * rstd * bf_hi(g.x));
            w.y = cvt_pk_bf16((x[2] - mean) * rstd * bf_lo(g.y), (x[3] - mean) * rstd * bf_hi(g.y));
            *(u32x2*)(mixed + to * 4096 + col) = w; }
        asm volatile("" ::: "memory"); }
#elif MK_M3_EPI == 1
    {
        M3_LANE();
        const unsigned go = (unsigned)((t0 + lr) * 2048 + vb + 4 * lq), mo = (unsigned)((t0 + lr) * 4096 + vb + 4 * lq);
        u32x2 g0[4][CT], g1[4][CT];
#define M3_GLOAD(G, HB) do { _Pragma("unroll") for (int r4 = 0; r4 < 4; ++r4) { _Pragma("unroll") for (int ct = 0; ct < CT; ++ct) G[r4][ct] = (MK_M3_PROBE && probe) ? (u32x2){0x3f803f80u, 0x3f803f80u} : *(const u32x2*)(gate + (go + (unsigned)((16 * (4 * (HB) + r4)) * 2048 + 16 * ct))); } } while (0)
#define M3_GFOLD(G, HB) do { _Pragma("unroll") for (int r4 = 0; r4 < 4; ++r4) { _Pragma("unroll") for (int ct = 0; ct < CT; ++ct) { f32x4& x = acc[4 * (HB) + r4][ct]; \
            x[0] *= bf_lo(G[r4][ct].x); x[1] *= bf_hi(G[r4][ct].x); x[2] *= bf_lo(G[r4][ct].y); x[3] *= bf_hi(G[r4][ct].y); } } } while (0)
#define M3_ROWS(G, HB) do { _Pragma("unroll") for (int r4 = 0; r4 < 4; ++r4) { const int rt = 4 * (HB) + r4, row = 16 * rt + lr; float s1 = 0.f, s2 = 0.f; \
            _Pragma("unroll") for (int w = 0; w < 8; ++w) { const f32x2 s = STATS[row * 8 + w]; s1 += s[0]; s2 += s[1]; } \
            const float mean = LNORM ? s1 * (1.0f / DV) : 0.f; const float var = s2 * (1.0f / DV) - mean * mean; const float rstd = 1.0f / sqrtf(var + 1e-6f); \
            _Pragma("unroll") for (int ct = 0; ct < CT; ++ct) { const f32x4 x = acc[rt][ct]; u32x2 w; \
                if (LNORM) { w.x = cvt_pk_bf16((x[0] - mean) * rstd * bf_lo(G[r4][ct].x), (x[1] - mean) * rstd * bf_hi(G[r4][ct].x)); w.y = cvt_pk_bf16((x[2] - mean) * rstd * bf_lo(G[r4][ct].y), (x[3] - mean) * rstd * bf_hi(G[r4][ct].y)); } \
                else { w.x = cvt_pk_bf16(x[0] * rstd, x[1] * rstd); w.y = cvt_pk_bf16(x[2] * rstd, x[3] * rstd); } \
                if (!(MK_M3_PROBE && probe)) *(u32x2*)(mixed + (mo + (unsigned)((16 * rt) * 4096 + 16 * ct))) = w; } } } while (0)
        __builtin_amdgcn_sched_barrier(0);
        M3_GLOAD(g0, 0);
#pragma unroll
        for (int rt = 0; rt < 8; ++rt) { float s1 = 0.f, s2 = 0.f;
#pragma unroll
            for (int ct = 0; ct < CT; ++ct)
#pragma unroll
                for (int r = 0; r < 4; ++r) { const float x = acc[rt][ct][r]; s1 += x; s2 += x * x; }
            s1 += __shfl_xor(s1, 16); s1 += __shfl_xor(s1, 32); s2 += __shfl_xor(s2, 16); s2 += __shfl_xor(s2, 32);
            if (lq == 0) STATS[(16 * rt + lr) * 8 + wave] = (f32x2){s1, s2}; }
        asm volatile("" ::: "memory");
        if (!LNORM) M3_GFOLD(g0, 0);
        M3_GLOAD(g1, 1);
        __syncthreads();
        M3_ROWS(g0, 0);
        asm volatile("" ::: "memory");
        if (!LNORM) M3_GFOLD(g1, 1);
        M3_ROWS(g1, 1);
#undef M3_GLOAD
#undef M3_GFOLD
#undef M3_ROWS
    }
#else
    {
        constexpr int LPR = DV / 8, RPI = 64 / LPR, NI = 8 / RPI;
        LAS unsigned char* OT = lds;
        u32x4 gv0[NI], gv1[NI];
        const auto mixrs = __builtin_amdgcn_make_buffer_rsrc((void*)mixed, 0, 0x7ffffff0, 0x00020000);
#define M3_GROWS(G, PASS) do { int tg_ = tid; asm volatile("" : "+v"(tg_)); const int ln_ = tg_ & 63; _Pragma("unroll") for (int i = 0; i < NI; ++i) { const int rl = wave * 8 + i * RPI + ln_ / LPR; \
            G[i] = ((MK_M3_PROBE == 1 || MK_M3_PROBE == 2 || MK_M3_PROBE == 4) && probe) ? (u32x4){0x3f803f80u, 0x3f803f80u, 0x3f803f80u, 0x3f803f80u} : *(const u32x4*)(gate + ((unsigned)((t0 + 64 * (PASS) + rl) * 2048 + 8 * (ln_ % LPR)))); } } while (0)
#define M3_NORM(PASS) do { M3_LANE(); _Pragma("unroll") for (int r4 = 0; r4 < 4; ++r4) { const int rt = 4 * (PASS) + r4, row = 16 * rt + lr; float s1 = 0.f, s2 = 0.f; \
            _Pragma("unroll") for (int w = 0; w < 8; ++w) { const f32x2 sv = STATS[row * 8 + w]; s1 += sv[0]; s2 += sv[1]; } \
            const float mean = LNORM ? s1 * (1.0f / DV) : 0.f; const float var = s2 * (1.0f / DV) - mean * mean; const float rstd = 1.0f / sqrtf(var + 1e-6f); \
            _Pragma("unroll") for (int ct = 0; ct < CT; ++ct) { const f32x4 x = acc[rt][ct]; f32x4 y; y[0] = (x[0] - mean) * rstd; y[1] = (x[1] - mean) * rstd; y[2] = (x[2] - mean) * rstd; y[3] = (x[3] - mean) * rstd; \
                *(LAS f32x4*)(OT + (16 * r4 + lr) * (DV * 4) + ((((vb >> 2) + 4 * ct + lq) ^ lr) << 4)) = y; } } } while (0)
#define M3_OUT(G, PASS) do { int to_ = tid; asm volatile("" : "+v"(to_)); const int ln_ = to_ & 63, c8 = ln_ % LPR; _Pragma("unroll") for (int i = 0; i < NI; ++i) { const int rl = wave * 8 + i * RPI + ln_ / LPR; \
            const f32x4 ya = *(const LAS f32x4*)(OT + rl * (DV * 4) + (((2 * c8) ^ (rl & 15)) << 4)), yb = *(const LAS f32x4*)(OT + rl * (DV * 4) + (((2 * c8 + 1) ^ (rl & 15)) << 4)); \
            const u32x4 g = G[i]; u32x4 w; \
            w.x = cvt_pk_bf16(ya[0] * bf_lo(g.x), ya[1] * bf_hi(g.x)); w.y = cvt_pk_bf16(ya[2] * bf_lo(g.y), ya[3] * bf_hi(g.y)); \
            w.z = cvt_pk_bf16(yb[0] * bf_lo(g.z), yb[1] * bf_hi(g.z)); w.w = cvt_pk_bf16(yb[2] * bf_lo(g.w), yb[3] * bf_hi(g.w)); \
            if (MK_M3_DEFER) pend.w[PASS][i] = w; \
            else if (!((MK_M3_PROBE == 1 || MK_M3_PROBE == 2 || MK_M3_PROBE == 3) && probe)) { \
                if (MK_M3_PROBE == 5 && probe) *(u32x4*)((char*)mixed + (((unsigned)(((t0 + 64 * (PASS) + rl) * 4096 + 8 * c8) * 2)) & 0xfff0u)) = w;   \
                else if (MK_M3_WT) __builtin_amdgcn_raw_buffer_store_b128(w, mixrs, (unsigned)(((t0 + 64 * (PASS) + rl) * 4096 + 8 * c8) * 2), 0, 16  ); \
                else if (MK_M3_NTST) __builtin_nontemporal_store(w, (u32x4*)(mixed + ((unsigned)((t0 + 64 * (PASS) + rl) * 4096 + 8 * c8)))); \
                else *(u32x4*)(mixed + ((unsigned)((t0 + 64 * (PASS) + rl) * 4096 + 8 * c8))) = w; } } } while (0)
        __builtin_amdgcn_sched_barrier(0);
        if constexpr (GEARLY) {
#pragma unroll
            for (int i = 0; i < NI; ++i) { gv0[i] = gvE0[i]; gv1[i] = gvE1[i]; } }
        else M3_GROWS(gv0, 0);
        {   M3_LANE();
#pragma unroll
            for (int rt = 0; rt < 8; ++rt) { float s1 = 0.f, s2 = 0.f;
#pragma unroll
                for (int ct = 0; ct < CT; ++ct)
#pragma unroll
                    for (int r = 0; r < 4; ++r) { const float x = acc[rt][ct][r]; s1 += x; s2 += x * x; }
                s1 += __shfl_xor(s1, 16); s1 += __shfl_xor(s1, 32); s2 += __shfl_xor(s2, 16); s2 += __shfl_xor(s2, 32);
                if (lq == 0) STATS[(16 * rt + lr) * 8 + wave] = (f32x2){s1, s2}; } }
        __syncthreads();
        M3_NORM(0);
        if constexpr (!GEARLY) M3_GROWS(gv1, 1);
        __syncthreads();
        M3_OUT(gv0, 0);
        __syncthreads();
        M3_NORM(1);
        __syncthreads();
        M3_OUT(gv1, 1);
        if (MK_M3_DEFER) { pend.mixed = mixed; pend.t0 = t0; pend.lpr = LPR; }
#undef M3_GROWS
#undef M3_NORM
#undef M3_OUT
    }
#endif
    __syncthreads();
#undef M3_LOADV
#undef M3_LOADS
#undef M3_LOADSTEP
}
#undef QFRAG
#undef PFRAG
#undef M3_BASES
#undef M3_PBASES
#undef M3_LANE
template <class AT> __device__ __forceinline__ void m3_phase(const AT& a, int l, LAS unsigned char* lds, int tid, int lane, int wave, int bid, int G, int probe = 0) {
    bf16_t* const mixr = (MK_M3_PROBE == 5 && probe) ? a.h + (size_t)bid * 32768 : a.mixed;
    M3Pend pend; pend.lpr = 0; pend.mixed = nullptr; pend.t0 = 0;
    const bool flip = MK_M3_FLIP && ((bid >> 4) & 1);
#pragma unroll 1
    for (int s_ = 0; s_ < 2; ++s_) {
    if ((s_ == 0) != flip) {
    for (int u = bid; u < 256; u += G) { if (MK_M3_DEFER) m3_flush(pend, tid, wave); const int rh = MK_M3_UNPAIR ? (u & 1) : (u >> 3) & 1, idx = MK_M3_UNPAIR ? (u >> 1) : (u & 7) | ((u >> 4) << 3), h = idx >> 5, c2 = idx & 31, t0 = 256 * c2 + 128 * rh, tk0 = 256 * c2;
        if (rh) m3_unit<4, false, 2, MK_M3_RDG, false>(lds, a.qg + h * 256, 1024, a.kg + h * 256, (MK_VT_BLK ? a.vgt + ((size_t)c2 * 2048 + h * 512) * 256 : a.vgt + (size_t)(h * 512) * T), a.kvg + (size_t)(h * 32 + c2) * 131072, a.sgg + h * 512, a.gla_gain + l * 2048 + h * 512, ((MK_M3_PROBE == 5 && probe) ? mixr : a.mixed + 2048 + h * 512), t0, tk0, tid, wave, pend, probe);
        else    m3_unit<4, false, 1, MK_M3_RDG, false>(lds, a.qg + h * 256, 1024, a.kg + h * 256, (MK_VT_BLK ? a.vgt + ((size_t)c2 * 2048 + h * 512) * 256 : a.vgt + (size_t)(h * 512) * T), a.kvg + (size_t)(h * 32 + c2) * 131072, a.sgg + h * 512, a.gla_gain + l * 2048 + h * 512, ((MK_M3_PROBE == 5 && probe) ? mixr : a.mixed + 2048 + h * 512), t0, tk0, tid, wave, pend, probe); }
    } else {
    for (int u = bid; u < 512; u += G) { const int rh = (MK_M3_UNPAIR ? (u & 1) : (u >> 3) & 1) ^ 1  , idx = MK_M3_UNPAIR ? (u >> 1) : (u & 7) | ((u >> 4) << 3), h = idx >> 5, c2 = idx & 31, t0 = 256 * c2 + 128 * rh, tk0 = 256 * c2;
        if (rh) m3_unit<2, true, 2, MK_M3_RDR, true>(lds, a.qr + h * 256, 2048, a.kr + h * 256, (MK_VT_BLK ? a.vrt + ((size_t)c2 * 2048 + h * 256) * 256 : a.vrt + (size_t)(h * 256) * T), a.kvr + (size_t)(h * 32 + c2) * 65536, a.srg + h * 256, a.ret_gain + l * 2048 + h * 256, ((MK_M3_PROBE == 5 && probe) ? mixr : a.mixed + h * 256), t0, tk0, tid, wave, pend, probe);
        else    m3_unit<2, true, 1, MK_M3_RDR, true>(lds, a.qr + h * 256, 2048, a.kr + h * 256, (MK_VT_BLK ? a.vrt + ((size_t)c2 * 2048 + h * 256) * 256 : a.vrt + (size_t)(h * 256) * T), a.kvr + (size_t)(h * 32 + c2) * 65536, a.srg + h * 256, a.ret_gain + l * 2048 + h * 256, ((MK_M3_PROBE == 5 && probe) ? mixr : a.mixed + h * 256), t0, tk0, tid, wave, pend, probe); }
    }
    }
    if (MK_M3_DEFER) m3_flush(pend, tid, wave);
}

template <class AT> __device__ __forceinline__ void final_phase(const AT& a, const u64* ss, int tid, int bid, int G) {
    const size_t n8 = (size_t)T * D / 8, stride = (size_t)G * NTHR; const size_t i00 = (size_t)bid * NTHR + tid;
    const bool colfix = (stride & 511) == 0;
    f32x4 g0 = ((const f32x4*)a.final_norm)[2 * (int)(i00 & 511)], g1 = ((const f32x4*)a.final_norm)[2 * (int)(i00 & 511) + 1];
    u32x4 v[2][8]; u64 sv[2][8];
#define FIN_LOAD(B, i0_) do { _Pragma("unroll") for (int j = 0; j < 8; ++j) { const size_t i = (i0_) + j * stride; const bool ok = i < n8; \
        v[B][j] = ok ? MK_NTLD(((const u32x4*)a.xb) + i) : (u32x4){0u, 0u, 0u, 0u}; sv[B][j] = ok ? ss[i >> 9] : 0ull; } } while (0)
#define FIN_STORE(B, i0_) do { _Pragma("unroll") for (int j = 0; j < 8; ++j) { const size_t i = (i0_) + j * stride; if (i < n8) { \
        if (!colfix) { const int c8 = (int)(i & 511); g0 = ((const f32x4*)a.final_norm)[2 * c8]; g1 = ((const f32x4*)a.final_norm)[2 * c8 + 1]; } \
        const float r = rs_of(sv[B][j]); const u32x4 x = v[B][j]; \
        f32x4 o0, o1; o0[0] = bf_lo(x.x) * r * g0[0]; o0[1] = bf_hi(x.x) * r * g0[1]; o0[2] = bf_lo(x.y) * r * g0[2]; o0[3] = bf_hi(x.y) * r * g0[3]; \
        o1[0] = bf_lo(x.z) * r * g1[0]; o1[1] = bf_hi(x.z) * r * g1[1]; o1[2] = bf_lo(x.w) * r * g1[2]; o1[3] = bf_hi(x.w) * r * g1[3]; \
        if (MK_FIN_NT) { __builtin_nontemporal_store(o0, ((f32x4*)a.out) + 2 * i); __builtin_nontemporal_store(o1, ((f32x4*)a.out) + 2 * i + 1); } else { ((f32x4*)a.out)[2 * i] = o0; ((f32x4*)a.out)[2 * i + 1] = o1; } } } } while (0)
    if (i00 < n8) FIN_LOAD(0, i00);
#pragma unroll 1
    for (size_t i0 = i00; i0 < n8; i0 += 16 * stride) {
        const size_t i1 = i0 + 8 * stride, i2 = i0 + 16 * stride;
        if (i1 < n8) FIN_LOAD(1, i1);
        FIN_STORE(0, i0);
        if (i1 < n8) { if (i2 < n8) FIN_LOAD(0, i2); FIN_STORE(1, i1); }
    }
#undef FIN_LOAD
#undef FIN_STORE
}

#ifndef MK_PH
#define MK_PH 1023
#endif
#ifndef MK_SP2
#define MK_SP2 true
#endif
#ifndef MK_ALIGN
#define MK_ALIGN true
#endif
#ifndef MK_STAG_SHIFT
#define MK_STAG_SHIFT 6
#endif
#ifndef MK_STAG
#define MK_STAG 0
#endif
#define STAGGER() do { if (MK_STAG) { const unsigned long long t0_ = __builtin_amdgcn_s_memrealtime(); const unsigned long long w_ = (unsigned long long)(((bid >> MK_STAG_SHIFT) & 3) * MK_STAG); while (__builtin_amdgcn_s_memrealtime() - t0_ < w_) __builtin_amdgcn_s_sleep(8); } } while (0)
#ifndef MK_REP_P0
#define MK_REP_P0 1
#endif
#ifndef MK_REP_G1
#define MK_REP_G1 1
#endif
#ifndef MK_REP_PREP
#define MK_REP_PREP 1
#endif
#ifndef MK_REP_M1
#define MK_REP_M1 1
#endif
#ifndef MK_REP_M3
#define MK_REP_M3 1
#endif
#ifndef MK_REP_G3
#define MK_REP_G3 1
#endif
#ifndef MK_REP_M12
#define MK_REP_M12 1
#endif
#ifndef MK_REP_FIN
#define MK_REP_FIN 1
#endif
#ifndef MK_REP_G2
#define MK_REP_G2 1
#endif
#ifndef MK_REP_G4
#define MK_REP_G4 1
#endif
#define REPEAT(n, k) for (int rep_ = 0; rep_ < (n); ++rep_, ((rep_ < (n)) ? xcd_barrier(bar) : (void)0))
typedef const Args __attribute__((address_space(4))) CArgs;
#define KARGS() ({ const CArgs* p_ = (const CArgs*)__builtin_amdgcn_kernarg_segment_ptr(); asm volatile("" : "+s"(p_)); p_; })
__global__ void __launch_bounds__(NTHR, 2) mk_fwd(Args args_unused) {
    extern __shared__ __attribute__((aligned(16))) unsigned char lds_raw[];
    LAS unsigned char* lds = (LAS unsigned char*)lds_raw;
    const int bid = blockIdx.x, G = gridDim.x;
    volatile LAS unsigned* MISC = (volatile LAS unsigned*)(lds + LDSCTL_OFF);
    if (threadIdx.x < 64) MISC[threadIdx.x] = 0u;
    const int wave_s = __builtin_amdgcn_readfirstlane((int)(threadIdx.x >> 6));
#define MK_TID() ({ int w_ = wave_s; unsigned z_ = 0u; asm volatile("" : "+s"(w_), "+v"(z_)); (w_ << 6) | (int)__builtin_amdgcn_mbcnt_hi(~0u, __builtin_amdgcn_mbcnt_lo(~0u, z_)); })
#define LANEIDS() int tid = MK_TID(); asm volatile("" : "+v"(tid)); const int lane = tid & 63, wave = __builtin_amdgcn_readfirstlane(tid >> 6); (void)lane; (void)wave
    __syncthreads();
    (void)xcd_barrier_post(KARGS()->ctl + CW_BAR, MISC + 8);
#define bar (XcdBarrier{KARGS()->ctl + CW_BAR, xb_xcc_id(), MISC + 8, (MK_TID() == 0) ? 1u : 0u})
#if MK_SPLIT || MK_DEBUG
#define IN(k) (KARGS()->ph_lo <= (k) && (k) < KARGS()->ph_hi)
#else
#define IN(k) true
#endif
#if MK_TIMING
#define STAMP(k) do { if (blockIdx.x == 0 && threadIdx.x == 0) KARGS()->ctl[CW_TS + (k)] = (unsigned)__builtin_amdgcn_s_memrealtime(); } while (0)
#else
#define STAMP(k) do { } while (0)
#endif
#define SEAM(k) do { if (IN(k) && IN((k) + 1)) xcd_barrier(bar); STAMP((k) + 1); } while (0)
    STAMP(0);
#define SSB() ((u64*)(KARGS()->ctl + CW_SS))

    if (MK_PH & 256) if (IN(0)) REPEAT(MK_REP_P0, 0) { LANEIDS(); p0_prologue(*KARGS(), lds, tid, lane, wave, bid, G); }
    SEAM(0);
#ifdef MK_XBAR
    for (int xb_ = 0; xb_ < MK_XBAR; ++xb_) xcd_barrier(bar);
#endif
    for (int l = 0; l < 2; ++l) {
        const int pb = 1 + 8 * l;
        if (MK_PH & 1) if (IN(pb + 0)) REPEAT(MK_REP_G1, 1) {
            const CArgs& a = *KARGS(); const u64* ss_in = SSB() + (size_t)(2 * l) * T;
            { LANEIDS(); ga_stage(a, l, ss_in, lds, tid, lane, wave, bid, G); }
            pg8::Gemm g{a.xb, a.win_t[l], D, 2 * D, 128, 2 * D, 128}; pg8::ProjOrder S; S.init(T / 256, NPROJ / 256, G, bid);
            pg8::EpiProj E{ss_in, a.pos, a.qr, a.kr, a.vrt, a.srg, a.gq, a.gk, a.vgt, a.sgg, (MK_G1_PROBE && rep_ + 1 < MK_REP_G1) ? 1 : 0};
            STAGGER(); pg8::gemm_phase<pg8::EpiProj, pg8::ProjOrder, MK_ALIGN, MK_SP2>(lds, g, S, E, MK_TID());
        }
        SEAM(pb + 0);
        if (MK_PH & 2) if (IN(pb + 1)) REPEAT(MK_REP_PREP, 2) { LANEIDS(); prep_phase(*KARGS(), l, lds, tid, lane, wave, bid, G); }
        SEAM(pb + 1);
        for (int rep12 = 0; rep12 < MK_REP_M12; ++rep12) {
        if (rep12) xcd_barrier(bar);
        if (MK_PH & 4) if (IN(pb + 2)) REPEAT(MK_REP_M1, 3) { LANEIDS(); m1_phase(*KARGS(), lds, tid, wave, bid, G); }
        SEAM(pb + 2);
        if (MK_PH & 8) if (IN(pb + 3)) { LANEIDS(); m2_phase(*KARGS(), tid, bid, G); }
        }
        SEAM(pb + 3);
        if (MK_PH & 16) if (IN(pb + 4)) REPEAT(MK_REP_M3, 5) { LANEIDS(); m3_phase(*KARGS(), l, lds, tid, lane, wave, bid, G, (MK_M3_PROBE && rep_ + 1 < MK_REP_M3) ? 1 : 0); }
        SEAM(pb + 4);
        if (MK_PH & 32) if (IN(pb + 5)) REPEAT(MK_REP_G2, 6) {
            const CArgs& a = *KARGS(); u64* ss_mid = SSB() + (size_t)(2 * l + 1) * T;
            pg8::Gemm g{a.mixed, a.wout_t[l], D, 2 * D, 128, MK_BLK_W ? 128 : 2 * D, MK_BLK_W ? D * 128 : 128}; pg8::StaticOrder S; S.init(T / 256, D / 256, G, bid);
            const bool lastrep_ = (rep_ == MK_REP_G2 - 1); pg8::EpiRes E{lastrep_ ? a.xb : (bf16_t*)((char*)a.qr + (size_t)200 * 1048576), lastrep_ ? ss_mid : (u64*)(a.ctl + CW_CHK), (u64*)(a.ctl + CW_CHK)};
            STAGGER(); pg8::gemm_phase<pg8::EpiRes, pg8::StaticOrder, MK_ALIGN, MK_SP2>(lds, g, S, E, MK_TID());
        }
        SEAM(pb + 5);
#if MK_TIMING
        if (l == 0 && blockIdx.x == 0 && threadIdx.x == 0) { KARGS()->ctl[CW_TS + 32] = (unsigned)__builtin_amdgcn_s_memtime(); KARGS()->ctl[CW_TS + 33] = (unsigned)__builtin_amdgcn_s_memrealtime(); }
#endif
        if (MK_PH & 64) if (IN(pb + 6)) REPEAT(MK_REP_G3, 7) {
            const CArgs& a = *KARGS(); const u64* ss_mid = SSB() + (size_t)(2 * l + 1) * T;
            pg8::Gemm g{a.xb, a.wgu_t[l], D, 2 * D, 128, MK_BLK_W ? 128 : 2 * D, MK_BLK_W ? 2 * FF * 128 : 128}; pg8::StaticOrder S; S.init(T / 256, 2 * FF / 256, G, bid);
            pg8::EpiSwiGLU E{ss_mid, a.h};
            STAGGER(); pg8::gemm_phase<pg8::EpiSwiGLU, pg8::StaticOrder, MK_ALIGN, MK_SP2>(lds, g, S, E, MK_TID());
        }
#if MK_TIMING
        if (l == 0 && blockIdx.x == 0 && threadIdx.x == 0) { KARGS()->ctl[CW_TS + 34] = (unsigned)__builtin_amdgcn_s_memtime(); KARGS()->ctl[CW_TS + 35] = (unsigned)__builtin_amdgcn_s_memrealtime(); }
#endif
        SEAM(pb + 6);
        if (MK_PH & 128) if (IN(pb + 7)) REPEAT(MK_REP_G4, 8) {
            const CArgs& a = *KARGS(); u64* ss_out = SSB() + (size_t)(2 * l + 2) * T;
            pg8::Gemm g{a.h, a.wd_t[l], FF, 128, T * 128, MK_BLK_W ? 128 : 2 * FF, MK_BLK_W ? D * 128 : 128}  ; pg8::StaticOrder S; S.init(T / 256, D / 256, G, bid);
            const bool lastrep_ = (rep_ == MK_REP_G4 - 1); pg8::EpiRes E{lastrep_ ? a.xb : (bf16_t*)((char*)a.qr + (size_t)200 * 1048576), lastrep_ ? ss_out : (u64*)(a.ctl + CW_CHK), (u64*)(a.ctl + CW_CHK)};
            STAGGER(); pg8::gemm_phase<pg8::EpiRes, pg8::StaticOrder, MK_ALIGN, MK_SP2>(lds, g, S, E, MK_TID());
        }
        SEAM(pb + 7);
    }
    if (MK_PH & 512) if (IN(17)) REPEAT(MK_REP_FIN, 17) { LANEIDS(); final_phase(*KARGS(), SSB() + (size_t)4 * T, tid, bid, G); }
    STAMP(18);
#undef IN
#undef SEAM
}

#ifndef MK_WS_ALIGN
#define MK_WS_ALIGN 256
#endif
struct Layout { size_t off; size_t take(size_t bytes) { const size_t al = MK_WS_ALIGN; off = (off + al - 1) / al * al; const size_t o = off; off += bytes; return o; } };
static size_t build_args(Args& a, void* const* d_in, void* d_out, unsigned char* ws, size_t base, int cvt_mask, int cvt_layers) {
    a.x = (const float*)d_in[0]; a.pos = (const int*)d_in[1]; a.mix_norm = (const float*)d_in[2]; a.w_in = (const float*)d_in[3]; a.gla_w_up = (const float*)d_in[4]; a.gla_b = (const float*)d_in[5];
    a.ret_gain = (const float*)d_in[6]; a.gla_gain = (const float*)d_in[7]; a.w_out = (const float*)d_in[8]; a.ffn_norm = (const float*)d_in[9]; a.w_gate = (const float*)d_in[10]; a.w_up = (const float*)d_in[11];
    a.w_down = (const float*)d_in[12]; a.final_norm = (const float*)d_in[13]; a.out = (float*)d_out;
    Layout L{base};
    a.ctl = (unsigned*)(ws + L.take(CTL_ZERO_BYTES));
    for (int l = 0; l < 2; ++l) { const bool on = l < cvt_layers;
        a.win_t[l] = (bf16_t*)(ws + ((on && (cvt_mask & 1)) ? L.take((size_t)NPROJ * D * 2) : L.off)); a.wga_t[l] = (bf16_t*)(ws + ((on && (cvt_mask & 1)) ? L.take((size_t)16 * D * 2) : L.off));
        a.wout_t[l] = (bf16_t*)(ws + ((on && (cvt_mask & 2)) ? L.take((size_t)D * D * 2) : L.off)); a.wgu_t[l] = (bf16_t*)(ws + ((on && (cvt_mask & 4)) ? L.take((size_t)2 * FF * D * 2) : L.off));
        a.wd_t[l] = (bf16_t*)(ws + ((on && (cvt_mask & 8)) ? L.take((size_t)D * FF * 2) : L.off)); }
    a.xb = (bf16_t*)(ws + L.take((size_t)T * D * 2)); a.rot = nullptr; a.ga = (float*)(ws + L.take((size_t)T * 16 * 4)); a.lam = (float*)(ws + L.take((size_t)64 * 1024 * 4));
    a.mixed = (bf16_t*)(ws + L.take((size_t)T * D * 2));
    const size_t ov0 = L.off;
    a.qr = (bf16_t*)(ws + L.take((size_t)T * 2048 * 2)); a.kr = (bf16_t*)(ws + L.take((size_t)T * 2048 * 2)); a.krt = nullptr; a.vrt = (bf16_t*)(ws + L.take((size_t)T * 2048 * 2));
    a.srg = (bf16_t*)(ws + L.take((size_t)T * 2048 * 2)); a.gq = (bf16_t*)(ws + L.take((size_t)T * 1024 * 2)); a.gk = (bf16_t*)(ws + L.take((size_t)T * 1024 * 2)); a.qg = (bf16_t*)(ws + L.take((size_t)T * 1024 * 2));
    a.kg = (bf16_t*)(ws + L.take((size_t)T * 1024 * 2)); a.kgt = nullptr; a.vgt = (bf16_t*)(ws + L.take((size_t)T * 2048 * 2)); a.sgg = (bf16_t*)(ws + L.take((size_t)T * 2048 * 2));
    a.kvr = (bf16_t*)(ws + L.take((size_t)8 * 64 * 65536 * 2)); a.kvg = (bf16_t*)(ws + L.take((size_t)4 * 64 * 131072 * 2));
    a.h = (bf16_t*)(ws + ov0);
    if (L.off < ov0 + (size_t)T * FF * 2) L.off = ov0 + (size_t)T * FF * 2;
    a.cvt_mask = cvt_mask; a.cvt_layers = cvt_layers;
    return L.off;
}
static int g_grid = 0;
static bool setup_once() {
    if (g_grid) return g_grid > 0;
    int dev = 0, cus = 0, per_cu = 0;
    if (hipGetDevice(&dev) != hipSuccess || hipDeviceGetAttribute(&cus, hipDeviceAttributeMultiprocessorCount, dev) != hipSuccess) { fprintf(stderr, "mk: device query failed\n"); g_grid = -1; return false; }
    if (hipFuncSetAttribute((const void*)mk_fwd, hipFuncAttributeMaxDynamicSharedMemorySize, LDS_BYTES) != hipSuccess) { fprintf(stderr, "mk: hipFuncSetAttribute failed\n"); g_grid = -1; return false; }
    if (hipOccupancyMaxActiveBlocksPerMultiprocessor(&per_cu, (const void*)mk_fwd, NTHR, LDS_BYTES) != hipSuccess || per_cu < 1) { fprintf(stderr, "mk: occupancy query says %d blocks per CU\n", per_cu); (void)hipGetLastError(); }
    g_grid = cus;
    return true;
}
static void launch_range(Args a, int lo, int hi, hipStream_t stream, bool zero_bar = true) {
    if (zero_bar) (void)hipMemsetAsync((char*)a.ctl + (size_t)CW_BAR * 4, 0, (size_t)XCD_BAR_WORDS * 4, stream);
    a.ph_lo = lo; a.ph_hi = hi;
    hipLaunchKernelGGL(mk_fwd, dim3(g_grid), dim3(NTHR), LDS_BYTES, stream, a);
    const hipError_t e = hipPeekAtLastError(); if (e != hipSuccess) fprintf(stderr, "mk: launch [%d,%d) failed: %s\n", lo, hi, hipGetErrorName(e));
}
}
#if MK_DEBUG
namespace nv {
constexpr int T_ = 8192, D_ = 4096, INW = 14352, FF_ = 11008;
constexpr int O_RQ = 0, O_RK = 2048, O_RV = 4096, O_RG = 6144, O_GQ = 8192, O_GK = 9216, O_GV = 10240, O_GG = 12288, O_GA = 14336;

__global__ __launch_bounds__(256) void k_rmsnorm(const float* __restrict__ x, const float* __restrict__ g, float* __restrict__ out) {
    const int row = blockIdx.x; const float* xr = x + (size_t)row * D_;
    float s = 0.f;
    for (int i = threadIdx.x; i < D_; i += 256) { const float v = xr[i]; s += v * v; }
    __shared__ float red[4];
    for (int o = 32; o > 0; o >>= 1) s += __shfl_xor(s, o);
    if ((threadIdx.x & 63) == 0) red[threadIdx.x >> 6] = s;
    __syncthreads();
    s = red[0] + red[1] + red[2] + red[3];
    const float r = 1.0f / sqrtf(s / (float)D_ + 1e-6f);
    for (int i = threadIdx.x; i < D_; i += 256) out[(size_t)row * D_ + i] = xr[i] * r * g[i];
}

template <int EPI>
__global__ __launch_bounds__(256) void k_sgemm(const float* __restrict__ A, const float* __restrict__ B, float* __restrict__ C, const float* __restrict__ R, int M, int N, int K) {
    __shared__ float As[16][132];
    __shared__ float Bs[16][132];
    const int bm = blockIdx.y * 128, bn = blockIdx.x * 128;
    const int tid = threadIdx.x, tx = tid & 15, ty = tid >> 4;
    float acc[8][8];
#pragma unroll
    for (int i = 0; i < 8; ++i)
#pragma unroll
        for (int j = 0; j < 8; ++j) acc[i][j] = 0.f;
    for (int k0 = 0; k0 < K; k0 += 16) {
#pragma unroll
        for (int i = 0; i < 2; ++i) {
            const int idx = tid + i * 256, r = idx >> 2, c4 = (idx & 3) * 4;
            const float4 v = *(const float4*)&A[(size_t)(bm + r) * K + k0 + c4];
            As[c4 + 0][r] = v.x; As[c4 + 1][r] = v.y; As[c4 + 2][r] = v.z; As[c4 + 3][r] = v.w;
        }
#pragma unroll
        for (int i = 0; i < 2; ++i) {
            const int idx = tid + i * 256, kr = idx >> 5, c4 = (idx & 31) * 4;
            float4 v = make_float4(0.f, 0.f, 0.f, 0.f);
            if (bn + c4 < N) v = *(const float4*)&B[(size_t)(k0 + kr) * N + bn + c4];
            *(float4*)&Bs[kr][c4] = v;
        }
        __syncthreads();
#pragma unroll
        for (int kk = 0; kk < 16; ++kk) {
            float a[8], b[8];
            const float4 a0 = *(const float4*)&As[kk][ty * 8], a1 = *(const float4*)&As[kk][ty * 8 + 4];
            const float4 b0 = *(const float4*)&Bs[kk][tx * 8], b1 = *(const float4*)&Bs[kk][tx * 8 + 4];
            a[0] = a0.x; a[1] = a0.y; a[2] = a0.z; a[3] = a0.w; a[4] = a1.x; a[5] = a1.y; a[6] = a1.z; a[7] = a1.w;
            b[0] = b0.x; b[1] = b0.y; b[2] = b0.z; b[3] = b0.w; b[4] = b1.x; b[5] = b1.y; b[6] = b1.z; b[7] = b1.w;
#pragma unroll
            for (int i = 0; i < 8; ++i)
#pragma unroll
                for (int j = 0; j < 8; ++j) acc[i][j] = fmaf(a[i], b[j], acc[i][j]);
        }
        __syncthreads();
    }
#pragma unroll
    for (int i = 0; i < 8; ++i) {
        const int r = bm + ty * 8 + i;
#pragma unroll
        for (int j4 = 0; j4 < 2; ++j4) {
            const int c = bn + tx * 8 + j4 * 4;
            if (c < N) {
                float4 v = make_float4(acc[i][j4 * 4 + 0], acc[i][j4 * 4 + 1], acc[i][j4 * 4 + 2], acc[i][j4 * 4 + 3]);
                if (EPI == 1) { const float4 rr = *(const float4*)&R[(size_t)r * N + c]; v.x += rr.x; v.y += rr.y; v.z += rr.z; v.w += rr.w; }
                if (EPI == 2) { const float4 gg = *(const float4*)&C[(size_t)r * N + c]; v.x *= gg.x / (1.0f + __expf(-gg.x)); v.y *= gg.y / (1.0f + __expf(-gg.y)); v.z *= gg.z / (1.0f + __expf(-gg.z)); v.w *= gg.w / (1.0f + __expf(-gg.w)); }
                *(float4*)&C[(size_t)r * N + c] = v;
            }
        }
    }
}

__device__ __forceinline__ float siluf(float x) { return x / (1.0f + __expf(-x)); }

__global__ __launch_bounds__(256) void k_rotary(float* __restrict__ proj, const int* __restrict__ pos) {
    const size_t gid = (size_t)blockIdx.x * 256 + threadIdx.x;
    const int i = (int)(gid & 127), h = (int)((gid >> 7) & 7), w = (int)((gid >> 10) & 1); const int t = (int)(gid >> 11);
    if (t >= T_) return;
    const float inv_freq = powf(10000.0f, -(float)i / 128.0f);
    const float ang = (float)pos[t] * inv_freq;
    const double rev = (double)ang * 0.15915494309189533577;
    const float fr = (float)(rev - floor(rev));
    const float c = __builtin_amdgcn_cosf(fr), s = __builtin_amdgcn_sinf(fr);
    float* p = proj + (size_t)t * INW + (w ? O_RK : O_RQ) + h * 256 + i;
    const float t1 = p[0], t2 = p[128];
    p[0] = t1 * c - t2 * s; p[128] = t1 * s + t2 * c;
}

__global__ __launch_bounds__(256) void k_gate(const float* __restrict__ proj, const float* __restrict__ wup, const float* __restrict__ b, float* __restrict__ loga) {
    const int t = blockIdx.x;
    const float* ga = proj + (size_t)t * INW + O_GA;
    for (int c = threadIdx.x; c < 1024; c += 256) {
        float z = b[c];
#pragma unroll
        for (int r = 0; r < 16; ++r) z = fmaf(ga[r], wup[r * 1024 + c], z);
        const float ls = fminf(z, 0.f) - log1pf(expf(-fabsf(z)));
        loga[(size_t)t * 1024 + c] = ls * (1.0f / 16.0f);
    }
}

template <int GLA>
__global__ __launch_bounds__(256) void k_recur(const float* __restrict__ proj, int qoff, int koff, int voff, int dv, const float* __restrict__ loga, float qs, float ks, float* __restrict__ out, int ostride) {
    const int vt = blockIdx.x, h = blockIdx.y, d = threadIdx.x, lane = d & 63, wave = d >> 6;
    float S[16];
#pragma unroll
    for (int j = 0; j < 16; ++j) S[j] = 0.f;
    const float gamma = 1.0f - exp2f(-5.0f - (float)h);
    __shared__ float part[2][4][16];
    for (int t = 0; t < T_; ++t) {
        const float* row = proj + (size_t)t * INW;
        const float q = row[qoff + h * 256 + d] * qs, k = row[koff + h * 256 + d] * ks;
        const float a = GLA ? expf(loga[(size_t)t * 1024 + h * 256 + d]) : gamma;
        float p[16];
#pragma unroll
        for (int j4 = 0; j4 < 4; ++j4) {
            const float4 v = *(const float4*)&row[voff + h * dv + vt * 16 + j4 * 4];
            S[j4 * 4 + 0] = a * S[j4 * 4 + 0] + k * v.x; S[j4 * 4 + 1] = a * S[j4 * 4 + 1] + k * v.y;
            S[j4 * 4 + 2] = a * S[j4 * 4 + 2] + k * v.z; S[j4 * 4 + 3] = a * S[j4 * 4 + 3] + k * v.w;
        }
#pragma unroll
        for (int j = 0; j < 16; ++j) p[j] = q * S[j];
#pragma unroll
        for (int j = 0; j < 16; ++j)
#pragma unroll
            for (int o = 32; o > 0; o >>= 1) p[j] += __shfl_xor(p[j], o);
        if (lane == 0) {
#pragma unroll
            for (int j = 0; j < 16; ++j) part[t & 1][wave][j] = p[j];
        }
        __syncthreads();
        if (d < 16) out[(size_t)t * ostride + h * dv + vt * 16 + d] = part[t & 1][0][d] + part[t & 1][1][d] + part[t & 1][2][d] + part[t & 1][3][d];
    }
}

__global__ __launch_bounds__(256) void k_headnorm(const float* __restrict__ proj, const float* __restrict__ ro, const float* __restrict__ go, const float* __restrict__ rgain, const float* __restrict__ ggain, float* __restrict__ mixed) {
    const int t = blockIdx.x, tid = threadIdx.x, lane = tid & 63, wave = tid >> 6;
    const float* row = proj + (size_t)t * INW;
    for (int hh = 0; hh < 2; ++hh) {
        const int h = wave * 2 + hh;
        float v[4]; float s = 0.f;
#pragma unroll
        for (int j = 0; j < 4; ++j) { v[j] = ro[(size_t)t * 2048 + h * 256 + lane + 64 * j]; s += v[j]; }
        for (int o = 32; o > 0; o >>= 1) s += __shfl_xor(s, o);
        const float mu = s / 256.f; float q = 0.f;
#pragma unroll
        for (int j = 0; j < 4; ++j) { v[j] -= mu; q += v[j] * v[j]; }
        for (int o = 32; o > 0; o >>= 1) q += __shfl_xor(q, o);
        const float rs = 1.0f / sqrtf(q / 256.f + 1e-6f);
#pragma unroll
        for (int j = 0; j < 4; ++j) { const int c = h * 256 + lane + 64 * j; mixed[(size_t)t * D_ + c] = siluf(row[O_RG + c]) * (v[j] * rs * rgain[c]); }
    }
    {
        const int h = wave;
        float v[8]; float q = 0.f;
#pragma unroll
        for (int j = 0; j < 8; ++j) { v[j] = go[(size_t)t * 2048 + h * 512 + lane + 64 * j]; q += v[j] * v[j]; }
        for (int o = 32; o > 0; o >>= 1) q += __shfl_xor(q, o);
        const float rs = 1.0f / sqrtf(q / 512.f + 1e-6f);
#pragma unroll
        for (int j = 0; j < 8; ++j) { const int c = h * 512 + lane + 64 * j; mixed[(size_t)t * D_ + 2048 + c] = siluf(row[O_GG + c]) * (v[j] * rs * ggain[c]); }
    }
}

__global__ __launch_bounds__(256) void k_swiglu(float* __restrict__ G, const float* __restrict__ U, size_t n4) {
    for (size_t i = (size_t)blockIdx.x * 256 + threadIdx.x; i < n4; i += (size_t)gridDim.x * 256) {
        float4 g = ((float4*)G)[i]; const float4 u = ((const float4*)U)[i];
        g.x = siluf(g.x) * u.x; g.y = siluf(g.y) * u.y; g.z = siluf(g.z) * u.z; g.w = siluf(g.w) * u.w;
        ((float4*)G)[i] = g;
    }
}

inline void forward(void* const* d_in, float* out, float* ws, size_t ws_size, hipStream_t st) {
    const float* x = (const float*)d_in[0]; const int* pos = (const int*)d_in[1];
    const float* mix_norm = (const float*)d_in[2]; const float* w_in = (const float*)d_in[3];
    const float* gla_w_up = (const float*)d_in[4]; const float* gla_b = (const float*)d_in[5];
    const float* ret_gain = (const float*)d_in[6]; const float* gla_gain = (const float*)d_in[7];
    const float* w_out = (const float*)d_in[8]; const float* ffn_norm = (const float*)d_in[9];
    const float* w_gate = (const float*)d_in[10]; const float* w_up = (const float*)d_in[11]; const float* w_down = (const float*)d_in[12];
    const float* final_norm = (const float*)d_in[13];
    size_t o = 0;
    float* xn = ws + o; o += (size_t)T_ * D_;
    float* proj = ws + o; o += (size_t)T_ * INW;
    float* loga = ws + o; o += (size_t)T_ * 1024;
    float* ro = ws + o; o += (size_t)T_ * 2048;
    float* go = ws + o; o += (size_t)T_ * 2048;
    float* mixed = ws + o; o += (size_t)T_ * D_;
    float* xa = ws + o; o += (size_t)T_ * D_;
    float* xb = ws + o; o += (size_t)T_ * D_;
    float* G = ws + o; o += (size_t)T_ * FF_;
    if (o * 4 > ws_size) { fprintf(stderr, "naive: ws too small: need %zu have %zu\n", o * 4, ws_size); return; }
    const float* xc = x;
    for (int l = 0; l < 2; ++l) {
        k_rmsnorm<<<T_, 256, 0, st>>>(xc, mix_norm + (size_t)l * D_, xn);
        k_sgemm<0><<<dim3((INW + 127) / 128, T_ / 128), 256, 0, st>>>(xn, w_in + (size_t)l * D_ * INW, proj, nullptr, T_, INW, D_);
        k_rotary<<<(T_ * 2048) / 256, 256, 0, st>>>(proj, pos);
        k_gate<<<T_, 256, 0, st>>>(proj, gla_w_up + (size_t)l * 16 * 1024, gla_b + (size_t)l * 1024, loga);
        k_recur<0><<<dim3(16, 8), 256, 0, st>>>(proj, O_RQ, O_RK, O_RV, 256, nullptr, 1.0f, 1.0f / 16.0f, ro, 2048);
        k_recur<1><<<dim3(32, 4), 256, 0, st>>>(proj, O_GQ, O_GK, O_GV, 512, loga, 1.0f / 16.0f, 1.0f, go, 2048);
        k_headnorm<<<T_, 256, 0, st>>>(proj, ro, go, ret_gain + (size_t)l * 2048, gla_gain + (size_t)l * 2048, mixed);
        k_sgemm<1><<<dim3(D_ / 128, T_ / 128), 256, 0, st>>>(mixed, w_out + (size_t)l * D_ * D_, xa, xc, T_, D_, D_);
        k_rmsnorm<<<T_, 256, 0, st>>>(xa, ffn_norm + (size_t)l * D_, xn);
        k_sgemm<0><<<dim3(FF_ / 128, T_ / 128), 256, 0, st>>>(xn, w_gate + (size_t)l * D_ * FF_, G, nullptr, T_, FF_, D_);
        k_sgemm<2><<<dim3(FF_ / 128, T_ / 128), 256, 0, st>>>(xn, w_up + (size_t)l * D_ * FF_, G, nullptr, T_, FF_, D_);
        k_sgemm<1><<<dim3(D_ / 128, T_ / 128), 256, 0, st>>>(G, w_down + (size_t)l * FF_ * D_, xb, xa, T_, D_, FF_);
        xc = xb;
    }
    k_rmsnorm<<<T_, 256, 0, st>>>(xc, final_norm, out);
}
}
#endif
#if MK_DEBUG
namespace dbg {
typedef unsigned short bf16_t;
constexpr int T = 8192, INW = 14352;
__device__ __forceinline__ float bf(bf16_t v) { return __uint_as_float((unsigned)v << 16); }
__device__ __forceinline__ void acc2(float* slot, float se, float sb) {
    for (int o = 32; o > 0; o >>= 1) { se += __shfl_xor(se, o); sb += __shfl_xor(sb, o); }
    if ((threadIdx.x & 63) == 0) { atomicAdd(slot, se); atomicAdd(slot + 1, sb); }
}
__global__ void k_cmp_bf16(const bf16_t* got, int gld, int transposed, const float* ref, int rld, int roff, int rows, int cols, int mode, float scale, float* slot) {
    float se = 0.f, sb = 0.f;
    for (size_t i = (size_t)blockIdx.x * blockDim.x + threadIdx.x; i < (size_t)rows * cols; i += (size_t)gridDim.x * blockDim.x) {
        const int r = (int)(i / cols), c = (int)(i % cols);
        float e = ref[(size_t)r * rld + roff + c] * scale;
        if (mode == 1) e = e / (1.0f + expf(-e));
        if (mode == 2 || mode == 3) { const int h = c >> 8; const float lg = log2f(1.0f - exp2f(-5.0f - (float)h)); const float ip1 = (float)((r & 127) + 1); e *= (mode == 2) ? exp2f(ip1 * lg) : exp2f(-ip1 * lg) * 0.0625f; }
        const float g = transposed ? bf(got[(size_t)c * gld + r]) : bf(got[(size_t)r * gld + c]);
        const float d = g - e; se += (d == d) ? d * d : 1e30f; sb += e * e;
    }
    acc2(slot, se, sb);
}
__global__ void k_cmp_f32(const float* got, int gld, const float* ref, int rld, int roff, int rows, int cols, float* slot) {
    float se = 0.f, sb = 0.f;
    for (size_t i = (size_t)blockIdx.x * blockDim.x + threadIdx.x; i < (size_t)rows * cols; i += (size_t)gridDim.x * blockDim.x) {
        const int r = (int)(i / cols), c = (int)(i % cols);
        const float e = ref[(size_t)r * rld + roff + c], g = got[(size_t)r * gld + c]; const float d = g - e; se += (d == d) ? d * d : 1e30f; sb += e * e; }
    acc2(slot, se, sb);
}
__global__ void k_cmp_tr(const bf16_t* a, int ald, const bf16_t* b, int bld, int rows, int cols, float* slot) {
    float se = 0.f, sb = 0.f;
    for (size_t i = (size_t)blockIdx.x * blockDim.x + threadIdx.x; i < (size_t)rows * cols; i += (size_t)gridDim.x * blockDim.x) {
        const int r = (int)(i / cols), c = (int)(i % cols); const float e = bf(a[(size_t)r * ald + c]), g = bf(b[(size_t)c * bld + r]); const float d = g - e; se += (d == d) ? d * d : 1e30f; sb += e * e; }
    acc2(slot, se, sb);
}
__global__ void k_cmp_ss(const float* ss, const float* ref, int rld, float* slot) {
    const int t = blockIdx.x; float s = 0.f; for (int i = threadIdx.x; i < 4096; i += 256) { const float v = ref[(size_t)t * rld + i]; s += v * v; }
    __shared__ float red[4]; for (int o = 32; o > 0; o >>= 1) s += __shfl_xor(s, o); if ((threadIdx.x & 63) == 0) red[threadIdx.x >> 6] = s; __syncthreads();
    if (threadIdx.x == 0) { const float e = red[0] + red[1] + red[2] + red[3], d = ss[t] - e; atomicAdd(slot, (d == d) ? d * d : 1e30f); atomicAdd(slot + 1, e * e); }
}
__global__ void k_cmp_gla(const bf16_t* qg, const bf16_t* kg, const float* lam, const float* proj, const float* loga, float* slot_q, float* slot_k, float* slot_l) {
    const int c = blockIdx.x, ch = blockIdx.y * 256 + threadIdx.x; float cum = 0.f, seq = 0.f, sbq = 0.f, sek = 0.f, sbk = 0.f;
    for (int tt = 0; tt < 128; ++tt) { const int t = c * 128 + tt; cum += loga[(size_t)t * 1024 + ch];
        const float eq = proj[(size_t)t * INW + 8192 + ch] * 0.0625f * expf(cum), ek = proj[(size_t)t * INW + 9216 + ch] * expf(-cum);
        float d = bf(qg[(size_t)t * 1024 + ch]) - eq; seq += (d == d) ? d * d : 1e30f; sbq += eq * eq; d = bf(kg[(size_t)t * 1024 + ch]) - ek; sek += (d == d) ? d * d : 1e30f; sbk += ek * ek; }
    const float el = expf(cum), dl = lam[c * 1024 + ch] - el;
    acc2(slot_q, seq, sbq); acc2(slot_k, sek, sbk); acc2(slot_l, (dl == dl) ? dl * dl : 1e30f, el * el);
}
__global__ void k_cmp_kv(const bf16_t* kb, int ldk, const bf16_t* vt, const bf16_t* kv, int DV, float* slot) {
    const int c = blockIdx.x, h = blockIdx.y, t0 = c * 128; float se = 0.f, sb = 0.f;
    for (int idx = threadIdx.x; idx < DV * 256; idx += 256) { const int v = idx >> 8, d = idx & 255; float e = 0.f;
        for (int j = 0; j < 128; ++j) e += bf(vt[(size_t)(h * DV + v) * T + t0 + j]) * bf(kb[(size_t)(t0 + j) * ldk + h * 256 + d]);
        const float g = bf(kv[((size_t)(h * 64 + c) * DV + v) * 256 + d]); const float dd = g - e; se += (dd == dd) ? dd * dd : 1e30f; sb += e * e; }
    acc2(slot, se, sb);
}
__global__ void k_cmp_s(const bf16_t* kb, int ldk, const bf16_t* vt, const bf16_t* sbuf, const float* lam, int DV, float* slot) {
    const int h = blockIdx.y; const int idx = blockIdx.x * 256 + threadIdx.x; const int v = idx >> 8, d = idx & 255; float se = 0.f, sb = 0.f, st = 0.f;
    const float lret = exp2f(128.0f * log2f(1.0f - exp2f(-5.0f - (float)h)));
    for (int c = 0; c < 64; ++c) { const float g = bf(sbuf[((size_t)(h * 64 + c) * DV + v) * 256 + d]); const float dd = g - st; se += (dd == dd) ? dd * dd : 1e30f; sb += st * st;
        float e = 0.f; for (int j = 0; j < 128; ++j) e += bf(vt[(size_t)(h * DV + v) * T + c * 128 + j]) * bf(kb[(size_t)(c * 128 + j) * ldk + h * 256 + d]);
        st = (lam ? lam[c * 1024 + h * 256 + d] : lret) * (st + e); }
    acc2(slot, se, sb);
}
__global__ void k_cmp_p(const bf16_t* q, const bf16_t* k, const bf16_t* pd, float* slot) {
    const int c = blockIdx.x, h = blockIdx.y, t0 = c * 128; float se[4] = {0.f, 0.f, 0.f, 0.f}, sb[4] = {0.f, 0.f, 0.f, 0.f};
    for (int idx = threadIdx.x; idx < 16384; idx += 256) { const int i = idx >> 7, j = idx & 127; float e = 0.f;
        for (int d = 0; d < 256; ++d) e += bf(q[(size_t)(t0 + i) * 2048 + h * 256 + d]) * bf(k[(size_t)(t0 + j) * 2048 + h * 256 + d]);
        const int cls = (j > i) ? 3 : ((i >> 4) != (j >> 4)) ? 0 : (j < i) ? 1 : 2;
        const float g = bf(pd[(size_t)(h * 64 + c) * 16384 + idx]); const float ee = (cls == 3) ? 0.f : e; const float dd = g - ee;
#pragma unroll
        for (int z = 0; z < 4; ++z) if (cls == z) { se[z] += (dd == dd) ? dd * dd : 1e30f; sb[z] += (z == 3) ? e * e : ee * ee; } }
#pragma unroll
    for (int z = 0; z < 4; ++z) acc2(slot + 2 * z, se[z], sb[z]);
}
__global__ void k_cmp_o(const bf16_t* q, const bf16_t* pd, const bf16_t* vt, const bf16_t* sbuf, const float* od, float* slot) {
    const int t = blockIdx.x, h = blockIdx.y, v = threadIdx.x, c = t >> 7, i = t & 127; float e = 0.f;
    for (int j = 0; j < 128; ++j) e += bf(pd[(size_t)(h * 64 + c) * 16384 + i * 128 + j]) * bf(vt[(size_t)(h * 256 + v) * T + c * 128 + j]);
    for (int d = 0; d < 256; ++d) e += bf(q[(size_t)t * 2048 + h * 256 + d]) * bf(sbuf[((size_t)(h * 64 + c) * 256 + v) * 256 + d]);
    const float g = od[(size_t)t * 2048 + h * 256 + v]; const float dd = g - e; acc2(slot, (dd == dd) ? dd * dd : 1e30f, e * e);
}
__global__ void k_decide(const float* slots, int n, const float* tol, float* code) {
    if (threadIdx.x || blockIdx.x) return; float cd = 9900.0f;
    for (int i = 0; i < n; ++i) { const float se = slots[2 * i], sb = slots[2 * i + 1]; const float rel = sqrtf(se / fmaxf(sb, 1e-30f));
        if (!(rel < tol[i]) || !(sb > 0.f)) { int b = (rel == rel && rel > 0.f) ? (int)floorf(2.0f * log10f(fmaxf(rel, 1e-3f) / 1e-3f)) : 20; b = b < 0 ? 0 : (b > 20 ? 20 : b); cd = (float)(10 + i) * powf(10.0f, (float)(2 + b)); break; } }
    *code = cd;
}
__global__ void k_fill_code(float* out, size_t n, const float* code) { const float c = *code; for (size_t i = (size_t)blockIdx.x * blockDim.x + threadIdx.x; i < n; i += (size_t)gridDim.x * blockDim.x) out[i] = c; }
}

extern "C" void kernel_launch(void* const* d_in, const int* in_sizes, int n_in, void* d_out, int out_size, void* d_ws, size_t ws_size, hipStream_t stream) {
    using namespace nv;
    if (!mk::setup_once()) return;
    hipStream_t st = stream; float* ws = (float*)d_ws;
    const float* x = (const float*)d_in[0]; const int* pos = (const int*)d_in[1]; const float* mix_norm = (const float*)d_in[2]; const float* w_in = (const float*)d_in[3];
    const float* gla_w_up = (const float*)d_in[4]; const float* gla_b = (const float*)d_in[5]; const float* ret_gain = (const float*)d_in[6]; const float* gla_gain = (const float*)d_in[7];
    const float* w_out = (const float*)d_in[8]; const float* ffn_norm = (const float*)d_in[9]; const float* w_gate = (const float*)d_in[10]; const float* w_up = (const float*)d_in[11]; const float* w_down = (const float*)d_in[12];
#if MK_DEBUG == 1
    size_t o = 0;
    float* xn = ws + o; o += (size_t)T_ * D_; float* proj = ws + o; o += (size_t)T_ * INW; float* loga = ws + o; o += (size_t)T_ * 1024; float* ro = ws + o; o += (size_t)T_ * 2048; float* go = ws + o; o += (size_t)T_ * 2048;
    float* mixed = ws + o; o += (size_t)T_ * D_; float* xa = ws + o; o += (size_t)T_ * D_;
    mk::Args a{}; size_t need = mk::build_args(a, d_in, d_out, (unsigned char*)d_ws, o * 4, 3, 1);
    a.dbgp = (bf16_t*)((unsigned char*)d_ws + need); need += (size_t)8 * 64 * 16384 * 2; a.dbgo = (float*)((unsigned char*)d_ws + need); need += (size_t)T_ * 2048 * 4;
    if (need > ws_size) { fprintf(stderr, "dbg: ws too small %zu > %zu\n", need, ws_size); return; }
    (void)hipMemsetAsync(a.ctl, 0, mk::CTL_ZERO_BYTES, st);
    k_rmsnorm<<<T_, 256, 0, st>>>(x, mix_norm, xn);
    k_sgemm<0><<<dim3((INW + 127) / 128, T_ / 128), 256, 0, st>>>(xn, w_in, proj, nullptr, T_, INW, D_);
    k_rotary<<<(T_ * 2048) / 256, 256, 0, st>>>(proj, pos);
    k_gate<<<T_, 256, 0, st>>>(proj, gla_w_up, gla_b, loga);
    k_recur<0><<<dim3(16, 8), 256, 0, st>>>(proj, O_RQ, O_RK, O_RV, 256, nullptr, 1.0f, 1.0f / 16.0f, ro, 2048);
    k_recur<1><<<dim3(32, 4), 256, 0, st>>>(proj, O_GQ, O_GK, O_GV, 512, loga, 1.0f / 16.0f, 1.0f, go, 2048);
    k_headnorm<<<T_, 256, 0, st>>>(proj, ro, go, ret_gain, gla_gain, mixed);
    k_sgemm<1><<<dim3(D_ / 128, T_ / 128), 256, 0, st>>>(mixed, w_out, xa, x, T_, D_, D_);
    float* slots = (float*)(a.ctl + mk::CW_CHK); float* tol = slots + 128; float* code = slots + 256;
#if MK_DBG_ONELAUNCH
    mk::launch_range(a, 0, 7, st);
#else
    for (int p = 0; p < 4; ++p) mk::launch_range(a, p, p + 1, st);
    dbg::k_cmp_kv<<<dim3(64, 8), 256, 0, st>>>(a.kr, 2048, a.vrt, a.kvr, 256, slots + 2 * 15);
    dbg::k_cmp_kv<<<dim3(64, 4), 256, 0, st>>>(a.kg, 1024, a.vgt, a.kvg, 512, slots + 2 * 16);
    mk::launch_range(a, 4, 5, st);
    dbg::k_cmp_s<<<dim3(256, 8), 256, 0, st>>>(a.kr, 2048, a.vrt, a.kvr, nullptr, 256, slots + 2 * 17);
    dbg::k_cmp_s<<<dim3(512, 4), 256, 0, st>>>(a.kg, 1024, a.vgt, a.kvg, a.lam, 512, slots + 2 * 18);
    mk::launch_range(a, 5, 6, st); mk::launch_range(a, 6, 7, st);
#endif
    const float* ss0 = (const float*)(a.ctl + mk::CW_SS); const float* ss1 = ss0 + T_;
    int n = 0; float htol[64];
    dim3 cg(2048), cb(256);
    dbg::k_cmp_ss<<<T_, 256, 0, st>>>(ss0, x, D_, slots + 2 * n); htol[n++] = 1e-4f;
    dbg::k_cmp_bf16<<<cg, cb, 0, st>>>(a.qr, 2048, 0, proj, INW, O_RQ, T_, 2048, 2, 1.0f, slots + 2 * n); htol[n++] = 1e-2f;
    dbg::k_cmp_bf16<<<cg, cb, 0, st>>>(a.kr, 2048, 0, proj, INW, O_RK, T_, 2048, 3, 1.0f, slots + 2 * n); htol[n++] = 1e-2f;
    dbg::k_cmp_bf16<<<cg, cb, 0, st>>>(a.vrt, T_, 1, proj, INW, O_RV, T_, 2048, 0, 1.0f, slots + 2 * n); htol[n++] = 1e-2f;
    dbg::k_cmp_bf16<<<cg, cb, 0, st>>>(a.srg, 2048, 0, proj, INW, O_RG, T_, 2048, 1, 1.0f, slots + 2 * n); htol[n++] = 1e-2f;
    dbg::k_cmp_bf16<<<cg, cb, 0, st>>>(a.gq, 1024, 0, proj, INW, O_GQ, T_, 1024, 0, 0.0625f, slots + 2 * n); htol[n++] = 1e-2f;
    dbg::k_cmp_bf16<<<cg, cb, 0, st>>>(a.gk, 1024, 0, proj, INW, O_GK, T_, 1024, 0, 1.0f, slots + 2 * n); htol[n++] = 1e-2f;
    dbg::k_cmp_bf16<<<cg, cb, 0, st>>>(a.vgt, T_, 1, proj, INW, O_GV, T_, 2048, 0, 1.0f, slots + 2 * n); htol[n++] = 1e-2f;
    dbg::k_cmp_bf16<<<cg, cb, 0, st>>>(a.sgg, 2048, 0, proj, INW, O_GG, T_, 2048, 1, 1.0f, slots + 2 * n); htol[n++] = 1e-2f;
    dbg::k_cmp_f32<<<cg, cb, 0, st>>>(a.ga, 16, proj, INW, O_GA, T_, 16, slots + 2 * n); htol[n++] = 1e-2f;
    dbg::k_cmp_tr<<<cg, cb, 0, st>>>(a.kr, 2048, a.krt, T_, T_, 2048, slots + 2 * n); htol[n++] = 1e-6f;
    dbg::k_cmp_gla<<<dim3(64, 4), 256, 0, st>>>(a.qg, a.kg, a.lam, proj, loga, slots + 2 * n, slots + 2 * (n + 1), slots + 2 * (n + 2)); htol[n++] = 2e-2f; htol[n++] = 2e-2f; htol[n++] = 2e-2f;
    dbg::k_cmp_tr<<<cg, cb, 0, st>>>(a.kg, 1024, a.kgt, T_, T_, 1024, slots + 2 * n); htol[n++] = 1e-6f;
#if MK_DBG_ONELAUNCH
    for (int i = 0; i < 4; ++i) { unsigned one = 0x3f800000u; (void)hipMemsetD32Async((hipDeviceptr_t)(slots + 2 * (15 + i) + 1), (int)one, 1, st); }
#endif
    htol[n++] = 1e-2f; htol[n++] = 1e-2f; htol[n++] = 1e-2f; htol[n++] = 1e-2f;
    dbg::k_cmp_p<<<dim3(64, 8), 256, 0, st>>>(a.qr, a.kr, a.dbgp, slots + 2 * n); htol[n++] = 1e-2f; htol[n++] = 1e-2f; htol[n++] = 1e-2f; htol[n++] = 1e-2f;
    dbg::k_cmp_o<<<dim3(T_, 8), 256, 0, st>>>(a.qr, a.dbgp, a.vrt, a.kvr, a.dbgo, slots + 2 * n); htol[n++] = 1e-2f;
    dbg::k_cmp_bf16<<<cg, cb, 0, st>>>(a.mixed, 4096, 0, mixed, D_, 0, T_, 2048, 0, 1.0f, slots + 2 * n); htol[n++] = 3e-2f;
    dbg::k_cmp_bf16<<<cg, cb, 0, st>>>(a.mixed + 2048, 4096, 0, mixed, D_, 2048, T_, 2048, 0, 1.0f, slots + 2 * n); htol[n++] = 3e-2f;
    dbg::k_cmp_f32<<<cg, cb, 0, st>>>((const float*)d_out, D_, xa, D_, 0, T_, D_, slots + 2 * n); htol[n++] = 1e-2f;
    dbg::k_cmp_bf16<<<cg, cb, 0, st>>>(a.xb, 4096, 0, xa, D_, 0, T_, D_, 0, 1.0f, slots + 2 * n); htol[n++] = 1e-2f;
    dbg::k_cmp_ss<<<T_, 256, 0, st>>>(ss1, xa, D_, slots + 2 * n); htol[n++] = 1e-2f;
#else
    size_t o = 0;
    float* xn = ws + o; o += (size_t)T_ * D_; float* xa = ws + o; o += (size_t)T_ * D_; float* xb2 = ws + o; o += (size_t)T_ * D_; float* G = ws + o; o += (size_t)T_ * FF_;
    mk::Args a{}; const size_t need = mk::build_args(a, d_in, d_out, (unsigned char*)d_ws, o * 4, 12, 1);
    if (need > ws_size) { fprintf(stderr, "dbg: ws too small %zu > %zu\n", need, ws_size); return; }
    (void)hipMemsetAsync(a.ctl, 0, mk::CTL_ZERO_BYTES, st);
    (void)hipMemcpyAsync(xa, x, (size_t)T_ * D_ * 4, hipMemcpyDeviceToDevice, st);
    (void)hipMemcpyAsync(d_out, x, (size_t)T_ * D_ * 4, hipMemcpyDeviceToDevice, st);
    k_rmsnorm<<<T_, 256, 0, st>>>(xa, ffn_norm, xn);
    k_sgemm<0><<<dim3(FF_ / 128, T_ / 128), 256, 0, st>>>(xn, w_gate, G, nullptr, T_, FF_, D_);
    k_sgemm<2><<<dim3(FF_ / 128, T_ / 128), 256, 0, st>>>(xn, w_up, G, nullptr, T_, FF_, D_);
    k_sgemm<1><<<dim3(D_ / 128, T_ / 128), 256, 0, st>>>(G, w_down, xb2, xa, T_, D_, FF_);
    mk::launch_range(a, 0, 1, st);
    (void)hipMemcpyAsync((float*)(a.ctl + mk::CW_SS) + T_, (float*)(a.ctl + mk::CW_SS), (size_t)T_ * 4, hipMemcpyDeviceToDevice, st);
#if MK_DBG_ONELAUNCH
    mk::launch_range(a, 7, 9, st);
#else
    mk::launch_range(a, 7, 8, st); mk::launch_range(a, 8, 9, st);
#endif
    float* slots = (float*)(a.ctl + mk::CW_CHK); float* tol = slots + 128; float* code = slots + 256;
    const float* ss2 = (const float*)(a.ctl + mk::CW_SS) + 2 * T_;
    int n = 0; float htol[64]; dim3 cg(2048), cb(256);
    dbg::k_cmp_bf16<<<cg, cb, 0, st>>>(a.h, FF_, 0, G, FF_, 0, T_, FF_, 0, 1.0f, slots + 2 * n); htol[n++] = 2e-2f;
    dbg::k_cmp_f32<<<cg, cb, 0, st>>>((const float*)d_out, D_, xb2, D_, 0, T_, D_, slots + 2 * n); htol[n++] = 1e-2f;
    dbg::k_cmp_bf16<<<cg, cb, 0, st>>>(a.xb, 4096, 0, xb2, D_, 0, T_, D_, 0, 1.0f, slots + 2 * n); htol[n++] = 1e-2f;
    dbg::k_cmp_ss<<<T_, 256, 0, st>>>(ss2, xb2, D_, slots + 2 * n); htol[n++] = 1e-2f;
#endif
    for (int i = 0; i < n; ++i) { unsigned bits; memcpy(&bits, &htol[i], 4); (void)hipMemsetD32Async((hipDeviceptr_t)(tol + i), (int)bits, 1, st); }
    dbg::k_decide<<<1, 64, 0, st>>>(slots, n, tol, code);
    dbg::k_fill_code<<<2048, 256, 0, st>>>((float*)d_out, (size_t)T_ * D_, code);
}
#endif

#if MK_TIMING
__global__ void k_timing_out(const unsigned* ts, float* out, size_t n, int selA, int selB) {
    auto dur = [&](int sel) { unsigned d = 0; if (sel == 0) d = ts[1] - ts[0]; else if (sel == 9) d = ts[18] - ts[17]; else d = (ts[sel + 1] - ts[sel]) + (ts[sel + 9] - ts[sel + 8]); return (float)d * 0.01f; };
    float c1 = dur(selA), c2 = 200.0f * dur(selB);
    if (selA == 99) {
        const float mhz = (float)(ts[34] - ts[32]) / (float)(ts[35] - ts[33]) * 100.0f; c1 = floorf(mhz / 50.0f + 0.5f) * 50.0f - 1000.0f; c2 = 100000.0f + floorf((float)(ts[35] - ts[33]) * 0.01f / 50.0f + 0.5f) * 50.0f; }
    for (size_t i = (size_t)blockIdx.x * blockDim.x + threadIdx.x; i < n; i += (size_t)gridDim.x * blockDim.x) out[i] = (i == 0) ? c2 : c1;
}
#endif
#if !MK_DEBUG
extern "C" void kernel_launch(void* const* d_in, const int* in_sizes, int n_in, void* d_out, int out_size, void* d_ws, size_t ws_size, hipStream_t stream) {
    if (!mk::setup_once()) return;
    mk::Args a{};
    const size_t need = mk::build_args(a, d_in, d_out, (unsigned char*)d_ws, 0, 15, 2);
    if (need > ws_size || n_in != 14) { fprintf(stderr, "mk: workspace too small (%zu > %zu) or wrong input count %d\n", need, ws_size, n_in); return; }
    (void)hipMemsetAsync(d_ws, 0, MK_SPLIT ? mk::CTL_ZERO_BYTES : mk::BAR_ZERO_BYTES, stream);
#if MK_SPLIT
    for (int p = 0; p < mk::N_PHASES; ++p) mk::launch_range(a, p, p + 1, stream);
#else
    mk::launch_range(a, 0, mk::N_PHASES, stream, false);
#endif
#if MK_TIMING
    k_timing_out<<<2048, 256, 0, stream>>>(a.ctl + mk::CW_TS, (float*)d_out, (size_t)8192 * 4096, MK_TSEL_A, MK_TSEL_B);
#endif
}
#endif
```

```cpp
#include <hip/hip_runtime.h>
#include <cstdio>
#include <cstdint>
#include <cstring>
#define MK_DEBUG 0
#define MK_SPLIT 0
#define MK_DBG_ONELAUNCH 0
#define MK_TIMING 0
#define MK_NT 1
namespace pg8 {
#define PG8_LAS __attribute__((address_space(3)))
typedef unsigned short bf16_t;
typedef short bf16x8 __attribute__((ext_vector_type(8)));
typedef float f32x4 __attribute__((ext_vector_type(4)));
typedef unsigned u32x4 __attribute__((ext_vector_type(4)));
constexpr int BM = 256, BK = 64, HALF = 128, HTB = HALF * BK * 2  , STAGE_BYTES = 8 * HTB, NXCD = 8, WGM = 8;

__host__ __device__ __forceinline__ int lds_byte(int r, int c) { const int st = (r >> 4) * 2 + (c >> 5), rr = r & 15, cc = c & 31, ob = rr * 64 + cc * 2; return st * 1024 + (ob ^ (((ob >> 9) & 1) << 5)); }
__host__ __device__ __forceinline__ void stage_rc(int b, int& R, int& C) { const int st = b / 1024, sb = b % 1024, swz = sb ^ (((sb >> 9) & 1) << 5); R = (st >> 1) * 16 + swz / 64; C = (st & 1) * 32 + (swz % 64) / 2; }
__host__ __device__ __forceinline__ int perm32(int rho) { const int n = rho >> 4, i = rho & 15; return 8 * (i >> 2) + 4 * n + (i & 3); }

struct Unit { int pm, pn, sw; };
struct Gemm { const bf16_t* A; const bf16_t* Bt; int K; int a_pitch, a_kstep, b_pitch, b_kstep; };

struct StaticOrder {
    int nM, nN, nwg, G, c;
    __host__ __device__ void init(int nM_, int nN_, int G_, int c_) { nM = nM_; nN = nN_; nwg = nM * nN; G = G_; c = c_; }
    __host__ __device__ bool next(int i, Unit& u) const {
        const long L = (long)i * G + c; if (L >= nwg) return false;
        int wgid = (int)L; { const int q = nwg / NXCD, r = nwg % NXCD, xcd = wgid % NXCD, off = wgid / NXCD; wgid = (xcd < r ? xcd * (q + 1) : r * (q + 1) + (xcd - r) * q) + off; }
        const int nig = WGM * nN, gid = wgid / nig, fm = gid * WGM, gsz = (nM - fm) < WGM ? (nM - fm) : WGM;
        u.pm = fm + ((wgid % nig) % gsz); u.pn = (wgid % nig) / gsz; u.sw = 0; return true;
    }
    __device__ __forceinline__ void a_ready(const Unit&) const {}
    __device__ __forceinline__ void done(const Unit&) const {}
};

#ifndef MK_EPI_NT
#define MK_EPI_NT 0
#endif
#ifndef MK_G1_PROBE
#define MK_G1_PROBE 0
#endif
#define MK_PST16(p, v) do { if (!((MK_G1_PROBE == 1 || (MK_G1_PROBE == 3 && issw_) || (MK_G1_PROBE == 4 && !issw_) || (MK_G1_PROBE == 5 && (blockIdx.x & 1))) && probe)) MK_ST16(p, v); } while (0)
#ifndef MK_EPI_LASTWT
#define MK_EPI_LASTWT 0
#endif
#if MK_EPI_NT
#define MK_ST16(p, v) __builtin_nontemporal_store((v), (u32x4*)(p))
#elif MK_EPI_LASTWT
#define MK_ST16(p, v) do { const u32x4 v_ = (v); void* const p_ = (void*)(p); if (lastu) asm volatile("global_store_dwordx4 %0, %1, off sc1\n\ts_nop 1" :: "v"(p_), "v"(v_) : "memory"); else *(u32x4*)p_ = v_; } while (0)
#else
#define MK_ST16(p, v) (*(u32x4*)(p) = (v))
#endif
#ifndef MK_VT_BLK
#define MK_VT_BLK 0
#endif

typedef __bf16 bf16x2v __attribute__((ext_vector_type(2)));
__device__ __forceinline__ unsigned cvt_pk_bf16(float lo, float hi) { bf16x2v v; v[0] = (__bf16)lo; v[1] = (__bf16)hi; return __builtin_bit_cast(unsigned, v); }
__device__ __forceinline__ u32x4 pack8(const f32x4 a, const f32x4 b) { u32x4 w; w.x = cvt_pk_bf16(a[0], a[1]); w.y = cvt_pk_bf16(a[2], a[3]); w.z = cvt_pk_bf16(b[0], b[1]); w.w = cvt_pk_bf16(b[2], b[3]); return w; }
typedef unsigned long long u64;
__device__ __forceinline__ u64 ss_fix(float sq) { return (u64)(sq * 1048576.0f + 0.5f); }
__device__ __forceinline__ float rs_of(u64 ss) { return __builtin_amdgcn_rsqf((float)ss * (1.0f / (1048576.0f * 4096.0f)) + 1e-6f); }
__device__ __forceinline__ float silu1f(float v) { return v * __builtin_amdgcn_rcpf(1.0f + __builtin_amdgcn_exp2f(-1.44269504f * v)); }
__device__ __forceinline__ f32x4 silu4(const f32x4 v) { f32x4 o; o[0] = silu1f(v[0]); o[1] = silu1f(v[1]); o[2] = silu1f(v[2]); o[3] = silu1f(v[3]); return o; }

constexpr int TT = 8192;

struct EpiProj {
    static constexpr bool PERM = true, AFTER_DRAIN = false;
    const u64* ss;
    const int* pos;
    bf16_t *qr, *kr, *vrt, *srg, *gq, *gk, *vgt, *sgg;
    int probe;
    __device__ __forceinline__ void operator()(const f32x4 (&acc)[2][2][4][2], const Unit& u, int wr, int wc, int fr_, int fq_, bool lastu = false) const {
        int fr = fr_, fq = fq_; asm volatile("" : "+v"(fr), "+v"(fq));
        int pn = u.pn; asm volatile("" : "+s"(pn));
        const bool issw_ = (pn >= 16 && pn < 24) || (pn >= 40 && pn < 48); (void)issw_;
        if (issw_) {
#if MK_VT_BLK
            bf16_t* dst = ((pn < 24) ? vrt + (size_t)(pn - 16) * 65536 : vgt + (size_t)(pn - 40) * 65536) + (size_t)u.pm * (2048 * 256) + (wc * 32 + 8 * fq);
#else
            bf16_t* dst = (pn < 24) ? vrt + (size_t)(pn - 16) * 256 * TT : vgt + (size_t)(pn - 40) * 256 * TT;
#endif
            const int tc0 = u.pm * BM + wc * 32 + 8 * fq;
            f32x4 rs[2][2];
#pragma unroll
            for (int bj = 0; bj < 2; ++bj)
#pragma unroll
                for (int n = 0; n < 2; ++n) { const u64* sp = ss + tc0 + bj * HALF + 4 * n; rs[bj][n] = (f32x4){rs_of(sp[0]), rs_of(sp[1]), rs_of(sp[2]), rs_of(sp[3])}; }
#pragma unroll
            for (int ai = 0; ai < 2; ++ai)
#pragma unroll
                for (int m = 0; m < 4; ++m) {
#if MK_VT_BLK
                    bf16_t* rowp = dst + (ai * HALF + wr * 64 + m * 16 + fr) * 256;
#else
                    bf16_t* rowp = dst + (size_t)(ai * HALF + wr * 64 + m * 16 + fr) * TT + tc0;
#endif

#pragma unroll
                    for (int bj = 0; bj < 2; ++bj) MK_PST16(rowp + bj * HALF, pack8(acc[ai][bj][m][0] * rs[bj][0], acc[ai][bj][m][1] * rs[bj][1])); }
            return;
        }
        const int t0 = u.pm * BM + wr * 64 + fr;
        const int cl = wc * 32 + 8 * fq;
        if (pn < 16) {
            const int h = pn & 7; const bool isk = pn >= 8; bf16_t* dst = (isk ? kr : qr) + h * 256;
            const float lg = log2f(1.0f - exp2f(-5.0f - (float)h));
            float invf[2][4];
#pragma unroll
            for (int n = 0; n < 2; ++n)
#pragma unroll
                for (int j = 0; j < 4; ++j) invf[n][j] = exp2f(-(float)(cl + 4 * n + j) * (13.287712379549449f / 128.0f));
            u64 ssv[2][4]; int pv[2][4];
#pragma unroll
            for (int ai = 0; ai < 2; ++ai)
#pragma unroll
                for (int m = 0; m < 4; ++m) { ssv[ai][m] = ss[t0 + ai * HALF + m * 16]; pv[ai][m] = pos[t0 + ai * HALF + m * 16]; }
            asm volatile("" ::: "memory");
#pragma unroll
            for (int ai = 0; ai < 2; ++ai)
#pragma unroll
                for (int m = 0; m < 4; ++m) { const int t = t0 + ai * HALF + m * 16; const float ip1 = (float)((t & 255) + 1); const float posf = (float)pv[ai][m];
                    const float sc = rs_of(ssv[ai][m]) * (isk ? exp2f(-ip1 * lg) * 0.0625f : exp2f(ip1 * lg));
                    f32x4 o1[2], o2[2];
#pragma unroll
                    for (int n = 0; n < 2; ++n) { f32x4 c4, s4;
#pragma unroll
                        for (int j = 0; j < 4; ++j) { const float fr = __builtin_amdgcn_fractf((posf * invf[n][j]) * 0.15915494309189535f); if (MK_G1_PROBE == 2 && probe) { c4[j] = 1.0f; s4[j] = fr; } else { c4[j] = __builtin_amdgcn_cosf(fr); s4[j] = __builtin_amdgcn_sinf(fr); } }
                        const f32x4 a = acc[ai][0][m][n], b = acc[ai][1][m][n]; o1[n] = (a * c4 - b * s4) * sc; o2[n] = (a * s4 + b * c4) * sc; }
                    bf16_t* rowp = dst + (size_t)t * 2048 + cl;
                    MK_PST16(rowp, pack8(o1[0], o1[1])); MK_PST16(rowp + HALF, pack8(o2[0], o2[1])); }
            return;
        }
        bf16_t* dst; int ld; float sc = 1.0f; bool act = false;
        if (pn < 32) { dst = srg + (pn - 24) * 256; ld = 2048; act = true; }
        else if (pn < 36) { dst = gq + (pn - 32) * 256; ld = 1024; sc = 0.0625f; }
        else if (pn < 40) { dst = gk + (pn - 36) * 256; ld = 1024; }
        else { dst = sgg + (pn - 48) * 256; ld = 2048; act = true; }
        u64 ssv[2][4];
#pragma unroll
        for (int ai = 0; ai < 2; ++ai)
#pragma unroll
            for (int m = 0; m < 4; ++m) ssv[ai][m] = ss[t0 + ai * HALF + m * 16];
        asm volatile("" ::: "memory");
#pragma unroll
        for (int ai = 0; ai < 2; ++ai)
#pragma unroll
            for (int m = 0; m < 4; ++m) { const int t = t0 + ai * HALF + m * 16; const float s = rs_of(ssv[ai][m]) * sc; bf16_t* rowp = dst + (size_t)t * ld + cl;
#pragma unroll
                for (int bj = 0; bj < 2; ++bj) { f32x4 v0 = acc[ai][bj][m][0] * s, v1 = acc[ai][bj][m][1] * s; if (act && !(MK_G1_PROBE == 2 && probe)) { v0 = silu4(v0); v1 = silu4(v1); }
                    MK_PST16(rowp + bj * HALF, pack8(v0, v1)); } }
    }
};

struct EpiRes {
    static constexpr bool PERM = true, AFTER_DRAIN = false;
    bf16_t* xb; u64* ssout; u64* dup;
    __device__ __forceinline__ void operator()(const f32x4 (&acc)[2][2][4][2], const Unit& u, int wr, int wc, int fr_, int fq_, bool lastu = false) const {
        int fr = fr_, fq = fq_; asm volatile("" : "+v"(fr), "+v"(fq));
        const int t0 = u.pm * BM + wr * 64 + fr, c0 = u.pn * BM + wc * 32 + 8 * fq;
        u32x4 xi[2][4][2];
#pragma unroll
        for (int ai = 0; ai < 2; ++ai)
#pragma unroll
            for (int m = 0; m < 4; ++m)
#pragma unroll
                for (int bj = 0; bj < 2; ++bj) xi[ai][m][bj] = *(const u32x4*)(xb + (size_t)(t0 + ai * HALF + m * 16) * 4096 + c0 + bj * HALF);
        asm volatile("" ::: "memory");
#pragma unroll
        for (int ai = 0; ai < 2; ++ai) {
#pragma unroll
            for (int m = 0; m < 4; ++m) { const int t = t0 + ai * HALF + m * 16; bf16_t* rowp = xb + (size_t)t * 4096 + c0; float sq = 0.f;
#pragma unroll
                for (int bj = 0; bj < 2; ++bj) { const u32x4 x = xi[ai][m][bj];
                    f32x4 o0 = acc[ai][bj][m][0], o1 = acc[ai][bj][m][1];
                    o0[0] += __uint_as_float(x.x << 16); o0[1] += __uint_as_float(x.x & 0xffff0000u); o0[2] += __uint_as_float(x.y << 16); o0[3] += __uint_as_float(x.y & 0xffff0000u);
                    o1[0] += __uint_as_float(x.z << 16); o1[1] += __uint_as_float(x.z & 0xffff0000u); o1[2] += __uint_as_float(x.w << 16); o1[3] += __uint_as_float(x.w & 0xffff0000u);
                    sq += ((o0[0] * o0[0] + o0[1] * o0[1]) + (o0[2] * o0[2] + o0[3] * o0[3])) + ((o1[0] * o1[0] + o1[1] * o1[1]) + (o1[2] * o1[2] + o1[3] * o1[3]));
                    MK_ST16(rowp + bj * HALF, pack8(o0, o1)); }
                sq += __shfl_xor(sq, 16); sq += __shfl_xor(sq, 32);
                if (fq == 0) atomicAdd(ssout + t, ss_fix(sq));
#ifdef MK_DUP_ATOMICS
                if (fq == 0) atomicAdd(dup + t, ss_fix(sq));
#endif
                } }
    }
};

struct EpiSwiGLU {
    static constexpr bool PERM = true, AFTER_DRAIN = false;
    const u64* ss; bf16_t* h;
    __device__ __forceinline__ void operator()(const f32x4 (&acc)[2][2][4][2], const Unit& u, int wr, int wc, int fr_, int fq_, bool lastu = false) const {
        int fr = fr_, fq = fq_; asm volatile("" : "+v"(fr), "+v"(fq));
        const int t0 = u.pm * BM + wr * 64 + fr, c0 = u.pn * HALF + wc * 32 + 8 * fq;
        u64 ssv[2][4];
#pragma unroll
        for (int ai = 0; ai < 2; ++ai)
#pragma unroll
            for (int m = 0; m < 4; ++m) ssv[ai][m] = ss[t0 + ai * HALF + m * 16];
        asm volatile("" ::: "memory");
#pragma unroll
        for (int ai = 0; ai < 2; ++ai)
#pragma unroll
            for (int m = 0; m < 4; ++m) { const int t = t0 + ai * HALF + m * 16; const float s = rs_of(ssv[ai][m]); f32x4 o[2];
#pragma unroll
                for (int n = 0; n < 2; ++n) { const f32x4 g = silu4(acc[ai][0][m][n] * s), uu = acc[ai][1][m][n] * s; o[n] = g * uu; }
                MK_ST16(h + ((size_t)(c0 >> 6) * TT + t) * 64 + (c0 & 63), pack8(o[0], o[1])); }
    }
};
struct ProjOrder : StaticOrder {
    __host__ __device__ bool next(int i, Unit& u) const { if (!StaticOrder::next(i, u)) return false; u.sw = ((u.pn >= 16 && u.pn < 24) || (u.pn >= 40 && u.pn < 48)) ? 1 : 0; return true; }
};
template <class Epi, class Sched, bool ALIGN_EPI = false, bool SP2 = false>
__device__ __forceinline__ void gemm_phase(PG8_LAS unsigned char* lds, const Gemm g, const Sched& S, const Epi& E, int tid_in) {
    int tid = tid_in; asm volatile("" : "+v"(tid));
    const int wid = __builtin_amdgcn_readfirstlane(tid >> 6), lane = tid & 63, wr = wid >> 2, wc = wid & 3, fr = lane & 15, fq = lane >> 4;
    const int K = g.K, nt = K / BK;
    unsigned voffA[2], voffB[2];
#pragma unroll
    for (int i = 0; i < 2; ++i) { int R, C; stage_rc(tid * 16 + i * 8192, R, C); const int Rb = Epi::PERM ? ((R & ~31) + perm32(R & 31)) : R;
        voffA[i] = (unsigned)(R * g.a_pitch + C * 2); voffB[i] = (unsigned)(Rb * g.b_pitch + C * 2); }
    const size_t kstep = (size_t)g.b_kstep, kstepA = (size_t)g.a_kstep;
    const size_t hstep = (size_t)HALF * g.b_pitch, hstepA = (size_t)HALF * g.a_pitch;
    const size_t tstep = 2 * hstep, tstepA = 2 * hstepA;
    const unsigned ldsw = (unsigned)wid * 1024u;
    const int aoff = lds_byte(wr * 64 + fr, fq * 8), boff = lds_byte(wc * 32 + fr, fq * 8);
#define PG8_SA(b, h) (((b) * 2 + (h)) * HTB)
#define PG8_SB(b, h) ((4 + (b) * 2 + (h)) * HTB)
#define PG8_STAGE(bufoff, gbase, voff) do { _Pragma("unroll") for (int _i = 0; _i < 2; ++_i) \
        __builtin_amdgcn_global_load_lds((const unsigned*)((const char*)(gbase) + (voff)[_i]), (PG8_LAS unsigned*)(lds + (bufoff) + ldsw + _i * 8192), 16, 0, 0); } while (0)
#define PG8_LDA(dst, b, h) do { _Pragma("unroll") for (int m = 0; m < 4; ++m) _Pragma("unroll") for (int k = 0; k < 2; ++k) dst[m][k] = *(const PG8_LAS bf16x8*)(lds + PG8_SA(b, h) + aoff + m * 2048 + k * 1024); } while (0)
#define PG8_LDB(dst, b, h) do { _Pragma("unroll") for (int n = 0; n < 2; ++n) _Pragma("unroll") for (int k = 0; k < 2; ++k) dst[n][k] = *(const PG8_LAS bf16x8*)(lds + PG8_SB(b, h) + boff + n * 2048 + k * 1024); } while (0)
#define PG8_MMA(ai, bj, At, Bt) do { __builtin_amdgcn_s_setprio(1); _Pragma("unroll") for (int m = 0; m < 4; ++m) _Pragma("unroll") for (int n = 0; n < 2; ++n) _Pragma("unroll") for (int k = 0; k < 2; ++k) \
        acc[ai][bj][m][n] = __builtin_amdgcn_mfma_f32_16x16x32_bf16(Bt[n][k], At[m][k], acc[ai][bj][m][n], 0, 0, 0); __builtin_amdgcn_s_setprio(0); } while (0)
#define PG8_WAIT_V(n) asm volatile("s_waitcnt vmcnt(" #n ")" ::: "memory")
#define PG8_WAIT_L(n) asm volatile("s_waitcnt lgkmcnt(" #n ")" ::: "memory")
#define PG8_BAR __builtin_amdgcn_s_barrier()
#define PG8_SCHED __builtin_amdgcn_sched_barrier(0)
    Unit cur, nxt; int ui = 0;
    if (!S.next(0, cur)) return;
    f32x4 acc[2][2][4][2];
#pragma unroll
    for (int a = 0; a < 2; ++a)
#pragma unroll
        for (int b = 0; b < 2; ++b)
#pragma unroll
            for (int m = 0; m < 4; ++m)
#pragma unroll
                for (int n = 0; n < 2; ++n) acc[a][b][m][n] = (f32x4){0.f, 0.f, 0.f, 0.f};
    bf16x8 At[4][2], B0[2][2], B1[2][2];
    const char* cA = cur.sw ? (const char*)g.Bt + (size_t)cur.pn * tstep : (const char*)g.A + (size_t)cur.pm * tstepA; const char* cB = cur.sw ? (const char*)g.A + (size_t)cur.pm * tstep : (const char*)g.Bt + (size_t)cur.pn * tstep;
    S.a_ready(cur);
    if constexpr (SP2) {
        PG8_STAGE(PG8_SB(0, 0), cB, voffB); PG8_STAGE(PG8_SB(0, 1), cB + hstep, voffB); PG8_STAGE(PG8_SA(0, 0), cA, voffA); PG8_STAGE(PG8_SA(0, 1), cA + hstepA, voffA);
        if (wr == 1) PG8_BAR;
        PG8_WAIT_V(2); PG8_BAR;
        PG8_STAGE(PG8_SB(1, 0), cB + kstep, voffB); PG8_STAGE(PG8_SA(1, 0), cA + kstepA, voffA); PG8_STAGE(PG8_SB(1, 1), cB + hstep + kstep, voffB);
        PG8_WAIT_V(6); PG8_BAR;
    } else {
        PG8_STAGE(PG8_SB(0, 0), cB, voffB); PG8_STAGE(PG8_SA(0, 0), cA, voffA); PG8_STAGE(PG8_SB(0, 1), cB + hstep, voffB); PG8_STAGE(PG8_SA(0, 1), cA + hstepA, voffA);
        if (wr == 1) PG8_BAR;
        PG8_WAIT_V(4); PG8_BAR;
        PG8_STAGE(PG8_SB(1, 0), cB + kstep, voffB); PG8_STAGE(PG8_SA(1, 0), cA + kstepA, voffA); PG8_STAGE(PG8_SB(1, 1), cB + hstep + kstep, voffB);
        PG8_WAIT_V(6); PG8_BAR;
    }
    for (;;) {
        const bool has_next = S.next(ui + 1, nxt);
        const char* nA = has_next ? (nxt.sw ? (const char*)g.Bt + (size_t)nxt.pn * tstep : (const char*)g.A + (size_t)nxt.pm * tstepA) : cA; const char* nB = has_next ? (nxt.sw ? (const char*)g.A + (size_t)nxt.pm * tstep : (const char*)g.Bt + (size_t)nxt.pn * tstep) : cB;
        for (int t = 0; t < nt; t += 2) {
            const bool last = (t == nt - 2);
            const char* a1 = cA + (size_t)(t + 1) * kstepA;
            const char* a2 = last ? nA : cA + (size_t)(t + 2) * kstepA; const char* b2 = last ? nB : cB + (size_t)(t + 2) * kstep;
            const char* a3 = a2 + kstepA; const char* b3 = b2 + kstep;
            if (last && has_next) S.a_ready(nxt);
            if constexpr (SP2) {
            PG8_LDB(B0, 0, 0); PG8_LDB(B1, 0, 1); PG8_SCHED; PG8_LDA(At, 0, 0); PG8_STAGE(PG8_SA(1, 1), a1 + hstepA, voffA);
            PG8_WAIT_V(8); PG8_WAIT_L(0); PG8_BAR; PG8_MMA(0, 0, At, B0); PG8_MMA(0, 1, At, B1); PG8_BAR; PG8_SCHED;
            PG8_LDA(At, 0, 1); PG8_STAGE(PG8_SB(0, 0), b2, voffB); PG8_STAGE(PG8_SB(0, 1), b2 + hstep, voffB); PG8_STAGE(PG8_SA(0, 0), a2, voffA);
            PG8_WAIT_V(8); PG8_WAIT_L(0); PG8_BAR; PG8_MMA(1, 0, At, B0); PG8_MMA(1, 1, At, B1); PG8_BAR; PG8_SCHED;
            PG8_LDB(B0, 1, 0); PG8_LDB(B1, 1, 1); PG8_SCHED; PG8_LDA(At, 1, 0); PG8_STAGE(PG8_SA(0, 1), a2 + hstepA, voffA);
            PG8_WAIT_V(8); PG8_WAIT_L(0); PG8_BAR; PG8_MMA(0, 0, At, B0); PG8_MMA(0, 1, At, B1); PG8_BAR; PG8_SCHED;
            PG8_LDA(At, 1, 1); PG8_STAGE(PG8_SB(1, 0), b3, voffB); PG8_STAGE(PG8_SB(1, 1), b3 + hstep, voffB); PG8_STAGE(PG8_SA(1, 0), a3, voffA);
            PG8_WAIT_V(8); PG8_WAIT_L(0); PG8_BAR; PG8_MMA(1, 0, At, B0); PG8_MMA(1, 1, At, B1); PG8_BAR; PG8_SCHED;
            } else {
            PG8_LDB(B0, 0, 0); PG8_SCHED; PG8_LDA(At, 0, 0); PG8_STAGE(PG8_SA(1, 1), a1 + hstepA, voffA);
            PG8_WAIT_L(8); PG8_BAR; PG8_WAIT_L(0); PG8_MMA(0, 0, At, B0); PG8_BAR; PG8_SCHED;
            PG8_LDB(B1, 0, 1); PG8_STAGE(PG8_SB(0, 0), b2, voffB);
            PG8_BAR; PG8_WAIT_L(0); PG8_MMA(0, 1, At, B1); PG8_BAR;
            PG8_LDA(At, 0, 1); PG8_STAGE(PG8_SA(0, 0), a2, voffA);
            PG8_BAR; PG8_WAIT_L(0); PG8_MMA(1, 0, At, B0); PG8_BAR; PG8_SCHED;
            PG8_STAGE(PG8_SB(0, 1), b2 + hstep, voffB);
            PG8_WAIT_V(6); PG8_BAR; PG8_MMA(1, 1, At, B1); PG8_BAR;
            PG8_LDB(B0, 1, 0); PG8_SCHED; PG8_LDA(At, 1, 0); PG8_STAGE(PG8_SA(0, 1), a2 + hstepA, voffA);
            PG8_WAIT_L(8); PG8_BAR; PG8_WAIT_L(0); PG8_MMA(0, 0, At, B0); PG8_BAR; PG8_SCHED;
            PG8_LDB(B1, 1, 1); PG8_STAGE(PG8_SB(1, 0), b3, voffB);
            PG8_BAR; PG8_WAIT_L(0); PG8_MMA(0, 1, At, B1); PG8_BAR;
            PG8_LDA(At, 1, 1); PG8_STAGE(PG8_SA(1, 0), a3, voffA);
            PG8_BAR; PG8_WAIT_L(0); PG8_MMA(1, 0, At, B0); PG8_BAR; PG8_SCHED;
            PG8_STAGE(PG8_SB(1, 1), b3 + hstep, voffB);
            PG8_WAIT_V(6); PG8_BAR; PG8_MMA(1, 1, At, B1); PG8_BAR;
            }
        }
        if constexpr (ALIGN_EPI) { if (wr == 0) PG8_BAR; }
        if constexpr (!Epi::AFTER_DRAIN) { int te_ = tid_in; asm volatile("" : "+v"(te_)); E(acc, cur, wr, wc, te_ & 15, (te_ & 63) >> 4, !has_next); S.done(cur); }
        if (!has_next) break;
#pragma unroll
        for (int a = 0; a < 2; ++a)
#pragma unroll
            for (int b = 0; b < 2; ++b)
#pragma unroll
                for (int m = 0; m < 4; ++m)
#pragma unroll
                    for (int n = 0; n < 2; ++n) acc[a][b][m][n] = (f32x4){0.f, 0.f, 0.f, 0.f};
        cur = nxt; cA = nA; cB = nB; ++ui;
        if constexpr (ALIGN_EPI) { if (wr == 1) PG8_BAR; }
    }
    PG8_WAIT_V(0);
    if constexpr (!ALIGN_EPI) { if (wr == 0) PG8_BAR; }
    PG8_BAR;
    if constexpr (Epi::AFTER_DRAIN) { E.fused(acc, cur, wr, wc, fr, fq, lds, wid, lane); S.done(cur); }
#undef PG8_SA
#undef PG8_SB
#undef PG8_STAGE
#undef PG8_LDA
#undef PG8_LDB
#undef PG8_MMA
#undef PG8_WAIT_V
#undef PG8_WAIT_L
#undef PG8_BAR
#undef PG8_SCHED
}
}

#ifndef MK_WT_STORES
#define MK_WT_STORES 1
#endif
#define GAS __attribute__((address_space(1)))
#define LAS __attribute__((address_space(3)))
typedef unsigned short bf16_t;
typedef short bf16x8 __attribute__((ext_vector_type(8)));
typedef float f32x4 __attribute__((ext_vector_type(4)));
typedef float f32x2 __attribute__((ext_vector_type(2)));
typedef unsigned u32x4 __attribute__((ext_vector_type(4)));
typedef unsigned u32x2 __attribute__((ext_vector_type(2)));
#define LDS_WAIT() asm volatile("s_waitcnt lgkmcnt(0)" ::: "memory")
#define VM_WAIT() asm volatile("s_waitcnt vmcnt(0)" ::: "memory")

namespace mk {
using pg8::cvt_pk_bf16; using pg8::pack8; using pg8::rs_of; using pg8::u64; using pg8::ss_fix;
constexpr int T = 8192, D = 4096, INW = 14352, NPROJ = 14336, FF = 11008;
constexpr int NWAVES = 8, NTHR = 512;
constexpr int LDS_BYTES = 147456;
constexpr int LDSCTL_OFF = 140 * 1024;
constexpr int CW_TMO = 0, CW_BAR = 0  , CW_SS = 8192  , CW_CHK = 98304  , CW_TS = 96000  ;
constexpr size_t CTL_ZERO_BYTES = 512 * 1024, BAR_ZERO_BYTES = 16384;
constexpr int N_PHASES = 18;

struct Args {
    const float* x; const int* pos; const float* mix_norm; const float* w_in; const float* gla_w_up; const float* gla_b; const float* ret_gain; const float* gla_gain;
    const float* w_out; const float* ffn_norm; const float* w_gate; const float* w_up; const float* w_down; const float* final_norm;
    float* out; unsigned* ctl;
    bf16_t* win_t[2]; bf16_t* wga_t[2]; bf16_t* wout_t[2]; bf16_t* wgu_t[2]; bf16_t* wd_t[2];
    bf16_t* xb; float* rot; float* ga; float* lam;
    bf16_t *qr, *kr, *krt, *vrt, *srg, *gq, *gk, *qg, *kg, *kgt, *vgt, *sgg, *kvr, *kvg, *mixed, *h;
    bf16_t* dbgp; float* dbgo;
    int ph_lo, ph_hi, cvt_mask, cvt_layers;
};

__device__ __forceinline__ void st16_wt(void* p, u32x4 v) {
#if MK_WT_STORES
    asm volatile("global_store_dwordx4 %0, %1, off sc1\n\ts_nop 1" :: "v"(p), "v"(v) : "memory");
#else
    *(u32x4*)p = v;
#endif
}
__device__ __forceinline__ float wave_sum(float v) {
#pragma unroll
    for (int o = 1; o < 64; o <<= 1) v += __shfl_xor(v, o);
    return v;
}
__device__ __forceinline__ float bf_lo(unsigned w) { return __uint_as_float(w << 16); }
__device__ __forceinline__ float bf_hi(unsigned w) { return __uint_as_float(w & 0xffff0000u); }
__device__ __forceinline__ float silu1(float v) { return v / (1.0f + __expf(-v)); }

#define XB_TMO      128
#define XB_XCNT(j)  (256  + 64 * (j))
#define XB_XSUB(j)  (1280 + 64 * (j))
#define XB_XGEN(j)  (2304 + 64 * (j))
#define XB_TOP      3328
#define XB_TOPGEN   3392
#define XCD_BAR_WORDS 3456
#define XB_SPIN_CAP (1u << 18)

__device__ __forceinline__ unsigned xb_ld(unsigned* p)              { return __hip_atomic_load(p, __ATOMIC_RELAXED, __HIP_MEMORY_SCOPE_AGENT); }
__device__ __forceinline__ unsigned xb_add(unsigned* p, unsigned v) { return __hip_atomic_fetch_add(p, v, __ATOMIC_RELAXED, __HIP_MEMORY_SCOPE_AGENT); }
__device__ __forceinline__ unsigned xb_xcc_id() { return (unsigned)__builtin_amdgcn_s_getreg((3 << 11) | 20) & 0xFu; }
#define XB_SPIN(cond, bar) do { unsigned _sp = 0; while (cond) { __builtin_amdgcn_s_sleep(1); \
    if ((++_sp & 255u) == 0u) { if (xb_ld(&(bar)[XB_TMO])) break; if (_sp > XB_SPIN_CAP) { atomicAdd(&(bar)[XB_TMO], 1u); break; } } } } while (0)

struct XcdBarrier {
    unsigned* bar; unsigned x;
    volatile LAS unsigned* st;
    unsigned leader;
};

__device__ __forceinline__ XcdBarrier xcd_barrier_post(unsigned* bar, volatile LAS unsigned* st) {
    XcdBarrier b; b.bar = bar; b.x = xb_xcc_id(); b.st = st; b.leader = (threadIdx.x == 0) ? 1u : 0u;
    if (threadIdx.x == 0) (void)xb_add(&bar[XB_XCNT(b.x)], 1u);
    return b;
}
__device__ __forceinline__ void xcd_barrier_complete(unsigned* bar, unsigned x, unsigned& nloc, unsigned& nx) {
    const unsigned G = gridDim.x * gridDim.y * gridDim.z;
    unsigned sum, cnt, mine, sp = 0u;
    for (;;) {
        sum = 0u; cnt = 0u; mine = 0u;
#pragma unroll
        for (unsigned j = 0; j < 16; ++j) { const unsigned c = xb_ld(&bar[XB_XCNT(j)]); sum += c; cnt += (c > 0u) ? 1u : 0u; mine = (j == x) ? c : mine; }
        if (sum == G) break;
        __builtin_amdgcn_s_sleep(1);
        if ((++sp & 255u) == 0u) { if (xb_ld(&bar[XB_TMO])) break; if (sp > XB_SPIN_CAP) { atomicAdd(&bar[XB_TMO], 1u); break; } }
    }
    nloc = mine > 0u ? mine : 1u; nx = cnt > 0u ? cnt : 1u;
}

__device__ __forceinline__ void xcd_barrier(const XcdBarrier& b) {
    asm volatile("s_waitcnt vmcnt(0)" ::: "memory");
    __syncthreads();
    if (b.leader) {
        unsigned* bar = b.bar;
        __builtin_amdgcn_s_waitcnt(0);
        unsigned nloc = b.st[0], nx = b.st[1];
        if (nloc == 0u) { xcd_barrier_complete(bar, b.x, nloc, nx); b.st[0] = nloc; b.st[1] = nx; }
        const unsigned old = xb_add(&bar[XB_XSUB(b.x)], 1u);
        const unsigned gen = old / nloc;
        if (old + 1u == (gen + 1u) * nloc) {
            __builtin_amdgcn_fence(__ATOMIC_RELEASE, "agent");
            asm volatile("s_waitcnt vmcnt(0)" ::: "memory");
            const unsigned og = xb_add(&bar[XB_TOP], 1u);
            const unsigned tg = og / nx;
            if (og + 1u == (tg + 1u) * nx) xb_add(&bar[XB_TOPGEN], 1u);
            else XB_SPIN(xb_ld(&bar[XB_TOPGEN]) == tg, bar);
            __builtin_amdgcn_fence(__ATOMIC_ACQUIRE, "agent");
            xb_add(&bar[XB_XGEN(b.x)], 1u);
            asm volatile("s_waitcnt vmcnt(0)" ::: "memory");
        } else {
            XB_SPIN(xb_ld(&bar[XB_XGEN(b.x)]) == gen, bar);
            __builtin_amdgcn_fence(__ATOMIC_ACQUIRE, "agent");
            asm volatile("s_waitcnt vmcnt(0)" ::: "memory");
        }
    }
    __syncthreads();
}

#ifndef MK_M3_RDG
#define MK_M3_RDG 4
#endif
#ifndef MK_M3_RDR
#define MK_M3_RDR 6
#endif
#ifndef MK_M3_EPI
#define MK_M3_EPI 2
#endif
#ifndef MK_M1V2
#define MK_M1V2 1
#endif
#ifndef MK_M3_UNPAIR
#define MK_M3_UNPAIR 0
#endif
#ifndef MK_M3_PROBE
#define MK_M3_PROBE 0
#endif
#ifndef MK_M3_WT
#define MK_M3_WT 1
#endif
#ifndef MK_M3_NTST
#define MK_M3_NTST 0
#endif
#ifndef MK_M3_FLIP
#define MK_M3_FLIP 0
#endif
#ifndef MK_M3_GEARLY
#define MK_M3_GEARLY 0
#endif
#ifndef MK_M3_DEFER
#define MK_M3_DEFER 0
#endif
#ifndef MK_M2_WT
#define MK_M2_WT 1
#endif
#ifndef MK_MIX_WT
#define MK_MIX_WT 0
#endif
#ifndef MK_FIN_NT
#define MK_FIN_NT 0
#endif
#ifndef MK_XB_WT
#define MK_XB_WT 0
#endif
#ifndef MK_P0_TEST
#define MK_P0_TEST 0
#endif
#ifndef MK_NT
#define MK_NT 0
#endif
#if MK_NT
#define MK_NTLD(p) __builtin_nontemporal_load(p)
#else
#define MK_NTLD(p) (*(p))
#endif
#ifndef MK_BLK_WIN
#define MK_BLK_WIN 0
#endif
#ifndef MK_BLK_W
#define MK_BLK_W 0
#endif
struct CvtItem { const float* W; const float* gain; bf16_t* WT; size_t dst_row0; int ldn, K, k0, n0, valid, nblk; };
template <class AT> __device__ __forceinline__ CvtItem cvt_decode(const AT& a, int it, int nitems) {
    constexpr int I_IN = 64 * 224, I_OUT = 64 * 64, I_G = 64 * 172, I_D = 172 * 64, I_LAYER = I_IN + I_OUT + 2 * I_G + I_D;
    CvtItem c; c.valid = 0; c.W = nullptr; c.gain = nullptr; c.WT = nullptr; c.dst_row0 = 0; c.ldn = 0; c.K = 0; c.k0 = 0; c.n0 = 0; c.nblk = 0;
    if (it >= nitems) return c;
    const int l = it / I_LAYER; int r = it - l * I_LAYER;
#define CVT_KN(r_, NB_) const int kin_ = (r_) & 3, blk_ = (r_) >> 2, nb = blk_ % (NB_), kb = (blk_ / (NB_)) * 4 + kin_
    if (r < I_IN) { if (a.cvt_mask & 1) { CVT_KN(r, 224); c = CvtItem{a.w_in + (size_t)l * D * INW, a.mix_norm + l * D, a.win_t[l], (size_t)(64 * nb), INW, D, 64 * kb, 64 * nb, 1, MK_BLK_WIN ? NPROJ : 0}; } return c; } r -= I_IN;
    if (r < I_OUT) { if (a.cvt_mask & 2) { CVT_KN(r, 64); c = CvtItem{a.w_out + (size_t)l * D * D, (kb < 32 ? a.ret_gain + l * 2048 : a.gla_gain + l * 2048 - 2048)  , a.wout_t[l], (size_t)(64 * nb), D, D, 64 * kb, 64 * nb, 1, MK_BLK_W ? D : 0}; } return c; } r -= I_OUT;
    if (r < 2 * I_G) { if (a.cvt_mask & 4) { const int up = r >= I_G ? 1 : 0; r -= up * I_G; CVT_KN(r, 172); const int n0 = 64 * nb;
        c = CvtItem{(up ? a.w_up : a.w_gate) + (size_t)l * D * FF, a.ffn_norm + l * D, a.wgu_t[l], (size_t)((n0 >> 7) * 256 + up * 128 + (n0 & 127)), FF, D, 64 * kb, n0, 1, MK_BLK_W ? 2 * FF : 0}; } return c; } r -= 2 * I_G;
    if (a.cvt_mask & 8) { CVT_KN(r, 64); c = CvtItem{a.w_down + (size_t)l * FF * D, nullptr, a.wd_t[l], (size_t)(64 * nb), D, FF, 64 * kb, 64 * nb, 1, MK_BLK_W ? D : 0}; }
#undef CVT_KN
    return c;
}
__device__ __forceinline__ const char* uni_ptr(const char* p) { const unsigned long long x = (unsigned long long)p; const unsigned lo = __builtin_amdgcn_readfirstlane((unsigned)x), hi = __builtin_amdgcn_readfirstlane((unsigned)(x >> 32)); return (const char*)(((unsigned long long)hi << 32) | lo); }
__device__ __forceinline__ void cvt_issue(const CvtItem& c, f32x4 (&v)[16], float (&g)[16], int lane) {
    const int kr = lane >> 4, c4 = (lane & 15) * 4;
    if (c.valid) {
        const char* wb = (const char*)(c.W + (size_t)c.k0 * c.ldn + c.n0); const unsigned vo = (unsigned)((kr * c.ldn + c4) * 4), rstep = (unsigned)(4 * c.ldn * 4);
#pragma unroll
        for (int i = 0; i < 16; ++i) { v[i] = __builtin_nontemporal_load((const f32x4*)(uni_ptr(wb + (size_t)i * rstep) + vo)); g[i] = c.gain ? c.gain[c.k0 + 4 * i + kr] : 1.0f; } }
}
__device__ __forceinline__ void cvt_to_lds(const f32x4 (&v)[16], const float (&g)[16], LAS float* scr, int lane) {
    const int kr = lane >> 4, c4 = (lane & 15) * 4;
#pragma unroll
    for (int i = 0; i < 16; ++i) { LAS float* p = scr + (4 * i + kr) * 65 + c4; p[0] = v[i][0] * g[i]; p[1] = v[i][1] * g[i]; p[2] = v[i][2] * g[i]; p[3] = v[i][3] * g[i]; }
    LDS_WAIT(); asm volatile("" ::: "memory");
}
__device__ __forceinline__ void cvt_store(const CvtItem& c, LAS float* scr, int lane) {
    const int cc = lane >> 3, nn = lane & 7;
#pragma unroll
    for (int j = 0; j < 8; ++j) { const int n = nn + 8 * j; const LAS float* s = scr + (8 * cc) * 65 + n;
        u32x4 o; o.x = cvt_pk_bf16(s[0 * 65], s[1 * 65]); o.y = cvt_pk_bf16(s[2 * 65], s[3 * 65]); o.z = cvt_pk_bf16(s[4 * 65], s[5 * 65]); o.w = cvt_pk_bf16(s[6 * 65], s[7 * 65]);
        char* dp = c.nblk ? (char*)(c.WT + ((size_t)(c.k0 >> 6) * c.nblk + c.dst_row0 + n) * 64 + 8 * cc)
                          : (char*)uni_ptr((const char*)(c.WT + (c.dst_row0 + 8 * j) * (size_t)c.K + c.k0)) + (unsigned)((nn * c.K + 8 * cc) * 2);
        __builtin_nontemporal_store(o, (u32x4*)dp); }
    LDS_WAIT(); asm volatile("" ::: "memory");
}
template <class AT> __device__ __forceinline__ void p0_prologue(const AT& a, LAS unsigned char* lds, int tid, int lane, int wave, int bid, int G) {
    LAS float* scr = (LAS float*)(lds + wave * 16640);
    const int gw = bid * NWAVES + wave, NGW = G * NWAVES;
    constexpr int I_LAYER = 64 * 224 + 64 * 64 + 2 * 64 * 172 + 172 * 64;
    const int nitems = a.cvt_layers * I_LAYER;
    {
        f32x4 v0[16], v1[16]; float g0[16], g1[16];
        CvtItem c0 = cvt_decode(a, gw, nitems), c1 = cvt_decode(a, gw + NGW, nitems);
        cvt_issue(c0, v0, g0, lane); cvt_issue(c1, v1, g1, lane);
#pragma unroll 1
        for (int it = gw; it < nitems; it += 2 * NGW) {
            if (c0.valid) cvt_to_lds(v0, g0, scr, lane);
            const CvtItem n0 = cvt_decode(a, it + 2 * NGW, nitems); cvt_issue(n0, v0, g0, lane);
            if (c0.valid) cvt_store(c0, scr, lane);
            if (c1.valid) cvt_to_lds(v1, g1, scr, lane);
            const CvtItem n1 = cvt_decode(a, it + 3 * NGW, nitems); cvt_issue(n1, v1, g1, lane);
            if (c1.valid) cvt_store(c1, scr, lane);
            c0 = n0; c1 = n1;
        }
    }
    if (a.cvt_mask & 1) for (int i = bid * NTHR + tid; i < a.cvt_layers * 16 * D; i += G * NTHR) { const int l = i / (16 * D), r = i - l * 16 * D, j = r / D, k = r - j * D;
        const float v = a.w_in[(size_t)l * D * INW + (size_t)k * INW + NPROJ + j] * a.mix_norm[l * D + k]; a.wga_t[l][r] = (bf16_t)(cvt_pk_bf16(v, 0.f) & 0xffffu); }
    u64* ss0 = (u64*)(a.ctl + CW_SS);
    for (int i = bid * NTHR + tid; i < 4 * T; i += G * NTHR) ss0[T + i] = 0ull;
    {
        f32x4 xv[16];
        if (gw < T) { const f32x4* xr = (const f32x4*)(a.x + (size_t)gw * D) + lane;
#pragma unroll
            for (int j = 0; j < 16; ++j) xv[j] = xr[64 * j]; }
#pragma unroll 1
        for (int m = gw; m < T; m += NGW) { u32x2* o8 = (u32x2*)(a.xb + (size_t)m * D) + lane; float s = 0.f; u32x2 w[16];
#pragma unroll
            for (int j = 0; j < 16; ++j) { const f32x4 v = xv[j]; s += (v[0] * v[0] + v[1] * v[1]) + (v[2] * v[2] + v[3] * v[3]); w[j].x = cvt_pk_bf16(v[0], v[1]); w[j].y = cvt_pk_bf16(v[2], v[3]); }
            if (m + NGW < T) { const f32x4* xr = (const f32x4*)(a.x + (size_t)(m + NGW) * D) + lane;
#pragma unroll
                for (int j = 0; j < 16; ++j) xv[j] = xr[64 * j]; }
#pragma unroll
            for (int j = 0; j < 16; ++j) { if (MK_XB_WT) __builtin_amdgcn_raw_buffer_store_b64(w[j], __builtin_amdgcn_make_buffer_rsrc((void*)a.xb, 0, 0x7ffffff0, 0x00020000), (unsigned)(((size_t)m * D + 4 * (lane + 64 * j)) * 2), 0, 16); else o8[64 * j] = w[j]; }
            s = wave_sum(s); if (lane == 0) ss0[m] = ss_fix(s); }
    }
}

template <class AT> __device__ __forceinline__ void ga_stage(const AT& a, int l, const u64* ss, LAS unsigned char* lds, int tid, int lane, int wave, int bid, int G) {
    LAS float* red = (LAS float*)lds;
    for (int tb = bid; tb < T / 32; tb += G) {
        f32x4 acc[2] = {(f32x4){0.f, 0.f, 0.f, 0.f}, (f32x4){0.f, 0.f, 0.f, 0.f}};
        const bf16_t* xa = a.xb + (size_t)(tb * 32 + (lane & 15)) * D + wave * 512 + 8 * (lane >> 4);
        const bf16_t* wb = a.wga_t[l] + (size_t)(lane & 15) * D + wave * 512 + 8 * (lane >> 4);
#pragma unroll 8
        for (int ks = 0; ks < 16; ++ks) { const bf16x8 b = *(const bf16x8*)(wb + 32 * ks);
            const bf16x8 a0 = *(const bf16x8*)(xa + 32 * ks), a1 = *(const bf16x8*)(xa + (size_t)16 * D + 32 * ks);
            acc[0] = __builtin_amdgcn_mfma_f32_16x16x32_bf16(a0, b, acc[0], 0, 0, 0); acc[1] = __builtin_amdgcn_mfma_f32_16x16x32_bf16(a1, b, acc[1], 0, 0, 0); }
        *(LAS f32x4*)(red + ((wave * 2 + 0) * 64 + lane) * 4) = acc[0]; *(LAS f32x4*)(red + ((wave * 2 + 1) * 64 + lane) * 4) = acc[1];
        __syncthreads();
        { const int mt = tid >> 8, ln = (tid >> 2) & 63, rg = tid & 3; float s = 0.f;
#pragma unroll
          for (int w = 0; w < 8; ++w) s += red[((w * 2 + mt) * 64 + ln) * 4 + rg];
          const int tok = tb * 32 + 16 * mt + (ln >> 4) * 4 + rg, j = ln & 15;
          a.ga[(size_t)tok * 16 + j] = s * rs_of(ss[tok]); }
        __syncthreads();
    }
}

__device__ __forceinline__ void gate_octet(float (&z)[8][8], const LAS float* gal, const LAS float* wl, const f32x4 b0, const f32x4 b1, int co, int tg) {
#pragma unroll
    for (int e = 0; e < 8; ++e) { z[e][0] = b0[0]; z[e][1] = b0[1]; z[e][2] = b0[2]; z[e][3] = b0[3]; z[e][4] = b1[0]; z[e][5] = b1[1]; z[e][6] = b1[2]; z[e][7] = b1[3]; }
#pragma unroll 2
    for (int r = 0; r < 16; ++r) { const f32x4 w0 = *(const LAS f32x4*)(wl + r * 256 + 8 * co), w1 = *(const LAS f32x4*)(wl + r * 256 + 8 * co + 4);
#pragma unroll
        for (int e = 0; e < 8; ++e) { const float g = gal[(8 * tg + e) * 16 + r];
            z[e][0] = fmaf(g, w0[0], z[e][0]); z[e][1] = fmaf(g, w0[1], z[e][1]); z[e][2] = fmaf(g, w0[2], z[e][2]); z[e][3] = fmaf(g, w0[3], z[e][3]);
            z[e][4] = fmaf(g, w1[0], z[e][4]); z[e][5] = fmaf(g, w1[1], z[e][5]); z[e][6] = fmaf(g, w1[2], z[e][6]); z[e][7] = fmaf(g, w1[3], z[e][7]); } }
#pragma unroll
    for (int j = 0; j < 8; ++j) { float run = 0.f;
#pragma unroll
        for (int e = 0; e < 8; ++e) { const float zz = z[e][j]; run += (fminf(zz, 0.f) - 0.69314718f * __builtin_amdgcn_logf(1.0f + __builtin_amdgcn_exp2f(-1.44269504f * fabsf(zz)))) * 0.0625f; z[e][j] = run; }
        if (j & 1) __builtin_amdgcn_sched_barrier(0); }
}
template <class AT> __device__ __forceinline__ void prep_phase(const AT& a, int l, LAS unsigned char* lds, int tid, int lane, int wave, int bid, int G) {
    LAS float* galA = (LAS float*)lds;
    LAS float* galB = (LAS float*)(lds + 8192);
    LAS float* tot = (LAS float*)(lds + 16384);
    LAS float* wl = (LAS float*)(lds + 32768);
    const float* wup = a.gla_w_up + (size_t)l * 16 * 1024; const float* gb = a.gla_b + l * 1024;
    for (int u = bid; u < 256; u += G) { const int h = u >> 6, c = u & 63, t0 = c * 128;
        u32x4 qin[8], kin[8]; f32x4 b0, b1;
        {
            int tz = tid; asm volatile("" : "+v"(tz)); const int co = tz & 31, tg = tz >> 5, ch = h * 256 + 8 * co;
            const unsigned rowoff = (unsigned)(((t0 + 8 * tg) * 1024 + ch) * 2);
            const f32x4 gB = *(const f32x4*)((const char*)(a.ga + (size_t)t0 * 16) + (unsigned)(tz * 16));
            f32x4 gA = (f32x4){0.f, 0.f, 0.f, 0.f}; if (c & 1) gA = *(const f32x4*)((const char*)(a.ga + (size_t)(t0 - 128) * 16) + (unsigned)(tz * 16));
            const unsigned wo = (unsigned)(((tz >> 6) * 1024 + 4 * (tz & 63)) * 4);
            const f32x4 wv0 = *(const f32x4*)((const char*)(wup + h * 256) + wo), wv1 = *(const f32x4*)((const char*)(wup + h * 256 + 8 * 1024) + wo);
            b0 = *(const f32x4*)((const char*)(gb + h * 256) + (unsigned)(co * 32)); b1 = *(const f32x4*)((const char*)(gb + h * 256 + 4) + (unsigned)(co * 32));
#pragma unroll
            for (int e = 0; e < 8; ++e) { qin[e] = MK_NTLD((const u32x4*)((const char*)a.gq + (rowoff + (unsigned)(e * 2048)))); kin[e] = MK_NTLD((const u32x4*)((const char*)a.gk + (rowoff + (unsigned)(e * 2048)))); }
            *(LAS f32x4*)(galB + tz * 4) = gB; *(LAS f32x4*)(galA + tz * 4) = gA;
            *(LAS f32x4*)(wl + (tz >> 6) * 256 + 4 * (tz & 63)) = wv0; *(LAS f32x4*)(wl + (8 + (tz >> 6)) * 256 + 4 * (tz & 63)) = wv1;
        }
        __syncthreads();
        int tz2 = tid; asm volatile("" : "+v"(tz2)); const int co = tz2 & 31, tg = tz2 >> 5, ch = h * 256 + 8 * co;
        const unsigned rowoff = (unsigned)(((t0 + 8 * tg) * 1024 + ch) * 2);
        float z[8][8]; float base[8];
#pragma unroll
        for (int j = 0; j < 8; ++j) base[j] = 0.f;
        if (c & 1) {
            gate_octet(z, galA, wl, b0, b1, co, tg);
#pragma unroll
            for (int j = 0; j < 8; ++j) tot[tg * 256 + 8 * co + j] = z[7][j];
            __syncthreads();
            for (int g2 = 0; g2 < 16; ++g2) { const f32x4 t0v = *(const LAS f32x4*)(tot + g2 * 256 + 8 * co), t1v = *(const LAS f32x4*)(tot + g2 * 256 + 8 * co + 4);
                base[0] += t0v[0]; base[1] += t0v[1]; base[2] += t0v[2]; base[3] += t0v[3]; base[4] += t1v[0]; base[5] += t1v[1]; base[6] += t1v[2]; base[7] += t1v[3]; }
            __syncthreads();
        }
        gate_octet(z, galB, wl, b0, b1, co, tg);
#pragma unroll
        for (int j = 0; j < 8; ++j) tot[tg * 256 + 8 * co + j] = z[7][j];
        __syncthreads();
        float off[8];
#pragma unroll
        for (int j = 0; j < 8; ++j) off[j] = base[j];
        for (int g2 = 0; g2 < tg; ++g2) { const f32x4 t0v = *(const LAS f32x4*)(tot + g2 * 256 + 8 * co), t1v = *(const LAS f32x4*)(tot + g2 * 256 + 8 * co + 4);
            off[0] += t0v[0]; off[1] += t0v[1]; off[2] += t0v[2]; off[3] += t0v[3]; off[4] += t1v[0]; off[5] += t1v[1]; off[6] += t1v[2]; off[7] += t1v[3]; }
#pragma unroll
        for (int e = 0; e < 8; ++e) { float qv[8], kv[8];
            const unsigned qw[4] = {qin[e].x, qin[e].y, qin[e].z, qin[e].w}, kw[4] = {kin[e].x, kin[e].y, kin[e].z, kin[e].w};
#pragma unroll
            for (int j = 0; j < 8; ++j) { const float cum = z[e][j] + off[j]; const float eq = __builtin_amdgcn_exp2f(1.44269504f * cum), ek = __builtin_amdgcn_rcpf(eq);
                const float qf = (j & 1) ? bf_hi(qw[j >> 1]) : bf_lo(qw[j >> 1]), kf = (j & 1) ? bf_hi(kw[j >> 1]) : bf_lo(kw[j >> 1]); qv[j] = qf * eq; kv[j] = kf * ek; }
            u32x4 qo, ko; qo.x = cvt_pk_bf16(qv[0], qv[1]); qo.y = cvt_pk_bf16(qv[2], qv[3]); qo.z = cvt_pk_bf16(qv[4], qv[5]); qo.w = cvt_pk_bf16(qv[6], qv[7]);
            ko.x = cvt_pk_bf16(kv[0], kv[1]); ko.y = cvt_pk_bf16(kv[2], kv[3]); ko.z = cvt_pk_bf16(kv[4], kv[5]); ko.w = cvt_pk_bf16(kv[6], kv[7]);
            if (MK_MIX_WT) { __builtin_amdgcn_raw_buffer_store_b128(qo, __builtin_amdgcn_make_buffer_rsrc((void*)a.qg, 0, 0x7ffffff0, 0x00020000), rowoff + (unsigned)(e * 2048), 0, 16); __builtin_amdgcn_raw_buffer_store_b128(ko, __builtin_amdgcn_make_buffer_rsrc((void*)a.kg, 0, 0x7ffffff0, 0x00020000), rowoff + (unsigned)(e * 2048), 0, 16); }
            else { *(u32x4*)((char*)a.qg + (rowoff + (unsigned)(e * 2048))) = qo; *(u32x4*)((char*)a.kg + (rowoff + (unsigned)(e * 2048))) = ko; }
            __builtin_amdgcn_sched_barrier(0); }
        if ((c & 1) && tg == 15) {
#pragma unroll
            for (int j = 0; j < 8; ++j) a.lam[(c >> 1) * 1024 + ch + j] = __builtin_amdgcn_exp2f(1.44269504f * (z[7][j] + off[j])); }
        __syncthreads();
    }
}

template <class AT> __device__ __forceinline__ void m1_phase(const AT& a, LAS unsigned char* lds, int tid, int wave, int bid, int G) {
    const int nsu = bid < 512 ? (512 - bid + G - 1) / G : 0, npass = 4 * nsu;
    if (npass == 0) return;
    f32x4 acc[8][4];
#pragma unroll
    for (int i = 0; i < 8; ++i)
#pragma unroll
        for (int j = 0; j < 4; ++j) acc[i][j] = (f32x4){0.f, 0.f, 0.f, 0.f};
    u32x2 w[8];
#define M1_DECODE(p_) const int su_ = bid + ((p_) >> 2) * G; const bf16_t *Ks, *Vt; int ldk, c2; \
        if (su_ < 256) { const int h = su_ >> 5; c2 = su_ & 31; Ks = a.kr + h * 256; ldk = 2048; Vt = MK_VT_BLK ? a.vrt + ((size_t)c2 * 2048 + h * 256) * 256 : a.vrt + (size_t)(h * 256) * T; } \
        else { const int s_ = su_ - 256, vh = (s_ >> 3) & 1, ix_ = (s_ & 7) | ((s_ >> 4) << 3), h = ix_ >> 5; c2 = ix_ & 31;     Ks = a.kg + h * 256; ldk = 1024; Vt = MK_VT_BLK ? a.vgt + ((size_t)c2 * 2048 + h * 512 + vh * 256) * 256 : a.vgt + (size_t)(h * 512 + vh * 256) * T; } \
        const int tk = c2 * 256 + ((p_) & 3) * 64
#define M1_ISSUE(p_, half_) do { M1_DECODE(p_); int tz = tid; asm volatile("" : "+v"(tz)); \
        { const int ln = tz & 63; const char* vbase = (const char*)(Vt + (MK_VT_BLK ? ((p_) & 3) * 64 : tk)); \
          _Pragma("unroll") for (int i = 0; i < 4; ++i) { const int r = 32 * wave + 8 * i + (ln >> 3), c = (ln & 7) ^ (4 * (i & 1) + (ln >> 4)); \
            __builtin_amdgcn_global_load_lds((const unsigned*)(vbase + (unsigned)((r * (MK_VT_BLK ? 256 : T) + c * 8) * 2)), (LAS unsigned*)(lds + 65536 + (half_) * 32768 + (4 * wave + i) * 1024), 16, 0, 0); } } \
        { const int dq = tz & 63, q = tz >> 6; const char* kbase = (const char*)(Ks + (size_t)tk * ldk); const unsigned kof = (unsigned)((8 * q * ldk + 4 * dq) * 2); \
          _Pragma("unroll") for (int i = 0; i < 8; ++i) w[i] = *(const u32x2*)(kbase + (kof + (unsigned)(i * ldk * 2))); } } while (0)
#define M1_KEL(i_) ((dd & 2) ? ((dd & 1) ? (w[i_].y >> 16) : (w[i_].y & 0xffffu)) : ((dd & 1) ? (w[i_].x >> 16) : (w[i_].x & 0xffffu)))
#define M1_STASH(half_) do { int tz = tid; asm volatile("" : "+v"(tz)); \
        { const int dq = tz & 63, q = tz >> 6; _Pragma("unroll") for (int dd = 0; dd < 4; ++dd) { u32x4 o; \
            o.x = M1_KEL(0) | (M1_KEL(1) << 16); o.y = M1_KEL(2) | (M1_KEL(3) << 16); o.z = M1_KEL(4) | (M1_KEL(5) << 16); o.w = M1_KEL(6) | (M1_KEL(7) << 16); \
            const int d = 4 * dq + dd, r = (d & ~31) + 16 * ((d >> 2) & 1) + 4 * ((d >> 3) & 3) + (d & 3); \
            *(LAS u32x4*)(lds + r * 256 + (((8 * (half_) + q) ^ (r & 15)) << 4)) = o; } } \
        asm volatile("s_waitcnt vmcnt(0)" ::: "memory"); } while (0)
#define M1_COMPUTE(half_) do { int tz = tid; asm volatile("" : "+v"(tz)); const int lr = tz & 15, lq = (tz & 63) >> 4, wd = wave & 1, wv = wave >> 1; \
        LAS unsigned char* kb = lds + (128 * wd + lr) * 256 + (((lq ^ lr) & 3) << 4); LAS unsigned char* vb = lds + 65536 + (half_) * 32768 + (64 * wv + lr) * 128; \
        _Pragma("unroll") for (int kk = 0; kk < 2; ++kk) { const int o = ((2 * (half_) + kk) ^ (lr >> 2)) << 6, ov = ((4 * kk + lq) ^ (lr >> 1)) << 4; bf16x8 Y[4]; \
            _Pragma("unroll") for (int j = 0; j < 4; ++j) Y[j] = *(const LAS bf16x8*)(vb + ov + j * 2048); \
            _Pragma("unroll") for (int ih = 0; ih < 2; ++ih) { bf16x8 X[4]; \
                _Pragma("unroll") for (int i = 0; i < 4; ++i) X[i] = *(const LAS bf16x8*)(kb + o + (4 * ih + i) * 4096); \
                _Pragma("unroll") for (int i = 0; i < 4; ++i) { _Pragma("unroll") for (int j = 0; j < 4; ++j) acc[4 * ih + i][j] = __builtin_amdgcn_mfma_f32_16x16x32_bf16(X[i], Y[j], acc[4 * ih + i][j], 0, 0, 0); } \
                asm volatile("" ::: "memory"); } } } while (0)
    M1_ISSUE(0, 0); M1_STASH(0);
    __syncthreads();
#pragma unroll 1
    for (int p = 0; p < npass; p += 2) {
        M1_ISSUE(p + 1, 1);
        M1_COMPUTE(0);
        M1_STASH(1);
        __syncthreads();
        const bool more = p + 2 < npass;
        if (more) M1_ISSUE(p + 2, 0);
        M1_COMPUTE(1);
        if (more) M1_STASH(0);
        if ((p & 3) == 2) {
            const int su = bid + (p >> 2) * G; bf16_t* out;
            if (su < 256) { const int h = su >> 5, c2 = su & 31; out = a.kvr + (size_t)(h * 32 + c2) * 65536; }
            else { const int s_ = su - 256, vh = (s_ >> 3) & 1, ix_ = (s_ & 7) | ((s_ >> 4) << 3), h = ix_ >> 5, c2 = ix_ & 31; out = a.kvg + (size_t)(h * 32 + c2) * 131072 + (size_t)vh * 65536; }
            int tz = tid; asm volatile("" : "+v"(tz)); const int lr = tz & 15, lq = (tz & 63) >> 4, wd = wave & 1, wv = wave >> 1;
            bf16_t* op = out + (size_t)((64 * wv + lr) * 256 + 128 * wd + 8 * lq); const auto ors = __builtin_amdgcn_make_buffer_rsrc((void*)out, 0, 0x7ffffff0, 0x00020000); const unsigned oo = (unsigned)(((64 * wv + lr) * 256 + 128 * wd + 8 * lq) * 2); (void)op;
#pragma unroll
            for (int i2 = 0; i2 < 4; ++i2)
#pragma unroll
                for (int j = 0; j < 4; ++j) { u32x4 w4; w4.x = cvt_pk_bf16(acc[2 * i2][j][0], acc[2 * i2][j][1]); w4.y = cvt_pk_bf16(acc[2 * i2][j][2], acc[2 * i2][j][3]);
                    w4.z = cvt_pk_bf16(acc[2 * i2 + 1][j][0], acc[2 * i2 + 1][j][1]); w4.w = cvt_pk_bf16(acc[2 * i2 + 1][j][2], acc[2 * i2 + 1][j][3]); if (MK_MIX_WT) __builtin_amdgcn_raw_buffer_store_b128(w4, ors, oo + (unsigned)(((16 * j) * 256 + 32 * i2) * 2), 0, 16); else *(u32x4*)(op + (16 * j) * 256 + 32 * i2) = w4; }
#pragma unroll
            for (int i = 0; i < 8; ++i)
#pragma unroll
                for (int j = 0; j < 4; ++j) acc[i][j] = (f32x4){0.f, 0.f, 0.f, 0.f};
        }
        __syncthreads();
    }
#undef M1_DECODE
#undef M1_ISSUE
#undef M1_KEL
#undef M1_STASH
#undef M1_COMPUTE
}
template <class AT> __device__ __forceinline__ void m2_phase(const AT& a, int tid, int bid, int G) {
    for (int blk = bid; blk < 256; blk += G) { const int vec = blk * NTHR + tid;
        bf16_t* base; size_t cstride; const float* lamp = nullptr; float lsc = 0.f;
        if (vec < 65536) { const int h = vec >> 13, rem = vec & 8191; base = a.kvr + (size_t)(h * 32) * 65536 + (size_t)rem * 8; cstride = 65536; lsc = exp2f(256.0f * log2f(1.0f - exp2f(-5.0f - (float)h))); }
        else { const int v2 = vec - 65536, h = v2 >> 14, rem = v2 & 16383; base = a.kvg + (size_t)(h * 32) * 131072 + (size_t)rem * 8; cstride = 131072; lamp = a.lam + h * 256 + 8 * (rem & 31); }
        const auto srs = __builtin_amdgcn_make_buffer_rsrc((void*)(blk < 128 ? a.kvr + (size_t)((blk >> 4) * 32) * 65536 : a.kvg + (size_t)(((blk - 128) >> 5) * 32) * 131072), 0, 0x7ffffff0, 0x00020000);
        const unsigned soff = (unsigned)((blk < 128 ? (vec & 8191) : ((vec - 65536) & 16383)) * 16), sstep = (unsigned)(blk < 128 ? 65536 * 2 : 131072 * 2);
        float st[8]; float z0 = 0.f; asm volatile("" : "+v"(z0));
#pragma unroll
        for (int e = 0; e < 8; ++e) st[e] = z0;
        u32x4 kv[2][4]; f32x4 l0[2][4], l1[2][4];
#define M2_LOAD(B, c0_) do { _Pragma("unroll") for (int j = 0; j < 4; ++j) kv[B][j] = MK_NTLD((const u32x4*)(base + (size_t)((c0_) + j) * cstride)); \
            if (lamp) { _Pragma("unroll") for (int j = 0; j < 4; ++j) { l0[B][j] = *(const f32x4*)(lamp + ((c0_) + j) * 1024); l1[B][j] = *(const f32x4*)(lamp + ((c0_) + j) * 1024 + 4); } } \
            else { _Pragma("unroll") for (int j = 0; j < 4; ++j) { l0[B][j] = (f32x4){lsc, lsc, lsc, lsc}; l1[B][j] = l0[B][j]; } } } while (0)
        M2_LOAD(0, 0);
#pragma unroll
        for (int b = 0; b < 8; ++b) { const int c0 = 4 * b, B = b & 1;
            if (b < 7) M2_LOAD((b + 1) & 1, c0 + 4);
#pragma unroll
            for (int j = 0; j < 4; ++j) {
                u32x4 o; o.x = cvt_pk_bf16(st[0], st[1]); o.y = cvt_pk_bf16(st[2], st[3]); o.z = cvt_pk_bf16(st[4], st[5]); o.w = cvt_pk_bf16(st[6], st[7]); if (MK_M2_WT) __builtin_amdgcn_raw_buffer_store_b128(o, srs, soff + (unsigned)(c0 + j) * sstep, 0, 16); else *(u32x4*)(base + (size_t)(c0 + j) * cstride) = o;
                st[0] = l0[B][j][0] * (st[0] + bf_lo(kv[B][j].x)); st[1] = l0[B][j][1] * (st[1] + bf_hi(kv[B][j].x)); st[2] = l0[B][j][2] * (st[2] + bf_lo(kv[B][j].y)); st[3] = l0[B][j][3] * (st[3] + bf_hi(kv[B][j].y));
                st[4] = l1[B][j][0] * (st[4] + bf_lo(kv[B][j].z)); st[5] = l1[B][j][1] * (st[5] + bf_hi(kv[B][j].z)); st[6] = l1[B][j][2] * (st[6] + bf_lo(kv[B][j].w)); st[7] = l1[B][j][3] * (st[7] + bf_hi(kv[B][j].w)); }
            asm volatile("" ::: "memory");
        }
#undef M2_LOAD
    }
}

#define M3_LANE() int tz_ = tid; asm volatile("" : "+v"(tz_)); const int lr = tz_ & 15, lq = (tz_ & 63) >> 4; (void)lr; (void)lq
#define M3_BASES() LAS unsigned char* qb4[4]; LAS unsigned char* pb4[4]; _Pragma("unroll") for (int b = 0; b < 4; ++b) { const int o_ = ((b ^ (lr >> 2)) << 6) + (((lq ^ lr) & 3) << 4); qb4[b] = QL + lr * 512 + o_; }
#define M3_PBASES() do { int tp_ = tid; asm volatile("" : "+v"(tp_)); const int lr_ = tp_ & 15, lq_ = (tp_ & 63) >> 4; _Pragma("unroll") for (int b = 0; b < 4; ++b) pb4[b] = PL + lr_ * 512 + (((b ^ (lr_ >> 2)) << 6) + (((lq_ ^ lr_) & 3) << 4)); } while (0)
#define QFRAG(rt, ks) (*(const LAS bf16x8*)(qb4[(ks) & 3] + (rt) * 8192 + ((ks) >> 2) * 256))
#define PFRAG(rt, ks) (*(const LAS bf16x8*)(pb4[(ks) & 3] + (rt) * 8192 + ((ks) >> 2) * 256))
struct M3Pend { u32x4 w[2][8]; bf16_t* mixed; int t0; int lpr; };
__device__ __forceinline__ void m3_flush(M3Pend& pd, int tid, int wave) {
    if (pd.lpr) {
        int tf_ = tid; asm volatile("" : "+v"(tf_)); const int ln = tf_ & 63, sh = (pd.lpr == 64) ? 6 : 5, rpi = 64 >> sh, ni = 8 >> (6 - sh), rsub = ln >> sh, c8 = ln & (pd.lpr - 1);
        const auto rs = __builtin_amdgcn_make_buffer_rsrc((void*)pd.mixed, 0, 0x7ffffff0, 0x00020000);
#pragma unroll
        for (int pass = 0; pass < 2; ++pass)
#pragma unroll
            for (int i = 0; i < 8; ++i) if (i < ni) { const int rl = wave * 8 + i * rpi + rsub;
                __builtin_amdgcn_raw_buffer_store_b128(pd.w[pass][i], rs, (unsigned)(((pd.t0 + 64 * pass + rl) * 4096 + 8 * c8) * 2), 0, MK_M3_WT ? 16 : 0); }
        pd.lpr = 0;
    }
}
template <int CT, bool LNORM, int NB, int RD, bool INPEND>
__device__ __forceinline__ void m3_unit(LAS unsigned char* lds, const bf16_t* Q, int ldq, const bf16_t* Kk, const bf16_t* VT, const bf16_t* ST, const bf16_t* gate, const float* gain, bf16_t* mixed, int t0, int tk0, int tid, int wave, M3Pend& pend, int probe = 0) {
    constexpr int DV = CT * 128, NP = 4 * NB;
    LAS unsigned char* QL = lds; LAS unsigned char* PL = lds + 65536; LAS f32x2* STATS = (LAS f32x2*)(lds + 131072);
    const int vb = wave * 16 * CT;
    bf16x8 ring[RD][CT];
#define M3_LOADV(ks, R) do { _Pragma("unroll") for (int ct = 0; ct < CT; ++ct) R[ct] = *(const bf16x8*)(VT + (MK_VT_BLK ? 0 : tk0) + (vo + (unsigned)((16 * ct) * (MK_VT_BLK ? 256 : T) + 32 * (ks)))); } while (0)
#define M3_LOADS(ks, R) do { _Pragma("unroll") for (int ct = 0; ct < CT; ++ct) R[ct] = *(const bf16x8*)(ST + (so + (unsigned)((16 * ct) * 256 + 32 * (ks)))); } while (0)
#define M3_LOADSTEP(k, R) do { if ((k) < 8) M3_LOADS((k), R); else if ((k) < NP + 8) M3_LOADV((k) - 8, R); } while (0)
    {
        M3_LANE(); M3_BASES();
#pragma unroll
        for (int i = 0; i < 8; ++i) { const int idx = tz_ + 512 * i, row = idx >> 5, ch = idx & 31;
            const u32x4 v = *(const u32x4*)(Q + (size_t)(t0 + row) * ldq + ch * 8); *(LAS u32x4*)(QL + row * 512 + ((ch ^ (row & 15)) << 4)) = v; }
        bf16x8 Kf[NB][8];
#pragma unroll
        for (int kb = 0; kb < NB; ++kb)
#pragma unroll
            for (int ks = 0; ks < 8; ++ks) Kf[kb][ks] = *(const bf16x8*)(Kk + (size_t)(tk0 + 128 * kb + 16 * wave + lr) * ldq + 32 * ks + 8 * lq);
        if constexpr (INPEND) { if (MK_M3_DEFER == 1) m3_flush(pend, tid, wave); }
        { const unsigned vo = (unsigned)((vb + lr) * (MK_VT_BLK ? 256 : T) + 8 * lq), so = (unsigned)((vb + lr) * 256 + 8 * lq);
#pragma unroll
            for (int j = 0; j < RD - 1; ++j) M3_LOADSTEP(j, ring[j]); }
        __syncthreads();
#pragma unroll
        for (int kb = 0; kb < NB; ++kb) { const bool diag = (kb == NB - 1);
#pragma unroll
            for (int rt = 0; rt < 8; ++rt) { f32x4 p = (f32x4){0.f, 0.f, 0.f, 0.f};
                if (!diag || rt >= wave) {
#pragma unroll
                    for (int ks = 0; ks < 8; ++ks) { const bf16x8 qf = QFRAG(rt, ks); p = __builtin_amdgcn_mfma_f32_16x16x32_bf16(Kf[kb][ks], qf, p, 0, 0, 0); }
                    if (diag && rt == wave) {
#pragma unroll
                        for (int r = 0; r < 4; ++r) if (4 * lq + r > lr) p[r] = 0.f; } }
                u32x2 w; w.x = cvt_pk_bf16(p[0], p[1]); w.y = cvt_pk_bf16(p[2], p[3]);
                *(LAS u32x2*)(PL + (16 * rt + lr) * 512 + ((((16 * kb + 2 * wave + (lq >> 1)) ^ lr) << 4) + ((lq & 1) << 3))) = w; } }
        __syncthreads();
    }
#if MK_M3_EPI == 2
    constexpr int LPR_ = DV / 8, RPI_ = 64 / LPR_, NI_ = 8 / RPI_; constexpr bool GEARLY = MK_M3_GEARLY && CT == 2;
    u32x4 gvE0[NI_], gvE1[NI_];
    if constexpr (GEARLY) { int tg_ = tid; asm volatile("" : "+v"(tg_)); const int ln_ = tg_ & 63;
#pragma unroll
        for (int i = 0; i < NI_; ++i) { const int rl = wave * 8 + i * RPI_ + ln_ / LPR_;
            gvE0[i] = *(const u32x4*)(gate + ((unsigned)((t0 + rl) * 2048 + 8 * (ln_ % LPR_)))); gvE1[i] = *(const u32x4*)(gate + ((unsigned)((t0 + 64 + rl) * 2048 + 8 * (ln_ % LPR_)))); } }
#endif
    f32x4 acc[8][CT];
#pragma unroll
    for (int rt = 0; rt < 8; ++rt)
#pragma unroll
        for (int ct = 0; ct < CT; ++ct) acc[rt][ct] = (f32x4){0.f, 0.f, 0.f, 0.f};
    {
        M3_LANE(); M3_BASES();
        const unsigned vo = (unsigned)((vb + lr) * (MK_VT_BLK ? 256 : T) + 8 * lq), so = (unsigned)((vb + lr) * 256 + 8 * lq);
        unsigned pboff = 0; int prpi = 0, pni = 0;
        const auto prs = __builtin_amdgcn_make_buffer_rsrc((void*)pend.mixed, 0, 0x7ffffff0, 0x00020000);
        if constexpr (INPEND) { if (MK_M3_DEFER == 2 && pend.lpr) { const int ln_ = tz_ & 63, sh_ = (pend.lpr == 64) ? 6 : 5; prpi = 64 >> sh_; pni = 8 >> (6 - sh_);
            pboff = (unsigned)(((pend.t0 + wave * 8 + (ln_ >> sh_)) * 4096 + 8 * (ln_ & (pend.lpr - 1))) * 2); } }
#define M3_PFLUSH(k) do { if constexpr (INPEND) { if (MK_M3_DEFER == 2 && ((k) & 7) < pni) __builtin_amdgcn_raw_buffer_store_b128(pend.w[(k) >> 3][(k) & 7], prs, pboff + (unsigned)((64 * ((k) >> 3) + ((k) & 7) * prpi) * 8192), 0, MK_M3_WT ? 16 : 0); } } while (0)
#define M3_MMA(R, FRAG) do { _Pragma("unroll") for (int rt = 0; rt < 8; ++rt) { const bf16x8 bfr = FRAG; \
            _Pragma("unroll") for (int ct = 0; ct < CT; ++ct) acc[rt][ct] = __builtin_amdgcn_mfma_f32_16x16x32_bf16(R[ct], bfr, acc[rt][ct], 0, 0, 0); } asm volatile("" ::: "memory"); } while (0)
#define M3_NEXT(k) do { if (!(MK_M3_PROBE >= 2 && probe)) M3_LOADSTEP((k) + RD - 1, ring[((k) + RD - 1) % RD]); } while (0)
#define M3_STEP(k) do { M3_PFLUSH(k); if ((k) < NP + 8) { if ((k) == 8) M3_PBASES(); M3_NEXT(k); if ((k) < 8) M3_MMA(ring[(k) % RD], QFRAG(rt, (k) & 7)); else M3_MMA(ring[(k) % RD], PFRAG(rt, ((k) - 8) & 7)); } } while (0)
        M3_STEP(0); M3_STEP(1); M3_STEP(2); M3_STEP(3); M3_STEP(4); M3_STEP(5); M3_STEP(6); M3_STEP(7);
        M3_STEP(8); M3_STEP(9); M3_STEP(10); M3_STEP(11); M3_STEP(12); M3_STEP(13); M3_STEP(14); M3_STEP(15);
        if constexpr (INPEND) { if (MK_M3_DEFER == 2) pend.lpr = 0; }
#undef M3_STEP
#undef M3_NEXT
#undef M3_MMA
#undef M3_PFLUSH
    }
#if MK_M3_EPI == 0
    {
        M3_LANE();
#pragma unroll
        for (int rt = 0; rt < 8; ++rt) { float s1 = 0.f, s2 = 0.f;
#pragma unroll
            for (int ct = 0; ct < CT; ++ct)
#pragma unroll
                for (int r = 0; r < 4; ++r) { const float x = acc[rt][ct][r]; s1 += x; s2 += x * x; }
            s1 += __shfl_xor(s1, 16); s1 += __shfl_xor(s1, 32); s2 += __shfl_xor(s2, 16); s2 += __shfl_xor(s2, 32);
            if (lq == 0) STATS[(16 * rt + lr) * 8 + wave] = (f32x2){s1, s2}; }
        __syncthreads();
    }
#pragma unroll
    for (int rt = 0; rt < 8; ++rt) { M3_LANE(); const int row = 16 * rt + lr;
        float s1 = 0.f, s2 = 0.f;
#pragma unroll
        for (int w = 0; w < 8; ++w) { const f32x2 s = STATS[row * 8 + w]; s1 += s[0]; s2 += s[1]; }
        const float mean = LNORM ? s1 * (1.0f / DV) : 0.f; const float var = s2 * (1.0f / DV) - mean * mean; const float rstd = 1.0f / sqrtf(var + 1e-6f);
        const size_t to = (size_t)(t0 + row);
#pragma unroll
        for (int ct = 0; ct < CT; ++ct) { const int col = vb + 16 * ct + 4 * lq; const u32x2 g = *(const u32x2*)(gate + to * 2048 + col);
            const f32x4 x = acc[rt][ct]; u32x2 w;
            w.x = cvt_pk_bf16((x[0] - mean) * rstd * bf_lo(g.x), (x[1] - mean) * rstd * bf_hi(g.x));
            w.y = cvt_pk_bf16((x[2] - mean) * rstd * bf_lo(g.y), (x[3] - mean) * rstd * bf_hi(g.y));
            *(u32x2*)(mixed + to * 4096 + col) = w; }
        asm volatile("" ::: "memory"); }
#elif MK_M3_EPI == 1
    {
        M3_LANE();
        const unsigned go = (unsigned)((t0 + lr) * 2048 + vb + 4 * lq), mo = (unsigned)((t0 + lr) * 4096 + vb + 4 * lq);
        u32x2 g0[4][CT], g1[4][CT];
#define M3_GLOAD(G, HB) do { _Pragma("unroll") for (int r4 = 0; r4 < 4; ++r4) { _Pragma("unroll") for (int ct = 0; ct < CT; ++ct) G[r4][ct] = (MK_M3_PROBE && probe) ? (u32x2){0x3f803f80u, 0x3f803f80u} : *(const u32x2*)(gate + (go + (unsigned)((16 * (4 * (HB) + r4)) * 2048 + 16 * ct))); } } while (0)
#define M3_GFOLD(G, HB) do { _Pragma("unroll") for (int r4 = 0; r4 < 4; ++r4) { _Pragma("unroll") for (int ct = 0; ct < CT; ++ct) { f32x4& x = acc[4 * (HB) + r4][ct]; \
            x[0] *= bf_lo(G[r4][ct].x); x[1] *= bf_hi(G[r4][ct].x); x[2] *= bf_lo(G[r4][ct].y); x[3] *= bf_hi(G[r4][ct].y); } } } while (0)
#define M3_ROWS(G, HB) do { _Pragma("unroll") for (int r4 = 0; r4 < 4; ++r4) { const int rt = 4 * (HB) + r4, row = 16 * rt + lr; float s1 = 0.f, s2 = 0.f; \
            _Pragma("unroll") for (int w = 0; w < 8; ++w) { const f32x2 s = STATS[row * 8 + w]; s1 += s[0]; s2 += s[1]; } \
            const float mean = LNORM ? s1 * (1.0f / DV) : 0.f; const float var = s2 * (1.0f / DV) - mean * mean; const float rstd = 1.0f / sqrtf(var + 1e-6f); \
            _Pragma("unroll") for (int ct = 0; ct < CT; ++ct) { const f32x4 x = acc[rt][ct]; u32x2 w; \
                if (LNORM) { w.x = cvt_pk_bf16((x[0] - mean) * rstd * bf_lo(G[r4][ct].x), (x[1] - mean) * rstd * bf_hi(G[r4][ct].x)); w.y = cvt_pk_bf16((x[2] - mean) * rstd * bf_lo(G[r4][ct].y), (x[3] - mean) * rstd * bf_hi(G[r4][ct].y)); } \
                else { w.x = cvt_pk_bf16(x[0] * rstd, x[1] * rstd); w.y = cvt_pk_bf16(x[2] * rstd, x[3] * rstd); } \
                if (!(MK_M3_PROBE && probe)) *(u32x2*)(mixed + (mo + (unsigned)((16 * rt) * 4096 + 16 * ct))) = w; } } } while (0)
        __builtin_amdgcn_sched_barrier(0);
        M3_GLOAD(g0, 0);
#pragma unroll
        for (int rt = 0; rt < 8; ++rt) { float s1 = 0.f, s2 = 0.f;
#pragma unroll
            for (int ct = 0; ct < CT; ++ct)
#pragma unroll
                for (int r = 0; r < 4; ++r) { const float x = acc[rt][ct][r]; s1 += x; s2 += x * x; }
            s1 += __shfl_xor(s1, 16); s1 += __shfl_xor(s1, 32); s2 += __shfl_xor(s2, 16); s2 += __shfl_xor(s2, 32);
            if (lq == 0) STATS[(16 * rt + lr) * 8 + wave] = (f32x2){s1, s2}; }
        asm volatile("" ::: "memory");
        if (!LNORM) M3_GFOLD(g0, 0);
        M3_GLOAD(g1, 1);
        __syncthreads();
        M3_ROWS(g0, 0);
        asm volatile("" ::: "memory");
        if (!LNORM) M3_GFOLD(g1, 1);
        M3_ROWS(g1, 1);
#undef M3_GLOAD
#undef M3_GFOLD
#undef M3_ROWS
    }
#else
    {
        constexpr int LPR = DV / 8, RPI = 64 / LPR, NI = 8 / RPI;
        LAS unsigned char* OT = lds;
        u32x4 gv0[NI], gv1[NI];
        const auto mixrs = __builtin_amdgcn_make_buffer_rsrc((void*)mixed, 0, 0x7ffffff0, 0x00020000);
#define M3_GROWS(G, PASS) do { int tg_ = tid; asm volatile("" : "+v"(tg_)); const int ln_ = tg_ & 63; _Pragma("unroll") for (int i = 0; i < NI; ++i) { const int rl = wave * 8 + i * RPI + ln_ / LPR; \
            G[i] = ((MK_M3_PROBE == 1 || MK_M3_PROBE == 2 || MK_M3_PROBE == 4) && probe) ? (u32x4){0x3f803f80u, 0x3f803f80u, 0x3f803f80u, 0x3f803f80u} : MK_NTLD((const u32x4*)(gate + ((unsigned)((t0 + 64 * (PASS) + rl) * 2048 + 8 * (ln_ % LPR))))); } } while (0)
#define M3_NORM(PASS) do { M3_LANE(); _Pragma("unroll") for (int r4 = 0; r4 < 4; ++r4) { const int rt = 4 * (PASS) + r4, row = 16 * rt + lr; float s1 = 0.f, s2 = 0.f; \
            _Pragma("unroll") for (int w = 0; w < 8; ++w) { const f32x2 sv = STATS[row * 8 + w]; s1 += sv[0]; s2 += sv[1]; } \
            const float mean = LNORM ? s1 * (1.0f / DV) : 0.f; const float var = s2 * (1.0f / DV) - mean * mean; const float rstd = 1.0f / sqrtf(var + 1e-6f); \
            _Pragma("unroll") for (int ct = 0; ct < CT; ++ct) { const f32x4 x = acc[rt][ct]; f32x4 y; y[0] = (x[0] - mean) * rstd; y[1] = (x[1] - mean) * rstd; y[2] = (x[2] - mean) * rstd; y[3] = (x[3] - mean) * rstd; \
                *(LAS f32x4*)(OT + (16 * r4 + lr) * (DV * 4) + ((((vb >> 2) + 4 * ct + lq) ^ lr) << 4)) = y; } } } while (0)
#define M3_OUT(G, PASS) do { int to_ = tid; asm volatile("" : "+v"(to_)); const int ln_ = to_ & 63, c8 = ln_ % LPR; _Pragma("unroll") for (int i = 0; i < NI; ++i) { const int rl = wave * 8 + i * RPI + ln_ / LPR; \
            const f32x4 ya = *(const LAS f32x4*)(OT + rl * (DV * 4) + (((2 * c8) ^ (rl & 15)) << 4)), yb = *(const LAS f32x4*)(OT + rl * (DV * 4) + (((2 * c8 + 1) ^ (rl & 15)) << 4)); \
            const u32x4 g = G[i]; u32x4 w; \
            w.x = cvt_pk_bf16(ya[0] * bf_lo(g.x), ya[1] * bf_hi(g.x)); w.y = cvt_pk_bf16(ya[2] * bf_lo(g.y), ya[3] * bf_hi(g.y)); \
            w.z = cvt_pk_bf16(yb[0] * bf_lo(g.z), yb[1] * bf_hi(g.z)); w.w = cvt_pk_bf16(yb[2] * bf_lo(g.w), yb[3] * bf_hi(g.w)); \
            if (MK_M3_DEFER) pend.w[PASS][i] = w; \
            else if (!((MK_M3_PROBE == 1 || MK_M3_PROBE == 2 || MK_M3_PROBE == 3) && probe)) { \
                if (MK_M3_PROBE == 5 && probe) *(u32x4*)((char*)mixed + (((unsigned)(((t0 + 64 * (PASS) + rl) * 4096 + 8 * c8) * 2)) & 0xfff0u)) = w;   \
                else if (MK_M3_WT) __builtin_amdgcn_raw_buffer_store_b128(w, mixrs, (unsigned)(((t0 + 64 * (PASS) + rl) * 4096 + 8 * c8) * 2), 0, 16  ); \
                else if (MK_M3_NTST) __builtin_nontemporal_store(w, (u32x4*)(mixed + ((unsigned)((t0 + 64 * (PASS) + rl) * 4096 + 8 * c8)))); \
                else *(u32x4*)(mixed + ((unsigned)((t0 + 64 * (PASS) + rl) * 4096 + 8 * c8))) = w; } } } while (0)
        __builtin_amdgcn_sched_barrier(0);
        if constexpr (GEARLY) {
#pragma unroll
            for (int i = 0; i < NI; ++i) { gv0[i] = gvE0[i]; gv1[i] = gvE1[i]; } }
        else M3_GROWS(gv0, 0);
        {   M3_LANE();
#pragma unroll
            for (int rt = 0; rt < 8; ++rt) { float s1 = 0.f, s2 = 0.f;
#pragma unroll
                for (int ct = 0; ct < CT; ++ct)
#pragma unroll
                    for (int r = 0; r < 4; ++r) { const float x = acc[rt][ct][r]; s1 += x; s2 += x * x; }
                s1 += __shfl_xor(s1, 16); s1 += __shfl_xor(s1, 32); s2 += __shfl_xor(s2, 16); s2 += __shfl_xor(s2, 32);
                if (lq == 0) STATS[(16 * rt + lr) * 8 + wave] = (f32x2){s1, s2}; } }
        __syncthreads();
        M3_NORM(0);
        if constexpr (!GEARLY) M3_GROWS(gv1, 1);
        __syncthreads();
        M3_OUT(gv0, 0);
        __syncthreads();
        M3_NORM(1);
        __syncthreads();
        M3_OUT(gv1, 1);
        if (MK_M3_DEFER) { pend.mixed = mixed; pend.t0 = t0; pend.lpr = LPR; }
#undef M3_GROWS
#undef M3_NORM
#undef M3_OUT
    }
#endif
    __syncthreads();
#undef M3_LOADV
#undef M3_LOADS
#undef M3_LOADSTEP
}
#undef QFRAG
#undef PFRAG
#undef M3_BASES
#undef M3_PBASES
#undef M3_LANE
template <class AT> __device__ __forceinline__ void m3_phase(const AT& a, int l, LAS unsigned char* lds, int tid, int lane, int wave, int bid, int G, int probe = 0) {
    bf16_t* const mixr = (MK_M3_PROBE == 5 && probe) ? a.h + (size_t)bid * 32768 : a.mixed;
    M3Pend pend; pend.lpr = 0; pend.mixed = nullptr; pend.t0 = 0;
    const bool flip = MK_M3_FLIP && ((bid >> 4) & 1);
#pragma unroll 1
    for (int s_ = 0; s_ < 2; ++s_) {
    if ((s_ == 0) != flip) {
    for (int u = bid; u < 256; u += G) { if (MK_M3_DEFER) m3_flush(pend, tid, wave); const int rh = MK_M3_UNPAIR ? (u & 1) : (u >> 3) & 1, idx = MK_M3_UNPAIR ? (u >> 1) : (u & 7) | ((u >> 4) << 3), h = idx >> 5, c2 = idx & 31, t0 = 256 * c2 + 128 * rh, tk0 = 256 * c2;
        if (rh) m3_unit<4, false, 2, MK_M3_RDG, false>(lds, a.qg + h * 256, 1024, a.kg + h * 256, (MK_VT_BLK ? a.vgt + ((size_t)c2 * 2048 + h * 512) * 256 : a.vgt + (size_t)(h * 512) * T), a.kvg + (size_t)(h * 32 + c2) * 131072, a.sgg + h * 512, a.gla_gain + l * 2048 + h * 512, ((MK_M3_PROBE == 5 && probe) ? mixr : a.mixed + 2048 + h * 512), t0, tk0, tid, wave, pend, probe);
        else    m3_unit<4, false, 1, MK_M3_RDG, false>(lds, a.qg + h * 256, 1024, a.kg + h * 256, (MK_VT_BLK ? a.vgt + ((size_t)c2 * 2048 + h * 512) * 256 : a.vgt + (size_t)(h * 512) * T), a.kvg + (size_t)(h * 32 + c2) * 131072, a.sgg + h * 512, a.gla_gain + l * 2048 + h * 512, ((MK_M3_PROBE == 5 && probe) ? mixr : a.mixed + 2048 + h * 512), t0, tk0, tid, wave, pend, probe); }
    } else {
    for (int u = bid; u < 512; u += G) { const int rh = (MK_M3_UNPAIR ? (u & 1) : (u >> 3) & 1) ^ 1  , idx = MK_M3_UNPAIR ? (u >> 1) : (u & 7) | ((u >> 4) << 3), h = idx >> 5, c2 = idx & 31, t0 = 256 * c2 + 128 * rh, tk0 = 256 * c2;
        if (rh) m3_unit<2, true, 2, MK_M3_RDR, true>(lds, a.qr + h * 256, 2048, a.kr + h * 256, (MK_VT_BLK ? a.vrt + ((size_t)c2 * 2048 + h * 256) * 256 : a.vrt + (size_t)(h * 256) * T), a.kvr + (size_t)(h * 32 + c2) * 65536, a.srg + h * 256, a.ret_gain + l * 2048 + h * 256, ((MK_M3_PROBE == 5 && probe) ? mixr : a.mixed + h * 256), t0, tk0, tid, wave, pend, probe);
        else    m3_unit<2, true, 1, MK_M3_RDR, true>(lds, a.qr + h * 256, 2048, a.kr + h * 256, (MK_VT_BLK ? a.vrt + ((size_t)c2 * 2048 + h * 256) * 256 : a.vrt + (size_t)(h * 256) * T), a.kvr + (size_t)(h * 32 + c2) * 65536, a.srg + h * 256, a.ret_gain + l * 2048 + h * 256, ((MK_M3_PROBE == 5 && probe) ? mixr : a.mixed + h * 256), t0, tk0, tid, wave, pend, probe); }
    }
    }
    if (MK_M3_DEFER) m3_flush(pend, tid, wave);
}

template <class AT> __device__ __forceinline__ void final_phase(const AT& a, const u64* ss, int tid, int bid, int G) {
    const size_t n8 = (size_t)T * D / 8, stride = (size_t)G * NTHR; const size_t i00 = (size_t)bid * NTHR + tid;
    const bool colfix = (stride & 511) == 0;
    f32x4 g0 = ((const f32x4*)a.final_norm)[2 * (int)(i00 & 511)], g1 = ((const f32x4*)a.final_norm)[2 * (int)(i00 & 511) + 1];
    u32x4 v[2][8]; u64 sv[2][8];
#define FIN_LOAD(B, i0_) do { _Pragma("unroll") for (int j = 0; j < 8; ++j) { const size_t i = (i0_) + j * stride; const bool ok = i < n8; \
        v[B][j] = ok ? MK_NTLD(((const u32x4*)a.xb) + i) : (u32x4){0u, 0u, 0u, 0u}; sv[B][j] = ok ? ss[i >> 9] : 0ull; } } while (0)
#define FIN_STORE(B, i0_) do { _Pragma("unroll") for (int j = 0; j < 8; ++j) { const size_t i = (i0_) + j * stride; if (i < n8) { \
        if (!colfix) { const int c8 = (int)(i & 511); g0 = ((const f32x4*)a.final_norm)[2 * c8]; g1 = ((const f32x4*)a.final_norm)[2 * c8 + 1]; } \
        const float r = rs_of(sv[B][j]); const u32x4 x = v[B][j]; \
        f32x4 o0, o1; o0[0] = bf_lo(x.x) * r * g0[0]; o0[1] = bf_hi(x.x) * r * g0[1]; o0[2] = bf_lo(x.y) * r * g0[2]; o0[3] = bf_hi(x.y) * r * g0[3]; \
        o1[0] = bf_lo(x.z) * r * g1[0]; o1[1] = bf_hi(x.z) * r * g1[1]; o1[2] = bf_lo(x.w) * r * g1[2]; o1[3] = bf_hi(x.w) * r * g1[3]; \
        if (MK_FIN_NT) { __builtin_nontemporal_store(o0, ((f32x4*)a.out) + 2 * i); __builtin_nontemporal_store(o1, ((f32x4*)a.out) + 2 * i + 1); } else { ((f32x4*)a.out)[2 * i] = o0; ((f32x4*)a.out)[2 * i + 1] = o1; } } } } while (0)
    if (i00 < n8) FIN_LOAD(0, i00);
#pragma unroll 1
    for (size_t i0 = i00; i0 < n8; i0 += 16 * stride) {
        const size_t i1 = i0 + 8 * stride, i2 = i0 + 16 * stride;
        if (i1 < n8) FIN_LOAD(1, i1);
        FIN_STORE(0, i0);
        if (i1 < n8) { if (i2 < n8) FIN_LOAD(0, i2); FIN_STORE(1, i1); }
    }
#undef FIN_LOAD
#undef FIN_STORE
}

#ifndef MK_PH
#define MK_PH 1023
#endif
#ifndef MK_SP2
#define MK_SP2 true
#endif
#ifndef MK_ALIGN
#define MK_ALIGN true
#endif
#ifndef MK_STAG_SHIFT
#define MK_STAG_SHIFT 6
#endif
#ifndef MK_STAG
#define MK_STAG 0
#endif
#define STAGGER() do { if (MK_STAG) { const unsigned long long t0_ = __builtin_amdgcn_s_memrealtime(); const unsigned long long w_ = (unsigned long long)(((bid >> MK_STAG_SHIFT) & 3) * MK_STAG); while (__builtin_amdgcn_s_memrealtime() - t0_ < w_) __builtin_amdgcn_s_sleep(8); } } while (0)
#ifndef MK_REP_P0
#define MK_REP_P0 1
#endif
#ifndef MK_REP_G1
#define MK_REP_G1 1
#endif
#ifndef MK_REP_PREP
#define MK_REP_PREP 1
#endif
#ifndef MK_REP_M1
#define MK_REP_M1 1
#endif
#ifndef MK_REP_M3
#define MK_REP_M3 1
#endif
#ifndef MK_REP_G3
#define MK_REP_G3 1
#endif
#ifndef MK_REP_M12
#define MK_REP_M12 1
#endif
#ifndef MK_REP_FIN
#define MK_REP_FIN 1
#endif
#ifndef MK_REP_G2
#define MK_REP_G2 1
#endif
#ifndef MK_REP_G4
#define MK_REP_G4 1
#endif
#define REPEAT(n, k) for (int rep_ = 0; rep_ < (n); ++rep_, ((rep_ < (n)) ? xcd_barrier(bar) : (void)0))
typedef const Args __attribute__((address_space(4))) CArgs;
#define KARGS() ({ const CArgs* p_ = (const CArgs*)__builtin_amdgcn_kernarg_segment_ptr(); asm volatile("" : "+s"(p_)); p_; })
__global__ void __launch_bounds__(NTHR, 2) mk_fwd(Args args_unused) {
    extern __shared__ __attribute__((aligned(16))) unsigned char lds_raw[];
    LAS unsigned char* lds = (LAS unsigned char*)lds_raw;
    const int bid = blockIdx.x, G = gridDim.x;
    volatile LAS unsigned* MISC = (volatile LAS unsigned*)(lds + LDSCTL_OFF);
    if (threadIdx.x < 64) MISC[threadIdx.x] = 0u;
    const int wave_s = __builtin_amdgcn_readfirstlane((int)(threadIdx.x >> 6));
#define MK_TID() ({ int w_ = wave_s; unsigned z_ = 0u; asm volatile("" : "+s"(w_), "+v"(z_)); (w_ << 6) | (int)__builtin_amdgcn_mbcnt_hi(~0u, __builtin_amdgcn_mbcnt_lo(~0u, z_)); })
#define LANEIDS() int tid = MK_TID(); asm volatile("" : "+v"(tid)); const int lane = tid & 63, wave = __builtin_amdgcn_readfirstlane(tid >> 6); (void)lane; (void)wave
    __syncthreads();
    (void)xcd_barrier_post(KARGS()->ctl + CW_BAR, MISC + 8);
#define bar (XcdBarrier{KARGS()->ctl + CW_BAR, xb_xcc_id(), MISC + 8, (MK_TID() == 0) ? 1u : 0u})
#if MK_SPLIT || MK_DEBUG
#define IN(k) (KARGS()->ph_lo <= (k) && (k) < KARGS()->ph_hi)
#else
#define IN(k) true
#endif
#if MK_TIMING
#define STAMP(k) do { if (blockIdx.x == 0 && threadIdx.x == 0) KARGS()->ctl[CW_TS + (k)] = (unsigned)__builtin_amdgcn_s_memrealtime(); } while (0)
#else
#define STAMP(k) do { } while (0)
#endif
#define SEAM(k) do { if (IN(k) && IN((k) + 1)) xcd_barrier(bar); STAMP((k) + 1); } while (0)
    STAMP(0);
#define SSB() ((u64*)(KARGS()->ctl + CW_SS))

    if (MK_PH & 256) if (IN(0)) REPEAT(MK_REP_P0, 0) { LANEIDS(); p0_prologue(*KARGS(), lds, tid, lane, wave, bid, G); }
    SEAM(0);
#ifdef MK_XBAR
    for (int xb_ = 0; xb_ < MK_XBAR; ++xb_) xcd_barrier(bar);
#endif
    for (int l = 0; l < 2; ++l) {
        const int pb = 1 + 8 * l;
        if (MK_PH & 1) if (IN(pb + 0)) REPEAT(MK_REP_G1, 1) {
            const CArgs& a = *KARGS(); const u64* ss_in = SSB() + (size_t)(2 * l) * T;
            { LANEIDS(); ga_stage(a, l, ss_in, lds, tid, lane, wave, bid, G); }
            pg8::Gemm g{a.xb, a.win_t[l], D, 2 * D, 128, 2 * D, 128}; pg8::ProjOrder S; S.init(T / 256, NPROJ / 256, G, bid);
            pg8::EpiProj E{ss_in, a.pos, a.qr, a.kr, a.vrt, a.srg, a.gq, a.gk, a.vgt, a.sgg, (MK_G1_PROBE && rep_ + 1 < MK_REP_G1) ? 1 : 0};
            STAGGER(); pg8::gemm_phase<pg8::EpiProj, pg8::ProjOrder, MK_ALIGN, MK_SP2>(lds, g, S, E, MK_TID());
        }
        SEAM(pb + 0);
        if (MK_PH & 2) if (IN(pb + 1)) REPEAT(MK_REP_PREP, 2) { LANEIDS(); prep_phase(*KARGS(), l, lds, tid, lane, wave, bid, G); }
        SEAM(pb + 1);
        for (int rep12 = 0; rep12 < MK_REP_M12; ++rep12) {
        if (rep12) xcd_barrier(bar);
        if (MK_PH & 4) if (IN(pb + 2)) REPEAT(MK_REP_M1, 3) { LANEIDS(); m1_phase(*KARGS(), lds, tid, wave, bid, G); }
        SEAM(pb + 2);
        if (MK_PH & 8) if (IN(pb + 3)) { LANEIDS(); m2_phase(*KARGS(), tid, bid, G); }
        }
        SEAM(pb + 3);
        if (MK_PH & 16) if (IN(pb + 4)) REPEAT(MK_REP_M3, 5) { LANEIDS(); m3_phase(*KARGS(), l, lds, tid, lane, wave, bid, G, (MK_M3_PROBE && rep_ + 1 < MK_REP_M3) ? 1 : 0); }
        SEAM(pb + 4);
        if (MK_PH & 32) if (IN(pb + 5)) REPEAT(MK_REP_G2, 6) {
            const CArgs& a = *KARGS(); u64* ss_mid = SSB() + (size_t)(2 * l + 1) * T;
            pg8::Gemm g{a.mixed, a.wout_t[l], D, 2 * D, 128, MK_BLK_W ? 128 : 2 * D, MK_BLK_W ? D * 128 : 128}; pg8::StaticOrder S; S.init(T / 256, D / 256, G, bid);
            const bool lastrep_ = (rep_ == MK_REP_G2 - 1); pg8::EpiRes E{lastrep_ ? a.xb : (bf16_t*)((char*)a.qr + (size_t)200 * 1048576), lastrep_ ? ss_mid : (u64*)(a.ctl + CW_CHK), (u64*)(a.ctl + CW_CHK)};
            STAGGER(); pg8::gemm_phase<pg8::EpiRes, pg8::StaticOrder, MK_ALIGN, MK_SP2>(lds, g, S, E, MK_TID());
        }
        SEAM(pb + 5);
#if MK_TIMING
        if (l == 0 && blockIdx.x == 0 && threadIdx.x == 0) { KARGS()->ctl[CW_TS + 32] = (unsigned)__builtin_amdgcn_s_memtime(); KARGS()->ctl[CW_TS + 33] = (unsigned)__builtin_amdgcn_s_memrealtime(); }
#endif
        if (MK_PH & 64) if (IN(pb + 6)) REPEAT(MK_REP_G3, 7) {
            const CArgs& a = *KARGS(); const u64* ss_mid = SSB() + (size_t)(2 * l + 1) * T;
            pg8::Gemm g{a.xb, a.wgu_t[l], D, 2 * D, 128, MK_BLK_W ? 128 : 2 * D, MK_BLK_W ? 2 * FF * 128 : 128}; pg8::StaticOrder S; S.init(T / 256, 2 * FF / 256, G, bid);
            pg8::EpiSwiGLU E{ss_mid, a.h};
            STAGGER(); pg8::gemm_phase<pg8::EpiSwiGLU, pg8::StaticOrder, MK_ALIGN, MK_SP2>(lds, g, S, E, MK_TID());
        }
#if MK_TIMING
        if (l == 0 && blockIdx.x == 0 && threadIdx.x == 0) { KARGS()->ctl[CW_TS + 34] = (unsigned)__builtin_amdgcn_s_memtime(); KARGS()->ctl[CW_TS + 35] = (unsigned)__builtin_amdgcn_s_memrealtime(); }
#endif
        SEAM(pb + 6);
        if (MK_PH & 128) if (IN(pb + 7)) REPEAT(MK_REP_G4, 8) {
            const CArgs& a = *KARGS(); u64* ss_out = SSB() + (size_t)(2 * l + 2) * T;
            pg8::Gemm g{a.h, a.wd_t[l], FF, 128, T * 128, MK_BLK_W ? 128 : 2 * FF, MK_BLK_W ? D * 128 : 128}  ; pg8::StaticOrder S; S.init(T / 256, D / 256, G, bid);
            const bool lastrep_ = (rep_ == MK_REP_G4 - 1); pg8::EpiRes E{lastrep_ ? a.xb : (bf16_t*)((char*)a.qr + (size_t)200 * 1048576), lastrep_ ? ss_out : (u64*)(a.ctl + CW_CHK), (u64*)(a.ctl + CW_CHK)};
            STAGGER(); pg8::gemm_phase<pg8::EpiRes, pg8::StaticOrder, MK_ALIGN, MK_SP2>(lds, g, S, E, MK_TID());
        }
        SEAM(pb + 7);
    }
    if (MK_PH & 512) if (IN(17)) REPEAT(MK_REP_FIN, 17) { LANEIDS(); final_phase(*KARGS(), SSB() + (size_t)4 * T, tid, bid, G); }
    STAMP(18);
#undef IN
#undef SEAM
}

#ifndef MK_WS_ALIGN
#define MK_WS_ALIGN 256
#endif
struct Layout { size_t off; size_t take(size_t bytes) { const size_t al = MK_WS_ALIGN; off = (off + al - 1) / al * al; const size_t o = off; off += bytes; return o; } };
static size_t build_args(Args& a, void* const* d_in, void* d_out, unsigned char* ws, size_t base, int cvt_mask, int cvt_layers) {
    a.x = (const float*)d_in[0]; a.pos = (const int*)d_in[1]; a.mix_norm = (const float*)d_in[2]; a.w_in = (const float*)d_in[3]; a.gla_w_up = (const float*)d_in[4]; a.gla_b = (const float*)d_in[5];
    a.ret_gain = (const float*)d_in[6]; a.gla_gain = (const float*)d_in[7]; a.w_out = (const float*)d_in[8]; a.ffn_norm = (const float*)d_in[9]; a.w_gate = (const float*)d_in[10]; a.w_up = (const float*)d_in[11];
    a.w_down = (const float*)d_in[12]; a.final_norm = (const float*)d_in[13]; a.out = (float*)d_out;
    Layout L{base};
    a.ctl = (unsigned*)(ws + L.take(CTL_ZERO_BYTES));
    for (int l = 0; l < 2; ++l) { const bool on = l < cvt_layers;
        a.win_t[l] = (bf16_t*)(ws + ((on && (cvt_mask & 1)) ? L.take((size_t)NPROJ * D * 2) : L.off)); a.wga_t[l] = (bf16_t*)(ws + ((on && (cvt_mask & 1)) ? L.take((size_t)16 * D * 2) : L.off));
        a.wout_t[l] = (bf16_t*)(ws + ((on && (cvt_mask & 2)) ? L.take((size_t)D * D * 2) : L.off)); a.wgu_t[l] = (bf16_t*)(ws + ((on && (cvt_mask & 4)) ? L.take((size_t)2 * FF * D * 2) : L.off));
        a.wd_t[l] = (bf16_t*)(ws + ((on && (cvt_mask & 8)) ? L.take((size_t)D * FF * 2) : L.off)); }
    a.xb = (bf16_t*)(ws + L.take((size_t)T * D * 2)); a.rot = nullptr; a.ga = (float*)(ws + L.take((size_t)T * 16 * 4)); a.lam = (float*)(ws + L.take((size_t)64 * 1024 * 4));
    a.mixed = (bf16_t*)(ws + L.take((size_t)T * D * 2));
    const size_t ov0 = L.off;
    a.qr = (bf16_t*)(ws + L.take((size_t)T * 2048 * 2)); a.kr = (bf16_t*)(ws + L.take((size_t)T * 2048 * 2)); a.krt = nullptr; a.vrt = (bf16_t*)(ws + L.take((size_t)T * 2048 * 2));
    a.srg = (bf16_t*)(ws + L.take((size_t)T * 2048 * 2)); a.gq = (bf16_t*)(ws + L.take((size_t)T * 1024 * 2)); a.gk = (bf16_t*)(ws + L.take((size_t)T * 1024 * 2)); a.qg = (bf16_t*)(ws + L.take((size_t)T * 1024 * 2));
    a.kg = (bf16_t*)(ws + L.take((size_t)T * 1024 * 2)); a.kgt = nullptr; a.vgt = (bf16_t*)(ws + L.take((size_t)T * 2048 * 2)); a.sgg = (bf16_t*)(ws + L.take((size_t)T * 2048 * 2));
    a.kvr = (bf16_t*)(ws + L.take((size_t)8 * 64 * 65536 * 2)); a.kvg = (bf16_t*)(ws + L.take((size_t)4 * 64 * 131072 * 2));
    a.h = (bf16_t*)(ws + ov0);
    if (L.off < ov0 + (size_t)T * FF * 2) L.off = ov0 + (size_t)T * FF * 2;
    a.cvt_mask = cvt_mask; a.cvt_layers = cvt_layers;
    return L.off;
}
static int g_grid = 0;
static bool setup_once() {
    if (g_grid) return g_grid > 0;
    int dev = 0, cus = 0, per_cu = 0;
    if (hipGetDevice(&dev) != hipSuccess || hipDeviceGetAttribute(&cus, hipDeviceAttributeMultiprocessorCount, dev) != hipSuccess) { fprintf(stderr, "mk: device query failed\n"); g_grid = -1; return false; }
    if (hipFuncSetAttribute((const void*)mk_fwd, hipFuncAttributeMaxDynamicSharedMemorySize, LDS_BYTES) != hipSuccess) { fprintf(stderr, "mk: hipFuncSetAttribute failed\n"); g_grid = -1; return false; }
    if (hipOccupancyMaxActiveBlocksPerMultiprocessor(&per_cu, (const void*)mk_fwd, NTHR, LDS_BYTES) != hipSuccess || per_cu < 1) { fprintf(stderr, "mk: occupancy query says %d blocks per CU\n", per_cu); (void)hipGetLastError(); }
    g_grid = cus;
    return true;
}
static void launch_range(Args a, int lo, int hi, hipStream_t stream, bool zero_bar = true) {
    if (zero_bar) (void)hipMemsetAsync((char*)a.ctl + (size_t)CW_BAR * 4, 0, (size_t)XCD_BAR_WORDS * 4, stream);
    a.ph_lo = lo; a.ph_hi = hi;
    hipLaunchKernelGGL(mk_fwd, dim3(g_grid), dim3(NTHR), LDS_BYTES, stream, a);
    const hipError_t e = hipPeekAtLastError(); if (e != hipSuccess) fprintf(stderr, "mk: launch [%d,%d) failed: %s\n", lo, hi, hipGetErrorName(e));
}
}
#if MK_DEBUG
namespace nv {
constexpr int T_ = 8192, D_ = 4096, INW = 14352, FF_ = 11008;
constexpr int O_RQ = 0, O_RK = 2048, O_RV = 4096, O_RG = 6144, O_GQ = 8192, O_GK = 9216, O_GV = 10240, O_GG = 12288, O_GA = 14336;

__global__ __launch_bounds__(256) void k_rmsnorm(const float* __restrict__ x, const float* __restrict__ g, float* __restrict__ out) {
    const int row = blockIdx.x; const float* xr = x + (size_t)row * D_;
    float s = 0.f;
    for (int i = threadIdx.x; i < D_; i += 256) { const float v = xr[i]; s += v * v; }
    __shared__ float red[4];
    for (int o = 32; o > 0; o >>= 1) s += __shfl_xor(s, o);
    if ((threadIdx.x & 63) == 0) red[threadIdx.x >> 6] = s;
    __syncthreads();
    s = red[0] + red[1] + red[2] + red[3];
    const float r = 1.0f / sqrtf(s / (float)D_ + 1e-6f);
    for (int i = threadIdx.x; i < D_; i += 256) out[(size_t)row * D_ + i] = xr[i] * r * g[i];
}

template <int EPI>
__global__ __launch_bounds__(256) void k_sgemm(const float* __restrict__ A, const float* __restrict__ B, float* __restrict__ C, const float* __restrict__ R, int M, int N, int K) {
    __shared__ float As[16][132];
    __shared__ float Bs[16][132];
    const int bm = blockIdx.y * 128, bn = blockIdx.x * 128;
    const int tid = threadIdx.x, tx = tid & 15, ty = tid >> 4;
    float acc[8][8];
#pragma unroll
    for (int i = 0; i < 8; ++i)
#pragma unroll
        for (int j = 0; j < 8; ++j) acc[i][j] = 0.f;
    for (int k0 = 0; k0 < K; k0 += 16) {
#pragma unroll
        for (int i = 0; i < 2; ++i) {
            const int idx = tid + i * 256, r = idx >> 2, c4 = (idx & 3) * 4;
            const float4 v = *(const float4*)&A[(size_t)(bm + r) * K + k0 + c4];
            As[c4 + 0][r] = v.x; As[c4 + 1][r] = v.y; As[c4 + 2][r] = v.z; As[c4 + 3][r] = v.w;
        }
#pragma unroll
        for (int i = 0; i < 2; ++i) {
            const int idx = tid + i * 256, kr = idx >> 5, c4 = (idx & 31) * 4;
            float4 v = make_float4(0.f, 0.f, 0.f, 0.f);
            if (bn + c4 < N) v = *(const float4*)&B[(size_t)(k0 + kr) * N + bn + c4];
            *(float4*)&Bs[kr][c4] = v;
        }
        __syncthreads();
#pragma unroll
        for (int kk = 0; kk < 16; ++kk) {
            float a[8], b[8];
            const float4 a0 = *(const float4*)&As[kk][ty * 8], a1 = *(const float4*)&As[kk][ty * 8 + 4];
            const float4 b0 = *(const float4*)&Bs[kk][tx * 8], b1 = *(const float4*)&Bs[kk][tx * 8 + 4];
            a[0] = a0.x; a[1] = a0.y; a[2] = a0.z; a[3] = a0.w; a[4] = a1.x; a[5] = a1.y; a[6] = a1.z; a[7] = a1.w;
            b[0] = b0.x; b[1] = b0.y; b[2] = b0.z; b[3] = b0.w; b[4] = b1.x; b[5] = b1.y; b[6] = b1.z; b[7] = b1.w;
#pragma unroll
            for (int i = 0; i < 8; ++i)
#pragma unroll
                for (int j = 0; j < 8; ++j) acc[i][j] = fmaf(a[i], b[j], acc[i][j]);
        }
        __syncthreads();
    }
#pragma unroll
    for (int i = 0; i < 8; ++i) {
        const int r = bm + ty * 8 + i;
#pragma unroll
        for (int j4 = 0; j4 < 2; ++j4) {
            const int c = bn + tx * 8 + j4 * 4;
            if (c < N) {
                float4 v = make_float4(acc[i][j4 * 4 + 0], acc[i][j4 * 4 + 1], acc[i][j4 * 4 + 2], acc[i][j4 * 4 + 3]);
                if (EPI == 1) { const float4 rr = *(const float4*)&R[(size_t)r * N + c]; v.x += rr.x; v.y += rr.y; v.z += rr.z; v.w += rr.w; }
                if (EPI == 2) { const float4 gg = *(const float4*)&C[(size_t)r * N + c]; v.x *= gg.x / (1.0f + __expf(-gg.x)); v.y *= gg.y / (1.0f + __expf(-gg.y)); v.z *= gg.z / (1.0f + __expf(-gg.z)); v.w *= gg.w / (1.0f + __expf(-gg.w)); }
                *(float4*)&C[(size_t)r * N + c] = v;
            }
        }
    }
}

__device__ __forceinline__ float siluf(float x) { return x / (1.0f + __expf(-x)); }

__global__ __launch_bounds__(256) void k_rotary(float* __restrict__ proj, const int* __restrict__ pos) {
    const size_t gid = (size_t)blockIdx.x * 256 + threadIdx.x;
    const int i = (int)(gid & 127), h = (int)((gid >> 7) & 7), w = (int)((gid >> 10) & 1); const int t = (int)(gid >> 11);
    if (t >= T_) return;
    const float inv_freq = powf(10000.0f, -(float)i / 128.0f);
    const float ang = (float)pos[t] * inv_freq;
    const double rev = (double)ang * 0.15915494309189533577;
    const float fr = (float)(rev - floor(rev));
    const float c = __builtin_amdgcn_cosf(fr), s = __builtin_amdgcn_sinf(fr);
    float* p = proj + (size_t)t * INW + (w ? O_RK : O_RQ) + h * 256 + i;
    const float t1 = p[0], t2 = p[128];
    p[0] = t1 * c - t2 * s; p[128] = t1 * s + t2 * c;
}

__global__ __launch_bounds__(256) void k_gate(const float* __restrict__ proj, const float* __restrict__ wup, const float* __restrict__ b, float* __restrict__ loga) {
    const int t = blockIdx.x;
    const float* ga = proj + (size_t)t * INW + O_GA;
    for (int c = threadIdx.x; c < 1024; c += 256) {
        float z = b[c];
#pragma unroll
        for (int r = 0; r < 16; ++r) z = fmaf(ga[r], wup[r * 1024 + c], z);
        const float ls = fminf(z, 0.f) - log1pf(expf(-fabsf(z)));
        loga[(size_t)t * 1024 + c] = ls * (1.0f / 16.0f);
    }
}

template <int GLA>
__global__ __launch_bounds__(256) void k_recur(const float* __restrict__ proj, int qoff, int koff, int voff, int dv, const float* __restrict__ loga, float qs, float ks, float* __restrict__ out, int ostride) {
    const int vt = blockIdx.x, h = blockIdx.y, d = threadIdx.x, lane = d & 63, wave = d >> 6;
    float S[16];
#pragma unroll
    for (int j = 0; j < 16; ++j) S[j] = 0.f;
    const float gamma = 1.0f - exp2f(-5.0f - (float)h);
    __shared__ float part[2][4][16];
    for (int t = 0; t < T_; ++t) {
        const float* row = proj + (size_t)t * INW;
        const float q = row[qoff + h * 256 + d] * qs, k = row[koff + h * 256 + d] * ks;
        const float a = GLA ? expf(loga[(size_t)t * 1024 + h * 256 + d]) : gamma;
        float p[16];
#pragma unroll
        for (int j4 = 0; j4 < 4; ++j4) {
            const float4 v = *(const float4*)&row[voff + h * dv + vt * 16 + j4 * 4];
            S[j4 * 4 + 0] = a * S[j4 * 4 + 0] + k * v.x; S[j4 * 4 + 1] = a * S[j4 * 4 + 1] + k * v.y;
            S[j4 * 4 + 2] = a * S[j4 * 4 + 2] + k * v.z; S[j4 * 4 + 3] = a * S[j4 * 4 + 3] + k * v.w;
        }
#pragma unroll
        for (int j = 0; j < 16; ++j) p[j] = q * S[j];
#pragma unroll
        for (int j = 0; j < 16; ++j)
#pragma unroll
            for (int o = 32; o > 0; o >>= 1) p[j] += __shfl_xor(p[j], o);
        if (lane == 0) {
#pragma unroll
            for (int j = 0; j < 16; ++j) part[t & 1][wave][j] = p[j];
        }
        __syncthreads();
        if (d < 16) out[(size_t)t * ostride + h * dv + vt * 16 + d] = part[t & 1][0][d] + part[t & 1][1][d] + part[t & 1][2][d] + part[t & 1][3][d];
    }
}

__global__ __launch_bounds__(256) void k_headnorm(const float* __restrict__ proj, const float* __restrict__ ro, const float* __restrict__ go, const float* __restrict__ rgain, const float* __restrict__ ggain, float* __restrict__ mixed) {
    const int t = blockIdx.x, tid = threadIdx.x, lane = tid & 63, wave = tid >> 6;
    const float* row = proj + (size_t)t * INW;
    for (int hh = 0; hh < 2; ++hh) {
        const int h = wave * 2 + hh;
        float v[4]; float s = 0.f;
#pragma unroll
        for (int j = 0; j < 4; ++j) { v[j] = ro[(size_t)t * 2048 + h * 256 + lane + 64 * j]; s += v[j]; }
        for (int o = 32; o > 0; o >>= 1) s += __shfl_xor(s, o);
        const float mu = s / 256.f; float q = 0.f;
#pragma unroll
        for (int j = 0; j < 4; ++j) { v[j] -= mu; q += v[j] * v[j]; }
        for (int o = 32; o > 0; o >>= 1) q += __shfl_xor(q, o);
        const float rs = 1.0f / sqrtf(q / 256.f + 1e-6f);
#pragma unroll
        for (int j = 0; j < 4; ++j) { const int c = h * 256 + lane + 64 * j; mixed[(size_t)t * D_ + c] = siluf(row[O_RG + c]) * (v[j] * rs * rgain[c]); }
    }
    {
        const int h = wave;
        float v[8]; float q = 0.f;
#pragma unroll
        for (int j = 0; j < 8; ++j) { v[j] = go[(size_t)t * 2048 + h * 512 + lane + 64 * j]; q += v[j] * v[j]; }
        for (int o = 32; o > 0; o >>= 1) q += __shfl_xor(q, o);
        const float rs = 1.0f / sqrtf(q / 512.f + 1e-6f);
#pragma unroll
        for (int j = 0; j < 8; ++j) { const int c = h * 512 + lane + 64 * j; mixed[(size_t)t * D_ + 2048 + c] = siluf(row[O_GG + c]) * (v[j] * rs * ggain[c]); }
    }
}

__global__ __launch_bounds__(256) void k_swiglu(float* __restrict__ G, const float* __restrict__ U, size_t n4) {
    for (size_t i = (size_t)blockIdx.x * 256 + threadIdx.x; i < n4; i += (size_t)gridDim.x * 256) {
        float4 g = ((float4*)G)[i]; const float4 u = ((const float4*)U)[i];
        g.x = siluf(g.x) * u.x; g.y = siluf(g.y) * u.y; g.z = siluf(g.z) * u.z; g.w = siluf(g.w) * u.w;
        ((float4*)G)[i] = g;
    }
}

inline void forward(void* const* d_in, float* out, float* ws, size_t ws_size, hipStream_t st) {
    const float* x = (const float*)d_in[0]; const int* pos = (const int*)d_in[1];
    const float* mix_norm = (const float*)d_in[2]; const float* w_in = (const float*)d_in[3];
    const float* gla_w_up = (const float*)d_in[4]; const float* gla_b = (const float*)d_in[5];
    const float* ret_gain = (const float*)d_in[6]; const float* gla_gain = (const float*)d_in[7];
    const float* w_out = (const float*)d_in[8]; const float* ffn_norm = (const float*)d_in[9];
    const float* w_gate = (const float*)d_in[10]; const float* w_up = (const float*)d_in[11]; const float* w_down = (const float*)d_in[12];
    const float* final_norm = (const float*)d_in[13];
    size_t o = 0;
    float* xn = ws + o; o += (size_t)T_ * D_;
    float* proj = ws + o; o += (size_t)T_ * INW;
    float* loga = ws + o; o += (size_t)T_ * 1024;
    float* ro = ws + o; o += (size_t)T_ * 2048;
    float* go = ws + o; o += (size_t)T_ * 2048;
    float* mixed = ws + o; o += (size_t)T_ * D_;
    float* xa = ws + o; o += (size_t)T_ * D_;
    float* xb = ws + o; o += (size_t)T_ * D_;
    float* G = ws + o; o += (size_t)T_ * FF_;
    if (o * 4 > ws_size) { fprintf(stderr, "naive: ws too small: need %zu have %zu\n", o * 4, ws_size); return; }
    const float* xc = x;
    for (int l = 0; l < 2; ++l) {
        k_rmsnorm<<<T_, 256, 0, st>>>(xc, mix_norm + (size_t)l * D_, xn);
        k_sgemm<0><<<dim3((INW + 127) / 128, T_ / 128), 256, 0, st>>>(xn, w_in + (size_t)l * D_ * INW, proj, nullptr, T_, INW, D_);
        k_rotary<<<(T_ * 2048) / 256, 256, 0, st>>>(proj, pos);
        k_gate<<<T_, 256, 0, st>>>(proj, gla_w_up + (size_t)l * 16 * 1024, gla_b + (size_t)l * 1024, loga);
        k_recur<0><<<dim3(16, 8), 256, 0, st>>>(proj, O_RQ, O_RK, O_RV, 256, nullptr, 1.0f, 1.0f / 16.0f, ro, 2048);
        k_recur<1><<<dim3(32, 4), 256, 0, st>>>(proj, O_GQ, O_GK, O_GV, 512, loga, 1.0f / 16.0f, 1.0f, go, 2048);
        k_headnorm<<<T_, 256, 0, st>>>(proj, ro, go, ret_gain + (size_t)l * 2048, gla_gain + (size_t)l * 2048, mixed);
        k_sgemm<1><<<dim3(D_ / 128, T_ / 128), 256, 0, st>>>(mixed, w_out + (size_t)l * D_ * D_, xa, xc, T_, D_, D_);
        k_rmsnorm<<<T_, 256, 0, st>>>(xa, ffn_norm + (size_t)l * D_, xn);
        k_sgemm<0><<<dim3(FF_ / 128, T_ / 128), 256, 0, st>>>(xn, w_gate + (size_t)l * D_ * FF_, G, nullptr, T_, FF_, D_);
        k_sgemm<2><<<dim3(FF_ / 128, T_ / 128), 256, 0, st>>>(xn, w_up + (size_t)l * D_ * FF_, G, nullptr, T_, FF_, D_);
        k_sgemm<1><<<dim3(D_ / 128, T_ / 128), 256, 0, st>>>(G, w_down + (size_t)l * FF_ * D_, xb, xa, T_, D_, FF_);
        xc = xb;
    }
    k_rmsnorm<<<T_, 256, 0, st>>>(xc, final_norm, out);
}
}
#endif
#if MK_DEBUG
namespace dbg {
typedef unsigned short bf16_t;
constexpr int T = 8192, INW = 14352;
__device__ __forceinline__ float bf(bf16_t v) { return __uint_as_float((unsigned)v << 16); }
__device__ __forceinline__ void acc2(float* slot, float se, float sb) {
    for (int o = 32; o > 0; o >>= 1) { se += __shfl_xor(se, o); sb += __shfl_xor(sb, o); }
    if ((threadIdx.x & 63) == 0) { atomicAdd(slot, se); atomicAdd(slot + 1, sb); }
}
__global__ void k_cmp_bf16(const bf16_t* got, int gld, int transposed, const float* ref, int rld, int roff, int rows, int cols, int mode, float scale, float* slot) {
    float se = 0.f, sb = 0.f;
    for (size_t i = (size_t)blockIdx.x * blockDim.x + threadIdx.x; i < (size_t)rows * cols; i += (size_t)gridDim.x * blockDim.x) {
        const int r = (int)(i / cols), c = (int)(i % cols);
        float e = ref[(size_t)r * rld + roff + c] * scale;
        if (mode == 1) e = e / (1.0f + expf(-e));
        if (mode == 2 || mode == 3) { const int h = c >> 8; const float lg = log2f(1.0f - exp2f(-5.0f - (float)h)); const float ip1 = (float)((r & 127) + 1); e *= (mode == 2) ? exp2f(ip1 * lg) : exp2f(-ip1 * lg) * 0.0625f; }
        const float g = transposed ? bf(got[(size_t)c * gld + r]) : bf(got[(size_t)r * gld + c]);
        const float d = g - e; se += (d == d) ? d * d : 1e30f; sb += e * e;
    }
    acc2(slot, se, sb);
}
__global__ void k_cmp_f32(const float* got, int gld, const float* ref, int rld, int roff, int rows, int cols, float* slot) {
    float se = 0.f, sb = 0.f;
    for (size_t i = (size_t)blockIdx.x * blockDim.x + threadIdx.x; i < (size_t)rows * cols; i += (size_t)gridDim.x * blockDim.x) {
        const int r = (int)(i / cols), c = (int)(i % cols);
        const float e = ref[(size_t)r * rld + roff + c], g = got[(size_t)r * gld + c]; const float d = g - e; se += (d == d) ? d * d : 1e30f; sb += e * e; }
    acc2(slot, se, sb);
}
__global__ void k_cmp_tr(const bf16_t* a, int ald, const bf16_t* b, int bld, int rows, int cols, float* slot) {
    float se = 0.f, sb = 0.f;
    for (size_t i = (size_t)blockIdx.x * blockDim.x + threadIdx.x; i < (size_t)rows * cols; i += (size_t)gridDim.x * blockDim.x) {
        const int r = (int)(i / cols), c = (int)(i % cols); const float e = bf(a[(size_t)r * ald + c]), g = bf(b[(size_t)c * bld + r]); const float d = g - e; se += (d == d) ? d * d : 1e30f; sb += e * e; }
    acc2(slot, se, sb);
}
__global__ void k_cmp_ss(const float* ss, const float* ref, int rld, float* slot) {
    const int t = blockIdx.x; float s = 0.f; for (int i = threadIdx.x; i < 4096; i += 256) { const float v = ref[(size_t)t * rld + i]; s += v * v; }
    __shared__ float red[4]; for (int o = 32; o > 0; o >>= 1) s += __shfl_xor(s, o); if ((threadIdx.x & 63) == 0) red[threadIdx.x >> 6] = s; __syncthreads();
    if (threadIdx.x == 0) { const float e = red[0] + red[1] + red[2] + red[3], d = ss[t] - e; atomicAdd(slot, (d == d) ? d * d : 1e30f); atomicAdd(slot + 1, e * e); }
}
__global__ void k_cmp_gla(const bf16_t* qg, const bf16_t* kg, const float* lam, const float* proj, const float* loga, float* slot_q, float* slot_k, float* slot_l) {
    const int c = blockIdx.x, ch = blockIdx.y * 256 + threadIdx.x; float cum = 0.f, seq = 0.f, sbq = 0.f, sek = 0.f, sbk = 0.f;
    for (int tt = 0; tt < 128; ++tt) { const int t = c * 128 + tt; cum += loga[(size_t)t * 1024 + ch];
        const float eq = proj[(size_t)t * INW + 8192 + ch] * 0.0625f * expf(cum), ek = proj[(size_t)t * INW + 9216 + ch] * expf(-cum);
        float d = bf(qg[(size_t)t * 1024 + ch]) - eq; seq += (d == d) ? d * d : 1e30f; sbq += eq * eq; d = bf(kg[(size_t)t * 1024 + ch]) - ek; sek += (d == d) ? d * d : 1e30f; sbk += ek * ek; }
    const float el = expf(cum), dl = lam[c * 1024 + ch] - el;
    acc2(slot_q, seq, sbq); acc2(slot_k, sek, sbk); acc2(slot_l, (dl == dl) ? dl * dl : 1e30f, el * el);
}
__global__ void k_cmp_kv(const bf16_t* kb, int ldk, const bf16_t* vt, const bf16_t* kv, int DV, float* slot) {
    const int c = blockIdx.x, h = blockIdx.y, t0 = c * 128; float se = 0.f, sb = 0.f;
    for (int idx = threadIdx.x; idx < DV * 256; idx += 256) { const int v = idx >> 8, d = idx & 255; float e = 0.f;
        for (int j = 0; j < 128; ++j) e += bf(vt[(size_t)(h * DV + v) * T + t0 + j]) * bf(kb[(size_t)(t0 + j) * ldk + h * 256 + d]);
        const float g = bf(kv[((size_t)(h * 64 + c) * DV + v) * 256 + d]); const float dd = g - e; se += (dd == dd) ? dd * dd : 1e30f; sb += e * e; }
    acc2(slot, se, sb);
}
__global__ void k_cmp_s(const bf16_t* kb, int ldk, const bf16_t* vt, const bf16_t* sbuf, const float* lam, int DV, float* slot) {
    const int h = blockIdx.y; const int idx = blockIdx.x * 256 + threadIdx.x; const int v = idx >> 8, d = idx & 255; float se = 0.f, sb = 0.f, st = 0.f;
    const float lret = exp2f(128.0f * log2f(1.0f - exp2f(-5.0f - (float)h)));
    for (int c = 0; c < 64; ++c) { const float g = bf(sbuf[((size_t)(h * 64 + c) * DV + v) * 256 + d]); const float dd = g - st; se += (dd == dd) ? dd * dd : 1e30f; sb += st * st;
        float e = 0.f; for (int j = 0; j < 128; ++j) e += bf(vt[(size_t)(h * DV + v) * T + c * 128 + j]) * bf(kb[(size_t)(c * 128 + j) * ldk + h * 256 + d]);
        st = (lam ? lam[c * 1024 + h * 256 + d] : lret) * (st + e); }
    acc2(slot, se, sb);
}
__global__ void k_cmp_p(const bf16_t* q, const bf16_t* k, const bf16_t* pd, float* slot) {
    const int c = blockIdx.x, h = blockIdx.y, t0 = c * 128; float se[4] = {0.f, 0.f, 0.f, 0.f}, sb[4] = {0.f, 0.f, 0.f, 0.f};
    for (int idx = threadIdx.x; idx < 16384; idx += 256) { const int i = idx >> 7, j = idx & 127; float e = 0.f;
        for (int d = 0; d < 256; ++d) e += bf(q[(size_t)(t0 + i) * 2048 + h * 256 + d]) * bf(k[(size_t)(t0 + j) * 2048 + h * 256 + d]);
        const int cls = (j > i) ? 3 : ((i >> 4) != (j >> 4)) ? 0 : (j < i) ? 1 : 2;
        const float g = bf(pd[(size_t)(h * 64 + c) * 16384 + idx]); const float ee = (cls == 3) ? 0.f : e; const float dd = g - ee;
#pragma unroll
        for (int z = 0; z < 4; ++z) if (cls == z) { se[z] += (dd == dd) ? dd * dd : 1e30f; sb[z] += (z == 3) ? e * e : ee * ee; } }
#pragma unroll
    for (int z = 0; z < 4; ++z) acc2(slot + 2 * z, se[z], sb[z]);
}
__global__ void k_cmp_o(const bf16_t* q, const bf16_t* pd, const bf16_t* vt, const bf16_t* sbuf, const float* od, float* slot) {
    const int t = blockIdx.x, h = blockIdx.y, v = threadIdx.x, c = t >> 7, i = t & 127; float e = 0.f;
    for (int j = 0; j < 128; ++j) e += bf(pd[(size_t)(h * 64 + c) * 16384 + i * 128 + j]) * bf(vt[(size_t)(h * 256 + v) * T + c * 128 + j]);
    for (int d = 0; d < 256; ++d) e += bf(q[(size_t)t * 2048 + h * 256 + d]) * bf(sbuf[((size_t)(h * 64 + c) * 256 + v) * 256 + d]);
    const float g = od[(size_t)t * 2048 + h * 256 + v]; const float dd = g - e; acc2(slot, (dd == dd) ? dd * dd : 1e30f, e * e);
}
__global__ void k_decide(const float* slots, int n, const float* tol, float* code) {
    if (threadIdx.x || blockIdx.x) return; float cd = 9900.0f;
    for (int i = 0; i < n; ++i) { const float se = slots[2 * i], sb = slots[2 * i + 1]; const float rel = sqrtf(se / fmaxf(sb, 1e-30f));
        if (!(rel < tol[i]) || !(sb > 0.f)) { int b = (rel == rel && rel > 0.f) ? (int)floorf(2.0f * log10f(fmaxf(rel, 1e-3f) / 1e-3f)) : 20; b = b < 0 ? 0 : (b > 20 ? 20 : b); cd = (float)(10 + i) * powf(10.0f, (float)(2 + b)); break; } }
    *code = cd;
}
__global__ void k_fill_code(float* out, size_t n, const float* code) { const float c = *code; for (size_t i = (size_t)blockIdx.x * blockDim.x + threadIdx.x; i < n; i += (size_t)gridDim.x * blockDim.x) out[i] = c; }
}

extern "C" void kernel_launch(void* const* d_in, const int* in_sizes, int n_in, void* d_out, int out_size, void* d_ws, size_t ws_size, hipStream_t stream) {
    using namespace nv;
    if (!mk::setup_once()) return;
    hipStream_t st = stream; float* ws = (float*)d_ws;
    const float* x = (const float*)d_in[0]; const int* pos = (const int*)d_in[1]; const float* mix_norm = (const float*)d_in[2]; const float* w_in = (const float*)d_in[3];
    const float* gla_w_up = (const float*)d_in[4]; const float* gla_b = (const float*)d_in[5]; const float* ret_gain = (const float*)d_in[6]; const float* gla_gain = (const float*)d_in[7];
    const float* w_out = (const float*)d_in[8]; const float* ffn_norm = (const float*)d_in[9]; const float* w_gate = (const float*)d_in[10]; const float* w_up = (const float*)d_in[11]; const float* w_down = (const float*)d_in[12];
#if MK_DEBUG == 1
    size_t o = 0;
    float* xn = ws + o; o += (size_t)T_ * D_; float* proj = ws + o; o += (size_t)T_ * INW; float* loga = ws + o; o += (size_t)T_ * 1024; float* ro = ws + o; o += (size_t)T_ * 2048; float* go = ws + o; o += (size_t)T_ * 2048;
    float* mixed = ws + o; o += (size_t)T_ * D_; float* xa = ws + o; o += (size_t)T_ * D_;
    mk::Args a{}; size_t need = mk::build_args(a, d_in, d_out, (unsigned char*)d_ws, o * 4, 3, 1);
    a.dbgp = (bf16_t*)((unsigned char*)d_ws + need); need += (size_t)8 * 64 * 16384 * 2; a.dbgo = (float*)((unsigned char*)d_ws + need); need += (size_t)T_ * 2048 * 4;
    if (need > ws_size) { fprintf(stderr, "dbg: ws too small %zu > %zu\n", need, ws_size); return; }
    (void)hipMemsetAsync(a.ctl, 0, mk::CTL_ZERO_BYTES, st);
    k_rmsnorm<<<T_, 256, 0, st>>>(x, mix_norm, xn);
    k_sgemm<0><<<dim3((INW + 127) / 128, T_ / 128), 256, 0, st>>>(xn, w_in, proj, nullptr, T_, INW, D_);
    k_rotary<<<(T_ * 2048) / 256, 256, 0, st>>>(proj, pos);
    k_gate<<<T_, 256, 0, st>>>(proj, gla_w_up, gla_b, loga);
    k_recur<0><<<dim3(16, 8), 256, 0, st>>>(proj, O_RQ, O_RK, O_RV, 256, nullptr, 1.0f, 1.0f / 16.0f, ro, 2048);
    k_recur<1><<<dim3(32, 4), 256, 0, st>>>(proj, O_GQ, O_GK, O_GV, 512, loga, 1.0f / 16.0f, 1.0f, go, 2048);
    k_headnorm<<<T_, 256, 0, st>>>(proj, ro, go, ret_gain, gla_gain, mixed);
    k_sgemm<1><<<dim3(D_ / 128, T_ / 128), 256, 0, st>>>(mixed, w_out, xa, x, T_, D_, D_);
    float* slots = (float*)(a.ctl + mk::CW_CHK); float* tol = slots + 128; float* code = slots + 256;
#if MK_DBG_ONELAUNCH
    mk::launch_range(a, 0, 7, st);
#else
    for (int p = 0; p < 4; ++p) mk::launch_range(a, p, p + 1, st);
    dbg::k_cmp_kv<<<dim3(64, 8), 256, 0, st>>>(a.kr, 2048, a.vrt, a.kvr, 256, slots + 2 * 15);
    dbg::k_cmp_kv<<<dim3(64, 4), 256, 0, st>>>(a.kg, 1024, a.vgt, a.kvg, 512, slots + 2 * 16);
    mk::launch_range(a, 4, 5, st);
    dbg::k_cmp_s<<<dim3(256, 8), 256, 0, st>>>(a.kr, 2048, a.vrt, a.kvr, nullptr, 256, slots + 2 * 17);
    dbg::k_cmp_s<<<dim3(512, 4), 256, 0, st>>>(a.kg, 1024, a.vgt, a.kvg, a.lam, 512, slots + 2 * 18);
    mk::launch_range(a, 5, 6, st); mk::launch_range(a, 6, 7, st);
#endif
    const float* ss0 = (const float*)(a.ctl + mk::CW_SS); const float* ss1 = ss0 + T_;
    int n = 0; float htol[64];
    dim3 cg(2048), cb(256);
    dbg::k_cmp_ss<<<T_, 256, 0, st>>>(ss0, x, D_, slots + 2 * n); htol[n++] = 1e-4f;
    dbg::k_cmp_bf16<<<cg, cb, 0, st>>>(a.qr, 2048, 0, proj, INW, O_RQ, T_, 2048, 2, 1.0f, slots + 2 * n); htol[n++] = 1e-2f;
    dbg::k_cmp_bf16<<<cg, cb, 0, st>>>(a.kr, 2048, 0, proj, INW, O_RK, T_, 2048, 3, 1.0f, slots + 2 * n); htol[n++] = 1e-2f;
    dbg::k_cmp_bf16<<<cg, cb, 0, st>>>(a.vrt, T_, 1, proj, INW, O_RV, T_, 2048, 0, 1.0f, slots + 2 * n); htol[n++] = 1e-2f;
    dbg::k_cmp_bf16<<<cg, cb, 0, st>>>(a.srg, 2048, 0, proj, INW, O_RG, T_, 2048, 1, 1.0f, slots + 2 * n); htol[n++] = 1e-2f;
    dbg::k_cmp_bf16<<<cg, cb, 0, st>>>(a.gq, 1024, 0, proj, INW, O_GQ, T_, 1024, 0, 0.0625f, slots + 2 * n); htol[n++] = 1e-2f;
    dbg::k_cmp_bf16<<<cg, cb, 0, st>>>(a.gk, 1024, 0, proj, INW, O_GK, T_, 1024, 0, 1.0f, slots + 2 * n); htol[n++] = 1e-2f;
    dbg::k_cmp_bf16<<<cg, cb, 0, st>>>(a.vgt, T_, 1, proj, INW, O_GV, T_, 2048, 0, 1.0f, slots + 2 * n); htol[n++] = 1e-2f;
    dbg::k_cmp_bf16<<<cg, cb, 0, st>>>(a.sgg, 2048, 0, proj, INW, O_GG, T_, 2048, 1, 1.0f, slots + 2 * n); htol[n++] = 1e-2f;
    dbg::k_cmp_f32<<<cg, cb, 0, st>>>(a.ga, 16, proj, INW, O_GA, T_, 16, slots + 2 * n); htol[n++] = 1e-2f;
    dbg::k_cmp_tr<<<cg, cb, 0, st>>>(a.kr, 2048, a.krt, T_, T_, 2048, slots + 2 * n); htol[n++] = 1e-6f;
    dbg::k_cmp_gla<<<dim3(64, 4), 256, 0, st>>>(a.qg, a.kg, a.lam, proj, loga, slots + 2 * n, slots + 2 * (n + 1), slots + 2 * (n + 2)); htol[n++] = 2e-2f; htol[n++] = 2e-2f; htol[n++] = 2e-2f;
    dbg::k_cmp_tr<<<cg, cb, 0, st>>>(a.kg, 1024, a.kgt, T_, T_, 1024, slots + 2 * n); htol[n++] = 1e-6f;
#if MK_DBG_ONELAUNCH
    for (int i = 0; i < 4; ++i) { unsigned one = 0x3f800000u; (void)hipMemsetD32Async((hipDeviceptr_t)(slots + 2 * (15 + i) + 1), (int)one, 1, st); }
#endif
    htol[n++] = 1e-2f; htol[n++] = 1e-2f; htol[n++] = 1e-2f; htol[n++] = 1e-2f;
    dbg::k_cmp_p<<<dim3(64, 8), 256, 0, st>>>(a.qr, a.kr, a.dbgp, slots + 2 * n); htol[n++] = 1e-2f; htol[n++] = 1e-2f; htol[n++] = 1e-2f; htol[n++] = 1e-2f;
    dbg::k_cmp_o<<<dim3(T_, 8), 256, 0, st>>>(a.qr, a.dbgp, a.vrt, a.kvr, a.dbgo, slots + 2 * n); htol[n++] = 1e-2f;
    dbg::k_cmp_bf16<<<cg, cb, 0, st>>>(a.mixed, 4096, 0, mixed, D_, 0, T_, 2048, 0, 1.0f, slots + 2 * n); htol[n++] = 3e-2f;
    dbg::k_cmp_bf16<<<cg, cb, 0, st>>>(a.mixed + 2048, 4096, 0, mixed, D_, 2048, T_, 2048, 0, 1.0f, slots + 2 * n); htol[n++] = 3e-2f;
    dbg::k_cmp_f32<<<cg, cb, 0, st>>>((const float*)d_out, D_, xa, D_, 0, T_, D_, slots + 2 * n); htol[n++] = 1e-2f;
    dbg::k_cmp_bf16<<<cg, cb, 0, st>>>(a.xb, 4096, 0, xa, D_, 0, T_, D_, 0, 1.0f, slots + 2 * n); htol[n++] = 1e-2f;
    dbg::k_cmp_ss<<<T_, 256, 0, st>>>(ss1, xa, D_, slots + 2 * n); htol[n++] = 1e-2f;
#else
    size_t o = 0;
    float* xn = ws + o; o += (size_t)T_ * D_; float* xa = ws + o; o += (size_t)T_ * D_; float* xb2 = ws + o; o += (size_t)T_ * D_; float* G = ws + o; o += (size_t)T_ * FF_;
    mk::Args a{}; const size_t need = mk::build_args(a, d_in, d_out, (unsigned char*)d_ws, o * 4, 12, 1);
    if (need > ws_size) { fprintf(stderr, "dbg: ws too small %zu > %zu\n", need, ws_size); return; }
    (void)hipMemsetAsync(a.ctl, 0, mk::CTL_ZERO_BYTES, st);
    (void)hipMemcpyAsync(xa, x, (size_t)T_ * D_ * 4, hipMemcpyDeviceToDevice, st);
    (void)hipMemcpyAsync(d_out, x, (size_t)T_ * D_ * 4, hipMemcpyDeviceToDevice, st);
    k_rmsnorm<<<T_, 256, 0, st>>>(xa, ffn_norm, xn);
    k_sgemm<0><<<dim3(FF_ / 128, T_ / 128), 256, 0, st>>>(xn, w_gate, G, nullptr, T_, FF_, D_);
    k_sgemm<2><<<dim3(FF_ / 128, T_ / 128), 256, 0, st>>>(xn, w_up, G, nullptr, T_, FF_, D_);
    k_sgemm<1><<<dim3(D_ / 128, T_ / 128), 256, 0, st>>>(G, w_down, xb2, xa, T_, D_, FF_);
    mk::launch_range(a, 0, 1, st);
    (void)hipMemcpyAsync((float*)(a.ctl + mk::CW_SS) + T_, (float*)(a.ctl + mk::CW_SS), (size_t)T_ * 4, hipMemcpyDeviceToDevice, st);
#if MK_DBG_ONELAUNCH
    mk::launch_range(a, 7, 9, st);
#else
    mk::launch_range(a, 7, 8, st); mk::launch_range(a, 8, 9, st);
#endif
    float* slots = (float*)(a.ctl + mk::CW_CHK); float* tol = slots + 128; float* code = slots + 256;
    const float* ss2 = (const float*)(a.ctl + mk::CW_SS) + 2 * T_;
    int n = 0; float htol[64]; dim3 cg(2048), cb(256);
    dbg::k_cmp_bf16<<<cg, cb, 0, st>>>(a.h, FF_, 0, G, FF_, 0, T_, FF_, 0, 1.0f, slots + 2 * n); htol[n++] = 2e-2f;
    dbg::k_cmp_f32<<<cg, cb, 0, st>>>((const float*)d_out, D_, xb2, D_, 0, T_, D_, slots + 2 * n); htol[n++] = 1e-2f;
    dbg::k_cmp_bf16<<<cg, cb, 0, st>>>(a.xb, 4096, 0, xb2, D_, 0, T_, D_, 0, 1.0f, slots + 2 * n); htol[n++] = 1e-2f;
    dbg::k_cmp_ss<<<T_, 256, 0, st>>>(ss2, xb2, D_, slots + 2 * n); htol[n++] = 1e-2f;
#endif
    for (int i = 0; i < n; ++i) { unsigned bits; memcpy(&bits, &htol[i], 4); (void)hipMemsetD32Async((hipDeviceptr_t)(tol + i), (int)bits, 1, st); }
    dbg::k_decide<<<1, 64, 0, st>>>(slots, n, tol, code);
    dbg::k_fill_code<<<2048, 256, 0, st>>>((float*)d_out, (size_t)T_ * D_, code);
}
#endif

#if MK_TIMING
__global__ void k_timing_out(const unsigned* ts, float* out, size_t n, int selA, int selB) {
    auto dur = [&](int sel) { unsigned d = 0; if (sel == 0) d = ts[1] - ts[0]; else if (sel == 9) d = ts[18] - ts[17]; else d = (ts[sel + 1] - ts[sel]) + (ts[sel + 9] - ts[sel + 8]); return (float)d * 0.01f; };
    float c1 = dur(selA), c2 = 200.0f * dur(selB);
    if (selA == 99) {
        const float mhz = (float)(ts[34] - ts[32]) / (float)(ts[35] - ts[33]) * 100.0f; c1 = floorf(mhz / 50.0f + 0.5f) * 50.0f - 1000.0f; c2 = 100000.0f + floorf((float)(ts[35] - ts[33]) * 0.01f / 50.0f + 0.5f) * 50.0f; }
    for (size_t i = (size_t)blockIdx.x * blockDim.x + threadIdx.x; i < n; i += (size_t)gridDim.x * blockDim.x) out[i] = (i == 0) ? c2 : c1;
}
#endif
#if !MK_DEBUG
extern "C" void kernel_launch(void* const* d_in, const int* in_sizes, int n_in, void* d_out, int out_size, void* d_ws, size_t ws_size, hipStream_t stream) {
    if (!mk::setup_once()) return;
    mk::Args a{};
    const size_t need = mk::build_args(a, d_in, d_out, (unsigned char*)d_ws, 0, 15, 2);
    if (need > ws_size || n_in != 14) { fprintf(stderr, "mk: workspace too small (%zu > %zu) or wrong input count %d\n", need, ws_size, n_in); return; }
    (void)hipMemsetAsync(d_ws, 0, MK_SPLIT ? mk::CTL_ZERO_BYTES : mk::BAR_ZERO_BYTES, stream);
#if MK_SPLIT
    for (int p = 0; p < mk::N_PHASES; ++p) mk::launch_range(a, p, p + 1, stream);
#else
    mk::launch_range(a, 0, mk::N_PHASES, stream, false);
#endif
#if MK_TIMING
    k_timing_out<<<2048, 256, 0, stream>>>(a.ctl + mk::CW_TS, (float*)d_out, (size_t)8192 * 4096, MK_TSEL_A, MK_TSEL_B);
#endif
}
#endif
```

```cpp
#include <hip/hip_runtime.h>
#include <cstdio>
#include <cstdint>
#include <cstring>
#define MK_DEBUG 0
#define MK_SPLIT 0
#define MK_DBG_ONELAUNCH 0
#define MK_TIMING 0
namespace pg8 {
#define PG8_LAS __attribute__((address_space(3)))
typedef unsigned short bf16_t;
typedef short bf16x8 __attribute__((ext_vector_type(8)));
typedef float f32x4 __attribute__((ext_vector_type(4)));
typedef unsigned u32x4 __attribute__((ext_vector_type(4)));
constexpr int BM = 256, BK = 64, HALF = 128, HTB = HALF * BK * 2  , STAGE_BYTES = 8 * HTB, NXCD = 8, WGM = 8;

__host__ __device__ __forceinline__ int lds_byte(int r, int c) { const int st = (r >> 4) * 2 + (c >> 5), rr = r & 15, cc = c & 31, ob = rr * 64 + cc * 2; return st * 1024 + (ob ^ (((ob >> 9) & 1) << 5)); }
__host__ __device__ __forceinline__ void stage_rc(int b, int& R, int& C) { const int st = b / 1024, sb = b % 1024, swz = sb ^ (((sb >> 9) & 1) << 5); R = (st >> 1) * 16 + swz / 64; C = (st & 1) * 32 + (swz % 64) / 2; }
__host__ __device__ __forceinline__ int perm32(int rho) { const int n = rho >> 4, i = rho & 15; return 8 * (i >> 2) + 4 * n + (i & 3); }

struct Unit { int pm, pn, sw; };
struct Gemm { const bf16_t* A; const bf16_t* Bt; int K; int a_pitch, a_kstep, b_pitch, b_kstep; };

struct StaticOrder {
    int nM, nN, nwg, G, c;
    __host__ __device__ void init(int nM_, int nN_, int G_, int c_) { nM = nM_; nN = nN_; nwg = nM * nN; G = G_; c = c_; }
    __host__ __device__ bool next(int i, Unit& u) const {
        const long L = (long)i * G + c; if (L >= nwg) return false;
        int wgid = (int)L; { const int q = nwg / NXCD, r = nwg % NXCD, xcd = wgid % NXCD, off = wgid / NXCD; wgid = (xcd < r ? xcd * (q + 1) : r * (q + 1) + (xcd - r) * q) + off; }
        const int nig = WGM * nN, gid = wgid / nig, fm = gid * WGM, gsz = (nM - fm) < WGM ? (nM - fm) : WGM;
        u.pm = fm + ((wgid % nig) % gsz); u.pn = (wgid % nig) / gsz; u.sw = 0; return true;
    }
    __device__ __forceinline__ void a_ready(const Unit&) const {}
    __device__ __forceinline__ void done(const Unit&) const {}
};

#ifndef MK_EPI_NT
#define MK_EPI_NT 0
#endif
#ifndef MK_G1_PROBE
#define MK_G1_PROBE 0
#endif
#define MK_PST16(p, v) do { if (!((MK_G1_PROBE == 1 || (MK_G1_PROBE == 3 && issw_) || (MK_G1_PROBE == 4 && !issw_) || (MK_G1_PROBE == 5 && (blockIdx.x & 1))) && probe)) MK_ST16(p, v); } while (0)
#ifndef MK_EPI_LASTWT
#define MK_EPI_LASTWT 0
#endif
#if MK_EPI_NT
#define MK_ST16(p, v) __builtin_nontemporal_store((v), (u32x4*)(p))
#elif MK_EPI_LASTWT
#define MK_ST16(p, v) do { const u32x4 v_ = (v); void* const p_ = (void*)(p); if (lastu) asm volatile("global_store_dwordx4 %0, %1, off sc1\n\ts_nop 1" :: "v"(p_), "v"(v_) : "memory"); else *(u32x4*)p_ = v_; } while (0)
#else
#define MK_ST16(p, v) (*(u32x4*)(p) = (v))
#endif
#ifndef MK_VT_BLK
#define MK_VT_BLK 0
#endif

typedef __bf16 bf16x2v __attribute__((ext_vector_type(2)));
__device__ __forceinline__ unsigned cvt_pk_bf16(float lo, float hi) { bf16x2v v; v[0] = (__bf16)lo; v[1] = (__bf16)hi; return __builtin_bit_cast(unsigned, v); }
__device__ __forceinline__ u32x4 pack8(const f32x4 a, const f32x4 b) { u32x4 w; w.x = cvt_pk_bf16(a[0], a[1]); w.y = cvt_pk_bf16(a[2], a[3]); w.z = cvt_pk_bf16(b[0], b[1]); w.w = cvt_pk_bf16(b[2], b[3]); return w; }
typedef unsigned long long u64;
__device__ __forceinline__ u64 ss_fix(float sq) { return (u64)(sq * 1048576.0f + 0.5f); }
__device__ __forceinline__ float rs_of(u64 ss) { return __builtin_amdgcn_rsqf((float)ss * (1.0f / (1048576.0f * 4096.0f)) + 1e-6f); }
__device__ __forceinline__ float silu1f(float v) { return v * __builtin_amdgcn_rcpf(1.0f + __builtin_amdgcn_exp2f(-1.44269504f * v)); }
__device__ __forceinline__ f32x4 silu4(const f32x4 v) { f32x4 o; o[0] = silu1f(v[0]); o[1] = silu1f(v[1]); o[2] = silu1f(v[2]); o[3] = silu1f(v[3]); return o; }

constexpr int TT = 8192;

struct EpiProj {
    static constexpr bool PERM = true, AFTER_DRAIN = false;
    const u64* ss;
    const int* pos;
    bf16_t *qr, *kr, *vrt, *srg, *gq, *gk, *vgt, *sgg;
    int probe;
    __device__ __forceinline__ void operator()(const f32x4 (&acc)[2][2][4][2], const Unit& u, int wr, int wc, int fr_, int fq_, bool lastu = false) const {
        int fr = fr_, fq = fq_; asm volatile("" : "+v"(fr), "+v"(fq));
        int pn = u.pn; asm volatile("" : "+s"(pn));
        const bool issw_ = (pn >= 16 && pn < 24) || (pn >= 40 && pn < 48); (void)issw_;
        if (issw_) {
#if MK_VT_BLK
            bf16_t* dst = ((pn < 24) ? vrt + (size_t)(pn - 16) * 65536 : vgt + (size_t)(pn - 40) * 65536) + (size_t)u.pm * (2048 * 256) + (wc * 32 + 8 * fq);
#else
            bf16_t* dst = (pn < 24) ? vrt + (size_t)(pn - 16) * 256 * TT : vgt + (size_t)(pn - 40) * 256 * TT;
#endif
            const int tc0 = u.pm * BM + wc * 32 + 8 * fq;
            f32x4 rs[2][2];
#pragma unroll
            for (int bj = 0; bj < 2; ++bj)
#pragma unroll
                for (int n = 0; n < 2; ++n) { const u64* sp = ss + tc0 + bj * HALF + 4 * n; rs[bj][n] = (f32x4){rs_of(sp[0]), rs_of(sp[1]), rs_of(sp[2]), rs_of(sp[3])}; }
#pragma unroll
            for (int ai = 0; ai < 2; ++ai)
#pragma unroll
                for (int m = 0; m < 4; ++m) {
#if MK_VT_BLK
                    bf16_t* rowp = dst + (ai * HALF + wr * 64 + m * 16 + fr) * 256;
#else
                    bf16_t* rowp = dst + (size_t)(ai * HALF + wr * 64 + m * 16 + fr) * TT + tc0;
#endif

#pragma unroll
                    for (int bj = 0; bj < 2; ++bj) MK_PST16(rowp + bj * HALF, pack8(acc[ai][bj][m][0] * rs[bj][0], acc[ai][bj][m][1] * rs[bj][1])); }
            return;
        }
        const int t0 = u.pm * BM + wr * 64 + fr;
        const int cl = wc * 32 + 8 * fq;
        if (pn < 16) {
            const int h = pn & 7; const bool isk = pn >= 8; bf16_t* dst = (isk ? kr : qr) + h * 256;
            const float lg = log2f(1.0f - exp2f(-5.0f - (float)h));
            float invf[2][4];
#pragma unroll
            for (int n = 0; n < 2; ++n)
#pragma unroll
                for (int j = 0; j < 4; ++j) invf[n][j] = exp2f(-(float)(cl + 4 * n + j) * (13.287712379549449f / 128.0f));
            u64 ssv[2][4]; int pv[2][4];
#pragma unroll
            for (int ai = 0; ai < 2; ++ai)
#pragma unroll
                for (int m = 0; m < 4; ++m) { ssv[ai][m] = ss[t0 + ai * HALF + m * 16]; pv[ai][m] = pos[t0 + ai * HALF + m * 16]; }
            asm volatile("" ::: "memory");
#pragma unroll
            for (int ai = 0; ai < 2; ++ai)
#pragma unroll
                for (int m = 0; m < 4; ++m) { const int t = t0 + ai * HALF + m * 16; const float ip1 = (float)((t & 255) + 1); const float posf = (float)pv[ai][m];
                    const float sc = rs_of(ssv[ai][m]) * (isk ? exp2f(-ip1 * lg) * 0.0625f : exp2f(ip1 * lg));
                    f32x4 o1[2], o2[2];
#pragma unroll
                    for (int n = 0; n < 2; ++n) { f32x4 c4, s4;
#pragma unroll
                        for (int j = 0; j < 4; ++j) { const float fr = __builtin_amdgcn_fractf((posf * invf[n][j]) * 0.15915494309189535f); if (MK_G1_PROBE == 2 && probe) { c4[j] = 1.0f; s4[j] = fr; } else { c4[j] = __builtin_amdgcn_cosf(fr); s4[j] = __builtin_amdgcn_sinf(fr); } }
                        const f32x4 a = acc[ai][0][m][n], b = acc[ai][1][m][n]; o1[n] = (a * c4 - b * s4) * sc; o2[n] = (a * s4 + b * c4) * sc; }
                    bf16_t* rowp = dst + (size_t)t * 2048 + cl;
                    MK_PST16(rowp, pack8(o1[0], o1[1])); MK_PST16(rowp + HALF, pack8(o2[0], o2[1])); }
            return;
        }
        bf16_t* dst; int ld; float sc = 1.0f; bool act = false;
        if (pn < 32) { dst = srg + (pn - 24) * 256; ld = 2048; act = true; }
        else if (pn < 36) { dst = gq + (pn - 32) * 256; ld = 1024; sc = 0.0625f; }
        else if (pn < 40) { dst = gk + (pn - 36) * 256; ld = 1024; }
        else { dst = sgg + (pn - 48) * 256; ld = 2048; act = true; }
        u64 ssv[2][4];
#pragma unroll
        for (int ai = 0; ai < 2; ++ai)
#pragma unroll
            for (int m = 0; m < 4; ++m) ssv[ai][m] = ss[t0 + ai * HALF + m * 16];
        asm volatile("" ::: "memory");
#pragma unroll
        for (int ai = 0; ai < 2; ++ai)
#pragma unroll
            for (int m = 0; m < 4; ++m) { const int t = t0 + ai * HALF + m * 16; const float s = rs_of(ssv[ai][m]) * sc; bf16_t* rowp = dst + (size_t)t * ld + cl;
#pragma unroll
                for (int bj = 0; bj < 2; ++bj) { f32x4 v0 = acc[ai][bj][m][0] * s, v1 = acc[ai][bj][m][1] * s; if (act && !(MK_G1_PROBE == 2 && probe)) { v0 = silu4(v0); v1 = silu4(v1); }
                    MK_PST16(rowp + bj * HALF, pack8(v0, v1)); } }
    }
};

struct EpiRes {
    static constexpr bool PERM = true, AFTER_DRAIN = false;
    bf16_t* xb; u64* ssout; u64* dup;
    __device__ __forceinline__ void operator()(const f32x4 (&acc)[2][2][4][2], const Unit& u, int wr, int wc, int fr_, int fq_, bool lastu = false) const {
        int fr = fr_, fq = fq_; asm volatile("" : "+v"(fr), "+v"(fq));
        const int t0 = u.pm * BM + wr * 64 + fr, c0 = u.pn * BM + wc * 32 + 8 * fq;
        u32x4 xi[2][4][2];
#pragma unroll
        for (int ai = 0; ai < 2; ++ai)
#pragma unroll
            for (int m = 0; m < 4; ++m)
#pragma unroll
                for (int bj = 0; bj < 2; ++bj) xi[ai][m][bj] = *(const u32x4*)(xb + (size_t)(t0 + ai * HALF + m * 16) * 4096 + c0 + bj * HALF);
        asm volatile("" ::: "memory");
#pragma unroll
        for (int ai = 0; ai < 2; ++ai) {
#pragma unroll
            for (int m = 0; m < 4; ++m) { const int t = t0 + ai * HALF + m * 16; bf16_t* rowp = xb + (size_t)t * 4096 + c0; float sq = 0.f;
#pragma unroll
                for (int bj = 0; bj < 2; ++bj) { const u32x4 x = xi[ai][m][bj];
                    f32x4 o0 = acc[ai][bj][m][0], o1 = acc[ai][bj][m][1];
                    o0[0] += __uint_as_float(x.x << 16); o0[1] += __uint_as_float(x.x & 0xffff0000u); o0[2] += __uint_as_float(x.y << 16); o0[3] += __uint_as_float(x.y & 0xffff0000u);
                    o1[0] += __uint_as_float(x.z << 16); o1[1] += __uint_as_float(x.z & 0xffff0000u); o1[2] += __uint_as_float(x.w << 16); o1[3] += __uint_as_float(x.w & 0xffff0000u);
                    sq += ((o0[0] * o0[0] + o0[1] * o0[1]) + (o0[2] * o0[2] + o0[3] * o0[3])) + ((o1[0] * o1[0] + o1[1] * o1[1]) + (o1[2] * o1[2] + o1[3] * o1[3]));
                    MK_ST16(rowp + bj * HALF, pack8(o0, o1)); }
                sq += __shfl_xor(sq, 16); sq += __shfl_xor(sq, 32);
                if (fq == 0) atomicAdd(ssout + t, ss_fix(sq));
#ifdef MK_DUP_ATOMICS
                if (fq == 0) atomicAdd(dup + t, ss_fix(sq));
#endif
                } }
    }
};

struct EpiSwiGLU {
    static constexpr bool PERM = true, AFTER_DRAIN = false;
    const u64* ss; bf16_t* h;
    __device__ __forceinline__ void operator()(const f32x4 (&acc)[2][2][4][2], const Unit& u, int wr, int wc, int fr_, int fq_, bool lastu = false) const {
        int fr = fr_, fq = fq_; asm volatile("" : "+v"(fr), "+v"(fq));
        const int t0 = u.pm * BM + wr * 64 + fr, c0 = u.pn * HALF + wc * 32 + 8 * fq;
        u64 ssv[2][4];
#pragma unroll
        for (int ai = 0; ai < 2; ++ai)
#pragma unroll
            for (int m = 0; m < 4; ++m) ssv[ai][m] = ss[t0 + ai * HALF + m * 16];
        asm volatile("" ::: "memory");
#pragma unroll
        for (int ai = 0; ai < 2; ++ai)
#pragma unroll
            for (int m = 0; m < 4; ++m) { const int t = t0 + ai * HALF + m * 16; const float s = rs_of(ssv[ai][m]); f32x4 o[2];
#pragma unroll
                for (int n = 0; n < 2; ++n) { const f32x4 g = silu4(acc[ai][0][m][n] * s), uu = acc[ai][1][m][n] * s; o[n] = g * uu; }
                MK_ST16(h + ((size_t)(c0 >> 6) * TT + t) * 64 + (c0 & 63), pack8(o[0], o[1])); }
    }
};
struct ProjOrder : StaticOrder {
    __host__ __device__ bool next(int i, Unit& u) const { if (!StaticOrder::next(i, u)) return false; u.sw = ((u.pn >= 16 && u.pn < 24) || (u.pn >= 40 && u.pn < 48)) ? 1 : 0; return true; }
};
template <class Epi, class Sched, bool ALIGN_EPI = false, bool SP2 = false>
__device__ __forceinline__ void gemm_phase(PG8_LAS unsigned char* lds, const Gemm g, const Sched& S, const Epi& E, int tid_in) {
    int tid = tid_in; asm volatile("" : "+v"(tid));
    const int wid = __builtin_amdgcn_readfirstlane(tid >> 6), lane = tid & 63, wr = wid >> 2, wc = wid & 3, fr = lane & 15, fq = lane >> 4;
    const int K = g.K, nt = K / BK;
    unsigned voffA[2], voffB[2];
#pragma unroll
    for (int i = 0; i < 2; ++i) { int R, C; stage_rc(tid * 16 + i * 8192, R, C); const int Rb = Epi::PERM ? ((R & ~31) + perm32(R & 31)) : R;
        voffA[i] = (unsigned)(R * g.a_pitch + C * 2); voffB[i] = (unsigned)(Rb * g.b_pitch + C * 2); }
    const size_t kstep = (size_t)g.b_kstep, kstepA = (size_t)g.a_kstep;
    const size_t hstep = (size_t)HALF * g.b_pitch, hstepA = (size_t)HALF * g.a_pitch;
    const size_t tstep = 2 * hstep, tstepA = 2 * hstepA;
    const unsigned ldsw = (unsigned)wid * 1024u;
    const int aoff = lds_byte(wr * 64 + fr, fq * 8), boff = lds_byte(wc * 32 + fr, fq * 8);
#define PG8_SA(b, h) (((b) * 2 + (h)) * HTB)
#define PG8_SB(b, h) ((4 + (b) * 2 + (h)) * HTB)
#define PG8_STAGE(bufoff, gbase, voff) do { _Pragma("unroll") for (int _i = 0; _i < 2; ++_i) \
        __builtin_amdgcn_global_load_lds((const unsigned*)((const char*)(gbase) + (voff)[_i]), (PG8_LAS unsigned*)(lds + (bufoff) + ldsw + _i * 8192), 16, 0, 0); } while (0)
#define PG8_LDA(dst, b, h) do { _Pragma("unroll") for (int m = 0; m < 4; ++m) _Pragma("unroll") for (int k = 0; k < 2; ++k) dst[m][k] = *(const PG8_LAS bf16x8*)(lds + PG8_SA(b, h) + aoff + m * 2048 + k * 1024); } while (0)
#define PG8_LDB(dst, b, h) do { _Pragma("unroll") for (int n = 0; n < 2; ++n) _Pragma("unroll") for (int k = 0; k < 2; ++k) dst[n][k] = *(const PG8_LAS bf16x8*)(lds + PG8_SB(b, h) + boff + n * 2048 + k * 1024); } while (0)
#define PG8_MMA(ai, bj, At, Bt) do { __builtin_amdgcn_s_setprio(1); _Pragma("unroll") for (int m = 0; m < 4; ++m) _Pragma("unroll") for (int n = 0; n < 2; ++n) _Pragma("unroll") for (int k = 0; k < 2; ++k) \
        acc[ai][bj][m][n] = __builtin_amdgcn_mfma_f32_16x16x32_bf16(Bt[n][k], At[m][k], acc[ai][bj][m][n], 0, 0, 0); __builtin_amdgcn_s_setprio(0); } while (0)
#define PG8_WAIT_V(n) asm volatile("s_waitcnt vmcnt(" #n ")" ::: "memory")
#define PG8_WAIT_L(n) asm volatile("s_waitcnt lgkmcnt(" #n ")" ::: "memory")
#define PG8_BAR __builtin_amdgcn_s_barrier()
#define PG8_SCHED __builtin_amdgcn_sched_barrier(0)
    Unit cur, nxt; int ui = 0;
    if (!S.next(0, cur)) return;
    f32x4 acc[2][2][4][2];
#pragma unroll
    for (int a = 0; a < 2; ++a)
#pragma unroll
        for (int b = 0; b < 2; ++b)
#pragma unroll
            for (int m = 0; m < 4; ++m)
#pragma unroll
                for (int n = 0; n < 2; ++n) acc[a][b][m][n] = (f32x4){0.f, 0.f, 0.f, 0.f};
    bf16x8 At[4][2], B0[2][2], B1[2][2];
    const char* cA = cur.sw ? (const char*)g.Bt + (size_t)cur.pn * tstep : (const char*)g.A + (size_t)cur.pm * tstepA; const char* cB = cur.sw ? (const char*)g.A + (size_t)cur.pm * tstep : (const char*)g.Bt + (size_t)cur.pn * tstep;
    S.a_ready(cur);
    if constexpr (SP2) {
        PG8_STAGE(PG8_SB(0, 0), cB, voffB); PG8_STAGE(PG8_SB(0, 1), cB + hstep, voffB); PG8_STAGE(PG8_SA(0, 0), cA, voffA); PG8_STAGE(PG8_SA(0, 1), cA + hstepA, voffA);
        if (wr == 1) PG8_BAR;
        PG8_WAIT_V(2); PG8_BAR;
        PG8_STAGE(PG8_SB(1, 0), cB + kstep, voffB); PG8_STAGE(PG8_SA(1, 0), cA + kstepA, voffA); PG8_STAGE(PG8_SB(1, 1), cB + hstep + kstep, voffB);
        PG8_WAIT_V(6); PG8_BAR;
    } else {
        PG8_STAGE(PG8_SB(0, 0), cB, voffB); PG8_STAGE(PG8_SA(0, 0), cA, voffA); PG8_STAGE(PG8_SB(0, 1), cB + hstep, voffB); PG8_STAGE(PG8_SA(0, 1), cA + hstepA, voffA);
        if (wr == 1) PG8_BAR;
        PG8_WAIT_V(4); PG8_BAR;
        PG8_STAGE(PG8_SB(1, 0), cB + kstep, voffB); PG8_STAGE(PG8_SA(1, 0), cA + kstepA, voffA); PG8_STAGE(PG8_SB(1, 1), cB + hstep + kstep, voffB);
        PG8_WAIT_V(6); PG8_BAR;
    }
    for (;;) {
        const bool has_next = S.next(ui + 1, nxt);
        const char* nA = has_next ? (nxt.sw ? (const char*)g.Bt + (size_t)nxt.pn * tstep : (const char*)g.A + (size_t)nxt.pm * tstepA) : cA; const char* nB = has_next ? (nxt.sw ? (const char*)g.A + (size_t)nxt.pm * tstep : (const char*)g.Bt + (size_t)nxt.pn * tstep) : cB;
        for (int t = 0; t < nt; t += 2) {
            const bool last = (t == nt - 2);
            const char* a1 = cA + (size_t)(t + 1) * kstepA;
            const char* a2 = last ? nA : cA + (size_t)(t + 2) * kstepA; const char* b2 = last ? nB : cB + (size_t)(t + 2) * kstep;
            const char* a3 = a2 + kstepA; const char* b3 = b2 + kstep;
            if (last && has_next) S.a_ready(nxt);
            if constexpr (SP2) {
            PG8_LDB(B0, 0, 0); PG8_LDB(B1, 0, 1); PG8_SCHED; PG8_LDA(At, 0, 0); PG8_STAGE(PG8_SA(1, 1), a1 + hstepA, voffA);
            PG8_WAIT_V(8); PG8_WAIT_L(0); PG8_BAR; PG8_MMA(0, 0, At, B0); PG8_MMA(0, 1, At, B1); PG8_BAR; PG8_SCHED;
            PG8_LDA(At, 0, 1); PG8_STAGE(PG8_SB(0, 0), b2, voffB); PG8_STAGE(PG8_SB(0, 1), b2 + hstep, voffB); PG8_STAGE(PG8_SA(0, 0), a2, voffA);
            PG8_WAIT_V(8); PG8_WAIT_L(0); PG8_BAR; PG8_MMA(1, 0, At, B0); PG8_MMA(1, 1, At, B1); PG8_BAR; PG8_SCHED;
            PG8_LDB(B0, 1, 0); PG8_LDB(B1, 1, 1); PG8_SCHED; PG8_LDA(At, 1, 0); PG8_STAGE(PG8_SA(0, 1), a2 + hstepA, voffA);
            PG8_WAIT_V(8); PG8_WAIT_L(0); PG8_BAR; PG8_MMA(0, 0, At, B0); PG8_MMA(0, 1, At, B1); PG8_BAR; PG8_SCHED;
            PG8_LDA(At, 1, 1); PG8_STAGE(PG8_SB(1, 0), b3, voffB); PG8_STAGE(PG8_SB(1, 1), b3 + hstep, voffB); PG8_STAGE(PG8_SA(1, 0), a3, voffA);
            PG8_WAIT_V(8); PG8_WAIT_L(0); PG8_BAR; PG8_MMA(1, 0, At, B0); PG8_MMA(1, 1, At, B1); PG8_BAR; PG8_SCHED;
            } else {
            PG8_LDB(B0, 0, 0); PG8_SCHED; PG8_LDA(At, 0, 0); PG8_STAGE(PG8_SA(1, 1), a1 + hstepA, voffA);
            PG8_WAIT_L(8); PG8_BAR; PG8_WAIT_L(0); PG8_MMA(0, 0, At, B0); PG8_BAR; PG8_SCHED;
            PG8_LDB(B1, 0, 1); PG8_STAGE(PG8_SB(0, 0), b2, voffB);
            PG8_BAR; PG8_WAIT_L(0); PG8_MMA(0, 1, At, B1); PG8_BAR;
            PG8_LDA(At, 0, 1); PG8_STAGE(PG8_SA(0, 0), a2, voffA);
            PG8_BAR; PG8_WAIT_L(0); PG8_MMA(1, 0, At, B0); PG8_BAR; PG8_SCHED;
            PG8_STAGE(PG8_SB(0, 1), b2 + hstep, voffB);
            PG8_WAIT_V(6); PG8_BAR; PG8_MMA(1, 1, At, B1); PG8_BAR;
            PG8_LDB(B0, 1, 0); PG8_SCHED; PG8_LDA(At, 1, 0); PG8_STAGE(PG8_SA(0, 1), a2 + hstepA, voffA);
            PG8_WAIT_L(8); PG8_BAR; PG8_WAIT_L(0); PG8_MMA(0, 0, At, B0); PG8_BAR; PG8_SCHED;
            PG8_LDB(B1, 1, 1); PG8_STAGE(PG8_SB(1, 0), b3, voffB);
            PG8_BAR; PG8_WAIT_L(0); PG8_MMA(0, 1, At, B1); PG8_BAR;
            PG8_LDA(At, 1, 1); PG8_STAGE(PG8_SA(1, 0), a3, voffA);
            PG8_BAR; PG8_WAIT_L(0); PG8_MMA(1, 0, At, B0); PG8_BAR; PG8_SCHED;
            PG8_STAGE(PG8_SB(1, 1), b3 + hstep, voffB);
            PG8_WAIT_V(6); PG8_BAR; PG8_MMA(1, 1, At, B1); PG8_BAR;
            }
        }
        if constexpr (ALIGN_EPI) { if (wr == 0) PG8_BAR; }
        if constexpr (!Epi::AFTER_DRAIN) { int te_ = tid_in; asm volatile("" : "+v"(te_)); E(acc, cur, wr, wc, te_ & 15, (te_ & 63) >> 4, !has_next); S.done(cur); }
        if (!has_next) break;
#pragma unroll
        for (int a = 0; a < 2; ++a)
#pragma unroll
            for (int b = 0; b < 2; ++b)
#pragma unroll
                for (int m = 0; m < 4; ++m)
#pragma unroll
                    for (int n = 0; n < 2; ++n) acc[a][b][m][n] = (f32x4){0.f, 0.f, 0.f, 0.f};
        cur = nxt; cA = nA; cB = nB; ++ui;
        if constexpr (ALIGN_EPI) { if (wr == 1) PG8_BAR; }
    }
    PG8_WAIT_V(0);
    if constexpr (!ALIGN_EPI) { if (wr == 0) PG8_BAR; }
    PG8_BAR;
    if constexpr (Epi::AFTER_DRAIN) { E.fused(acc, cur, wr, wc, fr, fq, lds, wid, lane); S.done(cur); }
#undef PG8_SA
#undef PG8_SB
#undef PG8_STAGE
#undef PG8_LDA
#undef PG8_LDB
#undef PG8_MMA
#undef PG8_WAIT_V
#undef PG8_WAIT_L
#undef PG8_BAR
#undef PG8_SCHED
}
}

#ifndef MK_WT_STORES
#define MK_WT_STORES 1
#endif
#define GAS __attribute__((address_space(1)))
#define LAS __attribute__((address_space(3)))
typedef unsigned short bf16_t;
typedef short bf16x8 __attribute__((ext_vector_type(8)));
typedef float f32x4 __attribute__((ext_vector_type(4)));
typedef float f32x2 __attribute__((ext_vector_type(2)));
typedef unsigned u32x4 __attribute__((ext_vector_type(4)));
typedef unsigned u32x2 __attribute__((ext_vector_type(2)));
#define LDS_WAIT() asm volatile("s_waitcnt lgkmcnt(0)" ::: "memory")
#define VM_WAIT() asm volatile("s_waitcnt vmcnt(0)" ::: "memory")

namespace mk {
using pg8::cvt_pk_bf16; using pg8::pack8; using pg8::rs_of; using pg8::u64; using pg8::ss_fix;
constexpr int T = 8192, D = 4096, INW = 14352, NPROJ = 14336, FF = 11008;
constexpr int NWAVES = 8, NTHR = 512;
constexpr int LDS_BYTES = 147456;
constexpr int LDSCTL_OFF = 140 * 1024;
constexpr int CW_TMO = 0, CW_BAR = 0  , CW_SS = 8192  , CW_CHK = 98304  , CW_TS = 96000  ;
constexpr size_t CTL_ZERO_BYTES = 512 * 1024, BAR_ZERO_BYTES = 16384;
constexpr int N_PHASES = 18;

struct Args {
    const float* x; const int* pos; const float* mix_norm; const float* w_in; const float* gla_w_up; const float* gla_b; const float* ret_gain; const float* gla_gain;
    const float* w_out; const float* ffn_norm; const float* w_gate; const float* w_up; const float* w_down; const float* final_norm;
    float* out; unsigned* ctl;
    bf16_t* win_t[2]; bf16_t* wga_t[2]; bf16_t* wout_t[2]; bf16_t* wgu_t[2]; bf16_t* wd_t[2];
    bf16_t* xb; float* rot; float* ga; float* lam;
    bf16_t *qr, *kr, *krt, *vrt, *srg, *gq, *gk, *qg, *kg, *kgt, *vgt, *sgg, *kvr, *kvg, *mixed, *h;
    bf16_t* dbgp; float* dbgo;
    int ph_lo, ph_hi, cvt_mask, cvt_layers;
};

__device__ __forceinline__ void st16_wt(void* p, u32x4 v) {
#if MK_WT_STORES
    asm volatile("global_store_dwordx4 %0, %1, off sc1\n\ts_nop 1" :: "v"(p), "v"(v) : "memory");
#else
    *(u32x4*)p = v;
#endif
}
__device__ __forceinline__ float wave_sum(float v) {
#pragma unroll
    for (int o = 1; o < 64; o <<= 1) v += __shfl_xor(v, o);
    return v;
}
__device__ __forceinline__ float bf_lo(unsigned w) { return __uint_as_float(w << 16); }
__device__ __forceinline__ float bf_hi(unsigned w) { return __uint_as_float(w & 0xffff0000u); }
__device__ __forceinline__ float silu1(float v) { return v / (1.0f + __expf(-v)); }

#define XB_TMO      128
#define XB_XCNT(j)  (256  + 64 * (j))
#define XB_XSUB(j)  (1280 + 64 * (j))
#define XB_XGEN(j)  (2304 + 64 * (j))
#define XB_TOP      3328
#define XB_TOPGEN   3392
#define XCD_BAR_WORDS 3456
#define XB_SPIN_CAP (1u << 18)

__device__ __forceinline__ unsigned xb_ld(unsigned* p)              { return __hip_atomic_load(p, __ATOMIC_RELAXED, __HIP_MEMORY_SCOPE_AGENT); }
__device__ __forceinline__ unsigned xb_add(unsigned* p, unsigned v) { return __hip_atomic_fetch_add(p, v, __ATOMIC_RELAXED, __HIP_MEMORY_SCOPE_AGENT); }
__device__ __forceinline__ unsigned xb_xcc_id() { return (unsigned)__builtin_amdgcn_s_getreg((3 << 11) | 20) & 0xFu; }
#define XB_SPIN(cond, bar) do { unsigned _sp = 0; while (cond) { __builtin_amdgcn_s_sleep(1); \
    if ((++_sp & 255u) == 0u) { if (xb_ld(&(bar)[XB_TMO])) break; if (_sp > XB_SPIN_CAP) { atomicAdd(&(bar)[XB_TMO], 1u); break; } } } } while (0)

struct XcdBarrier {
    unsigned* bar; unsigned x;
    volatile LAS unsigned* st;
    unsigned leader;
};

__device__ __forceinline__ XcdBarrier xcd_barrier_post(unsigned* bar, volatile LAS unsigned* st) {
    XcdBarrier b; b.bar = bar; b.x = xb_xcc_id(); b.st = st; b.leader = (threadIdx.x == 0) ? 1u : 0u;
    if (threadIdx.x == 0) (void)xb_add(&bar[XB_XCNT(b.x)], 1u);
    return b;
}
__device__ __forceinline__ void xcd_barrier_complete(unsigned* bar, unsigned x, unsigned& nloc, unsigned& nx) {
    const unsigned G = gridDim.x * gridDim.y * gridDim.z;
    unsigned sum, cnt, mine, sp = 0u;
    for (;;) {
        sum = 0u; cnt = 0u; mine = 0u;
#pragma unroll
        for (unsigned j = 0; j < 16; ++j) { const unsigned c = xb_ld(&bar[XB_XCNT(j)]); sum += c; cnt += (c > 0u) ? 1u : 0u; mine = (j == x) ? c : mine; }
        if (sum == G) break;
        __builtin_amdgcn_s_sleep(1);
        if ((++sp & 255u) == 0u) { if (xb_ld(&bar[XB_TMO])) break; if (sp > XB_SPIN_CAP) { atomicAdd(&bar[XB_TMO], 1u); break; } }
    }
    nloc = mine > 0u ? mine : 1u; nx = cnt > 0u ? cnt : 1u;
}

__device__ __forceinline__ void xcd_barrier(const XcdBarrier& b) {
    asm volatile("s_waitcnt vmcnt(0)" ::: "memory");
    __syncthreads();
    if (b.leader) {
        unsigned* bar = b.bar;
        __builtin_amdgcn_s_waitcnt(0);
        unsigned nloc = b.st[0], nx = b.st[1];
        if (nloc == 0u) { xcd_barrier_complete(bar, b.x, nloc, nx); b.st[0] = nloc; b.st[1] = nx; }
        const unsigned old = xb_add(&bar[XB_XSUB(b.x)], 1u);
        const unsigned gen = old / nloc;
        if (old + 1u == (gen + 1u) * nloc) {
            __builtin_amdgcn_fence(__ATOMIC_RELEASE, "agent");
            asm volatile("s_waitcnt vmcnt(0)" ::: "memory");
            const unsigned og = xb_add(&bar[XB_TOP], 1u);
            const unsigned tg = og / nx;
            if (og + 1u == (tg + 1u) * nx) xb_add(&bar[XB_TOPGEN], 1u);
            else XB_SPIN(xb_ld(&bar[XB_TOPGEN]) == tg, bar);
            __builtin_amdgcn_fence(__ATOMIC_ACQUIRE, "agent");
            xb_add(&bar[XB_XGEN(b.x)], 1u);
            asm volatile("s_waitcnt vmcnt(0)" ::: "memory");
        } else {
            XB_SPIN(xb_ld(&bar[XB_XGEN(b.x)]) == gen, bar);
            __builtin_amdgcn_fence(__ATOMIC_ACQUIRE, "agent");
            asm volatile("s_waitcnt vmcnt(0)" ::: "memory");
        }
    }
    __syncthreads();
}

#ifndef MK_M3_RDG
#define MK_M3_RDG 4
#endif
#ifndef MK_M3_RDR
#define MK_M3_RDR 6
#endif
#ifndef MK_M3_EPI
#define MK_M3_EPI 2
#endif
#ifndef MK_M1V2
#define MK_M1V2 1
#endif
#ifndef MK_M3_UNPAIR
#define MK_M3_UNPAIR 0
#endif
#ifndef MK_M3_PROBE
#define MK_M3_PROBE 0
#endif
#ifndef MK_M3_WT
#define MK_M3_WT 1
#endif
#ifndef MK_M3_NTST
#define MK_M3_NTST 0
#endif
#ifndef MK_M3_FLIP
#define MK_M3_FLIP 0
#endif
#ifndef MK_M3_GEARLY
#define MK_M3_GEARLY 0
#endif
#ifndef MK_M3_DEFER
#define MK_M3_DEFER 0
#endif
#ifndef MK_M2_WT
#define MK_M2_WT 1
#endif
#ifndef MK_MIX_WT
#define MK_MIX_WT 0
#endif
#ifndef MK_FIN_NT
#define MK_FIN_NT 1
#endif
#ifndef MK_XB_WT
#define MK_XB_WT 0
#endif
#ifndef MK_M1_VNT
#define MK_M1_VNT 1
#endif
#ifndef MK_P0_TEST
#define MK_P0_TEST 0
#endif
#ifndef MK_NT
#define MK_NT 1
#endif
#if MK_NT
#define MK_NTLD(p) __builtin_nontemporal_load(p)
#else
#define MK_NTLD(p) (*(p))
#endif
#ifndef MK_BLK_WIN
#define MK_BLK_WIN 0
#endif
#ifndef MK_BLK_W
#define MK_BLK_W 0
#endif
struct CvtItem { const float* W; const float* gain; bf16_t* WT; size_t dst_row0; int ldn, K, k0, n0, valid, nblk; };
template <class AT> __device__ __forceinline__ CvtItem cvt_decode(const AT& a, int it, int nitems) {
    constexpr int I_IN = 64 * 224, I_OUT = 64 * 64, I_G = 64 * 172, I_D = 172 * 64, I_LAYER = I_IN + I_OUT + 2 * I_G + I_D;
    CvtItem c; c.valid = 0; c.W = nullptr; c.gain = nullptr; c.WT = nullptr; c.dst_row0 = 0; c.ldn = 0; c.K = 0; c.k0 = 0; c.n0 = 0; c.nblk = 0;
    if (it >= nitems) return c;
    const int l = it / I_LAYER; int r = it - l * I_LAYER;
#define CVT_KN(r_, NB_) const int kin_ = (r_) & 3, blk_ = (r_) >> 2, nb = blk_ % (NB_), kb = (blk_ / (NB_)) * 4 + kin_
    if (r < I_IN) { if (a.cvt_mask & 1) { CVT_KN(r, 224); c = CvtItem{a.w_in + (size_t)l * D * INW, a.mix_norm + l * D, a.win_t[l], (size_t)(64 * nb), INW, D, 64 * kb, 64 * nb, 1, MK_BLK_WIN ? NPROJ : 0}; } return c; } r -= I_IN;
    if (r < I_OUT) { if (a.cvt_mask & 2) { CVT_KN(r, 64); c = CvtItem{a.w_out + (size_t)l * D * D, (kb < 32 ? a.ret_gain + l * 2048 : a.gla_gain + l * 2048 - 2048)  , a.wout_t[l], (size_t)(64 * nb), D, D, 64 * kb, 64 * nb, 1, MK_BLK_W ? D : 0}; } return c; } r -= I_OUT;
    if (r < 2 * I_G) { if (a.cvt_mask & 4) { const int up = r >= I_G ? 1 : 0; r -= up * I_G; CVT_KN(r, 172); const int n0 = 64 * nb;
        c = CvtItem{(up ? a.w_up : a.w_gate) + (size_t)l * D * FF, a.ffn_norm + l * D, a.wgu_t[l], (size_t)((n0 >> 7) * 256 + up * 128 + (n0 & 127)), FF, D, 64 * kb, n0, 1, MK_BLK_W ? 2 * FF : 0}; } return c; } r -= 2 * I_G;
    if (a.cvt_mask & 8) { CVT_KN(r, 64); c = CvtItem{a.w_down + (size_t)l * FF * D, nullptr, a.wd_t[l], (size_t)(64 * nb), D, FF, 64 * kb, 64 * nb, 1, MK_BLK_W ? D : 0}; }
#undef CVT_KN
    return c;
}
__device__ __forceinline__ const char* uni_ptr(const char* p) { const unsigned long long x = (unsigned long long)p; const unsigned lo = __builtin_amdgcn_readfirstlane((unsigned)x), hi = __builtin_amdgcn_readfirstlane((unsigned)(x >> 32)); return (const char*)(((unsigned long long)hi << 32) | lo); }
__device__ __forceinline__ void cvt_issue(const CvtItem& c, f32x4 (&v)[16], float (&g)[16], int lane) {
    const int kr = lane >> 4, c4 = (lane & 15) * 4;
    if (c.valid) {
        const char* wb = (const char*)(c.W + (size_t)c.k0 * c.ldn + c.n0); const unsigned vo = (unsigned)((kr * c.ldn + c4) * 4), rstep = (unsigned)(4 * c.ldn * 4);
#pragma unroll
        for (int i = 0; i < 16; ++i) { v[i] = __builtin_nontemporal_load((const f32x4*)(uni_ptr(wb + (size_t)i * rstep) + vo)); g[i] = c.gain ? c.gain[c.k0 + 4 * i + kr] : 1.0f; } }
}
__device__ __forceinline__ void cvt_to_lds(const f32x4 (&v)[16], const float (&g)[16], LAS float* scr, int lane) {
    const int kr = lane >> 4, c4 = (lane & 15) * 4;
#pragma unroll
    for (int i = 0; i < 16; ++i) { LAS float* p = scr + (4 * i + kr) * 65 + c4; p[0] = v[i][0] * g[i]; p[1] = v[i][1] * g[i]; p[2] = v[i][2] * g[i]; p[3] = v[i][3] * g[i]; }
    LDS_WAIT(); asm volatile("" ::: "memory");
}
__device__ __forceinline__ void cvt_store(const CvtItem& c, LAS float* scr, int lane) {
    const int cc = lane >> 3, nn = lane & 7;
#pragma unroll
    for (int j = 0; j < 8; ++j) { const int n = nn + 8 * j; const LAS float* s = scr + (8 * cc) * 65 + n;
        u32x4 o; o.x = cvt_pk_bf16(s[0 * 65], s[1 * 65]); o.y = cvt_pk_bf16(s[2 * 65], s[3 * 65]); o.z = cvt_pk_bf16(s[4 * 65], s[5 * 65]); o.w = cvt_pk_bf16(s[6 * 65], s[7 * 65]);
        char* dp = c.nblk ? (char*)(c.WT + ((size_t)(c.k0 >> 6) * c.nblk + c.dst_row0 + n) * 64 + 8 * cc)
                          : (char*)uni_ptr((const char*)(c.WT + (c.dst_row0 + 8 * j) * (size_t)c.K + c.k0)) + (unsigned)((nn * c.K + 8 * cc) * 2);
        __builtin_nontemporal_store(o, (u32x4*)dp); }
    LDS_WAIT(); asm volatile("" ::: "memory");
}
template <class AT> __device__ __forceinline__ void p0_prologue(const AT& a, LAS unsigned char* lds, int tid, int lane, int wave, int bid, int G) {
    LAS float* scr = (LAS float*)(lds + wave * 16640);
    const int gw = bid * NWAVES + wave, NGW = G * NWAVES;
    constexpr int I_LAYER = 64 * 224 + 64 * 64 + 2 * 64 * 172 + 172 * 64;
    const int nitems = a.cvt_layers * I_LAYER;
    {
        f32x4 v0[16], v1[16]; float g0[16], g1[16];
        CvtItem c0 = cvt_decode(a, gw, nitems), c1 = cvt_decode(a, gw + NGW, nitems);
        cvt_issue(c0, v0, g0, lane); cvt_issue(c1, v1, g1, lane);
#pragma unroll 1
        for (int it = gw; it < nitems; it += 2 * NGW) {
            if (c0.valid) cvt_to_lds(v0, g0, scr, lane);
            const CvtItem n0 = cvt_decode(a, it + 2 * NGW, nitems); cvt_issue(n0, v0, g0, lane);
            if (c0.valid) cvt_store(c0, scr, lane);
            if (c1.valid) cvt_to_lds(v1, g1, scr, lane);
            const CvtItem n1 = cvt_decode(a, it + 3 * NGW, nitems); cvt_issue(n1, v1, g1, lane);
            if (c1.valid) cvt_store(c1, scr, lane);
            c0 = n0; c1 = n1;
        }
    }
    if (a.cvt_mask & 1) for (int i = bid * NTHR + tid; i < a.cvt_layers * 16 * D; i += G * NTHR) { const int l = i / (16 * D), r = i - l * 16 * D, j = r / D, k = r - j * D;
        const float v = a.w_in[(size_t)l * D * INW + (size_t)k * INW + NPROJ + j] * a.mix_norm[l * D + k]; a.wga_t[l][r] = (bf16_t)(cvt_pk_bf16(v, 0.f) & 0xffffu); }
    u64* ss0 = (u64*)(a.ctl + CW_SS);
    for (int i = bid * NTHR + tid; i < 4 * T; i += G * NTHR) ss0[T + i] = 0ull;
    {
        f32x4 xv[16];
        if (gw < T) { const f32x4* xr = (const f32x4*)(a.x + (size_t)gw * D) + lane;
#pragma unroll
            for (int j = 0; j < 16; ++j) xv[j] = MK_NTLD(xr + 64 * j); }
#pragma unroll 1
        for (int m = gw; m < T; m += NGW) { u32x2* o8 = (u32x2*)(a.xb + (size_t)m * D) + lane; float s = 0.f; u32x2 w[16];
#pragma unroll
            for (int j = 0; j < 16; ++j) { const f32x4 v = xv[j]; s += (v[0] * v[0] + v[1] * v[1]) + (v[2] * v[2] + v[3] * v[3]); w[j].x = cvt_pk_bf16(v[0], v[1]); w[j].y = cvt_pk_bf16(v[2], v[3]); }
            if (m + NGW < T) { const f32x4* xr = (const f32x4*)(a.x + (size_t)(m + NGW) * D) + lane;
#pragma unroll
                for (int j = 0; j < 16; ++j) xv[j] = MK_NTLD(xr + 64 * j); }
#pragma unroll
            for (int j = 0; j < 16; ++j) { if (MK_XB_WT) __builtin_amdgcn_raw_buffer_store_b64(w[j], __builtin_amdgcn_make_buffer_rsrc((void*)a.xb, 0, 0x7ffffff0, 0x00020000), (unsigned)(((size_t)m * D + 4 * (lane + 64 * j)) * 2), 0, 16); else o8[64 * j] = w[j]; }
            s = wave_sum(s); if (lane == 0) ss0[m] = ss_fix(s); }
    }
}

template <class AT> __device__ __forceinline__ void ga_stage(const AT& a, int l, const u64* ss, LAS unsigned char* lds, int tid, int lane, int wave, int bid, int G) {
    LAS float* red = (LAS float*)lds;
    for (int tb = bid; tb < T / 32; tb += G) {
        f32x4 acc[2] = {(f32x4){0.f, 0.f, 0.f, 0.f}, (f32x4){0.f, 0.f, 0.f, 0.f}};
        const bf16_t* xa = a.xb + (size_t)(tb * 32 + (lane & 15)) * D + wave * 512 + 8 * (lane >> 4);
        const bf16_t* wb = a.wga_t[l] + (size_t)(lane & 15) * D + wave * 512 + 8 * (lane >> 4);
#pragma unroll 8
        for (int ks = 0; ks < 16; ++ks) { const bf16x8 b = *(const bf16x8*)(wb + 32 * ks);
            const bf16x8 a0 = *(const bf16x8*)(xa + 32 * ks), a1 = *(const bf16x8*)(xa + (size_t)16 * D + 32 * ks);
            acc[0] = __builtin_amdgcn_mfma_f32_16x16x32_bf16(a0, b, acc[0], 0, 0, 0); acc[1] = __builtin_amdgcn_mfma_f32_16x16x32_bf16(a1, b, acc[1], 0, 0, 0); }
        *(LAS f32x4*)(red + ((wave * 2 + 0) * 64 + lane) * 4) = acc[0]; *(LAS f32x4*)(red + ((wave * 2 + 1) * 64 + lane) * 4) = acc[1];
        __syncthreads();
        { const int mt = tid >> 8, ln = (tid >> 2) & 63, rg = tid & 3; float s = 0.f;
#pragma unroll
          for (int w = 0; w < 8; ++w) s += red[((w * 2 + mt) * 64 + ln) * 4 + rg];
          const int tok = tb * 32 + 16 * mt + (ln >> 4) * 4 + rg, j = ln & 15;
          a.ga[(size_t)tok * 16 + j] = s * rs_of(ss[tok]); }
        __syncthreads();
    }
}

__device__ __forceinline__ void gate_octet(float (&z)[8][8], const LAS float* gal, const LAS float* wl, const f32x4 b0, const f32x4 b1, int co, int tg) {
#pragma unroll
    for (int e = 0; e < 8; ++e) { z[e][0] = b0[0]; z[e][1] = b0[1]; z[e][2] = b0[2]; z[e][3] = b0[3]; z[e][4] = b1[0]; z[e][5] = b1[1]; z[e][6] = b1[2]; z[e][7] = b1[3]; }
#pragma unroll 2
    for (int r = 0; r < 16; ++r) { const f32x4 w0 = *(const LAS f32x4*)(wl + r * 256 + 8 * co), w1 = *(const LAS f32x4*)(wl + r * 256 + 8 * co + 4);
#pragma unroll
        for (int e = 0; e < 8; ++e) { const float g = gal[(8 * tg + e) * 16 + r];
            z[e][0] = fmaf(g, w0[0], z[e][0]); z[e][1] = fmaf(g, w0[1], z[e][1]); z[e][2] = fmaf(g, w0[2], z[e][2]); z[e][3] = fmaf(g, w0[3], z[e][3]);
            z[e][4] = fmaf(g, w1[0], z[e][4]); z[e][5] = fmaf(g, w1[1], z[e][5]); z[e][6] = fmaf(g, w1[2], z[e][6]); z[e][7] = fmaf(g, w1[3], z[e][7]); } }
#pragma unroll
    for (int j = 0; j < 8; ++j) { float run = 0.f;
#pragma unroll
        for (int e = 0; e < 8; ++e) { const float zz = z[e][j]; run += (fminf(zz, 0.f) - 0.69314718f * __builtin_amdgcn_logf(1.0f + __builtin_amdgcn_exp2f(-1.44269504f * fabsf(zz)))) * 0.0625f; z[e][j] = run; }
        if (j & 1) __builtin_amdgcn_sched_barrier(0); }
}
template <class AT> __device__ __forceinline__ void prep_phase(const AT& a, int l, LAS unsigned char* lds, int tid, int lane, int wave, int bid, int G) {
    LAS float* galA = (LAS float*)lds;
    LAS float* galB = (LAS float*)(lds + 8192);
    LAS float* tot = (LAS float*)(lds + 16384);
    LAS float* wl = (LAS float*)(lds + 32768);
    const float* wup = a.gla_w_up + (size_t)l * 16 * 1024; const float* gb = a.gla_b + l * 1024;
    for (int u = bid; u < 256; u += G) { const int h = u >> 6, c = u & 63, t0 = c * 128;
        u32x4 qin[8], kin[8]; f32x4 b0, b1;
        {
            int tz = tid; asm volatile("" : "+v"(tz)); const int co = tz & 31, tg = tz >> 5, ch = h * 256 + 8 * co;
            const unsigned rowoff = (unsigned)(((t0 + 8 * tg) * 1024 + ch) * 2);
            const f32x4 gB = *(const f32x4*)((const char*)(a.ga + (size_t)t0 * 16) + (unsigned)(tz * 16));
            f32x4 gA = (f32x4){0.f, 0.f, 0.f, 0.f}; if (c & 1) gA = *(const f32x4*)((const char*)(a.ga + (size_t)(t0 - 128) * 16) + (unsigned)(tz * 16));
            const unsigned wo = (unsigned)(((tz >> 6) * 1024 + 4 * (tz & 63)) * 4);
            const f32x4 wv0 = *(const f32x4*)((const char*)(wup + h * 256) + wo), wv1 = *(const f32x4*)((const char*)(wup + h * 256 + 8 * 1024) + wo);
            b0 = *(const f32x4*)((const char*)(gb + h * 256) + (unsigned)(co * 32)); b1 = *(const f32x4*)((const char*)(gb + h * 256 + 4) + (unsigned)(co * 32));
#pragma unroll
            for (int e = 0; e < 8; ++e) { qin[e] = MK_NTLD((const u32x4*)((const char*)a.gq + (rowoff + (unsigned)(e * 2048)))); kin[e] = MK_NTLD((const u32x4*)((const char*)a.gk + (rowoff + (unsigned)(e * 2048)))); }
            *(LAS f32x4*)(galB + tz * 4) = gB; *(LAS f32x4*)(galA + tz * 4) = gA;
            *(LAS f32x4*)(wl + (tz >> 6) * 256 + 4 * (tz & 63)) = wv0; *(LAS f32x4*)(wl + (8 + (tz >> 6)) * 256 + 4 * (tz & 63)) = wv1;
        }
        __syncthreads();
        int tz2 = tid; asm volatile("" : "+v"(tz2)); const int co = tz2 & 31, tg = tz2 >> 5, ch = h * 256 + 8 * co;
        const unsigned rowoff = (unsigned)(((t0 + 8 * tg) * 1024 + ch) * 2);
        float z[8][8]; float base[8];
#pragma unroll
        for (int j = 0; j < 8; ++j) base[j] = 0.f;
        if (c & 1) {
            gate_octet(z, galA, wl, b0, b1, co, tg);
#pragma unroll
            for (int j = 0; j < 8; ++j) tot[tg * 256 + 8 * co + j] = z[7][j];
            __syncthreads();
            for (int g2 = 0; g2 < 16; ++g2) { const f32x4 t0v = *(const LAS f32x4*)(tot + g2 * 256 + 8 * co), t1v = *(const LAS f32x4*)(tot + g2 * 256 + 8 * co + 4);
                base[0] += t0v[0]; base[1] += t0v[1]; base[2] += t0v[2]; base[3] += t0v[3]; base[4] += t1v[0]; base[5] += t1v[1]; base[6] += t1v[2]; base[7] += t1v[3]; }
            __syncthreads();
        }
        gate_octet(z, galB, wl, b0, b1, co, tg);
#pragma unroll
        for (int j = 0; j < 8; ++j) tot[tg * 256 + 8 * co + j] = z[7][j];
        __syncthreads();
        float off[8];
#pragma unroll
        for (int j = 0; j < 8; ++j) off[j] = base[j];
        for (int g2 = 0; g2 < tg; ++g2) { const f32x4 t0v = *(const LAS f32x4*)(tot + g2 * 256 + 8 * co), t1v = *(const LAS f32x4*)(tot + g2 * 256 + 8 * co + 4);
            off[0] += t0v[0]; off[1] += t0v[1]; off[2] += t0v[2]; off[3] += t0v[3]; off[4] += t1v[0]; off[5] += t1v[1]; off[6] += t1v[2]; off[7] += t1v[3]; }
#pragma unroll
        for (int e = 0; e < 8; ++e) { float qv[8], kv[8];
            const unsigned qw[4] = {qin[e].x, qin[e].y, qin[e].z, qin[e].w}, kw[4] = {kin[e].x, kin[e].y, kin[e].z, kin[e].w};
#pragma unroll
            for (int j = 0; j < 8; ++j) { const float cum = z[e][j] + off[j]; const float eq = __builtin_amdgcn_exp2f(1.44269504f * cum), ek = __builtin_amdgcn_rcpf(eq);
                const float qf = (j & 1) ? bf_hi(qw[j >> 1]) : bf_lo(qw[j >> 1]), kf = (j & 1) ? bf_hi(kw[j >> 1]) : bf_lo(kw[j >> 1]); qv[j] = qf * eq; kv[j] = kf * ek; }
            u32x4 qo, ko; qo.x = cvt_pk_bf16(qv[0], qv[1]); qo.y = cvt_pk_bf16(qv[2], qv[3]); qo.z = cvt_pk_bf16(qv[4], qv[5]); qo.w = cvt_pk_bf16(qv[6], qv[7]);
            ko.x = cvt_pk_bf16(kv[0], kv[1]); ko.y = cvt_pk_bf16(kv[2], kv[3]); ko.z = cvt_pk_bf16(kv[4], kv[5]); ko.w = cvt_pk_bf16(kv[6], kv[7]);
            if (MK_MIX_WT) { __builtin_amdgcn_raw_buffer_store_b128(qo, __builtin_amdgcn_make_buffer_rsrc((void*)a.qg, 0, 0x7ffffff0, 0x00020000), rowoff + (unsigned)(e * 2048), 0, 16); __builtin_amdgcn_raw_buffer_store_b128(ko, __builtin_amdgcn_make_buffer_rsrc((void*)a.kg, 0, 0x7ffffff0, 0x00020000), rowoff + (unsigned)(e * 2048), 0, 16); }
            else { *(u32x4*)((char*)a.qg + (rowoff + (unsigned)(e * 2048))) = qo; *(u32x4*)((char*)a.kg + (rowoff + (unsigned)(e * 2048))) = ko; }
            __builtin_amdgcn_sched_barrier(0); }
        if ((c & 1) && tg == 15) {
#pragma unroll
            for (int j = 0; j < 8; ++j) a.lam[(c >> 1) * 1024 + ch + j] = __builtin_amdgcn_exp2f(1.44269504f * (z[7][j] + off[j])); }
        __syncthreads();
    }
}

template <class AT> __device__ __forceinline__ void m1_phase(const AT& a, LAS unsigned char* lds, int tid, int wave, int bid, int G) {
    const int nsu = bid < 512 ? (512 - bid + G - 1) / G : 0, npass = 4 * nsu;
    if (npass == 0) return;
    f32x4 acc[8][4];
#pragma unroll
    for (int i = 0; i < 8; ++i)
#pragma unroll
        for (int j = 0; j < 4; ++j) acc[i][j] = (f32x4){0.f, 0.f, 0.f, 0.f};
    u32x2 w[8];
#define M1_DECODE(p_) const int su_ = bid + ((p_) >> 2) * G; const bf16_t *Ks, *Vt; int ldk, c2; \
        if (su_ < 256) { const int h = su_ >> 5; c2 = su_ & 31; Ks = a.kr + h * 256; ldk = 2048; Vt = MK_VT_BLK ? a.vrt + ((size_t)c2 * 2048 + h * 256) * 256 : a.vrt + (size_t)(h * 256) * T; } \
        else { const int s_ = su_ - 256, vh = (s_ >> 3) & 1, ix_ = (s_ & 7) | ((s_ >> 4) << 3), h = ix_ >> 5; c2 = ix_ & 31;     Ks = a.kg + h * 256; ldk = 1024; Vt = MK_VT_BLK ? a.vgt + ((size_t)c2 * 2048 + h * 512 + vh * 256) * 256 : a.vgt + (size_t)(h * 512 + vh * 256) * T; } \
        const int tk = c2 * 256 + ((p_) & 3) * 64
#define M1_ISSUE(p_, half_) do { M1_DECODE(p_); int tz = tid; asm volatile("" : "+v"(tz)); \
        { const int ln = tz & 63; const char* vbase = (const char*)(Vt + (MK_VT_BLK ? ((p_) & 3) * 64 : tk)); \
          _Pragma("unroll") for (int i = 0; i < 4; ++i) { const int r = 32 * wave + 8 * i + (ln >> 3), c = (ln & 7) ^ (4 * (i & 1) + (ln >> 4)); \
            __builtin_amdgcn_global_load_lds((const unsigned*)(vbase + (unsigned)((r * (MK_VT_BLK ? 256 : T) + c * 8) * 2)), (LAS unsigned*)(lds + 65536 + (half_) * 32768 + (4 * wave + i) * 1024), 16, 0, MK_M1_VNT ? 2 : 0); } } \
        { const int dq = tz & 63, q = tz >> 6; const char* kbase = (const char*)(Ks + (size_t)tk * ldk); const unsigned kof = (unsigned)((8 * q * ldk + 4 * dq) * 2); \
          _Pragma("unroll") for (int i = 0; i < 8; ++i) w[i] = *(const u32x2*)(kbase + (kof + (unsigned)(i * ldk * 2))); } } while (0)
#define M1_KEL(i_) ((dd & 2) ? ((dd & 1) ? (w[i_].y >> 16) : (w[i_].y & 0xffffu)) : ((dd & 1) ? (w[i_].x >> 16) : (w[i_].x & 0xffffu)))
#define M1_STASH(half_) do { int tz = tid; asm volatile("" : "+v"(tz)); \
        { const int dq = tz & 63, q = tz >> 6; _Pragma("unroll") for (int dd = 0; dd < 4; ++dd) { u32x4 o; \
            o.x = M1_KEL(0) | (M1_KEL(1) << 16); o.y = M1_KEL(2) | (M1_KEL(3) << 16); o.z = M1_KEL(4) | (M1_KEL(5) << 16); o.w = M1_KEL(6) | (M1_KEL(7) << 16); \
            const int d = 4 * dq + dd, r = (d & ~31) + 16 * ((d >> 2) & 1) + 4 * ((d >> 3) & 3) + (d & 3); \
            *(LAS u32x4*)(lds + r * 256 + (((8 * (half_) + q) ^ (r & 15)) << 4)) = o; } } \
        asm volatile("s_waitcnt vmcnt(0)" ::: "memory"); } while (0)
#define M1_COMPUTE(half_) do { int tz = tid; asm volatile("" : "+v"(tz)); const int lr = tz & 15, lq = (tz & 63) >> 4, wd = wave & 1, wv = wave >> 1; \
        LAS unsigned char* kb = lds + (128 * wd + lr) * 256 + (((lq ^ lr) & 3) << 4); LAS unsigned char* vb = lds + 65536 + (half_) * 32768 + (64 * wv + lr) * 128; \
        _Pragma("unroll") for (int kk = 0; kk < 2; ++kk) { const int o = ((2 * (half_) + kk) ^ (lr >> 2)) << 6, ov = ((4 * kk + lq) ^ (lr >> 1)) << 4; bf16x8 Y[4]; \
            _Pragma("unroll") for (int j = 0; j < 4; ++j) Y[j] = *(const LAS bf16x8*)(vb + ov + j * 2048); \
            _Pragma("unroll") for (int ih = 0; ih < 2; ++ih) { bf16x8 X[4]; \
                _Pragma("unroll") for (int i = 0; i < 4; ++i) X[i] = *(const LAS bf16x8*)(kb + o + (4 * ih + i) * 4096); \
                _Pragma("unroll") for (int i = 0; i < 4; ++i) { _Pragma("unroll") for (int j = 0; j < 4; ++j) acc[4 * ih + i][j] = __builtin_amdgcn_mfma_f32_16x16x32_bf16(X[i], Y[j], acc[4 * ih + i][j], 0, 0, 0); } \
                asm volatile("" ::: "memory"); } } } while (0)
    M1_ISSUE(0, 0); M1_STASH(0);
    __syncthreads();
#pragma unroll 1
    for (int p = 0; p < npass; p += 2) {
        M1_ISSUE(p + 1, 1);
        M1_COMPUTE(0);
        M1_STASH(1);
        __syncthreads();
        const bool more = p + 2 < npass;
        if (more) M1_ISSUE(p + 2, 0);
        M1_COMPUTE(1);
        if (more) M1_STASH(0);
        if ((p & 3) == 2) {
            const int su = bid + (p >> 2) * G; bf16_t* out;
            if (su < 256) { const int h = su >> 5, c2 = su & 31; out = a.kvr + (size_t)(h * 32 + c2) * 65536; }
            else { const int s_ = su - 256, vh = (s_ >> 3) & 1, ix_ = (s_ & 7) | ((s_ >> 4) << 3), h = ix_ >> 5, c2 = ix_ & 31; out = a.kvg + (size_t)(h * 32 + c2) * 131072 + (size_t)vh * 65536; }
            int tz = tid; asm volatile("" : "+v"(tz)); const int lr = tz & 15, lq = (tz & 63) >> 4, wd = wave & 1, wv = wave >> 1;
            bf16_t* op = out + (size_t)((64 * wv + lr) * 256 + 128 * wd + 8 * lq); const auto ors = __builtin_amdgcn_make_buffer_rsrc((void*)out, 0, 0x7ffffff0, 0x00020000); const unsigned oo = (unsigned)(((64 * wv + lr) * 256 + 128 * wd + 8 * lq) * 2); (void)op;
#pragma unroll
            for (int i2 = 0; i2 < 4; ++i2)
#pragma unroll
                for (int j = 0; j < 4; ++j) { u32x4 w4; w4.x = cvt_pk_bf16(acc[2 * i2][j][0], acc[2 * i2][j][1]); w4.y = cvt_pk_bf16(acc[2 * i2][j][2], acc[2 * i2][j][3]);
                    w4.z = cvt_pk_bf16(acc[2 * i2 + 1][j][0], acc[2 * i2 + 1][j][1]); w4.w = cvt_pk_bf16(acc[2 * i2 + 1][j][2], acc[2 * i2 + 1][j][3]); if (MK_MIX_WT) __builtin_amdgcn_raw_buffer_store_b128(w4, ors, oo + (unsigned)(((16 * j) * 256 + 32 * i2) * 2), 0, 16); else *(u32x4*)(op + (16 * j) * 256 + 32 * i2) = w4; }
#pragma unroll
            for (int i = 0; i < 8; ++i)
#pragma unroll
                for (int j = 0; j < 4; ++j) acc[i][j] = (f32x4){0.f, 0.f, 0.f, 0.f};
        }
        __syncthreads();
    }
#undef M1_DECODE
#undef M1_ISSUE
#undef M1_KEL
#undef M1_STASH
#undef M1_COMPUTE
}
template <class AT> __device__ __forceinline__ void m2_phase(const AT& a, int tid, int bid, int G) {
    for (int blk = bid; blk < 256; blk += G) { const int vec = blk * NTHR + tid;
        bf16_t* base; size_t cstride; const float* lamp = nullptr; float lsc = 0.f;
        if (vec < 65536) { const int h = vec >> 13, rem = vec & 8191; base = a.kvr + (size_t)(h * 32) * 65536 + (size_t)rem * 8; cstride = 65536; lsc = exp2f(256.0f * log2f(1.0f - exp2f(-5.0f - (float)h))); }
        else { const int v2 = vec - 65536, h = v2 >> 14, rem = v2 & 16383; base = a.kvg + (size_t)(h * 32) * 131072 + (size_t)rem * 8; cstride = 131072; lamp = a.lam + h * 256 + 8 * (rem & 31); }
        const auto srs = __builtin_amdgcn_make_buffer_rsrc((void*)(blk < 128 ? a.kvr + (size_t)((blk >> 4) * 32) * 65536 : a.kvg + (size_t)(((blk - 128) >> 5) * 32) * 131072), 0, 0x7ffffff0, 0x00020000);
        const unsigned soff = (unsigned)((blk < 128 ? (vec & 8191) : ((vec - 65536) & 16383)) * 16), sstep = (unsigned)(blk < 128 ? 65536 * 2 : 131072 * 2);
        float st[8]; float z0 = 0.f; asm volatile("" : "+v"(z0));
#pragma unroll
        for (int e = 0; e < 8; ++e) st[e] = z0;
        u32x4 kv[2][4]; f32x4 l0[2][4], l1[2][4];
#define M2_LOAD(B, c0_) do { _Pragma("unroll") for (int j = 0; j < 4; ++j) kv[B][j] = MK_NTLD((const u32x4*)(base + (size_t)((c0_) + j) * cstride)); \
            if (lamp) { _Pragma("unroll") for (int j = 0; j < 4; ++j) { l0[B][j] = *(const f32x4*)(lamp + ((c0_) + j) * 1024); l1[B][j] = *(const f32x4*)(lamp + ((c0_) + j) * 1024 + 4); } } \
            else { _Pragma("unroll") for (int j = 0; j < 4; ++j) { l0[B][j] = (f32x4){lsc, lsc, lsc, lsc}; l1[B][j] = l0[B][j]; } } } while (0)
        M2_LOAD(0, 0);
#pragma unroll
        for (int b = 0; b < 8; ++b) { const int c0 = 4 * b, B = b & 1;
            if (b < 7) M2_LOAD((b + 1) & 1, c0 + 4);
#pragma unroll
            for (int j = 0; j < 4; ++j) {
                u32x4 o; o.x = cvt_pk_bf16(st[0], st[1]); o.y = cvt_pk_bf16(st[2], st[3]); o.z = cvt_pk_bf16(st[4], st[5]); o.w = cvt_pk_bf16(st[6], st[7]); if (MK_M2_WT) __builtin_amdgcn_raw_buffer_store_b128(o, srs, soff + (unsigned)(c0 + j) * sstep, 0, 16); else *(u32x4*)(base + (size_t)(c0 + j) * cstride) = o;
                st[0] = l0[B][j][0] * (st[0] + bf_lo(kv[B][j].x)); st[1] = l0[B][j][1] * (st[1] + bf_hi(kv[B][j].x)); st[2] = l0[B][j][2] * (st[2] + bf_lo(kv[B][j].y)); st[3] = l0[B][j][3] * (st[3] + bf_hi(kv[B][j].y));
                st[4] = l1[B][j][0] * (st[4] + bf_lo(kv[B][j].z)); st[5] = l1[B][j][1] * (st[5] + bf_hi(kv[B][j].z)); st[6] = l1[B][j][2] * (st[6] + bf_lo(kv[B][j].w)); st[7] = l1[B][j][3] * (st[7] + bf_hi(kv[B][j].w)); }
            asm volatile("" ::: "memory");
        }
#undef M2_LOAD
    }
}

#define M3_LANE() int tz_ = tid; asm volatile("" : "+v"(tz_)); const int lr = tz_ & 15, lq = (tz_ & 63) >> 4; (void)lr; (void)lq
#define M3_BASES() LAS unsigned char* qb4[4]; LAS unsigned char* pb4[4]; _Pragma("unroll") for (int b = 0; b < 4; ++b) { const int o_ = ((b ^ (lr >> 2)) << 6) + (((lq ^ lr) & 3) << 4); qb4[b] = QL + lr * 512 + o_; }
#define M3_PBASES() do { int tp_ = tid; asm volatile("" : "+v"(tp_)); const int lr_ = tp_ & 15, lq_ = (tp_ & 63) >> 4; _Pragma("unroll") for (int b = 0; b < 4; ++b) pb4[b] = PL + lr_ * 512 + (((b ^ (lr_ >> 2)) << 6) + (((lq_ ^ lr_) & 3) << 4)); } while (0)
#define QFRAG(rt, ks) (*(const LAS bf16x8*)(qb4[(ks) & 3] + (rt) * 8192 + ((ks) >> 2) * 256))
#define PFRAG(rt, ks) (*(const LAS bf16x8*)(pb4[(ks) & 3] + (rt) * 8192 + ((ks) >> 2) * 256))
struct M3Pend { u32x4 w[2][8]; bf16_t* mixed; int t0; int lpr; };
__device__ __forceinline__ void m3_flush(M3Pend& pd, int tid, int wave) {
    if (pd.lpr) {
        int tf_ = tid; asm volatile("" : "+v"(tf_)); const int ln = tf_ & 63, sh = (pd.lpr == 64) ? 6 : 5, rpi = 64 >> sh, ni = 8 >> (6 - sh), rsub = ln >> sh, c8 = ln & (pd.lpr - 1);
        const auto rs = __builtin_amdgcn_make_buffer_rsrc((void*)pd.mixed, 0, 0x7ffffff0, 0x00020000);
#pragma unroll
        for (int pass = 0; pass < 2; ++pass)
#pragma unroll
            for (int i = 0; i < 8; ++i) if (i < ni) { const int rl = wave * 8 + i * rpi + rsub;
                __builtin_amdgcn_raw_buffer_store_b128(pd.w[pass][i], rs, (unsigned)(((pd.t0 + 64 * pass + rl) * 4096 + 8 * c8) * 2), 0, MK_M3_WT ? 16 : 0); }
        pd.lpr = 0;
    }
}
template <int CT, bool LNORM, int NB, int RD, bool INPEND>
__device__ __forceinline__ void m3_unit(LAS unsigned char* lds, const bf16_t* Q, int ldq, const bf16_t* Kk, const bf16_t* VT, const bf16_t* ST, const bf16_t* gate, const float* gain, bf16_t* mixed, int t0, int tk0, int tid, int wave, M3Pend& pend, int probe = 0) {
    constexpr int DV = CT * 128, NP = 4 * NB;
    LAS unsigned char* QL = lds; LAS unsigned char* PL = lds + 65536; LAS f32x2* STATS = (LAS f32x2*)(lds + 131072);
    const int vb = wave * 16 * CT;
    bf16x8 ring[RD][CT];
#define M3_LOADV(ks, R) do { _Pragma("unroll") for (int ct = 0; ct < CT; ++ct) R[ct] = *(const bf16x8*)(VT + (MK_VT_BLK ? 0 : tk0) + (vo + (unsigned)((16 * ct) * (MK_VT_BLK ? 256 : T) + 32 * (ks)))); } while (0)
#define M3_LOADS(ks, R) do { _Pragma("unroll") for (int ct = 0; ct < CT; ++ct) R[ct] = *(const bf16x8*)(ST + (so + (unsigned)((16 * ct) * 256 + 32 * (ks)))); } while (0)
#define M3_LOADSTEP(k, R) do { if ((k) < 8) M3_LOADS((k), R); else if ((k) < NP + 8) M3_LOADV((k) - 8, R); } while (0)
    {
        M3_LANE(); M3_BASES();
#pragma unroll
        for (int i = 0; i < 8; ++i) { const int idx = tz_ + 512 * i, row = idx >> 5, ch = idx & 31;
            const u32x4 v = *(const u32x4*)(Q + (size_t)(t0 + row) * ldq + ch * 8); *(LAS u32x4*)(QL + row * 512 + ((ch ^ (row & 15)) << 4)) = v; }
        bf16x8 Kf[NB][8];
#pragma unroll
        for (int kb = 0; kb < NB; ++kb)
#pragma unroll
            for (int ks = 0; ks < 8; ++ks) Kf[kb][ks] = *(const bf16x8*)(Kk + (size_t)(tk0 + 128 * kb + 16 * wave + lr) * ldq + 32 * ks + 8 * lq);
        if constexpr (INPEND) { if (MK_M3_DEFER == 1) m3_flush(pend, tid, wave); }
        { const unsigned vo = (unsigned)((vb + lr) * (MK_VT_BLK ? 256 : T) + 8 * lq), so = (unsigned)((vb + lr) * 256 + 8 * lq);
#pragma unroll
            for (int j = 0; j < RD - 1; ++j) M3_LOADSTEP(j, ring[j]); }
        __syncthreads();
#pragma unroll
        for (int kb = 0; kb < NB; ++kb) { const bool diag = (kb == NB - 1);
#pragma unroll
            for (int rt = 0; rt < 8; ++rt) { f32x4 p = (f32x4){0.f, 0.f, 0.f, 0.f};
                if (!diag || rt >= wave) {
#pragma unroll
                    for (int ks = 0; ks < 8; ++ks) { const bf16x8 qf = QFRAG(rt, ks); p = __builtin_amdgcn_mfma_f32_16x16x32_bf16(Kf[kb][ks], qf, p, 0, 0, 0); }
                    if (diag && rt == wave) {
#pragma unroll
                        for (int r = 0; r < 4; ++r) if (4 * lq + r > lr) p[r] = 0.f; } }
                u32x2 w; w.x = cvt_pk_bf16(p[0], p[1]); w.y = cvt_pk_bf16(p[2], p[3]);
                *(LAS u32x2*)(PL + (16 * rt + lr) * 512 + ((((16 * kb + 2 * wave + (lq >> 1)) ^ lr) << 4) + ((lq & 1) << 3))) = w; } }
        __syncthreads();
    }
#if MK_M3_EPI == 2
    constexpr int LPR_ = DV / 8, RPI_ = 64 / LPR_, NI_ = 8 / RPI_; constexpr bool GEARLY = MK_M3_GEARLY && CT == 2;
    u32x4 gvE0[NI_], gvE1[NI_];
    if constexpr (GEARLY) { int tg_ = tid; asm volatile("" : "+v"(tg_)); const int ln_ = tg_ & 63;
#pragma unroll
        for (int i = 0; i < NI_; ++i) { const int rl = wave * 8 + i * RPI_ + ln_ / LPR_;
            gvE0[i] = *(const u32x4*)(gate + ((unsigned)((t0 + rl) * 2048 + 8 * (ln_ % LPR_)))); gvE1[i] = *(const u32x4*)(gate + ((unsigned)((t0 + 64 + rl) * 2048 + 8 * (ln_ % LPR_)))); } }
#endif
    f32x4 acc[8][CT];
#pragma unroll
    for (int rt = 0; rt < 8; ++rt)
#pragma unroll
        for (int ct = 0; ct < CT; ++ct) acc[rt][ct] = (f32x4){0.f, 0.f, 0.f, 0.f};
    {
        M3_LANE(); M3_BASES();
        const unsigned vo = (unsigned)((vb + lr) * (MK_VT_BLK ? 256 : T) + 8 * lq), so = (unsigned)((vb + lr) * 256 + 8 * lq);
        unsigned pboff = 0; int prpi = 0, pni = 0;
        const auto prs = __builtin_amdgcn_make_buffer_rsrc((void*)pend.mixed, 0, 0x7ffffff0, 0x00020000);
        if constexpr (INPEND) { if (MK_M3_DEFER == 2 && pend.lpr) { const int ln_ = tz_ & 63, sh_ = (pend.lpr == 64) ? 6 : 5; prpi = 64 >> sh_; pni = 8 >> (6 - sh_);
            pboff = (unsigned)(((pend.t0 + wave * 8 + (ln_ >> sh_)) * 4096 + 8 * (ln_ & (pend.lpr - 1))) * 2); } }
#define M3_PFLUSH(k) do { if constexpr (INPEND) { if (MK_M3_DEFER == 2 && ((k) & 7) < pni) __builtin_amdgcn_raw_buffer_store_b128(pend.w[(k) >> 3][(k) & 7], prs, pboff + (unsigned)((64 * ((k) >> 3) + ((k) & 7) * prpi) * 8192), 0, MK_M3_WT ? 16 : 0); } } while (0)
#define M3_MMA(R, FRAG) do { _Pragma("unroll") for (int rt = 0; rt < 8; ++rt) { const bf16x8 bfr = FRAG; \
            _Pragma("unroll") for (int ct = 0; ct < CT; ++ct) acc[rt][ct] = __builtin_amdgcn_mfma_f32_16x16x32_bf16(R[ct], bfr, acc[rt][ct], 0, 0, 0); } asm volatile("" ::: "memory"); } while (0)
#define M3_NEXT(k) do { if (!(MK_M3_PROBE >= 2 && probe)) M3_LOADSTEP((k) + RD - 1, ring[((k) + RD - 1) % RD]); } while (0)
#define M3_STEP(k) do { M3_PFLUSH(k); if ((k) < NP + 8) { if ((k) == 8) M3_PBASES(); M3_NEXT(k); if ((k) < 8) M3_MMA(ring[(k) % RD], QFRAG(rt, (k) & 7)); else M3_MMA(ring[(k) % RD], PFRAG(rt, ((k) - 8) & 7)); } } while (0)
        M3_STEP(0); M3_STEP(1); M3_STEP(2); M3_STEP(3); M3_STEP(4); M3_STEP(5); M3_STEP(6); M3_STEP(7);
        M3_STEP(8); M3_STEP(9); M3_STEP(10); M3_STEP(11); M3_STEP(12); M3_STEP(13); M3_STEP(14); M3_STEP(15);
        if constexpr (INPEND) { if (MK_M3_DEFER == 2) pend.lpr = 0; }
#undef M3_STEP
#undef M3_NEXT
#undef M3_MMA
#undef M3_PFLUSH
    }
#if MK_M3_EPI == 0
    {
        M3_LANE();
#pragma unroll
        for (int rt = 0; rt < 8; ++rt) { float s1 = 0.f, s2 = 0.f;
#pragma unroll
            for (int ct = 0; ct < CT; ++ct)
#pragma unroll
                for (int r = 0; r < 4; ++r) { const float x = acc[rt][ct][r]; s1 += x; s2 += x * x; }
            s1 += __shfl_xor(s1, 16); s1 += __shfl_xor(s1, 32); s2 += __shfl_xor(s2, 16); s2 += __shfl_xor(s2, 32);
            if (lq == 0) STATS[(16 * rt + lr) * 8 + wave] = (f32x2){s1, s2}; }
        __syncthreads();
    }
#pragma unroll
    for (int rt = 0; rt < 8; ++rt) { M3_LANE(); const int row = 16 * rt + lr;
        float s1 = 0.f, s2 = 0.f;
#pragma unroll
        for (int w = 0; w < 8; ++w) { const f32x2 s = STATS[row * 8 + w]; s1 += s[0]; s2 += s[1]; }
        const float mean = LNORM ? s1 * (1.0f / DV) : 0.f; const float var = s2 * (1.0f / DV) - mean * mean; const float rstd = 1.0f / sqrtf(var + 1e-6f);
        const size_t to = (size_t)(t0 + row);
#pragma unroll
        for (int ct = 0; ct < CT; ++ct) { const int col = vb + 16 * ct + 4 * lq; const u32x2 g = *(const u32x2*)(gate + to * 2048 + col);
            const f32x4 x = acc[rt][ct]; u32x2 w;
            w.x = cvt_pk_bf16((x[0] - mean) * rstd * bf_lo(g.x), (x[1] - mean) * rstd * bf_hi(g.x));
            w.y = cvt_pk_bf16((x[2] - mean) * rstd * bf_lo(g.y), (x[3] - mean) * rstd * bf_hi(g.y));
            *(u32x2*)(mixed + to * 4096 + col) = w; }
        asm volatile("" ::: "memory"); }
#elif MK_M3_EPI == 1
    {
        M3_LANE();
        const unsigned go = (unsigned)((t0 + lr) * 2048 + vb + 4 * lq), mo = (unsigned)((t0 + lr) * 4096 + vb + 4 * lq);
        u32x2 g0[4][CT], g1[4][CT];
#define M3_GLOAD(G, HB) do { _Pragma("unroll") for (int r4 = 0; r4 < 4; ++r4) { _Pragma("unroll") for (int ct = 0; ct < CT; ++ct) G[r4][ct] = (MK_M3_PROBE && probe) ? (u32x2){0x3f803f80u, 0x3f803f80u} : *(const u32x2*)(gate + (go + (unsigned)((16 * (4 * (HB) + r4)) * 2048 + 16 * ct))); } } while (0)
#define M3_GFOLD(G, HB) do { _Pragma("unroll") for (int r4 = 0; r4 < 4; ++r4) { _Pragma("unroll") for (int ct = 0; ct < CT; ++ct) { f32x4& x = acc[4 * (HB) + r4][ct]; \
            x[0] *= bf_lo(G[r4][ct].x); x[1] *= bf_hi(G[r4][ct].x); x[2] *= bf_lo(G[r4][ct].y); x[3] *= bf_hi(G[r4][ct].y); } } } while (0)
#define M3_ROWS(G, HB) do { _Pragma("unroll") for (int r4 = 0; r4 < 4; ++r4) { const int rt = 4 * (HB) + r4, row = 16 * rt + lr; float s1 = 0.f, s2 = 0.f; \
            _Pragma("unroll") for (int w = 0; w < 8; ++w) { const f32x2 s = STATS[row * 8 + w]; s1 += s[0]; s2 += s[1]; } \
            const float mean = LNORM ? s1 * (1.0f / DV) : 0.f; const float var = s2 * (1.0f / DV) - mean * mean; const float rstd = 1.0f / sqrtf(var + 1e-6f); \
            _Pragma("unroll") for (int ct = 0; ct < CT; ++ct) { const f32x4 x = acc[rt][ct]; u32x2 w; \
                if (LNORM) { w.x = cvt_pk_bf16((x[0] - mean) * rstd * bf_lo(G[r4][ct].x), (x[1] - mean) * rstd * bf_hi(G[r4][ct].x)); w.y = cvt_pk_bf16((x[2] - mean) * rstd * bf_lo(G[r4][ct].y), (x[3] - mean) * rstd * bf_hi(G[r4][ct].y)); } \
                else { w.x = cvt_pk_bf16(x[0] * rstd, x[1] * rstd); w.y = cvt_pk_bf16(x[2] * rstd, x[3] * rstd); } \
                if (!(MK_M3_PROBE && probe)) *(u32x2*)(mixed + (mo + (unsigned)((16 * rt) * 4096 + 16 * ct))) = w; } } } while (0)
        __builtin_amdgcn_sched_barrier(0);
        M3_GLOAD(g0, 0);
#pragma unroll
        for (int rt = 0; rt < 8; ++rt) { float s1 = 0.f, s2 = 0.f;
#pragma unroll
            for (int ct = 0; ct < CT; ++ct)
#pragma unroll
                for (int r = 0; r < 4; ++r) { const float x = acc[rt][ct][r]; s1 += x; s2 += x * x; }
            s1 += __shfl_xor(s1, 16); s1 += __shfl_xor(s1, 32); s2 += __shfl_xor(s2, 16); s2 += __shfl_xor(s2, 32);
            if (lq == 0) STATS[(16 * rt + lr) * 8 + wave] = (f32x2){s1, s2}; }
        asm volatile("" ::: "memory");
        if (!LNORM) M3_GFOLD(g0, 0);
        M3_GLOAD(g1, 1);
        __syncthreads();
        M3_ROWS(g0, 0);
        asm volatile("" ::: "memory");
        if (!LNORM) M3_GFOLD(g1, 1);
        M3_ROWS(g1, 1);
#undef M3_GLOAD
#undef M3_GFOLD
#undef M3_ROWS
    }
#else
    {
        constexpr int LPR = DV / 8, RPI = 64 / LPR, NI = 8 / RPI;
        LAS unsigned char* OT = lds;
        u32x4 gv0[NI], gv1[NI];
        const auto mixrs = __builtin_amdgcn_make_buffer_rsrc((void*)mixed, 0, 0x7ffffff0, 0x00020000);
#define M3_GROWS(G, PASS) do { int tg_ = tid; asm volatile("" : "+v"(tg_)); const int ln_ = tg_ & 63; _Pragma("unroll") for (int i = 0; i < NI; ++i) { const int rl = wave * 8 + i * RPI + ln_ / LPR; \
            G[i] = ((MK_M3_PROBE == 1 || MK_M3_PROBE == 2 || MK_M3_PROBE == 4) && probe) ? (u32x4){0x3f803f80u, 0x3f803f80u, 0x3f803f80u, 0x3f803f80u} : MK_NTLD((const u32x4*)(gate + ((unsigned)((t0 + 64 * (PASS) + rl) * 2048 + 8 * (ln_ % LPR))))); } } while (0)
#define M3_NORM(PASS) do { M3_LANE(); _Pragma("unroll") for (int r4 = 0; r4 < 4; ++r4) { const int rt = 4 * (PASS) + r4, row = 16 * rt + lr; float s1 = 0.f, s2 = 0.f; \
            _Pragma("unroll") for (int w = 0; w < 8; ++w) { const f32x2 sv = STATS[row * 8 + w]; s1 += sv[0]; s2 += sv[1]; } \
            const float mean = LNORM ? s1 * (1.0f / DV) : 0.f; const float var = s2 * (1.0f / DV) - mean * mean; const float rstd = 1.0f / sqrtf(var + 1e-6f); \
            _Pragma("unroll") for (int ct = 0; ct < CT; ++ct) { const f32x4 x = acc[rt][ct]; f32x4 y; y[0] = (x[0] - mean) * rstd; y[1] = (x[1] - mean) * rstd; y[2] = (x[2] - mean) * rstd; y[3] = (x[3] - mean) * rstd; \
                *(LAS f32x4*)(OT + (16 * r4 + lr) * (DV * 4) + ((((vb >> 2) + 4 * ct + lq) ^ lr) << 4)) = y; } } } while (0)
#define M3_OUT(G, PASS) do { int to_ = tid; asm volatile("" : "+v"(to_)); const int ln_ = to_ & 63, c8 = ln_ % LPR; _Pragma("unroll") for (int i = 0; i < NI; ++i) { const int rl = wave * 8 + i * RPI + ln_ / LPR; \
            const f32x4 ya = *(const LAS f32x4*)(OT + rl * (DV * 4) + (((2 * c8) ^ (rl & 15)) << 4)), yb = *(const LAS f32x4*)(OT + rl * (DV * 4) + (((2 * c8 + 1) ^ (rl & 15)) << 4)); \
            const u32x4 g = G[i]; u32x4 w; \
            w.x = cvt_pk_bf16(ya[0] * bf_lo(g.x), ya[1] * bf_hi(g.x)); w.y = cvt_pk_bf16(ya[2] * bf_lo(g.y), ya[3] * bf_hi(g.y)); \
            w.z = cvt_pk_bf16(yb[0] * bf_lo(g.z), yb[1] * bf_hi(g.z)); w.w = cvt_pk_bf16(yb[2] * bf_lo(g.w), yb[3] * bf_hi(g.w)); \
            if (MK_M3_DEFER) pend.w[PASS][i] = w; \
            else if (!((MK_M3_PROBE == 1 || MK_M3_PROBE == 2 || MK_M3_PROBE == 3) && probe)) { \
                if (MK_M3_PROBE == 5 && probe) *(u32x4*)((char*)mixed + (((unsigned)(((t0 + 64 * (PASS) + rl) * 4096 + 8 * c8) * 2)) & 0xfff0u)) = w;   \
                else if (MK_M3_WT) __builtin_amdgcn_raw_buffer_store_b128(w, mixrs, (unsigned)(((t0 + 64 * (PASS) + rl) * 4096 + 8 * c8) * 2), 0, 16  ); \
                else if (MK_M3_NTST) __builtin_nontemporal_store(w, (u32x4*)(mixed + ((unsigned)((t0 + 64 * (PASS) + rl) * 4096 + 8 * c8)))); \
                else *(u32x4*)(mixed + ((unsigned)((t0 + 64 * (PASS) + rl) * 4096 + 8 * c8))) = w; } } } while (0)
        __builtin_amdgcn_sched_barrier(0);
        if constexpr (GEARLY) {
#pragma unroll
            for (int i = 0; i < NI; ++i) { gv0[i] = gvE0[i]; gv1[i] = gvE1[i]; } }
        else M3_GROWS(gv0, 0);
        {   M3_LANE();
#pragma unroll
            for (int rt = 0; rt < 8; ++rt) { float s1 = 0.f, s2 = 0.f;
#pragma unroll
                for (int ct = 0; ct < CT; ++ct)
#pragma unroll
                    for (int r = 0; r < 4; ++r) { const float x = acc[rt][ct][r]; s1 += x; s2 += x * x; }
                s1 += __shfl_xor(s1, 16); s1 += __shfl_xor(s1, 32); s2 += __shfl_xor(s2, 16); s2 += __shfl_xor(s2, 32);
                if (lq == 0) STATS[(16 * rt + lr) * 8 + wave] = (f32x2){s1, s2}; } }
        __syncthreads();
        M3_NORM(0);
        if constexpr (!GEARLY) M3_GROWS(gv1, 1);
        __syncthreads();
        M3_OUT(gv0, 0);
        __syncthreads();
        M3_NORM(1);
        __syncthreads();
        M3_OUT(gv1, 1);
        if (MK_M3_DEFER) { pend.mixed = mixed; pend.t0 = t0; pend.lpr = LPR; }
#undef M3_GROWS
#undef M3_NORM
#undef M3_OUT
    }
#endif
    __syncthreads();
#undef M3_LOADV
#undef M3_LOADS
#undef M3_LOADSTEP
}
#undef QFRAG
#undef PFRAG
#undef M3_BASES
#undef M3_PBASES
#undef M3_LANE
template <class AT> __device__ __forceinline__ void m3_phase(const AT& a, int l, LAS unsigned char* lds, int tid, int lane, int wave, int bid, int G, int probe = 0) {
    bf16_t* const mixr = (MK_M3_PROBE == 5 && probe) ? a.h + (size_t)bid * 32768 : a.mixed;
    M3Pend pend; pend.lpr = 0; pend.mixed = nullptr; pend.t0 = 0;
    const bool flip = MK_M3_FLIP && ((bid >> 4) & 1);
#pragma unroll 1
    for (int s_ = 0; s_ < 2; ++s_) {
    if ((s_ == 0) != flip) {
    for (int u = bid; u < 256; u += G) { if (MK_M3_DEFER) m3_flush(pend, tid, wave); const int rh = MK_M3_UNPAIR ? (u & 1) : (u >> 3) & 1, idx = MK_M3_UNPAIR ? (u >> 1) : (u & 7) | ((u >> 4) << 3), h = idx >> 5, c2 = idx & 31, t0 = 256 * c2 + 128 * rh, tk0 = 256 * c2;
        if (rh) m3_unit<4, false, 2, MK_M3_RDG, false>(lds, a.qg + h * 256, 1024, a.kg + h * 256, (MK_VT_BLK ? a.vgt + ((size_t)c2 * 2048 + h * 512) * 256 : a.vgt + (size_t)(h * 512) * T), a.kvg + (size_t)(h * 32 + c2) * 131072, a.sgg + h * 512, a.gla_gain + l * 2048 + h * 512, ((MK_M3_PROBE == 5 && probe) ? mixr : a.mixed + 2048 + h * 512), t0, tk0, tid, wave, pend, probe);
        else    m3_unit<4, false, 1, MK_M3_RDG, false>(lds, a.qg + h * 256, 1024, a.kg + h * 256, (MK_VT_BLK ? a.vgt + ((size_t)c2 * 2048 + h * 512) * 256 : a.vgt + (size_t)(h * 512) * T), a.kvg + (size_t)(h * 32 + c2) * 131072, a.sgg + h * 512, a.gla_gain + l * 2048 + h * 512, ((MK_M3_PROBE == 5 && probe) ? mixr : a.mixed + 2048 + h * 512), t0, tk0, tid, wave, pend, probe); }
    } else {
    for (int u = bid; u < 512; u += G) { const int rh = (MK_M3_UNPAIR ? (u & 1) : (u >> 3) & 1) ^ 1  , idx = MK_M3_UNPAIR ? (u >> 1) : (u & 7) | ((u >> 4) << 3), h = idx >> 5, c2 = idx & 31, t0 = 256 * c2 + 128 * rh, tk0 = 256 * c2;
        if (rh) m3_unit<2, true, 2, MK_M3_RDR, true>(lds, a.qr + h * 256, 2048, a.kr + h * 256, (MK_VT_BLK ? a.vrt + ((size_t)c2 * 2048 + h * 256) * 256 : a.vrt + (size_t)(h * 256) * T), a.kvr + (size_t)(h * 32 + c2) * 65536, a.srg + h * 256, a.ret_gain + l * 2048 + h * 256, ((MK_M3_PROBE == 5 && probe) ? mixr : a.mixed + h * 256), t0, tk0, tid, wave, pend, probe);
        else    m3_unit<2, true, 1, MK_M3_RDR, true>(lds, a.qr + h * 256, 2048, a.kr + h * 256, (MK_VT_BLK ? a.vrt + ((size_t)c2 * 2048 + h * 256) * 256 : a.vrt + (size_t)(h * 256) * T), a.kvr + (size_t)(h * 32 + c2) * 65536, a.srg + h * 256, a.ret_gain + l * 2048 + h * 256, ((MK_M3_PROBE == 5 && probe) ? mixr : a.mixed + h * 256), t0, tk0, tid, wave, pend, probe); }
    }
    }
    if (MK_M3_DEFER) m3_flush(pend, tid, wave);
}

template <class AT> __device__ __forceinline__ void final_phase(const AT& a, const u64* ss, int tid, int bid, int G) {
    const size_t n8 = (size_t)T * D / 8, stride = (size_t)G * NTHR; const size_t i00 = (size_t)bid * NTHR + tid;
    const bool colfix = (stride & 511) == 0;
    f32x4 g0 = ((const f32x4*)a.final_norm)[2 * (int)(i00 & 511)], g1 = ((const f32x4*)a.final_norm)[2 * (int)(i00 & 511) + 1];
    u32x4 v[2][8]; u64 sv[2][8];
#define FIN_LOAD(B, i0_) do { _Pragma("unroll") for (int j = 0; j < 8; ++j) { const size_t i = (i0_) + j * stride; const bool ok = i < n8; \
        v[B][j] = ok ? MK_NTLD(((const u32x4*)a.xb) + i) : (u32x4){0u, 0u, 0u, 0u}; sv[B][j] = ok ? ss[i >> 9] : 0ull; } } while (0)
#define FIN_STORE(B, i0_) do { _Pragma("unroll") for (int j = 0; j < 8; ++j) { const size_t i = (i0_) + j * stride; if (i < n8) { \
        if (!colfix) { const int c8 = (int)(i & 511); g0 = ((const f32x4*)a.final_norm)[2 * c8]; g1 = ((const f32x4*)a.final_norm)[2 * c8 + 1]; } \
        const float r = rs_of(sv[B][j]); const u32x4 x = v[B][j]; \
        f32x4 o0, o1; o0[0] = bf_lo(x.x) * r * g0[0]; o0[1] = bf_hi(x.x) * r * g0[1]; o0[2] = bf_lo(x.y) * r * g0[2]; o0[3] = bf_hi(x.y) * r * g0[3]; \
        o1[0] = bf_lo(x.z) * r * g1[0]; o1[1] = bf_hi(x.z) * r * g1[1]; o1[2] = bf_lo(x.w) * r * g1[2]; o1[3] = bf_hi(x.w) * r * g1[3]; \
        if (MK_FIN_NT) { __builtin_nontemporal_store(o0, ((f32x4*)a.out) + 2 * i); __builtin_nontemporal_store(o1, ((f32x4*)a.out) + 2 * i + 1); } else { ((f32x4*)a.out)[2 * i] = o0; ((f32x4*)a.out)[2 * i + 1] = o1; } } } } while (0)
    if (i00 < n8) FIN_LOAD(0, i00);
#pragma unroll 1
    for (size_t i0 = i00; i0 < n8; i0 += 16 * stride) {
        const size_t i1 = i0 + 8 * stride, i2 = i0 + 16 * stride;
        if (i1 < n8) FIN_LOAD(1, i1);
        FIN_STORE(0, i0);
        if (i1 < n8) { if (i2 < n8) FIN_LOAD(0, i2); FIN_STORE(1, i1); }
    }
#undef FIN_LOAD
#undef FIN_STORE
}

#ifndef MK_PH
#define MK_PH 1023
#endif
#ifndef MK_SP2
#define MK_SP2 true
#endif
#ifndef MK_ALIGN
#define MK_ALIGN true
#endif
#ifndef MK_STAG_SHIFT
#define MK_STAG_SHIFT 6
#endif
#ifndef MK_STAG
#define MK_STAG 0
#endif
#define STAGGER() do { if (MK_STAG) { const unsigned long long t0_ = __builtin_amdgcn_s_memrealtime(); const unsigned long long w_ = (unsigned long long)(((bid >> MK_STAG_SHIFT) & 3) * MK_STAG); while (__builtin_amdgcn_s_memrealtime() - t0_ < w_) __builtin_amdgcn_s_sleep(8); } } while (0)
#ifndef MK_REP_P0
#define MK_REP_P0 1
#endif
#ifndef MK_REP_G1
#define MK_REP_G1 1
#endif
#ifndef MK_REP_PREP
#define MK_REP_PREP 1
#endif
#ifndef MK_REP_M1
#define MK_REP_M1 1
#endif
#ifndef MK_REP_M3
#define MK_REP_M3 1
#endif
#ifndef MK_REP_G3
#define MK_REP_G3 1
#endif
#ifndef MK_REP_M12
#define MK_REP_M12 1
#endif
#ifndef MK_REP_FIN
#define MK_REP_FIN 1
#endif
#ifndef MK_REP_G2
#define MK_REP_G2 1
#endif
#ifndef MK_REP_G4
#define MK_REP_G4 1
#endif
#define REPEAT(n, k) for (int rep_ = 0; rep_ < (n); ++rep_, ((rep_ < (n)) ? xcd_barrier(bar) : (void)0))
typedef const Args __attribute__((address_space(4))) CArgs;
#define KARGS() ({ const CArgs* p_ = (const CArgs*)__builtin_amdgcn_kernarg_segment_ptr(); asm volatile("" : "+s"(p_)); p_; })
__global__ void __launch_bounds__(NTHR, 2) mk_fwd(Args args_unused) {
    extern __shared__ __attribute__((aligned(16))) unsigned char lds_raw[];
    LAS unsigned char* lds = (LAS unsigned char*)lds_raw;
    const int bid = blockIdx.x, G = gridDim.x;
    volatile LAS unsigned* MISC = (volatile LAS unsigned*)(lds + LDSCTL_OFF);
    if (threadIdx.x < 64) MISC[threadIdx.x] = 0u;
    const int wave_s = __builtin_amdgcn_readfirstlane((int)(threadIdx.x >> 6));
#define MK_TID() ({ int w_ = wave_s; unsigned z_ = 0u; asm volatile("" : "+s"(w_), "+v"(z_)); (w_ << 6) | (int)__builtin_amdgcn_mbcnt_hi(~0u, __builtin_amdgcn_mbcnt_lo(~0u, z_)); })
#define LANEIDS() int tid = MK_TID(); asm volatile("" : "+v"(tid)); const int lane = tid & 63, wave = __builtin_amdgcn_readfirstlane(tid >> 6); (void)lane; (void)wave
    __syncthreads();
    (void)xcd_barrier_post(KARGS()->ctl + CW_BAR, MISC + 8);
#define bar (XcdBarrier{KARGS()->ctl + CW_BAR, xb_xcc_id(), MISC + 8, (MK_TID() == 0) ? 1u : 0u})
#if MK_SPLIT || MK_DEBUG
#define IN(k) (KARGS()->ph_lo <= (k) && (k) < KARGS()->ph_hi)
#else
#define IN(k) true
#endif
#if MK_TIMING
#define STAMP(k) do { if (blockIdx.x == 0 && threadIdx.x == 0) KARGS()->ctl[CW_TS + (k)] = (unsigned)__builtin_amdgcn_s_memrealtime(); } while (0)
#else
#define STAMP(k) do { } while (0)
#endif
#define SEAM(k) do { if (IN(k) && IN((k) + 1)) xcd_barrier(bar); STAMP((k) + 1); } while (0)
    STAMP(0);
#define SSB() ((u64*)(KARGS()->ctl + CW_SS))

    if (MK_PH & 256) if (IN(0)) REPEAT(MK_REP_P0, 0) { LANEIDS(); p0_prologue(*KARGS(), lds, tid, lane, wave, bid, G); }
    SEAM(0);
#ifdef MK_XBAR
    for (int xb_ = 0; xb_ < MK_XBAR; ++xb_) xcd_barrier(bar);
#endif
    for (int l = 0; l < 2; ++l) {
        const int pb = 1 + 8 * l;
        if (MK_PH & 1) if (IN(pb + 0)) REPEAT(MK_REP_G1, 1) {
            const CArgs& a = *KARGS(); const u64* ss_in = SSB() + (size_t)(2 * l) * T;
            { LANEIDS(); ga_stage(a, l, ss_in, lds, tid, lane, wave, bid, G); }
            pg8::Gemm g{a.xb, a.win_t[l], D, 2 * D, 128, 2 * D, 128}; pg8::ProjOrder S; S.init(T / 256, NPROJ / 256, G, bid);
            pg8::EpiProj E{ss_in, a.pos, a.qr, a.kr, a.vrt, a.srg, a.gq, a.gk, a.vgt, a.sgg, (MK_G1_PROBE && rep_ + 1 < MK_REP_G1) ? 1 : 0};
            STAGGER(); pg8::gemm_phase<pg8::EpiProj, pg8::ProjOrder, MK_ALIGN, MK_SP2>(lds, g, S, E, MK_TID());
        }
        SEAM(pb + 0);
        if (MK_PH & 2) if (IN(pb + 1)) REPEAT(MK_REP_PREP, 2) { LANEIDS(); prep_phase(*KARGS(), l, lds, tid, lane, wave, bid, G); }
        SEAM(pb + 1);
        for (int rep12 = 0; rep12 < MK_REP_M12; ++rep12) {
        if (rep12) xcd_barrier(bar);
        if (MK_PH & 4) if (IN(pb + 2)) REPEAT(MK_REP_M1, 3) { LANEIDS(); m1_phase(*KARGS(), lds, tid, wave, bid, G); }
        SEAM(pb + 2);
        if (MK_PH & 8) if (IN(pb + 3)) { LANEIDS(); m2_phase(*KARGS(), tid, bid, G); }
        }
        SEAM(pb + 3);
        if (MK_PH & 16) if (IN(pb + 4)) REPEAT(MK_REP_M3, 5) { LANEIDS(); m3_phase(*KARGS(), l, lds, tid, lane, wave, bid, G, (MK_M3_PROBE && rep_ + 1 < MK_REP_M3) ? 1 : 0); }
        SEAM(pb + 4);
        if (MK_PH & 32) if (IN(pb + 5)) REPEAT(MK_REP_G2, 6) {
            const CArgs& a = *KARGS(); u64* ss_mid = SSB() + (size_t)(2 * l + 1) * T;
            pg8::Gemm g{a.mixed, a.wout_t[l], D, 2 * D, 128, MK_BLK_W ? 128 : 2 * D, MK_BLK_W ? D * 128 : 128}; pg8::StaticOrder S; S.init(T / 256, D / 256, G, bid);
            const bool lastrep_ = (rep_ == MK_REP_G2 - 1); pg8::EpiRes E{lastrep_ ? a.xb : (bf16_t*)((char*)a.qr + (size_t)200 * 1048576), lastrep_ ? ss_mid : (u64*)(a.ctl + CW_CHK), (u64*)(a.ctl + CW_CHK)};
            STAGGER(); pg8::gemm_phase<pg8::EpiRes, pg8::StaticOrder, MK_ALIGN, MK_SP2>(lds, g, S, E, MK_TID());
        }
        SEAM(pb + 5);
#if MK_TIMING
        if (l == 0 && blockIdx.x == 0 && threadIdx.x == 0) { KARGS()->ctl[CW_TS + 32] = (unsigned)__builtin_amdgcn_s_memtime(); KARGS()->ctl[CW_TS + 33] = (unsigned)__builtin_amdgcn_s_memrealtime(); }
#endif
        if (MK_PH & 64) if (IN(pb + 6)) REPEAT(MK_REP_G3, 7) {
            const CArgs& a = *KARGS(); const u64* ss_mid = SSB() + (size_t)(2 * l + 1) * T;
            pg8::Gemm g{a.xb, a.wgu_t[l], D, 2 * D, 128, MK_BLK_W ? 128 : 2 * D, MK_BLK_W ? 2 * FF * 128 : 128}; pg8::StaticOrder S; S.init(T / 256, 2 * FF / 256, G, bid);
            pg8::EpiSwiGLU E{ss_mid, a.h};
            STAGGER(); pg8::gemm_phase<pg8::EpiSwiGLU, pg8::StaticOrder, MK_ALIGN, MK_SP2>(lds, g, S, E, MK_TID());
        }
#if MK_TIMING
        if (l == 0 && blockIdx.x == 0 && threadIdx.x == 0) { KARGS()->ctl[CW_TS + 34] = (unsigned)__builtin_amdgcn_s_memtime(); KARGS()->ctl[CW_TS + 35] = (unsigned)__builtin_amdgcn_s_memrealtime(); }
#endif
        SEAM(pb + 6);
        if (MK_PH & 128) if (IN(pb + 7)) REPEAT(MK_REP_G4, 8) {
            const CArgs& a = *KARGS(); u64* ss_out = SSB() + (size_t)(2 * l + 2) * T;
            pg8::Gemm g{a.h, a.wd_t[l], FF, 128, T * 128, MK_BLK_W ? 128 : 2 * FF, MK_BLK_W ? D * 128 : 128}  ; pg8::StaticOrder S; S.init(T / 256, D / 256, G, bid);
            const bool lastrep_ = (rep_ == MK_REP_G4 - 1); pg8::EpiRes E{lastrep_ ? a.xb : (bf16_t*)((char*)a.qr + (size_t)200 * 1048576), lastrep_ ? ss_out : (u64*)(a.ctl + CW_CHK), (u64*)(a.ctl + CW_CHK)};
            STAGGER(); pg8::gemm_phase<pg8::EpiRes, pg8::StaticOrder, MK_ALIGN, MK_SP2>(lds, g, S, E, MK_TID());
        }
        SEAM(pb + 7);
    }
    if (MK_PH & 512) if (IN(17)) REPEAT(MK_REP_FIN, 17) { LANEIDS(); final_phase(*KARGS(), SSB() + (size_t)4 * T, tid, bid, G); }
    STAMP(18);
#undef IN
#undef SEAM
}

#ifndef MK_WS_ALIGN
#define MK_WS_ALIGN 256
#endif
struct Layout { size_t off; size_t take(size_t bytes) { const size_t al = MK_WS_ALIGN; off = (off + al - 1) / al * al; const size_t o = off; off += bytes; return o; } };
static size_t build_args(Args& a, void* const* d_in, void* d_out, unsigned char* ws, size_t base, int cvt_mask, int cvt_layers) {
    a.x = (const float*)d_in[0]; a.pos = (const int*)d_in[1]; a.mix_norm = (const float*)d_in[2]; a.w_in = (const float*)d_in[3]; a.gla_w_up = (const float*)d_in[4]; a.gla_b = (const float*)d_in[5];
    a.ret_gain = (const float*)d_in[6]; a.gla_gain = (const float*)d_in[7]; a.w_out = (const float*)d_in[8]; a.ffn_norm = (const float*)d_in[9]; a.w_gate = (const float*)d_in[10]; a.w_up = (const float*)d_in[11];
    a.w_down = (const float*)d_in[12]; a.final_norm = (const float*)d_in[13]; a.out = (float*)d_out;
    Layout L{base};
    a.ctl = (unsigned*)(ws + L.take(CTL_ZERO_BYTES));
    for (int l = 0; l < 2; ++l) { const bool on = l < cvt_layers;
        a.win_t[l] = (bf16_t*)(ws + ((on && (cvt_mask & 1)) ? L.take((size_t)NPROJ * D * 2) : L.off)); a.wga_t[l] = (bf16_t*)(ws + ((on && (cvt_mask & 1)) ? L.take((size_t)16 * D * 2) : L.off));
        a.wout_t[l] = (bf16_t*)(ws + ((on && (cvt_mask & 2)) ? L.take((size_t)D * D * 2) : L.off)); a.wgu_t[l] = (bf16_t*)(ws + ((on && (cvt_mask & 4)) ? L.take((size_t)2 * FF * D * 2) : L.off));
        a.wd_t[l] = (bf16_t*)(ws + ((on && (cvt_mask & 8)) ? L.take((size_t)D * FF * 2) : L.off)); }
    a.xb = (bf16_t*)(ws + L.take((size_t)T * D * 2)); a.rot = nullptr; a.ga = (float*)(ws + L.take((size_t)T * 16 * 4)); a.lam = (float*)(ws + L.take((size_t)64 * 1024 * 4));
    a.mixed = (bf16_t*)(ws + L.take((size_t)T * D * 2));
    const size_t ov0 = L.off;
    a.qr = (bf16_t*)(ws + L.take((size_t)T * 2048 * 2)); a.kr = (bf16_t*)(ws + L.take((size_t)T * 2048 * 2)); a.krt = nullptr; a.vrt = (bf16_t*)(ws + L.take((size_t)T * 2048 * 2));
    a.srg = (bf16_t*)(ws + L.take((size_t)T * 2048 * 2)); a.gq = (bf16_t*)(ws + L.take((size_t)T * 1024 * 2)); a.gk = (bf16_t*)(ws + L.take((size_t)T * 1024 * 2)); a.qg = (bf16_t*)(ws + L.take((size_t)T * 1024 * 2));
    a.kg = (bf16_t*)(ws + L.take((size_t)T * 1024 * 2)); a.kgt = nullptr; a.vgt = (bf16_t*)(ws + L.take((size_t)T * 2048 * 2)); a.sgg = (bf16_t*)(ws + L.take((size_t)T * 2048 * 2));
    a.kvr = (bf16_t*)(ws + L.take((size_t)8 * 64 * 65536 * 2)); a.kvg = (bf16_t*)(ws + L.take((size_t)4 * 64 * 131072 * 2));
    a.h = (bf16_t*)(ws + ov0);
    if (L.off < ov0 + (size_t)T * FF * 2) L.off = ov0 + (size_t)T * FF * 2;
    a.cvt_mask = cvt_mask; a.cvt_layers = cvt_layers;
    return L.off;
}
static int g_grid = 0;
static bool setup_once() {
    if (g_grid) return g_grid > 0;
    int dev = 0, cus = 0, per_cu = 0;
    if (hipGetDevice(&dev) != hipSuccess || hipDeviceGetAttribute(&cus, hipDeviceAttributeMultiprocessorCount, dev) != hipSuccess) { fprintf(stderr, "mk: device query failed\n"); g_grid = -1; return false; }
    if (hipFuncSetAttribute((const void*)mk_fwd, hipFuncAttributeMaxDynamicSharedMemorySize, LDS_BYTES) != hipSuccess) { fprintf(stderr, "mk: hipFuncSetAttribute failed\n"); g_grid = -1; return false; }
    if (hipOccupancyMaxActiveBlocksPerMultiprocessor(&per_cu, (const void*)mk_fwd, NTHR, LDS_BYTES) != hipSuccess || per_cu < 1) { fprintf(stderr, "mk: occupancy query says %d blocks per CU\n", per_cu); (void)hipGetLastError(); }
    g_grid = cus;
    return true;
}
static void launch_range(Args a, int lo, int hi, hipStream_t stream, bool zero_bar = true) {
    if (zero_bar) (void)hipMemsetAsync((char*)a.ctl + (size_t)CW_BAR * 4, 0, (size_t)XCD_BAR_WORDS * 4, stream);
    a.ph_lo = lo; a.ph_hi = hi;
    hipLaunchKernelGGL(mk_fwd, dim3(g_grid), dim3(NTHR), LDS_BYTES, stream, a);
    const hipError_t e = hipPeekAtLastError(); if (e != hipSuccess) fprintf(stderr, "mk: launch [%d,%d) failed: %s\n", lo, hi, hipGetErrorName(e));
}
}
#if MK_DEBUG
namespace nv {
constexpr int T_ = 8192, D_ = 4096, INW = 14352, FF_ = 11008;
constexpr int O_RQ = 0, O_RK = 2048, O_RV = 4096, O_RG = 6144, O_GQ = 8192, O_GK = 9216, O_GV = 10240, O_GG = 12288, O_GA = 14336;

__global__ __launch_bounds__(256) void k_rmsnorm(const float* __restrict__ x, const float* __restrict__ g, float* __restrict__ out) {
    const int row = blockIdx.x; const float* xr = x + (size_t)row * D_;
    float s = 0.f;
    for (int i = threadIdx.x; i < D_; i += 256) { const float v = xr[i]; s += v * v; }
    __shared__ float red[4];
    for (int o = 32; o > 0; o >>= 1) s += __shfl_xor(s, o);
    if ((threadIdx.x & 63) == 0) red[threadIdx.x >> 6] = s;
    __syncthreads();
    s = red[0] + red[1] + red[2] + red[3];
    const float r = 1.0f / sqrtf(s / (float)D_ + 1e-6f);
    for (int i = threadIdx.x; i < D_; i += 256) out[(size_t)row * D_ + i] = xr[i] * r * g[i];
}

template <int EPI>
__global__ __launch_bounds__(256) void k_sgemm(const float* __restrict__ A, const float* __restrict__ B, float* __restrict__ C, const float* __restrict__ R, int M, int N, int K) {
    __shared__ float As[16][132];
    __shared__ float Bs[16][132];
    const int bm = blockIdx.y * 128, bn = blockIdx.x * 128;
    const int tid = threadIdx.x, tx = tid & 15, ty = tid >> 4;
    float acc[8][8];
#pragma unroll
    for (int i = 0; i < 8; ++i)
#pragma unroll
        for (int j = 0; j < 8; ++j) acc[i][j] = 0.f;
    for (int k0 = 0; k0 < K; k0 += 16) {
#pragma unroll
        for (int i = 0; i < 2; ++i) {
            const int idx = tid + i * 256, r = idx >> 2, c4 = (idx & 3) * 4;
            const float4 v = *(const float4*)&A[(size_t)(bm + r) * K + k0 + c4];
            As[c4 + 0][r] = v.x; As[c4 + 1][r] = v.y; As[c4 + 2][r] = v.z; As[c4 + 3][r] = v.w;
        }
#pragma unroll
        for (int i = 0; i < 2; ++i) {
            const int idx = tid + i * 256, kr = idx >> 5, c4 = (idx & 31) * 4;
            float4 v = make_float4(0.f, 0.f, 0.f, 0.f);
            if (bn + c4 < N) v = *(const float4*)&B[(size_t)(k0 + kr) * N + bn + c4];
            *(float4*)&Bs[kr][c4] = v;
        }
        __syncthreads();
#pragma unroll
        for (int kk = 0; kk < 16; ++kk) {
            float a[8], b[8];
            const float4 a0 = *(const float4*)&As[kk][ty * 8], a1 = *(const float4*)&As[kk][ty * 8 + 4];
            const float4 b0 = *(const float4*)&Bs[kk][tx * 8], b1 = *(const float4*)&Bs[kk][tx * 8 + 4];
            a[0] = a0.x; a[1] = a0.y; a[2] = a0.z; a[3] = a0.w; a[4] = a1.x; a[5] = a1.y; a[6] = a1.z; a[7] = a1.w;
            b[0] = b0.x; b[1] = b0.y; b[2] = b0.z; b[3] = b0.w; b[4] = b1.x; b[5] = b1.y; b[6] = b1.z; b[7] = b1.w;
#pragma unroll
            for (int i = 0; i < 8; ++i)
#pragma unroll
                for (int j = 0; j < 8; ++j) acc[i][j] = fmaf(a[i], b[j], acc[i][j]);
        }
        __syncthreads();
    }
#pragma unroll
    for (int i = 0; i < 8; ++i) {
        const int r = bm + ty * 8 + i;
#pragma unroll
        for (int j4 = 0; j4 < 2; ++j4) {
            const int c = bn + tx * 8 + j4 * 4;
            if (c < N) {
                float4 v = make_float4(acc[i][j4 * 4 + 0], acc[i][j4 * 4 + 1], acc[i][j4 * 4 + 2], acc[i][j4 * 4 + 3]);
                if (EPI == 1) { const float4 rr = *(const float4*)&R[(size_t)r * N + c]; v.x += rr.x; v.y += rr.y; v.z += rr.z; v.w += rr.w; }
                if (EPI == 2) { const float4 gg = *(const float4*)&C[(size_t)r * N + c]; v.x *= gg.x / (1.0f + __expf(-gg.x)); v.y *= gg.y / (1.0f + __expf(-gg.y)); v.z *= gg.z / (1.0f + __expf(-gg.z)); v.w *= gg.w / (1.0f + __expf(-gg.w)); }
                *(float4*)&C[(size_t)r * N + c] = v;
            }
        }
    }
}

__device__ __forceinline__ float siluf(float x) { return x / (1.0f + __expf(-x)); }

__global__ __launch_bounds__(256) void k_rotary(float* __restrict__ proj, const int* __restrict__ pos) {
    const size_t gid = (size_t)blockIdx.x * 256 + threadIdx.x;
    const int i = (int)(gid & 127), h = (int)((gid >> 7) & 7), w = (int)((gid >> 10) & 1); const int t = (int)(gid >> 11);
    if (t >= T_) return;
    const float inv_freq = powf(10000.0f, -(float)i / 128.0f);
    const float ang = (float)pos[t] * inv_freq;
    const double rev = (double)ang * 0.15915494309189533577;
    const float fr = (float)(rev - floor(rev));
    const float c = __builtin_amdgcn_cosf(fr), s = __builtin_amdgcn_sinf(fr);
    float* p = proj + (size_t)t * INW + (w ? O_RK : O_RQ) + h * 256 + i;
    const float t1 = p[0], t2 = p[128];
    p[0] = t1 * c - t2 * s; p[128] = t1 * s + t2 * c;
}

__global__ __launch_bounds__(256) void k_gate(const float* __restrict__ proj, const float* __restrict__ wup, const float* __restrict__ b, float* __restrict__ loga) {
    const int t = blockIdx.x;
    const float* ga = proj + (size_t)t * INW + O_GA;
    for (int c = threadIdx.x; c < 1024; c += 256) {
        float z = b[c];
#pragma unroll
        for (int r = 0; r < 16; ++r) z = fmaf(ga[r], wup[r * 1024 + c], z);
        const float ls = fminf(z, 0.f) - log1pf(expf(-fabsf(z)));
        loga[(size_t)t * 1024 + c] = ls * (1.0f / 16.0f);
    }
}

template <int GLA>
__global__ __launch_bounds__(256) void k_recur(const float* __restrict__ proj, int qoff, int koff, int voff, int dv, const float* __restrict__ loga, float qs, float ks, float* __restrict__ out, int ostride) {
    const int vt = blockIdx.x, h = blockIdx.y, d = threadIdx.x, lane = d & 63, wave = d >> 6;
    float S[16];
#pragma unroll
    for (int j = 0; j < 16; ++j) S[j] = 0.f;
    const float gamma = 1.0f - exp2f(-5.0f - (float)h);
    __shared__ float part[2][4][16];
    for (int t = 0; t < T_; ++t) {
        const float* row = proj + (size_t)t * INW;
        const float q = row[qoff + h * 256 + d] * qs, k = row[koff + h * 256 + d] * ks;
        const float a = GLA ? expf(loga[(size_t)t * 1024 + h * 256 + d]) : gamma;
        float p[16];
#pragma unroll
        for (int j4 = 0; j4 < 4; ++j4) {
            const float4 v = *(const float4*)&row[voff + h * dv + vt * 16 + j4 * 4];
            S[j4 * 4 + 0] = a * S[j4 * 4 + 0] + k * v.x; S[j4 * 4 + 1] = a * S[j4 * 4 + 1] + k * v.y;
            S[j4 * 4 + 2] = a * S[j4 * 4 + 2] + k * v.z; S[j4 * 4 + 3] = a * S[j4 * 4 + 3] + k * v.w;
        }
#pragma unroll
        for (int j = 0; j < 16; ++j) p[j] = q * S[j];
#pragma unroll
        for (int j = 0; j < 16; ++j)
#pragma unroll
            for (int o = 32; o > 0; o >>= 1) p[j] += __shfl_xor(p[j], o);
        if (lane == 0) {
#pragma unroll
            for (int j = 0; j < 16; ++j) part[t & 1][wave][j] = p[j];
        }
        __syncthreads();
        if (d < 16) out[(size_t)t * ostride + h * dv + vt * 16 + d] = part[t & 1][0][d] + part[t & 1][1][d] + part[t & 1][2][d] + part[t & 1][3][d];
    }
}

__global__ __launch_bounds__(256) void k_headnorm(const float* __restrict__ proj, const float* __restrict__ ro, const float* __restrict__ go, const float* __restrict__ rgain, const float* __restrict__ ggain, float* __restrict__ mixed) {
    const int t = blockIdx.x, tid = threadIdx.x, lane = tid & 63, wave = tid >> 6;
    const float* row = proj + (size_t)t * INW;
    for (int hh = 0; hh < 2; ++hh) {
        const int h = wave * 2 + hh;
        float v[4]; float s = 0.f;
#pragma unroll
        for (int j = 0; j < 4; ++j) { v[j] = ro[(size_t)t * 2048 + h * 256 + lane + 64 * j]; s += v[j]; }
        for (int o = 32; o > 0; o >>= 1) s += __shfl_xor(s, o);
        const float mu = s / 256.f; float q = 0.f;
#pragma unroll
        for (int j = 0; j < 4; ++j) { v[j] -= mu; q += v[j] * v[j]; }
        for (int o = 32; o > 0; o >>= 1) q += __shfl_xor(q, o);
        const float rs = 1.0f / sqrtf(q / 256.f + 1e-6f);
#pragma unroll
        for (int j = 0; j < 4; ++j) { const int c = h * 256 + lane + 64 * j; mixed[(size_t)t * D_ + c] = siluf(row[O_RG + c]) * (v[j] * rs * rgain[c]); }
    }
    {
        const int h = wave;
        float v[8]; float q = 0.f;
#pragma unroll
        for (int j = 0; j < 8; ++j) { v[j] = go[(size_t)t * 2048 + h * 512 + lane + 64 * j]; q += v[j] * v[j]; }
        for (int o = 32; o > 0; o >>= 1) q += __shfl_xor(q, o);
        const float rs = 1.0f / sqrtf(q / 512.f + 1e-6f);
#pragma unroll
        for (int j = 0; j < 8; ++j) { const int c = h * 512 + lane + 64 * j; mixed[(size_t)t * D_ + 2048 + c] = siluf(row[O_GG + c]) * (v[j] * rs * ggain[c]); }
    }
}

__global__ __launch_bounds__(256) void k_swiglu(float* __restrict__ G, const float* __restrict__ U, size_t n4) {
    for (size_t i = (size_t)blockIdx.x * 256 + threadIdx.x; i < n4; i += (size_t)gridDim.x * 256) {
        float4 g = ((float4*)G)[i]; const float4 u = ((const float4*)U)[i];
        g.x = siluf(g.x) * u.x; g.y = siluf(g.y) * u.y; g.z = siluf(g.z) * u.z; g.w = siluf(g.w) * u.w;
        ((float4*)G)[i] = g;
    }
}

inline void forward(void* const* d_in, float* out, float* ws, size_t ws_size, hipStream_t st) {
    const float* x = (const float*)d_in[0]; const int* pos = (const int*)d_in[1];
    const float* mix_norm = (const float*)d_in[2]; const float* w_in = (const float*)d_in[3];
    const float* gla_w_up = (const float*)d_in[4]; const float* gla_b = (const float*)d_in[5];
    const float* ret_gain = (const float*)d_in[6]; const float* gla_gain = (const float*)d_in[7];
    const float* w_out = (const float*)d_in[8]; const float* ffn_norm = (const float*)d_in[9];
    const float* w_gate = (const float*)d_in[10]; const float* w_up = (const float*)d_in[11]; const float* w_down = (const float*)d_in[12];
    const float* final_norm = (const float*)d_in[13];
    size_t o = 0;
    float* xn = ws + o; o += (size_t)T_ * D_;
    float* proj = ws + o; o += (size_t)T_ * INW;
    float* loga = ws + o; o += (size_t)T_ * 1024;
    float* ro = ws + o; o += (size_t)T_ * 2048;
    float* go = ws + o; o += (size_t)T_ * 2048;
    float* mixed = ws + o; o += (size_t)T_ * D_;
    float* xa = ws + o; o += (size_t)T_ * D_;
    float* xb = ws + o; o += (size_t)T_ * D_;
    float* G = ws + o; o += (size_t)T_ * FF_;
    if (o * 4 > ws_size) { fprintf(stderr, "naive: ws too small: need %zu have %zu\n", o * 4, ws_size); return; }
    const float* xc = x;
    for (int l = 0; l < 2; ++l) {
        k_rmsnorm<<<T_, 256, 0, st>>>(xc, mix_norm + (size_t)l * D_, xn);
        k_sgemm<0><<<dim3((INW + 127) / 128, T_ / 128), 256, 0, st>>>(xn, w_in + (size_t)l * D_ * INW, proj, nullptr, T_, INW, D_);
        k_rotary<<<(T_ * 2048) / 256, 256, 0, st>>>(proj, pos);
        k_gate<<<T_, 256, 0, st>>>(proj, gla_w_up + (size_t)l * 16 * 1024, gla_b + (size_t)l * 1024, loga);
        k_recur<0><<<dim3(16, 8), 256, 0, st>>>(proj, O_RQ, O_RK, O_RV, 256, nullptr, 1.0f, 1.0f / 16.0f, ro, 2048);
        k_recur<1><<<dim3(32, 4), 256, 0, st>>>(proj, O_GQ, O_GK, O_GV, 512, loga, 1.0f / 16.0f, 1.0f, go, 2048);
        k_headnorm<<<T_, 256, 0, st>>>(proj, ro, go, ret_gain + (size_t)l * 2048, gla_gain + (size_t)l * 2048, mixed);
        k_sgemm<1><<<dim3(D_ / 128, T_ / 128), 256, 0, st>>>(mixed, w_out + (size_t)l * D_ * D_, xa, xc, T_, D_, D_);
        k_rmsnorm<<<T_, 256, 0, st>>>(xa, ffn_norm + (size_t)l * D_, xn);
        k_sgemm<0><<<dim3(FF_ / 128, T_ / 128), 256, 0, st>>>(xn, w_gate + (size_t)l * D_ * FF_, G, nullptr, T_, FF_, D_);
        k_sgemm<2><<<dim3(FF_ / 128, T_ / 128), 256, 0, st>>>(xn, w_up + (size_t)l * D_ * FF_, G, nullptr, T_, FF_, D_);
        k_sgemm<1><<<dim3(D_ / 128, T_ / 128), 256, 0, st>>>(G, w_down + (size_t)l * FF_ * D_, xb, xa, T_, D_, FF_);
        xc = xb;
    }
    k_rmsnorm<<<T_, 256, 0, st>>>(xc, final_norm, out);
}
}
#endif
#if MK_DEBUG
namespace dbg {
typedef unsigned short bf16_t;
constexpr int T = 8192, INW = 14352;
__device__ __forceinline__ float bf(bf16_t v) { return __uint_as_float((unsigned)v << 16); }
__device__ __forceinline__ void acc2(float* slot, float se, float sb) {
    for (int o = 32; o > 0; o >>= 1) { se += __shfl_xor(se, o); sb += __shfl_xor(sb, o); }
    if ((threadIdx.x & 63) == 0) { atomicAdd(slot, se); atomicAdd(slot + 1, sb); }
}
__global__ void k_cmp_bf16(const bf16_t* got, int gld, int transposed, const float* ref, int rld, int roff, int rows, int cols, int mode, float scale, float* slot) {
    float se = 0.f, sb = 0.f;
    for (size_t i = (size_t)blockIdx.x * blockDim.x + threadIdx.x; i < (size_t)rows * cols; i += (size_t)gridDim.x * blockDim.x) {
        const int r = (int)(i / cols), c = (int)(i % cols);
        float e = ref[(size_t)r * rld + roff + c] * scale;
        if (mode == 1) e = e / (1.0f + expf(-e));
        if (mode == 2 || mode == 3) { const int h = c >> 8; const float lg = log2f(1.0f - exp2f(-5.0f - (float)h)); const float ip1 = (float)((r & 127) + 1); e *= (mode == 2) ? exp2f(ip1 * lg) : exp2f(-ip1 * lg) * 0.0625f; }
        const float g = transposed ? bf(got[(size_t)c * gld + r]) : bf(got[(size_t)r * gld + c]);
        const float d = g - e; se += (d == d) ? d * d : 1e30f; sb += e * e;
    }
    acc2(slot, se, sb);
}
__global__ void k_cmp_f32(const float* got, int gld, const float* ref, int rld, int roff, int rows, int cols, float* slot) {
    float se = 0.f, sb = 0.f;
    for (size_t i = (size_t)blockIdx.x * blockDim.x + threadIdx.x; i < (size_t)rows * cols; i += (size_t)gridDim.x * blockDim.x) {
        const int r = (int)(i / cols), c = (int)(i % cols);
        const float e = ref[(size_t)r * rld + roff + c], g = got[(size_t)r * gld + c]; const float d = g - e; se += (d == d) ? d * d : 1e30f; sb += e * e; }
    acc2(slot, se, sb);
}
__global__ void k_cmp_tr(const bf16_t* a, int ald, const bf16_t* b, int bld, int rows, int cols, float* slot) {
    float se = 0.f, sb = 0.f;
    for (size_t i = (size_t)blockIdx.x * blockDim.x + threadIdx.x; i < (size_t)rows * cols; i += (size_t)gridDim.x * blockDim.x) {
        const int r = (int)(i / cols), c = (int)(i % cols); const float e = bf(a[(size_t)r * ald + c]), g = bf(b[(size_t)c * bld + r]); const float d = g - e; se += (d == d) ? d * d : 1e30f; sb += e * e; }
    acc2(slot, se, sb);
}
__global__ void k_cmp_ss(const float* ss, const float* ref, int rld, float* slot) {
    const int t = blockIdx.x; float s = 0.f; for (int i = threadIdx.x; i < 4096; i += 256) { const float v = ref[(size_t)t * rld + i]; s += v * v; }
    __shared__ float red[4]; for (int o = 32; o > 0; o >>= 1) s += __shfl_xor(s, o); if ((threadIdx.x & 63) == 0) red[threadIdx.x >> 6] = s; __syncthreads();
    if (threadIdx.x == 0) { const float e = red[0] + red[1] + red[2] + red[3], d = ss[t] - e; atomicAdd(slot, (d == d) ? d * d : 1e30f); atomicAdd(slot + 1, e * e); }
}
__global__ void k_cmp_gla(const bf16_t* qg, const bf16_t* kg, const float* lam, const float* proj, const float* loga, float* slot_q, float* slot_k, float* slot_l) {
    const int c = blockIdx.x, ch = blockIdx.y * 256 + threadIdx.x; float cum = 0.f, seq = 0.f, sbq = 0.f, sek = 0.f, sbk = 0.f;
    for (int tt = 0; tt < 128; ++tt) { const int t = c * 128 + tt; cum += loga[(size_t)t * 1024 + ch];
        const float eq = proj[(size_t)t * INW + 8192 + ch] * 0.0625f * expf(cum), ek = proj[(size_t)t * INW + 9216 + ch] * expf(-cum);
        float d = bf(qg[(size_t)t * 1024 + ch]) - eq; seq += (d == d) ? d * d : 1e30f; sbq += eq * eq; d = bf(kg[(size_t)t * 1024 + ch]) - ek; sek += (d == d) ? d * d : 1e30f; sbk += ek * ek; }
    const float el = expf(cum), dl = lam[c * 1024 + ch] - el;
    acc2(slot_q, seq, sbq); acc2(slot_k, sek, sbk); acc2(slot_l, (dl == dl) ? dl * dl : 1e30f, el * el);
}
__global__ void k_cmp_kv(const bf16_t* kb, int ldk, const bf16_t* vt, const bf16_t* kv, int DV, float* slot) {
    const int c = blockIdx.x, h = blockIdx.y, t0 = c * 128; float se = 0.f, sb = 0.f;
    for (int idx = threadIdx.x; idx < DV * 256; idx += 256) { const int v = idx >> 8, d = idx & 255; float e = 0.f;
        for (int j = 0; j < 128; ++j) e += bf(vt[(size_t)(h * DV + v) * T + t0 + j]) * bf(kb[(size_t)(t0 + j) * ldk + h * 256 + d]);
        const float g = bf(kv[((size_t)(h * 64 + c) * DV + v) * 256 + d]); const float dd = g - e; se += (dd == dd) ? dd * dd : 1e30f; sb += e * e; }
    acc2(slot, se, sb);
}
__global__ void k_cmp_s(const bf16_t* kb, int ldk, const bf16_t* vt, const bf16_t* sbuf, const float* lam, int DV, float* slot) {
    const int h = blockIdx.y; const int idx = blockIdx.x * 256 + threadIdx.x; const int v = idx >> 8, d = idx & 255; float se = 0.f, sb = 0.f, st = 0.f;
    const float lret = exp2f(128.0f * log2f(1.0f - exp2f(-5.0f - (float)h)));
    for (int c = 0; c < 64; ++c) { const float g = bf(sbuf[((size_t)(h * 64 + c) * DV + v) * 256 + d]); const float dd = g - st; se += (dd == dd) ? dd * dd : 1e30f; sb += st * st;
        float e = 0.f; for (int j = 0; j < 128; ++j) e += bf(vt[(size_t)(h * DV + v) * T + c * 128 + j]) * bf(kb[(size_t)(c * 128 + j) * ldk + h * 256 + d]);
        st = (lam ? lam[c * 1024 + h * 256 + d] : lret) * (st + e); }
    acc2(slot, se, sb);
}
__global__ void k_cmp_p(const bf16_t* q, const bf16_t* k, const bf16_t* pd, float* slot) {
    const int c = blockIdx.x, h = blockIdx.y, t0 = c * 128; float se[4] = {0.f, 0.f, 0.f, 0.f}, sb[4] = {0.f, 0.f, 0.f, 0.f};
    for (int idx = threadIdx.x; idx < 16384; idx += 256) { const int i = idx >> 7, j = idx & 127; float e = 0.f;
        for (int d = 0; d < 256; ++d) e += bf(q[(size_t)(t0 + i) * 2048 + h * 256 + d]) * bf(k[(size_t)(t0 + j) * 2048 + h * 256 + d]);
        const int cls = (j > i) ? 3 : ((i >> 4) != (j >> 4)) ? 0 : (j < i) ? 1 : 2;
        const float g = bf(pd[(size_t)(h * 64 + c) * 16384 + idx]); const float ee = (cls == 3) ? 0.f : e; const float dd = g - ee;
#pragma unroll
        for (int z = 0; z < 4; ++z) if (cls == z) { se[z] += (dd == dd) ? dd * dd : 1e30f; sb[z] += (z == 3) ? e * e : ee * ee; } }
#pragma unroll
    for (int z = 0; z < 4; ++z) acc2(slot + 2 * z, se[z], sb[z]);
}
__global__ void k_cmp_o(const bf16_t* q, const bf16_t* pd, const bf16_t* vt, const bf16_t* sbuf, const float* od, float* slot) {
    const int t = blockIdx.x, h = blockIdx.y, v = threadIdx.x, c = t >> 7, i = t & 127; float e = 0.f;
    for (int j = 0; j < 128; ++j) e += bf(pd[(size_t)(h * 64 + c) * 16384 + i * 128 + j]) * bf(vt[(size_t)(h * 256 + v) * T + c * 128 + j]);
    for (int d = 0; d < 256; ++d) e += bf(q[(size_t)t * 2048 + h * 256 + d]) * bf(sbuf[((size_t)(h * 64 + c) * 256 + v) * 256 + d]);
    const float g = od[(size_t)t * 2048 + h * 256 + v]; const float dd = g - e; acc2(slot, (dd == dd) ? dd * dd : 1e30f, e * e);
}
__global__ void k_decide(const float* slots, int n, const float* tol, float* code) {
    if (threadIdx.x || blockIdx.x) return; float cd = 9900.0f;
    for (int i = 0; i < n; ++i) { const float se = slots[2 * i], sb = slots[2 * i + 1]; const float rel = sqrtf(se / fmaxf(sb, 1e-30f));
        if (!(rel < tol[i]) || !(sb > 0.f)) { int b = (rel == rel && rel > 0.f) ? (int)floorf(2.0f * log10f(fmaxf(rel, 1e-3f) / 1e-3f)) : 20; b = b < 0 ? 0 : (b > 20 ? 20 : b); cd = (float)(10 + i) * powf(10.0f, (float)(2 + b)); break; } }
    *code = cd;
}
__global__ void k_fill_code(float* out, size_t n, const float* code) { const float c = *code; for (size_t i = (size_t)blockIdx.x * blockDim.x + threadIdx.x; i < n; i += (size_t)gridDim.x * blockDim.x) out[i] = c; }
}

extern "C" void kernel_launch(void* const* d_in, const int* in_sizes, int n_in, void* d_out, int out_size, void* d_ws, size_t ws_size, hipStream_t stream) {
    using namespace nv;
    if (!mk::setup_once()) return;
    hipStream_t st = stream; float* ws = (float*)d_ws;
    const float* x = (const float*)d_in[0]; const int* pos = (const int*)d_in[1]; const float* mix_norm = (const float*)d_in[2]; const float* w_in = (const float*)d_in[3];
    const float* gla_w_up = (const float*)d_in[4]; const float* gla_b = (const float*)d_in[5]; const float* ret_gain = (const float*)d_in[6]; const float* gla_gain = (const float*)d_in[7];
    const float* w_out = (const float*)d_in[8]; const float* ffn_norm = (const float*)d_in[9]; const float* w_gate = (const float*)d_in[10]; const float* w_up = (const float*)d_in[11]; const float* w_down = (const float*)d_in[12];
#if MK_DEBUG == 1
    size_t o = 0;
    float* xn = ws + o; o += (size_t)T_ * D_; float* proj = ws + o; o += (size_t)T_ * INW; float* loga = ws + o; o += (size_t)T_ * 1024; float* ro = ws + o; o += (size_t)T_ * 2048; float* go = ws + o; o += (size_t)T_ * 2048;
    float* mixed = ws + o; o += (size_t)T_ * D_; float* xa = ws + o; o += (size_t)T_ * D_;
    mk::Args a{}; size_t need = mk::build_args(a, d_in, d_out, (unsigned char*)d_ws, o * 4, 3, 1);
    a.dbgp = (bf16_t*)((unsigned char*)d_ws + need); need += (size_t)8 * 64 * 16384 * 2; a.dbgo = (float*)((unsigned char*)d_ws + need); need += (size_t)T_ * 2048 * 4;
    if (need > ws_size) { fprintf(stderr, "dbg: ws too small %zu > %zu\n", need, ws_size); return; }
    (void)hipMemsetAsync(a.ctl, 0, mk::CTL_ZERO_BYTES, st);
    k_rmsnorm<<<T_, 256, 0, st>>>(x, mix_norm, xn);
    k_sgemm<0><<<dim3((INW + 127) / 128, T_ / 128), 256, 0, st>>>(xn, w_in, proj, nullptr, T_, INW, D_);
    k_rotary<<<(T_ * 2048) / 256, 256, 0, st>>>(proj, pos);
    k_gate<<<T_, 256, 0, st>>>(proj, gla_w_up, gla_b, loga);
    k_recur<0><<<dim3(16, 8), 256, 0, st>>>(proj, O_RQ, O_RK, O_RV, 256, nullptr, 1.0f, 1.0f / 16.0f, ro, 2048);
    k_recur<1><<<dim3(32, 4), 256, 0, st>>>(proj, O_GQ, O_GK, O_GV, 512, loga, 1.0f / 16.0f, 1.0f, go, 2048);
    k_headnorm<<<T_, 256, 0, st>>>(proj, ro, go, ret_gain, gla_gain, mixed);
    k_sgemm<1><<<dim3(D_ / 128, T_ / 128), 256, 0, st>>>(mixed, w_out, xa, x, T_, D_, D_);
    float* slots = (float*)(a.ctl + mk::CW_CHK); float* tol = slots + 128; float* code = slots + 256;
#if MK_DBG_ONELAUNCH
    mk::launch_range(a, 0, 7, st);
#else
    for (int p = 0; p < 4; ++p) mk::launch_range(a, p, p + 1, st);
    dbg::k_cmp_kv<<<dim3(64, 8), 256, 0, st>>>(a.kr, 2048, a.vrt, a.kvr, 256, slots + 2 * 15);
    dbg::k_cmp_kv<<<dim3(64, 4), 256, 0, st>>>(a.kg, 1024, a.vgt, a.kvg, 512, slots + 2 * 16);
    mk::launch_range(a, 4, 5, st);
    dbg::k_cmp_s<<<dim3(256, 8), 256, 0, st>>>(a.kr, 2048, a.vrt, a.kvr, nullptr, 256, slots + 2 * 17);
    dbg::k_cmp_s<<<dim3(512, 4), 256, 0, st>>>(a.kg, 1024, a.vgt, a.kvg, a.lam, 512, slots + 2 * 18);
    mk::launch_range(a, 5, 6, st); mk::launch_range(a, 6, 7, st);
#endif
    const float* ss0 = (const float*)(a.ctl + mk::CW_SS); const float* ss1 = ss0 + T_;
    int n = 0; float htol[64];
    dim3 cg(2048), cb(256);
    dbg::k_cmp_ss<<<T_, 256, 0, st>>>(ss0, x, D_, slots + 2 * n); htol[n++] = 1e-4f;
    dbg::k_cmp_bf16<<<cg, cb, 0, st>>>(a.qr, 2048, 0, proj, INW, O_RQ, T_, 2048, 2, 1.0f, slots + 2 * n); htol[n++] = 1e-2f;
    dbg::k_cmp_bf16<<<cg, cb, 0, st>>>(a.kr, 2048, 0, proj, INW, O_RK, T_, 2048, 3, 1.0f, slots + 2 * n); htol[n++] = 1e-2f;
    dbg::k_cmp_bf16<<<cg, cb, 0, st>>>(a.vrt, T_, 1, proj, INW, O_RV, T_, 2048, 0, 1.0f, slots + 2 * n); htol[n++] = 1e-2f;
    dbg::k_cmp_bf16<<<cg, cb, 0, st>>>(a.srg, 2048, 0, proj, INW, O_RG, T_, 2048, 1, 1.0f, slots + 2 * n); htol[n++] = 1e-2f;
    dbg::k_cmp_bf16<<<cg, cb, 0, st>>>(a.gq, 1024, 0, proj, INW, O_GQ, T_, 1024, 0, 0.0625f, slots + 2 * n); htol[n++] = 1e-2f;
    dbg::k_cmp_bf16<<<cg, cb, 0, st>>>(a.gk, 1024, 0, proj, INW, O_GK, T_, 1024, 0, 1.0f, slots + 2 * n); htol[n++] = 1e-2f;
    dbg::k_cmp_bf16<<<cg, cb, 0, st>>>(a.vgt, T_, 1, proj, INW, O_GV, T_, 2048, 0, 1.0f, slots + 2 * n); htol[n++] = 1e-2f;
    dbg::k_cmp_bf16<<<cg, cb, 0, st>>>(a.sgg, 2048, 0, proj, INW, O_GG, T_, 2048, 1, 1.0f, slots + 2 * n); htol[n++] = 1e-2f;
    dbg::k_cmp_f32<<<cg, cb, 0, st>>>(a.ga, 16, proj, INW, O_GA, T_, 16, slots + 2 * n); htol[n++] = 1e-2f;
    dbg::k_cmp_tr<<<cg, cb, 0, st>>>(a.kr, 2048, a.krt, T_, T_, 2048, slots + 2 * n); htol[n++] = 1e-6f;
    dbg::k_cmp_gla<<<dim3(64, 4), 256, 0, st>>>(a.qg, a.kg, a.lam, proj, loga, slots + 2 * n, slots + 2 * (n + 1), slots + 2 * (n + 2)); htol[n++] = 2e-2f; htol[n++] = 2e-2f; htol[n++] = 2e-2f;
    dbg::k_cmp_tr<<<cg, cb, 0, st>>>(a.kg, 1024, a.kgt, T_, T_, 1024, slots + 2 * n); htol[n++] = 1e-6f;
#if MK_DBG_ONELAUNCH
    for (int i = 0; i < 4; ++i) { unsigned one = 0x3f800000u; (void)hipMemsetD32Async((hipDeviceptr_t)(slots + 2 * (15 + i) + 1), (int)one, 1, st); }
#endif
    htol[n++] = 1e-2f; htol[n++] = 1e-2f; htol[n++] = 1e-2f; htol[n++] = 1e-2f;
    dbg::k_cmp_p<<<dim3(64, 8), 256, 0, st>>>(a.qr, a.kr, a.dbgp, slots + 2 * n); htol[n++] = 1e-2f; htol[n++] = 1e-2f; htol[n++] = 1e-2f; htol[n++] = 1e-2f;
    dbg::k_cmp_o<<<dim3(T_, 8), 256, 0, st>>>(a.qr, a.dbgp, a.vrt, a.kvr, a.dbgo, slots + 2 * n); htol[n++] = 1e-2f;
    dbg::k_cmp_bf16<<<cg, cb, 0, st>>>(a.mixed, 4096, 0, mixed, D_, 0, T_, 2048, 0, 1.0f, slots + 2 * n); htol[n++] = 3e-2f;
    dbg::k_cmp_bf16<<<cg, cb, 0, st>>>(a.mixed + 2048, 4096, 0, mixed, D_, 2048, T_, 2048, 0, 1.0f, slots + 2 * n); htol[n++] = 3e-2f;
    dbg::k_cmp_f32<<<cg, cb, 0, st>>>((const float*)d_out, D_, xa, D_, 0, T_, D_, slots + 2 * n); htol[n++] = 1e-2f;
    dbg::k_cmp_bf16<<<cg, cb, 0, st>>>(a.xb, 4096, 0, xa, D_, 0, T_, D_, 0, 1.0f, slots + 2 * n); htol[n++] = 1e-2f;
    dbg::k_cmp_ss<<<T_, 256, 0, st>>>(ss1, xa, D_, slots + 2 * n); htol[n++] = 1e-2f;
#else
    size_t o = 0;
    float* xn = ws + o; o += (size_t)T_ * D_; float* xa = ws + o; o += (size_t)T_ * D_; float* xb2 = ws + o; o += (size_t)T_ * D_; float* G = ws + o; o += (size_t)T_ * FF_;
    mk::Args a{}; const size_t need = mk::build_args(a, d_in, d_out, (unsigned char*)d_ws, o * 4, 12, 1);
    if (need > ws_size) { fprintf(stderr, "dbg: ws too small %zu > %zu\n", need, ws_size); return; }
    (void)hipMemsetAsync(a.ctl, 0, mk::CTL_ZERO_BYTES, st);
    (void)hipMemcpyAsync(xa, x, (size_t)T_ * D_ * 4, hipMemcpyDeviceToDevice, st);
    (void)hipMemcpyAsync(d_out, x, (size_t)T_ * D_ * 4, hipMemcpyDeviceToDevice, st);
    k_rmsnorm<<<T_, 256, 0, st>>>(xa, ffn_norm, xn);
    k_sgemm<0><<<dim3(FF_ / 128, T_ / 128), 256, 0, st>>>(xn, w_gate, G, nullptr, T_, FF_, D_);
    k_sgemm<2><<<dim3(FF_ / 128, T_ / 128), 256, 0, st>>>(xn, w_up, G, nullptr, T_, FF_, D_);
    k_sgemm<1><<<dim3(D_ / 128, T_ / 128), 256, 0, st>>>(G, w_down, xb2, xa, T_, D_, FF_);
    mk::launch_range(a, 0, 1, st);
    (void)hipMemcpyAsync((float*)(a.ctl + mk::CW_SS) + T_, (float*)(a.ctl + mk::CW_SS), (size_t)T_ * 4, hipMemcpyDeviceToDevice, st);
#if MK_DBG_ONELAUNCH
    mk::launch_range(a, 7, 9, st);
#else
    mk::launch_range(a, 7, 8, st); mk::launch_range(a, 8, 9, st);
#endif
    float* slots = (float*)(a.ctl + mk::CW_CHK); float* tol = slots + 128; float* code = slots + 256;
    const float* ss2 = (const float*)(a.ctl + mk::CW_SS) + 2 * T_;
    int n = 0; float htol[64]; dim3 cg(2048), cb(256);
    dbg::k_cmp_bf16<<<cg, cb, 0, st>>>(a.h, FF_, 0, G, FF_, 0, T_, FF_, 0, 1.0f, slots + 2 * n); htol[n++] = 2e-2f;
    dbg::k_cmp_f32<<<cg, cb, 0, st>>>((const float*)d_out, D_, xb2, D_, 0, T_, D_, slots + 2 * n); htol[n++] = 1e-2f;
    dbg::k_cmp_bf16<<<cg, cb, 0, st>>>(a.xb, 4096, 0, xb2, D_, 0, T_, D_, 0, 1.0f, slots + 2 * n); htol[n++] = 1e-2f;
    dbg::k_cmp_ss<<<T_, 256, 0, st>>>(ss2, xb2, D_, slots + 2 * n); htol[n++] = 1e-2f;
#endif
    for (int i = 0; i < n; ++i) { unsigned bits; memcpy(&bits, &htol[i], 4); (void)hipMemsetD32Async((hipDeviceptr_t)(tol + i), (int)bits, 1, st); }
    dbg::k_decide<<<1, 64, 0, st>>>(slots, n, tol, code);
    dbg::k_fill_code<<<2048, 256, 0, st>>>((float*)d_out, (size_t)T_ * D_, code);
}
#endif

#if MK_TIMING
__global__ void k_timing_out(const unsigned* ts, float* out, size_t n, int selA, int selB) {
    auto dur = [&](int sel) { unsigned d = 0; if (sel == 0) d = ts[1] - ts[0]; else if (sel == 9) d = ts[18] - ts[17]; else d = (ts[sel + 1] - ts[sel]) + (ts[sel + 9] - ts[sel + 8]); return (float)d * 0.01f; };
    float c1 = dur(selA), c2 = 200.0f * dur(selB);
    if (selA == 99) {
        const float mhz = (float)(ts[34] - ts[32]) / (float)(ts[35] - ts[33]) * 100.0f; c1 = floorf(mhz / 50.0f + 0.5f) * 50.0f - 1000.0f; c2 = 100000.0f + floorf((float)(ts[35] - ts[33]) * 0.01f / 50.0f + 0.5f) * 50.0f; }
    for (size_t i = (size_t)blockIdx.x * blockDim.x + threadIdx.x; i < n; i += (size_t)gridDim.x * blockDim.x) out[i] = (i == 0) ? c2 : c1;
}
#endif
#if !MK_DEBUG
extern "C" void kernel_launch(void* const* d_in, const int* in_sizes, int n_in, void* d_out, int out_size, void* d_ws, size_t ws_size, hipStream_t stream) {
    if (!mk::setup_once()) return;
    mk::Args a{};
    const size_t need = mk::build_args(a, d_in, d_out, (unsigned char*)d_ws, 0, 15, 2);
    if (need > ws_size || n_in != 14) { fprintf(stderr, "mk: workspace too small (%zu > %zu) or wrong input count %d\n", need, ws_size, n_in); return; }
    (void)hipMemsetAsync(d_ws, 0, MK_SPLIT ? mk::CTL_ZERO_BYTES : mk::BAR_ZERO_BYTES, stream);
#if MK_SPLIT
    for (int p = 0; p < mk::N_PHASES; ++p) mk::launch_range(a, p, p + 1, stream);
#else
    mk::launch_range(a, 0, mk::N_PHASES, stream, false);
#endif
#if MK_TIMING
    k_timing_out<<<2048, 256, 0, stream>>>(a.ctl + mk::CW_TS, (float*)d_out, (size_t)8192 * 4096, MK_TSEL_A, MK_TSEL_B);
#endif
}
#endif
```
